# Optimizing an MI355X kernel written in HIP

```python
import jax
import jax.numpy as jnp
from jax import lax
import numpy as np

D_MODEL = 1024
BATCH = 8
SEQ = 4096
DEPTH = 4

GRID_W = 64
CTX_LEN = 256
EPS = 1e-6
N_BRANCH = 4
BRANCH_W = D_MODEL // 2

CONV_W = BRANCH_W
CONV_K = 3
LRU_W = BRANCH_W
LRU_HEADS = 8
LRU_HD = LRU_W // LRU_HEADS
LRU_CONV_K = 4
LRU_C = 8.0
CMLP_W = BRANCH_W
CMLP_GROUPS = 4
CMLP_GD = CMLP_W // CMLP_GROUPS
CHUNK = 128
MLA_HEADS = 8
QK_NOPE = 64
QK_ROPE = 32
V_HD = BRANCH_W // MLA_HEADS
Q_LORA = 384
KV_LORA = 256
MLA_SCALE = (QK_NOPE + QK_ROPE) ** -0.5
ROPE_THETA = 10000.0
Q_BLOCK = 128
D_FF = -(-8 * D_MODEL // (3 * 256)) * 256

SPLIT_SIZES = (LRU_W, KV_LORA, QK_ROPE, LRU_W, Q_LORA, CONV_W, CONV_W, CONV_W, CMLP_W, CMLP_W, N_BRANCH * D_MODEL)
IN_W = sum(SPLIT_SIZES)
CTX_STATE_COLS = LRU_W + KV_LORA + QK_ROPE

kernel_name = 'hybrid_flow_backbone'


def rms_norm(x, g):
    x32 = x.astype(jnp.float32)
    y = x32 * lax.rsqrt(jnp.mean(x32 * x32, axis=-1, keepdims=True) + EPS)
    return (y * g.astype(jnp.float32)).astype(x.dtype)


def layer_norm(x, g, b):
    x32 = x.astype(jnp.float32)
    mu = jnp.mean(x32, axis=-1, keepdims=True)
    var = jnp.mean(jnp.square(x32 - mu), axis=-1, keepdims=True)
    y = (x32 - mu) * lax.rsqrt(var + EPS) * g.astype(jnp.float32) + b.astype(jnp.float32)
    return y.astype(x.dtype)


def modulate(h, shift, scale):
    return h * (1 + scale) + shift


def split_cols(z, sizes):
    idx = tuple(int(i) for i in np.cumsum(sizes)[:-1])
    return jnp.split(z, idx, axis=-1)


def dwconv(x, w, pad_left):
    k, ch = w.shape
    return lax.conv_general_dilated(
        x, w[:, None, :].astype(x.dtype), window_strides=(1,),
        padding=((pad_left, k - 1 - pad_left),),
        dimension_numbers=('NWC', 'WIO', 'NWC'), feature_group_count=ch)


def axial_rope_tables(row, col):
    n_freq = QK_ROPE // 4
    inv = ROPE_THETA ** (-jnp.arange(n_freq, dtype=jnp.float32) / n_freq)
    ang_r = row.astype(jnp.float32)[:, None] * inv
    ang_c = col.astype(jnp.float32)[:, None] * inv
    return jnp.cos(ang_r), jnp.sin(ang_r), jnp.cos(ang_c), jnp.sin(ang_c)


def _rotate(x, cos, sin):
    m = x.shape[-1] // 2
    x1, x2 = x[..., :m], x[..., m:]
    cos = cos.astype(x.dtype)
    sin = sin.astype(x.dtype)
    return jnp.concatenate([x1 * cos - x2 * sin, x1 * sin + x2 * cos], axis=-1)


def axial_rope(x, cos_r, sin_r, cos_c, sin_c):
    half = QK_ROPE // 2
    return jnp.concatenate([_rotate(x[..., :half], cos_r, sin_r), _rotate(x[..., half:], cos_c, sin_c)], axis=-1)


def short_conv_mixer(a_b, a_c, a_x, w_conv):
    return a_b * dwconv(a_c * a_x, w_conv, CONV_K // 2)


def rglru_coeffs(xc, w_a, b_a, w_x, b_x, lam):
    bn, n, _ = xc.shape
    x32 = xc.astype(jnp.float32)
    xh = x32.reshape(bn, n, LRU_HEADS, LRU_HD)
    r = jax.nn.sigmoid(jnp.einsum('blhi,hij->blhj', xh, w_a.astype(jnp.float32)).reshape(bn, n, LRU_W) + b_a.astype(jnp.float32))
    i = jax.nn.sigmoid(jnp.einsum('blhi,hij->blhj', xh, w_x.astype(jnp.float32)).reshape(bn, n, LRU_W) + b_x.astype(jnp.float32))
    log_a = -LRU_C * r * jax.nn.softplus(-lam.astype(jnp.float32))
    a = jnp.exp(log_a)
    b = jnp.sqrt(-jnp.expm1(2.0 * log_a)) * (i * x32)
    return a, b


def _scan_combine(left, right):
    a_l, b_l = left
    a_r, b_r = right
    return a_l * a_r, a_r * b_l + b_r


def linear_scan(a, b, h0, reverse):
    if h0 is not None:
        edge = -1 if reverse else 0
        b = b.at[:, edge].add(a[:, edge] * h0)
    return lax.associative_scan(_scan_combine, (a, b), reverse=reverse, axis=1)[1]


def rglru_bidirectional(x_lat, x_ctx, conv_w, conv_b, w_a, b_a, w_x, b_x, lam, need_ctx):
    xl = dwconv(x_lat, conv_w, LRU_CONV_K // 2) + conv_b
    xc = dwconv(x_ctx, conv_w, LRU_CONV_K // 2) + conv_b
    lat_sum = None
    ctx_sum = None
    for d, rev in enumerate((False, True)):
        a_c, b_c = rglru_coeffs(xc, w_a[d], b_a[d], w_x[d], b_x[d], lam[d])
        h_c = linear_scan(a_c, b_c, None, rev)
        h0 = h_c[:, 0] if rev else h_c[:, -1]
        a_l, b_l = rglru_coeffs(xl, w_a[d], b_a[d], w_x[d], b_x[d], lam[d])
        h_l = linear_scan(a_l, b_l, h0, rev)
        lat_sum = h_l if lat_sum is None else lat_sum + h_l
        if need_ctx:
            ctx_sum = h_c if ctx_sum is None else ctx_sum + h_c
    ctx_out = ctx_sum.astype(x_ctx.dtype) if need_ctx else None
    return lat_sum.astype(x_lat.dtype), ctx_out


def chunk_mlp_mixer(u_pre, v_pre, ln_g, ln_b, w_s, b_s):
    bn, n, _ = u_pre.shape
    u = jax.nn.gelu(u_pre)
    v = layer_norm(jax.nn.gelu(v_pre), ln_g, ln_b)
    vc = v.reshape(bn, n // CHUNK, CHUNK, CMLP_GROUPS, CMLP_GD)
    mixed = jnp.einsum('gpq,bnqgd->bnpgd', w_s, vc) + b_s.T[None, None, :, :, None]
    return u * mixed.reshape(bn, n, CMLP_W)


def mla_keys_values(kv_lat, k_rope, kv_norm_g, w_kv_up, rope):
    bn, n, _ = kv_lat.shape
    kv = (rms_norm(kv_lat, kv_norm_g) @ w_kv_up).reshape(bn, n, MLA_HEADS, QK_NOPE + V_HD)
    k_nope, v = kv[..., :QK_NOPE], kv[..., QK_NOPE:]
    if rope is not None:
        k_rope = axial_rope(k_rope, *rope)
    k_rope = jnp.broadcast_to(k_rope[:, :, None, :], (bn, n, MLA_HEADS, QK_ROPE))
    return jnp.concatenate([k_nope, k_rope], axis=-1), v


def mla_queries(q_lat, q_norm_g, w_q_up, rope):
    bn, n, _ = q_lat.shape
    q = (rms_norm(q_lat, q_norm_g) @ w_q_up).reshape(bn, n, MLA_HEADS, QK_NOPE + QK_ROPE)
    if rope is None:
        return q
    return jnp.concatenate([q[..., :QK_NOPE], axial_rope(q[..., QK_NOPE:], *rope)], axis=-1)


def softmax_attention(q, k, v):
    s = jnp.einsum('bqhd,bkhd->bhqk', q, k).astype(jnp.float32) * MLA_SCALE
    p = jax.nn.softmax(s, axis=-1).astype(v.dtype)
    return jnp.einsum('bhqk,bkhd->bqhd', p, v)


def latent_attention(q, k_all, v_all):
    bn, n, h, dk = q.shape
    qb = jnp.moveaxis(q.reshape(bn, n // Q_BLOCK, Q_BLOCK, h, dk), 1, 0)
    ob = lax.map(lambda qq: softmax_attention(qq, k_all, v_all), qb)
    return jnp.moveaxis(ob, 0, 1).reshape(bn, n, h * V_HD)


def merge_branches(ys, gate_pre, w_branch, w_out):
    d = w_out.shape[0]
    g = jax.nn.sigmoid(gate_pre)
    merged = g[..., :d] * (ys[0] @ w_branch[0])
    for n in range(1, N_BRANCH):
        merged = merged + g[..., n * d:(n + 1) * d] * (ys[n] @ w_branch[n])
    return merged @ w_out


def swiglu(h, w1, w3, w2):
    return (jax.nn.silu(h @ w1) * (h @ w3)) @ w2


def setup_inputs(seed: int = 0) -> dict:
    key = jax.random.key(seed)
    k = jax.random.split(key, 32)
    f32 = jnp.float32

    def nrm(i, shape, scale):
        return scale * jax.random.normal(k[i], shape, f32)

    L = DEPTH
    a_target = jax.random.uniform(k[16], (L, 2, LRU_W), f32, 0.9, 0.999)
    a_base = a_target ** (1.0 / LRU_C)
    lam = jnp.log(a_base) - jnp.log1p(-a_base)
    return {
        'x': nrm(0, (BATCH, SEQ, D_MODEL), 1.0),
        'c': nrm(1, (BATCH, D_MODEL), 1.0),
        'ctx': nrm(2, (BATCH, CTX_LEN, D_MODEL), 1.0),
        'c_ctx': nrm(3, (D_MODEL,), 1.0),
        'w_mod': nrm(4, (L, D_MODEL, 6 * D_MODEL), 0.5 * D_MODEL ** -0.5),
        'b_mod': nrm(5, (L, 6 * D_MODEL), 0.01),
        'norm1_g': 1.0 + nrm(6, (L, D_MODEL), 0.05),
        'norm2_g': 1.0 + nrm(7, (L, D_MODEL), 0.05),
        'w_in': nrm(8, (L, D_MODEL, IN_W), D_MODEL ** -0.5),
        'conv_a_w': nrm(9, (L, CONV_K, CONV_W), CONV_K ** -0.5),
        'lru_conv_w': nrm(10, (L, LRU_CONV_K, LRU_W), LRU_CONV_K ** -0.5),
        'lru_conv_b': nrm(11, (L, LRU_W), 0.01),
        'lru_w_a': nrm(12, (L, 2, LRU_HEADS, LRU_HD, LRU_HD), LRU_HD ** -0.5),
        'lru_b_a': nrm(13, (L, 2, LRU_W), 0.01),
        'lru_w_x': nrm(14, (L, 2, LRU_HEADS, LRU_HD, LRU_HD), LRU_HD ** -0.5),
        'lru_b_x': nrm(15, (L, 2, LRU_W), 0.01),
        'lru_lam': lam,
        'cmlp_ln_g': 1.0 + nrm(17, (L, CMLP_W), 0.05),
        'cmlp_ln_b': nrm(18, (L, CMLP_W), 0.01),
        'cmlp_w_s': nrm(19, (L, CMLP_GROUPS, CHUNK, CHUNK), CHUNK ** -0.5),
        'cmlp_b_s': 1.0 + nrm(20, (L, CMLP_GROUPS, CHUNK), 0.05),
        'mla_q_norm_g': 1.0 + nrm(21, (L, Q_LORA), 0.05),
        'mla_kv_norm_g': 1.0 + nrm(22, (L, KV_LORA), 0.05),
        'mla_w_q_up': nrm(23, (L, Q_LORA, MLA_HEADS * (QK_NOPE + QK_ROPE)), Q_LORA ** -0.5),
        'mla_w_kv_up': nrm(24, (L, KV_LORA, MLA_HEADS * (QK_NOPE + V_HD)), KV_LORA ** -0.5),
        'w_branch': nrm(25, (L, N_BRANCH, BRANCH_W, D_MODEL), BRANCH_W ** -0.5),
        'w_out': nrm(26, (L, D_MODEL, D_MODEL), D_MODEL ** -0.5),
        'w_ff1': nrm(27, (L, D_MODEL, D_FF), D_MODEL ** -0.5),
        'w_ff3': nrm(28, (L, D_MODEL, D_FF), D_MODEL ** -0.5),
        'w_ff2': nrm(29, (L, D_FF, D_MODEL), D_FF ** -0.5),
        'final_norm_g': 1.0 + nrm(30, (D_MODEL,), 0.05),
    }


def reference(x, c, ctx, c_ctx, w_mod, b_mod, norm1_g, norm2_g, w_in, conv_a_w,
              lru_conv_w, lru_conv_b, lru_w_a, lru_b_a, lru_w_x, lru_b_x, lru_lam,
              cmlp_ln_g, cmlp_ln_b, cmlp_w_s, cmlp_b_s, mla_q_norm_g, mla_kv_norm_g,
              mla_w_q_up, mla_w_kv_up, w_branch, w_out, w_ff1, w_ff3, w_ff2, final_norm_g):
    d = x.shape[-1]
    n_lat = x.shape[1]
    rows = n_lat // GRID_W
    row = jnp.repeat(jnp.arange(rows), GRID_W)
    col = jnp.tile(jnp.arange(GRID_W), rows)
    rope_k = axial_rope_tables(row, col)
    rope_q = tuple(t[:, None, :] for t in rope_k)
    s_lat = jax.nn.silu(c)
    s_ctx = jax.nn.silu(c_ctx)
    xc = ctx
    for l in range(DEPTH):
        last = l == DEPTH - 1
        sh1, sc1, g1, sh2, sc2, g2 = (m[:, None, :] for m in jnp.split(s_lat @ w_mod[l] + b_mod[l], 6, axis=-1))
        if last:
            sh1c, sc1c = jnp.split(s_ctx @ w_mod[l][:, :2 * d] + b_mod[l][:2 * d], 2, axis=-1)
        else:
            sh1c, sc1c, g1c, sh2c, sc2c, g2c = jnp.split(s_ctx @ w_mod[l] + b_mod[l], 6, axis=-1)

        h = modulate(rms_norm(x, norm1_g[l]), sh1, sc1)
        hc = modulate(rms_norm(xc, norm1_g[l]), sh1c, sc1c)
        (lru_x, kv_lat, k_rope, lru_g, q_lat, a_b, a_c, a_x, c_u, c_v, gate_pre) = split_cols(h @ w_in[l], SPLIT_SIZES)
        if last:
            lru_xc, kv_latc, k_ropec = split_cols(hc @ w_in[l][:, :CTX_STATE_COLS], SPLIT_SIZES[:3])
        else:
            (lru_xc, kv_latc, k_ropec, lru_gc, q_latc, a_bc, a_cc, a_xc, c_uc, c_vc, gate_prec) = split_cols(hc @ w_in[l], SPLIT_SIZES)

        h_lru, hc_lru = rglru_bidirectional(lru_x, lru_xc, lru_conv_w[l], lru_conv_b[l], lru_w_a[l], lru_b_a[l],
                                            lru_w_x[l], lru_b_x[l], lru_lam[l], not last)
        y_b = jax.nn.gelu(lru_g) * h_lru
        k_lat, v_lat = mla_keys_values(kv_lat, k_rope, mla_kv_norm_g[l], mla_w_kv_up[l], rope_k)
        k_ctx, v_ctx = mla_keys_values(kv_latc, k_ropec, mla_kv_norm_g[l], mla_w_kv_up[l], None)
        q = mla_queries(q_lat, mla_q_norm_g[l], mla_w_q_up[l], rope_q)
        y_d = latent_attention(q, jnp.concatenate([k_lat, k_ctx], axis=1), jnp.concatenate([v_lat, v_ctx], axis=1))
        y_a = short_conv_mixer(a_b, a_c, a_x, conv_a_w[l])
        y_c = chunk_mlp_mixer(c_u, c_v, cmlp_ln_g[l], cmlp_ln_b[l], cmlp_w_s[l], cmlp_b_s[l])

        x = x + g1 * merge_branches((y_a, y_b, y_c, y_d), gate_pre, w_branch[l], w_out[l])
        h2 = modulate(rms_norm(x, norm2_g[l]), sh2, sc2)
        x = x + g2 * swiglu(h2, w_ff1[l], w_ff3[l], w_ff2[l])

        if not last:
            yc_b = jax.nn.gelu(lru_gc) * hc_lru
            qc = mla_queries(q_latc, mla_q_norm_g[l], mla_w_q_up[l], None)
            oc = softmax_attention(qc, k_ctx, v_ctx)
            yc_d = oc.reshape(oc.shape[0], oc.shape[1], MLA_HEADS * V_HD)
            yc_a = short_conv_mixer(a_bc, a_cc, a_xc, conv_a_w[l])
            yc_c = chunk_mlp_mixer(c_uc, c_vc, cmlp_ln_g[l], cmlp_ln_b[l], cmlp_w_s[l], cmlp_b_s[l])
            xc = xc + g1c * merge_branches((yc_a, yc_b, yc_c, yc_d), gate_prec, w_branch[l], w_out[l])
            h2c = modulate(rms_norm(xc, norm2_g[l]), sh2c, sc2c)
            xc = xc + g2c * swiglu(h2c, w_ff1[l], w_ff3[l], w_ff2[l])
    return rms_norm(x, final_norm_g)
```

```cpp
#include <hip/hip_runtime.h>
#include <hip/hip_bf16.h>
#include <hip/hip_cooperative_groups.h>
#include <cstdio>
#include <cstdint>
namespace cg = cooperative_groups;

typedef unsigned short u16;
using bf16x8 = __attribute__((ext_vector_type(8))) short;
using f32x4 = __attribute__((ext_vector_type(4))) float;

#define NB 8
#define SL 4096
#define SC 256
#define ST 4352
#define MTOT 34816
#define DM 1024
#define NTHR 512
#define EPS 1e-6f
#define LDS_BYTES 159744
#define DUP_ATTN 1
#define DUP_C1 1
#define DUP_C2 1
#define DUP_E 1
#define EXTRA_SYNC 0
#define GSYNC() do { xcd_barrier(xb); for (int q_ = 0; q_ < EXTRA_SYNC; ++q_) xcd_barrier(xb); } while (0)
#define DUP_LRU1 1
#define DUP_LRU3 1
#define DUP_PROJ 1

#define OFF_WINA 0
#define OFF_WINB (OFF_WINA + 2560 * 1024)
#define OFF_WGATE (OFF_WINB + 1792 * 1024)
#define OFF_WBR (OFF_WGATE + 4096 * 1024)
#define OFF_WOUT (OFF_WBR + 4 * 1024 * 512)
#define OFF_WFF13 (OFF_WOUT + 1024 * 1024)
#define OFF_WFF2 (OFF_WFF13 + 5632 * 1024)
#define OFF_WQUP (OFF_WFF2 + 1024 * 2816)
#define OFF_WKVUP (OFF_WQUP + 768 * 384)
#define OFF_WS (OFF_WKVUP + 1024 * 256)
#define OFF_WLRU (OFF_WS + 4 * 128 * 128)
#define W_ELEMS (OFF_WLRU + 2 * 8 * 4 * 32 * 64)

struct P {
  const float *x, *c, *ctx, *c_ctx, *w_mod, *b_mod, *norm1_g, *norm2_g, *w_in, *conv_a_w, *lru_conv_w, *lru_conv_b,
      *lru_w_a, *lru_b_a, *lru_w_x, *lru_b_x, *lru_lam, *cmlp_ln_g, *cmlp_ln_b, *cmlp_w_s, *cmlp_b_s, *q_norm_g,
      *kv_norm_g, *w_q_up, *w_kv_up, *w_branch, *w_out, *w_ff1, *w_ff3, *w_ff2, *final_g;
  float *out, *Xc, *mod, *rope;
  float2* summ;
  float* ssq;
  unsigned* bar;
  u16 *W, *H, *Ycat, *R1, *Q, *K, *Vt;
};

__device__ __forceinline__ uint32_t pack2(float a, float b) { uint32_t r; asm("v_cvt_pk_bf16_f32 %0, %1, %2" : "=v"(r) : "v"(a), "v"(b)); return r; }
__device__ __forceinline__ u16 f2bf(float f) { return (u16)(pack2(f, f) & 0xffffu); }
__device__ __forceinline__ float bf2f(u16 h) { return __uint_as_float(((uint32_t)h) << 16); }
__device__ __forceinline__ float sigmoidf_(float x) { return 1.f / (1.f + __expf(-x)); }
__device__ __forceinline__ float sigmoid_rcp_(float x) { return __builtin_amdgcn_rcpf(1.f + __expf(-x)); }
__device__ __forceinline__ float siluf_(float x) { return x * __builtin_amdgcn_rcpf(1.f + __expf(-x)); }
__device__ __forceinline__ float geluf_(float x) {
  float u = 0.7978845608028654f * (x + 0.044715f * x * x * x);
  return x * __builtin_amdgcn_rcpf(1.f + __expf(-2.f * u));
}
__device__ __forceinline__ void unpack8(const uint4& v, float* f) {
  f[0] = __uint_as_float(v.x << 16); f[1] = __uint_as_float(v.x & 0xffff0000u);
  f[2] = __uint_as_float(v.y << 16); f[3] = __uint_as_float(v.y & 0xffff0000u);
  f[4] = __uint_as_float(v.z << 16); f[5] = __uint_as_float(v.z & 0xffff0000u);
  f[6] = __uint_as_float(v.w << 16); f[7] = __uint_as_float(v.w & 0xffff0000u);
}
__device__ __forceinline__ uint4 pack8(const float* f) {
  uint4 v; v.x = pack2(f[0], f[1]); v.y = pack2(f[2], f[3]); v.z = pack2(f[4], f[5]); v.w = pack2(f[6], f[7]); return v;
}
template <int CTRL, int ROWMASK>
__device__ __forceinline__ float dpp0f(float src) {
  return __int_as_float(__builtin_amdgcn_update_dpp(0, __float_as_int(src), CTRL, ROWMASK, 0xf, false));
}
__device__ __forceinline__ float wave_sum(float v) {
  v += dpp0f<0x111, 0xf>(v); v += dpp0f<0x112, 0xf>(v); v += dpp0f<0x114, 0xf>(v); v += dpp0f<0x118, 0xf>(v);
  v += dpp0f<0x142, 0xa>(v); v += dpp0f<0x143, 0xc>(v);
  return __int_as_float(__builtin_amdgcn_readlane(__float_as_int(v), 63));
}
__device__ __forceinline__ float* xrow_ptr(const P& p, int r) {
  int b = r / ST, t = r - b * ST;
  return t < SL ? p.out + ((size_t)(b * SL + t)) * DM : p.Xc + ((size_t)(b * SC + t - SL)) * DM;
}
__device__ __forceinline__ int mod_idx(int r) { int b = r / ST, t = r - b * ST; return t < SL ? b : 8; }

template <int MT>
__device__ __forceinline__ void gemm_main(const u16* __restrict__ A, int lda, const u16* __restrict__ B, int ldb, int K,
                                          u16* lds, f32x4 (&acc)[MT][4]) {
  constexpr int BM = MT * 64;
  constexpr int ASZ = BM * 72, BSZ = 128 * 72, STG = ASZ + BSZ;
  int tid = threadIdx.x; asm volatile("" : "+v"(tid));
  const int lane = tid & 63, wid = tid >> 6, wr = wid >> 1, wc = wid & 1, fr = lane & 15, fq = lane >> 4;
  uint4 ra[MT], rb[2];
  const int nk = K >> 6;
  const int crow = tid >> 3, ckc = (tid & 7) * 8;
#pragma unroll
  for (int i = 0; i < MT; ++i) ra[i] = *(const uint4*)(A + (size_t)(crow + i * 64) * lda + ckc);
#pragma unroll
  for (int i = 0; i < 2; ++i) rb[i] = *(const uint4*)(B + (size_t)(crow + i * 64) * ldb + ckc);
  {
    u16* sa = lds; u16* sb = lds + ASZ;
#pragma unroll
    for (int i = 0; i < MT; ++i) *(uint4*)(sa + (crow + i * 64) * 72 + ckc) = ra[i];
#pragma unroll
    for (int i = 0; i < 2; ++i) *(uint4*)(sb + (crow + i * 64) * 72 + ckc) = rb[i];
  }
  __syncthreads();
  for (int kt = 0; kt < nk; ++kt) {
    const bool more = (kt + 1 < nk);
    if (more) {
      const int k0 = (kt + 1) * 64 + ckc;
#pragma unroll
      for (int i = 0; i < MT; ++i) ra[i] = *(const uint4*)(A + (size_t)(crow + i * 64) * lda + k0);
#pragma unroll
      for (int i = 0; i < 2; ++i) rb[i] = *(const uint4*)(B + (size_t)(crow + i * 64) * ldb + k0);
    }
    const u16* sa = lds + (kt & 1) * STG;
    const u16* sb = sa + ASZ;
#pragma unroll
    for (int ks = 0; ks < 2; ++ks) {
      bf16x8 a[MT], b[4];
#pragma unroll
      for (int m = 0; m < MT; ++m) a[m] = *(const bf16x8*)(sa + (wr * MT * 16 + m * 16 + fr) * 72 + ks * 32 + fq * 8);
#pragma unroll
      for (int n = 0; n < 4; ++n) b[n] = *(const bf16x8*)(sb + (wc * 64 + n * 16 + fr) * 72 + ks * 32 + fq * 8);
#pragma unroll
      for (int m = 0; m < MT; ++m)
#pragma unroll
        for (int n = 0; n < 4; ++n) acc[m][n] = __builtin_amdgcn_mfma_f32_16x16x32_bf16(a[m], b[n], acc[m][n], 0, 0, 0);
    }
    if (more) {
      u16* wa = lds + ((kt + 1) & 1) * STG; u16* wb = wa + ASZ;
#pragma unroll
      for (int i = 0; i < MT; ++i) *(uint4*)(wa + (crow + i * 64) * 72 + ckc) = ra[i];
#pragma unroll
      for (int i = 0; i < 2; ++i) *(uint4*)(wb + (crow + i * 64) * 72 + ckc) = rb[i];
    }
    __syncthreads();
  }
}

template <int MT, class Pre, class Epi>
__device__ __forceinline__ void gemm_phase(const u16* A, int lda, const u16* B, int ldb, int K, int nct, u16* lds, Pre pre,
                                           Epi epi, int id0, int idstride, int idoff) {
  constexpr int BM = MT * 64;
  const int nrt = MTOT / BM, ntile = nrt * nct;
  int first = id0;
  if (first < idoff) { int kk = (idoff - first + idstride - 1) / idstride; first += kk * idstride; }
  for (int gid = first; gid < idoff + ntile; gid += idstride) {
    int id = gid - idoff;
    int g = id / (8 * nct), rem = id - g * 8 * nct;
    int ct = rem >> 3, rt = g * 8 + (rem & 7);
    f32x4 acc[MT][4];
#pragma unroll
    for (int m = 0; m < MT; ++m)
#pragma unroll
      for (int n = 0; n < 4; ++n) acc[m][n] = (f32x4){0.f, 0.f, 0.f, 0.f};
    pre(rt * BM);
    gemm_main<MT>(A + (size_t)rt * BM * lda, lda, B + (size_t)ct * 128 * ldb, ldb, K, lds, acc);
    epi(rt * BM, ct * 128, acc);
    __syncthreads();
  }
}

#define LAS3 __attribute__((address_space(3)))
namespace g8 {
constexpr int BM = 256, BK = 64, HALF = 128, HTB = HALF * BK * 2, STAGE_BYTES = 8 * HTB, NXCD = 8, WGM = 8;
__device__ __forceinline__ int lds_byte(int r, int c) { const int st = (r >> 4) * 2 + (c >> 5), rr = r & 15, cc = c & 31, ob = rr * 64 + cc * 2; return st * 1024 + (ob ^ (((ob >> 9) & 1) << 5)); }
__device__ __forceinline__ void stage_rc(int b, int& R, int& C) { const int st = b / 1024, sb = b % 1024, swz = sb ^ (((sb >> 9) & 1) << 5); R = (st >> 1) * 16 + swz / 64; C = (st & 1) * 32 + (swz % 64) / 2; }
__device__ __forceinline__ int perm32(int rho) { const int n = rho >> 4, i = rho & 15; return 8 * (i >> 2) + 4 * n + (i & 3); }
struct Unit { const char* A; const char* B; int lda, K, pm, pn, aux; };
struct Order {
  int nM, nN, nwg, G, c;
  __device__ void init(int nM_, int nN_, int G_, int c_) { nM = nM_; nN = nN_; nwg = nM * nN; G = G_; c = c_; }
  __device__ bool tile(int i, int& pm, int& pn) const {
    const long L = (long)i * G + c; if (L >= nwg) return false;
    int wgid = (int)L; { const int q = nwg / NXCD, r = nwg % NXCD, xcd = wgid % NXCD, off = wgid / NXCD; wgid = (xcd < r ? xcd * (q + 1) : r * (q + 1) + (xcd - r) * q) + off; }
    const int nig = WGM * nN, gid = wgid / nig, fm = gid * WGM, gsz = (nM - fm) < WGM ? (nM - fm) : WGM;
    pm = fm + ((wgid % nig) % gsz); pn = (wgid % nig) / gsz;
    if (nM == 128) pm += pm >> 4;
    return true;
  }
};
struct Simple {
  Order o; const u16* A; const u16* Bt; int lda, K;
  __device__ bool next(int i, Unit& u) const {
    int pm, pn; if (!o.tile(i, pm, pn)) return false;
    u.A = (const char*)(A + (size_t)pm * 256 * lda); u.B = (const char*)(Bt + (size_t)pn * 256 * K); u.lda = lda; u.K = K; u.pm = pm; u.pn = pn; u.aux = 0; return true;
  }
};
__device__ __forceinline__ unsigned cvt_pk_bf16(float lo, float hi) { unsigned r; asm volatile("v_cvt_pk_bf16_f32 %0, %1, %2" : "=v"(r) : "v"(lo), "v"(hi)); return r; }

template <bool PERM, class Sched, class Epi>
__device__ __forceinline__ void gemm_phase(LAS3 unsigned char* lds, const Sched& S, const Epi& E) {
  int tid = threadIdx.x; asm volatile("" : "+v"(tid));
  const int wid = __builtin_amdgcn_readfirstlane(tid >> 6), lane = tid & 63, wr = wid >> 2, wc = wid & 3, fr = lane & 15, fq = lane >> 4;
  const size_t kstep = (size_t)(BK * 2);
#define G8_VOFF(LDA_, K_) do { int _t2 = tid; asm volatile("" : "+v"(_t2)); _Pragma("unroll") for (int _i = 0; _i < 2; ++_i) { int R, C; stage_rc(_t2 * 16 + _i * 8192, R, C); \
    const int Rb = PERM ? ((R & ~31) + perm32(R & 31)) : R; voffA[_i] = (unsigned)(R * (LDA_) + C) * 2u; voffB[_i] = (unsigned)(Rb * (K_) + C) * 2u; } \
    hstepA = (size_t)HALF * (LDA_) * 2; hstepB = (size_t)HALF * (K_) * 2; } while (0)
  const unsigned ldsw = (unsigned)wid * 1024u;
  const int aoff = lds_byte(wr * 64 + fr, fq * 8), boff = lds_byte(wc * 32 + fr, fq * 8);
#define G8_SA(b, h) (((b) * 2 + (h)) * HTB)
#define G8_SB(b, h) ((4 + (b) * 2 + (h)) * HTB)
#define G8_STAGE(bufoff, gbase, voff) do { _Pragma("unroll") for (int _i = 0; _i < 2; ++_i) \
    __builtin_amdgcn_global_load_lds((const unsigned*)((const char*)(gbase) + (voff)[_i]), (LAS3 unsigned*)(lds + (bufoff) + ldsw + _i * 8192), 16, 0, 0); } while (0)
#define G8_LDA(dst, b, h) do { _Pragma("unroll") for (int m = 0; m < 4; ++m) _Pragma("unroll") for (int k = 0; k < 2; ++k) dst[m][k] = *(const LAS3 bf16x8*)(lds + G8_SA(b, h) + aoff + m * 2048 + k * 1024); } while (0)
#define G8_LDB(dst, b, h) do { _Pragma("unroll") for (int n = 0; n < 2; ++n) _Pragma("unroll") for (int k = 0; k < 2; ++k) dst[n][k] = *(const LAS3 bf16x8*)(lds + G8_SB(b, h) + boff + n * 2048 + k * 1024); } while (0)
#define G8_MMA(ai, bj, At, Bt) do { __builtin_amdgcn_s_setprio(1); _Pragma("unroll") for (int m = 0; m < 4; ++m) _Pragma("unroll") for (int n = 0; n < 2; ++n) _Pragma("unroll") for (int k = 0; k < 2; ++k) \
    acc[ai][bj][m][n] = __builtin_amdgcn_mfma_f32_16x16x32_bf16(Bt[n][k], At[m][k], acc[ai][bj][m][n], 0, 0, 0); __builtin_amdgcn_s_setprio(0); } while (0)
#define G8_WAIT_V(n) asm volatile("s_waitcnt vmcnt(" #n ")" ::: "memory")
#define G8_WAIT_L(n) asm volatile("s_waitcnt lgkmcnt(" #n ")" ::: "memory")
#define G8_BAR __builtin_amdgcn_s_barrier()
#define G8_SCHED __builtin_amdgcn_sched_barrier(0)
  Unit cur, nxt; int ui = 0;
  if (!S.next(0, cur)) return;
  f32x4 acc[2][2][4][2];
#pragma unroll
  for (int a = 0; a < 2; ++a)
#pragma unroll
    for (int b = 0; b < 2; ++b)
#pragma unroll
      for (int m = 0; m < 4; ++m)
#pragma unroll
        for (int n = 0; n < 2; ++n) acc[a][b][m][n] = (f32x4){0.f, 0.f, 0.f, 0.f};
  bf16x8 At[4][2], B0[2][2], B1[2][2];
  const char* cA = cur.A; const char* cB = cur.B;
  unsigned voffA[2], voffB[2];
  size_t hstepA, hstepB;
  G8_VOFF(cur.lda, cur.K);
  G8_STAGE(G8_SB(0, 0), cB, voffB); G8_STAGE(G8_SA(0, 0), cA, voffA); G8_STAGE(G8_SB(0, 1), cB + hstepB, voffB); G8_STAGE(G8_SA(0, 1), cA + hstepA, voffA);
  if (wr == 1) G8_BAR;
  G8_WAIT_V(4); G8_BAR;
  G8_STAGE(G8_SB(1, 0), cB + kstep, voffB); G8_STAGE(G8_SA(1, 0), cA + kstep, voffA); G8_STAGE(G8_SB(1, 1), cB + hstepB + kstep, voffB);
  G8_WAIT_V(6); G8_BAR;
  for (;;) {
    const bool has_next = S.next(ui + 1, nxt);
    if (!has_next) nxt = cur;
    const char* nA = nxt.A; const char* nB = nxt.B;
    const int nt = cur.K / BK;
    for (int t = 0; t < nt; t += 2) {
      const bool last = (t == nt - 2);
      const char* a1 = cA + (size_t)(t + 1) * kstep;
      const char* a2 = last ? nA : cA + (size_t)(t + 2) * kstep; const char* b2 = last ? nB : cB + (size_t)(t + 2) * kstep;
      const char* a3 = a2 + kstep; const char* b3 = b2 + kstep;
      G8_LDB(B0, 0, 0); G8_SCHED; G8_LDA(At, 0, 0); G8_STAGE(G8_SA(1, 1), a1 + hstepA, voffA);
      G8_WAIT_L(8); G8_BAR; G8_WAIT_L(0); G8_MMA(0, 0, At, B0); G8_BAR; G8_SCHED;
      if (last) G8_VOFF(nxt.lda, nxt.K);
      G8_LDB(B1, 0, 1); G8_STAGE(G8_SB(0, 0), b2, voffB);
      G8_BAR; G8_WAIT_L(0); G8_MMA(0, 1, At, B1); G8_BAR;
      G8_LDA(At, 0, 1); G8_STAGE(G8_SA(0, 0), a2, voffA);
      G8_BAR; G8_WAIT_L(0); G8_MMA(1, 0, At, B0); G8_BAR; G8_SCHED;
      G8_STAGE(G8_SB(0, 1), b2 + hstepB, voffB);
      G8_WAIT_V(6); G8_BAR; G8_MMA(1, 1, At, B1); G8_BAR;
      G8_LDB(B0, 1, 0); G8_SCHED; G8_LDA(At, 1, 0); G8_STAGE(G8_SA(0, 1), a2 + hstepA, voffA);
      G8_WAIT_L(8); G8_BAR; G8_WAIT_L(0); G8_MMA(0, 0, At, B0); G8_BAR; G8_SCHED;
      G8_LDB(B1, 1, 1); G8_STAGE(G8_SB(1, 0), b3, voffB);
      G8_BAR; G8_WAIT_L(0); G8_MMA(0, 1, At, B1); G8_BAR;
      G8_LDA(At, 1, 1); G8_STAGE(G8_SA(1, 0), a3, voffA);
      G8_BAR; G8_WAIT_L(0); G8_MMA(1, 0, At, B0); G8_BAR; G8_SCHED;
      G8_STAGE(G8_SB(1, 1), b3 + hstepB, voffB);
      G8_WAIT_V(6); G8_BAR; G8_MMA(1, 1, At, B1); G8_BAR;
    }
    E(acc, cur, wr, wc, fr, fq, tid);
    if (!has_next) break;
#pragma unroll
    for (int a = 0; a < 2; ++a)
#pragma unroll
      for (int b = 0; b < 2; ++b)
#pragma unroll
        for (int m = 0; m < 4; ++m)
#pragma unroll
          for (int n = 0; n < 2; ++n) acc[a][b][m][n] = (f32x4){0.f, 0.f, 0.f, 0.f};
    cur = nxt; cA = nA; cB = nB; ++ui;
  }
  G8_WAIT_V(0);
  if (wr == 0) G8_BAR;
  G8_BAR;
#undef G8_VOFF
#undef G8_SA
#undef G8_SB
#undef G8_STAGE
#undef G8_LDA
#undef G8_LDB
#undef G8_MMA
#undef G8_WAIT_V
#undef G8_WAIT_L
#undef G8_BAR
#undef G8_SCHED
}
}

__device__ __forceinline__ void convT_job(const float* src0, const float* src1, int ldsrc, int kind, int off, int nvalid, u16* dst, int K,
                          int Ndst, const float* kscale, float mult, float* lds) {
  int tid = threadIdx.x; asm volatile("" : "+v"(tid));
  const int nkt = K >> 6, nitems = nkt * (Ndst >> 7);
  for (int it = blockIdx.x; it < nitems; it += gridDim.x) {
    const int kt = it % nkt, nt = it / nkt;
    float v[16];
#pragma unroll
    for (int e = 0; e < 16; ++e) {
      int idx = tid + e * 512, i = idx >> 7, j = idx & 127, n = nt * 128 + j, k = kt * 64 + i;
      if (kind == 0) {
        v[e] = (n < nvalid) ? src0[(size_t)k * ldsrc + off + n] : 0.f;
      } else {
        int g = n >> 8, w = n & 255;
        const float* sp = (w < 128) ? src0 : src1;
        v[e] = sp[(size_t)k * ldsrc + g * 128 + (w & 127)];
      }
    }
#pragma unroll
    for (int e = 0; e < 16; ++e) {
      int idx = tid + e * 512, i = idx >> 7, j = idx & 127, k = kt * 64 + i;
      float x = v[e];
      if (kscale) x *= kscale[k];
      lds[j * 65 + i] = x * mult;
    }
    __syncthreads();
#pragma unroll
    for (int e = 0; e < 8; ++e) {
      int idx = tid + e * 512, j = idx >> 5, i2 = (idx & 31) * 2;
      *(uint32_t*)(dst + (size_t)(nt * 128 + j) * K + kt * 64 + i2) = pack2(lds[j * 65 + i2], lds[j * 65 + i2 + 1]);
    }
    __syncthreads();
  }
}

__device__ void convert_weights(const P& p, int l, float* lds) {
  const float* win = p.w_in + (size_t)l * 1024 * 8352;
#pragma unroll 1
  for (int job = 0; job < 12; ++job) {
    const float* s0 = win; const float* s1 = nullptr; const float* ksc = nullptr;
    int ldsrc = 8352, kind = 0, off = 0, nvalid = 0, K = 1024, Ndst = 0; float mult = 1.f; u16* dst = p.W;
    if (job == 0) { off = 1696; nvalid = 2560; dst += OFF_WINA; Ndst = 2560; }
    else if (job == 1) { off = 0; nvalid = 1696; dst += OFF_WINB; Ndst = 1792; }
    else if (job == 2) { off = 4256; nvalid = 4096; dst += OFF_WGATE; Ndst = 4096; }
    else if (job < 7) { const int n = job - 3; s0 = p.w_branch + ((size_t)l * 4 + n) * 512 * 1024; ldsrc = 1024; nvalid = 1024; dst += OFF_WBR + (size_t)n * 1024 * 512; K = 512; Ndst = 1024; }
    else if (job == 7) { s0 = p.w_out + (size_t)l * 1024 * 1024; ldsrc = 1024; nvalid = 1024; dst += OFF_WOUT; Ndst = 1024; }
    else if (job == 8) { s0 = p.w_ff1 + (size_t)l * 1024 * 2816; s1 = p.w_ff3 + (size_t)l * 1024 * 2816; ldsrc = 2816; kind = 1; dst += OFF_WFF13; Ndst = 5632; }
    else if (job == 9) { s0 = p.w_ff2 + (size_t)l * 2816 * 1024; ldsrc = 1024; nvalid = 1024; dst += OFF_WFF2; K = 2816; Ndst = 1024; }
    else if (job == 10) { s0 = p.w_q_up + (size_t)l * 384 * 768; ldsrc = 768; nvalid = 768; dst += OFF_WQUP; K = 384; Ndst = 768; ksc = p.q_norm_g + l * 384; mult = 0.10206207261596575f * 1.4426950408889634f; }
    else { s0 = p.w_kv_up + (size_t)l * 256 * 1024; ldsrc = 1024; nvalid = 1024; dst += OFF_WKVUP; K = 256; Ndst = 1024; ksc = p.kv_norm_g + l * 256; }
    convT_job(s0, s1, ldsrc, kind, off, nvalid, dst, K, Ndst, ksc, mult, lds);
  }
  int tidc = threadIdx.x; asm volatile("" : "+v"(tidc));
  const int gt = blockIdx.x * NTHR + tidc, gs = gridDim.x * NTHR;
  for (int i = gt; i < 4 * 128 * 128; i += gs) p.W[OFF_WS + i] = f2bf(p.cmlp_w_s[(size_t)l * 65536 + i]);
  for (int i = gt; i < 2 * 8 * 128 * 64; i += gs) {
    int k = i & 63, n = (i >> 6) & 127, h = (i >> 13) & 7, d = i >> 16;
    const float* src = (n < 64) ? p.lru_w_a : p.lru_w_x;
    p.W[OFF_WLRU + i] = f2bf(src[((((size_t)l * 2 + d) * 8 + h) * 64 + k) * 64 + (n & 63)]);
  }
}

__device__ void phase0(const P& p, unsigned char* smem) {
  int tid = threadIdx.x; asm volatile("" : "+v"(tid));
  const int gt = blockIdx.x * NTHR + tid, gs = gridDim.x * NTHR;
  {
    const float4* s = (const float4*)p.x; float4* d = (float4*)p.out;
    for (int i = gt; i < NB * SL * DM / 4; i += gs) d[i] = s[i];
    const float4* s2 = (const float4*)p.ctx; float4* d2 = (float4*)p.Xc;
    for (int i = gt; i < NB * SC * DM / 4; i += gs) d2[i] = s2[i];
  }
  for (int idx = gt; idx < SL * 8; idx += gs) {
    int t = idx >> 3, i = idx & 7;
    float inv = exp2f(-(float)i * 0.125f * 13.287712379549449f);
    float ar = (float)(t >> 6) * inv, ac = (float)(t & 63) * inv;
    const float i2pi = 0.15915494309189535f;
    float rr = ar * i2pi; rr -= floorf(rr); rr *= 6.283185307179586f;
    float rc = ac * i2pi; rc -= floorf(rc); rc *= 6.283185307179586f;
    p.rope[t * 32 + i] = __cosf(rr); p.rope[t * 32 + 8 + i] = __sinf(rr);
    p.rope[t * 32 + 16 + i] = __cosf(rc); p.rope[t * 32 + 24 + i] = __sinf(rc);
  }
  float* sS = (float*)smem; float* red = sS + 9 * 1024;
  for (int it = blockIdx.x; it < 4 * 96; it += gridDim.x) {
    const int l = it / 96, cgp = it - l * 96;
    for (int idx = tid; idx < 9216; idx += 512) {
      int m = idx >> 10, k = idx & 1023;
      float v = (m < 8) ? p.c[m * 1024 + k] : p.c_ctx[k];
      sS[idx] = siluf_(v);
    }
    __syncthreads();
    const int cj = tid & 63, kp = tid >> 6, j = cgp * 64 + cj;
    float a[9];
#pragma unroll
    for (int m = 0; m < 9; ++m) a[m] = 0.f;
    for (int k0 = kp * 128; k0 < kp * 128 + 128; k0 += 16) {
      float w[16];
#pragma unroll
      for (int u = 0; u < 16; ++u) w[u] = p.w_mod[((size_t)l * 1024 + k0 + u) * 6144 + j];
#pragma unroll
      for (int u = 0; u < 16; ++u)
#pragma unroll
        for (int m = 0; m < 9; ++m) a[m] += sS[m * 1024 + k0 + u] * w[u];
    }
#pragma unroll
    for (int m = 0; m < 9; ++m) red[(kp * 9 + m) * 64 + cj] = a[m];
    __syncthreads();
    for (int idx = tid; idx < 576; idx += 512) {
      int m = idx >> 6, c2 = idx & 63;
      float s = 0.f;
      for (int q = 0; q < 8; ++q) s += red[(q * 9 + m) * 64 + c2];
      p.mod[((size_t)l * 9 + m) * 6144 + cgp * 64 + c2] = s + p.b_mod[l * 6144 + cgp * 64 + c2];
    }
    __syncthreads();
  }
}

__device__ void norm_mod(const P& p, int l, const float* g, int off_sh, int off_sc) {
  int tid = threadIdx.x; asm volatile("" : "+v"(tid));
  const int lane = tid & 63, wid = tid >> 6;
  for (int r = blockIdx.x * 8 + wid; r < MTOT; r += gridDim.x * 8) {
    const float* xr = xrow_ptr(p, r);
    const float* md = p.mod + ((size_t)l * 9 + mod_idx(r)) * 6144;
    float4 v[4];
    float ss = 0.f;
#pragma unroll
    for (int i = 0; i < 4; ++i) {
      v[i] = *(const float4*)(xr + i * 256 + lane * 4);
      ss += v[i].x * v[i].x + v[i].y * v[i].y + v[i].z * v[i].z + v[i].w * v[i].w;
    }
    ss = wave_sum(ss);
    const float inv = rsqrtf(ss * (1.f / 1024.f) + EPS);
#pragma unroll
    for (int i = 0; i < 4; ++i) {
      const int k = i * 256 + lane * 4;
      float4 gg = *(const float4*)(g + k);
      float4 sh = *(const float4*)(md + off_sh + k);
      float4 sc = *(const float4*)(md + off_sc + k);
      float o0 = v[i].x * inv * gg.x * (1.f + sc.x) + sh.x;
      float o1 = v[i].y * inv * gg.y * (1.f + sc.y) + sh.y;
      float o2 = v[i].z * inv * gg.z * (1.f + sc.z) + sh.z;
      float o3 = v[i].w * inv * gg.w * (1.f + sc.w) + sh.w;
      uint2 o; o.x = pack2(o0, o1); o.y = pack2(o2, o3);
      *(uint2*)(p.H + (size_t)r * 1024 + k) = o;
    }
  }
}

__device__ void conva_item(const P& p, int l, int item) {
  int tid = threadIdx.x; asm volatile("" : "+v"(tid));
  const u16* Zb1 = p.R1;
  const float* cw = p.conv_a_w + (size_t)l * 3 * 512;
  for (int e = 0; e < 32; ++e) {
    int idx = tid + e * 512, rr = idx >> 6, cgp = idx & 63;
    int r = item * 256 + rr;
    int b = r / ST, t = r - b * ST;
    int isctx = t >= SL, pos = isctx ? t - SL : t, seglen = isctx ? SC : SL;
    float acc[8];
#pragma unroll
    for (int i = 0; i < 8; ++i) acc[i] = 0.f;
#pragma unroll
    for (int k = 0; k < 3; ++k) {
      int pos2 = pos - 1 + k;
      if (pos2 >= 0 && pos2 < seglen) {
        size_t r2 = (size_t)(r - 1 + k);
        uint4 vc = *(const uint4*)(Zb1 + r2 * 2560 + 512 + cgp * 8);
        uint4 vx = *(const uint4*)(Zb1 + r2 * 2560 + 1024 + cgp * 8);
        float fc[8], fx[8];
        unpack8(vc, fc); unpack8(vx, fx);
#pragma unroll
        for (int i = 0; i < 8; ++i) acc[i] += cw[k * 512 + cgp * 8 + i] * (fc[i] * fx[i]);
      }
    }
    uint4 vb = *(const uint4*)(Zb1 + (size_t)r * 2560 + cgp * 8);
    float fb[8];
    unpack8(vb, fb);
#pragma unroll
    for (int i = 0; i < 8; ++i) acc[i] *= fb[i];
    *(uint4*)(p.Ycat + (size_t)r * 2048 + cgp * 8) = pack8(acc);
  }
}

__device__ void cmlp_item(const P& p, int l, int item, unsigned char* smem) {
  int tid = threadIdx.x; asm volatile("" : "+v"(tid));
  const int lane = tid & 63, wid = tid >> 6, fr = lane & 15, fq = lane >> 4;
  const int g = item & 3, bj = item >> 2;
  const int rowbase = bj * 128;
  u16* vT = (u16*)smem;
  float* sMu = (float*)(smem + 128 * 136 * 2);
  float* sRs = sMu + 128;
  const u16* Zb1 = p.R1;
  {
    uint4 vv[16];
#pragma unroll
    for (int rr = 0; rr < 16; ++rr) vv[rr] = *(const uint4*)(Zb1 + (size_t)(rowbase + wid * 16 + rr) * 2560 + 2048 + lane * 8);
#pragma unroll
    for (int rr = 0; rr < 16; ++rr) {
      int q = wid * 16 + rr;
      float f[8];
      unpack8(vv[rr], f);
      float s = 0.f;
#pragma unroll
      for (int i = 0; i < 8; ++i) { f[i] = geluf_(f[i]); s += f[i]; }
      s = wave_sum(s);
      float mu = s * (1.f / 512.f);
      float d2 = 0.f;
#pragma unroll
      for (int i = 0; i < 8; ++i) { float d = f[i] - mu; d2 += d * d; }
      d2 = wave_sum(d2);
      if (lane == 0) { sMu[q] = mu; sRs[q] = rsqrtf(d2 * (1.f / 512.f) + EPS); }
    }
  }
  __syncthreads();
  const float* lg = p.cmlp_ln_g + l * 512 + g * 128;
  const float* lb = p.cmlp_ln_b + l * 512 + g * 128;
#pragma unroll
  for (int e = 0; e < 4; ++e) {
    int idx = tid + e * 512, q = idx >> 4, dc = idx & 15;
    uint4 v = *(const uint4*)(Zb1 + (size_t)(rowbase + q) * 2560 + 2048 + g * 128 + dc * 8);
    float f[8];
    unpack8(v, f);
    float mu = sMu[q], rs = sRs[q];
#pragma unroll
    for (int i = 0; i < 8; ++i) {
      float val = (geluf_(f[i]) - mu) * rs * lg[dc * 8 + i] + lb[dc * 8 + i];
      vT[(dc * 8 + i) * 136 + q] = f2bf(val);
    }
  }
  __syncthreads();
  const u16* Ws = p.W + OFF_WS + (size_t)g * 128 * 128;
  f32x4 acc[8];
#pragma unroll
  for (int n = 0; n < 8; ++n) acc[n] = (f32x4){0.f, 0.f, 0.f, 0.f};
#pragma unroll
  for (int ks = 0; ks < 4; ++ks) {
    bf16x8 a = *(const bf16x8*)(Ws + (wid * 16 + fr) * 128 + ks * 32 + fq * 8);
#pragma unroll
    for (int n = 0; n < 8; ++n) {
      bf16x8 bb = *(const bf16x8*)(vT + (n * 16 + fr) * 136 + ks * 32 + fq * 8);
      acc[n] = __builtin_amdgcn_mfma_f32_16x16x32_bf16(bb, a, acc[n], 0, 0, 0);
    }
  }
  {
    const int pp = wid * 16 + fr;
    const size_t r = (size_t)(rowbase + pp);
    const float bsv = p.cmlp_b_s[((size_t)l * 4 + g) * 128 + pp];
    uint2 uu[8];
#pragma unroll
    for (int n = 0; n < 8; ++n) uu[n] = *(const uint2*)(Zb1 + r * 2560 + 1536 + g * 128 + n * 16 + fq * 4);
#pragma unroll
    for (int n = 0; n < 8; ++n) {
      float u0 = __uint_as_float(uu[n].x << 16), u1 = __uint_as_float(uu[n].x & 0xffff0000u);
      float u2 = __uint_as_float(uu[n].y << 16), u3 = __uint_as_float(uu[n].y & 0xffff0000u);
      uint2 ov;
      ov.x = pack2(geluf_(u0) * (acc[n][0] + bsv), geluf_(u1) * (acc[n][1] + bsv));
      ov.y = pack2(geluf_(u2) * (acc[n][2] + bsv), geluf_(u3) * (acc[n][3] + bsv));
      *(uint2*)(p.Ycat + r * 2048 + 1024 + g * 128 + n * 16 + fq * 4) = ov;
    }
  }
  __syncthreads();
}

template <int CTRL, int ROWMASK>
__device__ __forceinline__ float dppf(float old, float src) {
  return __int_as_float(__builtin_amdgcn_update_dpp(__float_as_int(old), __float_as_int(src), CTRL, ROWMASK, 0xf, false));
}
#define LSCAN_STEP(A_, B_, CTRL, RM) do { const float A2_ = dppf<CTRL, RM>(1.f, A_), B2_ = dppf<CTRL, RM>(0.f, B_); B_ = A_ * B2_ + B_; A_ = A_ * A2_; } while (0)
#define LSCAN64(A_, B_) do { LSCAN_STEP(A_, B_, 0x111, 0xf); LSCAN_STEP(A_, B_, 0x112, 0xf); LSCAN_STEP(A_, B_, 0x114, 0xf); LSCAN_STEP(A_, B_, 0x118, 0xf); \
    LSCAN_STEP(A_, B_, 0x142, 0xa); LSCAN_STEP(A_, B_, 0x143, 0xc); } while (0)

template <int PASS>
__device__ void lru_run(const P& p, int l, int it_first, int it_stride, unsigned char* smem) {
  int tid = threadIdx.x; asm volatile("" : "+v"(tid));
  const int lane = tid & 63, wid = tid >> 6, fr = lane & 15, fq = lane >> 4;
  u16* sX = (u16*)smem;
  float* sA = (float*)(smem + 18432);
  float* sB = sA + 64 * 130;
  float* sH = sB + 64 * 130;
  float* sCw = sH + 128 * 65;
  float* sCarry = sCw + 320;
  float* sPar = sCarry + 128;
  u16* sW = (u16*)(sPar + 384);
  const u16* Zb2 = p.R1;
  int cur_h = -1;
  uint4 cv[2][4];
#define LRU_LOADCV(ITEM) do { const int h_ = (ITEM) & 7, bj_ = (ITEM) >> 3; const int b_ = bj_ / 34, j_ = bj_ - b_ * 34; const int ic_ = j_ >= 32; \
    const int p0_ = ic_ ? (j_ - 32) * 128 : j_ * 128, sl_ = ic_ ? SC : SL, rs_ = bj_ * 128 - p0_; \
    _Pragma("unroll") for (int e = 0; e < 2; ++e) { int idx = tid + e * 512, pp = idx >> 3, cgp = idx & 7; \
      _Pragma("unroll") for (int k = 0; k < 4; ++k) { int pos = p0_ + pp - 2 + k; cv[e][k] = make_uint4(0, 0, 0, 0); \
        if (pos >= 0 && pos < sl_) cv[e][k] = *(const uint4*)(Zb2 + (size_t)(rs_ + pos) * 1792 + h_ * 64 + cgp * 8); } } } while (0)
  if (it_first < 2176) LRU_LOADCV(it_first);
  for (int item = it_first; item < 2176; item += it_stride) {
    const int h = item & 7, bj = item >> 3;
    const int b = bj / 34, j = bj - b * 34;
    const int rowbase = bj * 128;
    const int isctx = j >= 32;
    const int ordf = isctx ? j - 32 : j + 2, ordr = 33 - j;
    float cA[16], cB[16];
    uint4 gv[2];
    if (PASS == 3) {
#pragma unroll
      for (int q = 0; q < 16; ++q) {
        const int pi = wid * 16 + q, d = pi >> 6, ch = pi & 63, o = d ? ordr : ordf;
        cA[q] = 1.f; cB[q] = 0.f;
        if (lane < o) { float2 v = p.summ[((size_t)(b * 2 + d) * 512 + h * 64 + ch) * 34 + lane]; cA[q] = v.x; cB[q] = v.y; }
      }
#pragma unroll
      for (int e = 0; e < 2; ++e) {
        int idx = tid + e * 512, pos = idx >> 3, cgp = idx & 7;
        gv[e] = *(const uint4*)(Zb2 + (size_t)(rowbase + pos) * 1792 + 800 + h * 64 + cgp * 8);
      }
    }
    if (h != cur_h) {
      cur_h = h;
      __syncthreads();
      if (tid < 320) {
        int k = tid >> 6, i = tid & 63;
        sCw[tid] = (k < 4) ? p.lru_conv_w[((size_t)l * 4 + k) * 512 + h * 64 + i] : p.lru_conv_b[l * 512 + h * 64 + i];
      }
      if (tid < 128) {
        const int d = tid >> 6, ch = tid & 63;
        const size_t pidx = ((size_t)l * 2 + d) * 512 + h * 64 + ch;
        sPar[tid * 3] = p.lru_b_a[pidx]; sPar[tid * 3 + 1] = p.lru_b_x[pidx];
        sPar[tid * 3 + 2] = 8.f * log1pf(__expf(-p.lru_lam[pidx]));
      }
#pragma unroll
      for (int e = 0; e < 4; ++e) {
        int idx = tid + e * 512, row = idx >> 3, kc = idx & 7;
        const int d = row >> 7, n = row & 127;
        *(uint4*)(sW + row * 72 + kc * 8) = *(const uint4*)(p.W + OFF_WLRU + (size_t)((d * 8 + h) * 128 + n) * 64 + kc * 8);
      }
      __syncthreads();
    }
#pragma unroll
    for (int e = 0; e < 2; ++e) {
      int idx = tid + e * 512, pp = idx >> 3, cgp = idx & 7;
      float a8[8];
#pragma unroll
      for (int i = 0; i < 8; ++i) a8[i] = sCw[256 + cgp * 8 + i];
#pragma unroll
      for (int k = 0; k < 4; ++k) {
        float f[8];
        unpack8(cv[e][k], f);
#pragma unroll
        for (int i = 0; i < 8; ++i) a8[i] += sCw[k * 64 + cgp * 8 + i] * f[i];
      }
      *(uint4*)(sX + pp * 72 + cgp * 8) = pack8(a8);
    }
    if (item + it_stride < 2176) LRU_LOADCV(item + it_stride);
    if (PASS == 3) {
#pragma unroll
      for (int q = 0; q < 16; ++q) LSCAN64(cA[q], cB[q]);
      if (lane == 63) {
#pragma unroll
        for (int q = 0; q < 16; ++q) sCarry[wid * 16 + q] = cB[q];
      }
    }
    __syncthreads();
    for (int d = 0; d < 2; ++d) {
      const u16* Wl = sW + d * 128 * 72;
      f32x4 acc[8];
#pragma unroll
      for (int n = 0; n < 8; ++n) acc[n] = (f32x4){0.f, 0.f, 0.f, 0.f};
      {
        const bf16x8 a0 = *(const bf16x8*)(sX + (wid * 16 + fr) * 72 + fq * 8);
        const bf16x8 a1 = *(const bf16x8*)(sX + (wid * 16 + fr) * 72 + 32 + fq * 8);
#pragma unroll
        for (int n = 0; n < 8; ++n) {
          const bf16x8 b0 = *(const bf16x8*)(Wl + (n * 16 + fr) * 72 + fq * 8);
          const bf16x8 b1 = *(const bf16x8*)(Wl + (n * 16 + fr) * 72 + 32 + fq * 8);
          acc[n] = __builtin_amdgcn_mfma_f32_16x16x32_bf16(a0, b0, acc[n], 0, 0, 0);
          acc[n] = __builtin_amdgcn_mfma_f32_16x16x32_bf16(a1, b1, acc[n], 0, 0, 0);
        }
      }
#pragma unroll
      for (int nt = 0; nt < 4; ++nt) {
        const int ch = nt * 16 + fr;
        const float ba = sPar[(d * 64 + ch) * 3], bx = sPar[(d * 64 + ch) * 3 + 1], sp8 = sPar[(d * 64 + ch) * 3 + 2];
#pragma unroll
        for (int jj = 0; jj < 4; ++jj) {
          const int pos = wid * 16 + fq * 4 + jj;
          const float xl = bf2f(sX[pos * 72 + ch]);
          const float rg = sigmoid_rcp_(acc[nt][jj] + ba), ig = sigmoid_rcp_(acc[nt + 4][jj] + bx);
          const float la = -sp8 * rg;
          const float av = __expf(la);
          const float x2 = 2.f * la;
          const float ser = -x2 * (1.f + x2 * (0.5f + x2 * (0.16666667f + x2 * (0.041666667f + x2 * 0.0083333333f))));
          const float om = (x2 > -0.25f) ? ser : (1.f - av * av);
          const float bb = __builtin_amdgcn_sqrtf(om) * ig * xl;
          const int si = d ? 127 - pos : pos;
          sA[ch * 130 + si] = av;
          sB[ch * 130 + si] = bb;
        }
      }
      __syncthreads();
      {
        float a0[8], b0[8], A[8], B[8];
#pragma unroll
        for (int c = 0; c < 8; ++c) {
          const int ch = wid * 8 + c;
          const float2 va = *(const float2*)(sA + ch * 130 + 2 * lane), vb = *(const float2*)(sB + ch * 130 + 2 * lane);
          a0[c] = va.x; b0[c] = vb.x;
          A[c] = va.x * va.y; B[c] = va.y * vb.x + vb.y;
        }
#pragma unroll
        for (int c = 0; c < 8; ++c) LSCAN64(A[c], B[c]);
#pragma unroll
        for (int c = 0; c < 8; ++c) {
          const int ch = wid * 8 + c;
          if (PASS == 1) {
            if (lane == 63) p.summ[((size_t)(b * 2 + d) * 512 + h * 64 + ch) * 34 + (d ? ordr : ordf)] = make_float2(A[c], B[c]);
          } else {
            const float carry = sCarry[d * 64 + ch];
            const float hincl = A[c] * carry + B[c];
            const float hprev = dppf<0x138, 0xf>(carry, hincl);
            const float heven = a0[c] * hprev + b0[c];
            const int se = 2 * lane, pe = d ? 127 - se : se, po = d ? 126 - se : se + 1;
            if (d == 0) { sH[pe * 65 + ch] = heven; sH[po * 65 + ch] = hincl; }
            else { sH[pe * 65 + ch] += heven; sH[po * 65 + ch] += hincl; }
          }
        }
      }
      __syncthreads();
    }
    if (PASS == 3) {
#pragma unroll
      for (int e = 0; e < 2; ++e) {
        int idx = tid + e * 512, pos = idx >> 3, cgp = idx & 7;
        const size_t r = (size_t)(rowbase + pos);
        float gf[8], y[8];
        unpack8(gv[e], gf);
#pragma unroll
        for (int i = 0; i < 8; ++i) y[i] = geluf_(gf[i]) * sH[pos * 65 + cgp * 8 + i];
        *(uint4*)(p.Ycat + r * 2048 + 512 + h * 64 + cgp * 8) = pack8(y);
      }
      __syncthreads();
    }
  }
}

__device__ void krope_item(const P& p, int item) {
  int tid = threadIdx.x; asm volatile("" : "+v"(tid));
  const u16* Zb2 = p.R1;
#pragma unroll
  for (int e = 0; e < 8; ++e) {
    int idx = tid + e * 512, rr = idx >> 4, pi = idx & 15, axis = pi >> 3, i = pi & 7;
    int r = item * 256 + rr, b = r / ST, t = r - b * ST;
    float x1 = bf2f(Zb2[(size_t)r * 1792 + 768 + axis * 16 + i]);
    float x2 = bf2f(Zb2[(size_t)r * 1792 + 768 + axis * 16 + 8 + i]);
    float o1 = x1, o2 = x2;
    if (t < SL) {
      float cs = p.rope[t * 32 + axis * 16 + i], sn = p.rope[t * 32 + axis * 16 + 8 + i];
      o1 = x1 * cs - x2 * sn;
      o2 = x1 * sn + x2 * cs;
    }
    u16 b1 = f2bf(o1), b2 = f2bf(o2);
#pragma unroll
    for (int h = 0; h < 8; ++h) {
      size_t base = ((size_t)(b * 8 + h) * ST + t) * 96 + 64 + axis * 16 + i;
      p.K[base] = b1;
      p.K[base + 8] = b2;
    }
  }
}

__device__ void attn_item(const P& p, int item, unsigned char* smem) {
  int tid = threadIdx.x; asm volatile("" : "+v"(tid));
  const int lane = tid & 63, wid = tid >> 6, fr = lane & 15, fq = lane >> 4;
  int b, h, t0, kt0, kt1;
  if (item < 1024) { b = item >> 7; h = (item >> 4) & 7; t0 = (item & 15) * 256; kt0 = 0; kt1 = 68; }
  else { int i2 = item - 1024; b = i2 >> 3; h = i2 & 7; t0 = SL; kt0 = 64; kt1 = 68; }
  const u16* Kb = p.K + (size_t)(b * 8 + h) * ST * 96;
  const u16* Vb = p.Vt + (size_t)(b * 8 + h) * 64 * ST;
  const u16* Qb = p.Q + (size_t)(b * 8 + h) * ST * 96;
  constexpr int KS = 104, VS = 136, KSZ = 128 * KS, VSZ = 64 * VS, STG = KSZ + VSZ;
  u16* lds = (u16*)smem;
  bf16x8 qf[2][3];
#pragma unroll
  for (int nq = 0; nq < 2; ++nq)
#pragma unroll
    for (int ks = 0; ks < 3; ++ks)
      qf[nq][ks] = *(const bf16x8*)(Qb + (size_t)(t0 + wid * 32 + nq * 16 + fr) * 96 + ks * 32 + fq * 8);
  if (item < 1024) {
#pragma unroll
    for (int nq = 0; nq < 2; ++nq) {
      const int t = t0 + wid * 32 + nq * 16 + fr;
      const float* rp = p.rope + t * 32 + (fq >> 1) * 16;
      union { bf16x8 v; uint32_t u[4]; } own, oth, res;
      own.v = qf[nq][2];
#pragma unroll
      for (int i = 0; i < 4; ++i) oth.u[i] = __shfl_xor(own.u[i], 16);
      float fo[8], fp[8], fres[8];
      { uint4 t4 = make_uint4(own.u[0], own.u[1], own.u[2], own.u[3]); unpack8(t4, fo); }
      { uint4 t4 = make_uint4(oth.u[0], oth.u[1], oth.u[2], oth.u[3]); unpack8(t4, fp); }
#pragma unroll
      for (int j = 0; j < 8; ++j) {
        float cs = rp[j], sn = rp[8 + j];
        fres[j] = (fq & 1) ? (fp[j] * sn + fo[j] * cs) : (fo[j] * cs - fp[j] * sn);
      }
      uint4 r4 = pack8(fres);
      res.u[0] = r4.x; res.u[1] = r4.y; res.u[2] = r4.z; res.u[3] = r4.w;
      qf[nq][2] = res.v;
    }
  }
  f32x4 o[4][2];
#pragma unroll
  for (int m = 0; m < 4; ++m)
#pragma unroll
    for (int n = 0; n < 2; ++n) o[m][n] = (f32x4){0.f, 0.f, 0.f, 0.f};
  float mrun[2] = {-1e30f, -1e30f}, lrun[2] = {0.f, 0.f};
  const int T0 = kt0 >> 1, T1 = kt1 >> 1;
  uint4 rk0, rk1, rk2, rv0, rv1;
  const int c0_ = tid, c1_ = tid + 512, c2_ = tid + 1024;
  const int kcv0_ = c0_ & 15, kcv1_ = c1_ & 15;
  const int vslot0_ = 32 * (kcv0_ >> 2) + 16 * (kcv0_ & 1) + 4 * ((kcv0_ & 3) >> 1);
  const int vslot1_ = 32 * (kcv1_ >> 2) + 16 * (kcv1_ & 1) + 4 * ((kcv1_ & 3) >> 1);
#define ATT_LD(tt) do { const size_t key0_ = (size_t)(tt) * 128; const u16* kb_ = Kb + key0_ * 96; \
    rk0 = *(const uint4*)(kb_ + (size_t)c0_ * 8); rk1 = *(const uint4*)(kb_ + (size_t)c1_ * 8); rk2 = *(const uint4*)(kb_ + (size_t)c2_ * 8); \
    rv0 = *(const uint4*)(Vb + (size_t)(c0_ >> 4) * ST + key0_ + (c0_ & 15) * 8); \
    rv1 = *(const uint4*)(Vb + (size_t)(c1_ >> 4) * ST + key0_ + (c1_ & 15) * 8); } while (0)
#define ATT_ST(st) do { u16* sk_ = lds + (st) * STG; u16* sv_ = sk_ + KSZ; \
    *(uint4*)(sk_ + (c0_ / 12) * KS + (c0_ % 12) * 8) = rk0; *(uint4*)(sk_ + (c1_ / 12) * KS + (c1_ % 12) * 8) = rk1; *(uint4*)(sk_ + (c2_ / 12) * KS + (c2_ % 12) * 8) = rk2; \
    *(uint2*)(sv_ + (c0_ >> 4) * VS + vslot0_) = make_uint2(rv0.x, rv0.y); *(uint2*)(sv_ + (c0_ >> 4) * VS + vslot0_ + 8) = make_uint2(rv0.z, rv0.w); \
    *(uint2*)(sv_ + (c1_ >> 4) * VS + vslot1_) = make_uint2(rv1.x, rv1.y); *(uint2*)(sv_ + (c1_ >> 4) * VS + vslot1_ + 8) = make_uint2(rv1.z, rv1.w); } while (0)
  ATT_LD(T0); ATT_ST(0);
  __syncthreads();
  for (int kt = T0; kt < T1; ++kt) {
    const bool more = (kt + 1 < T1);
    if (more) ATT_LD(kt + 1);
    const int cur = (kt - T0) & 1;
    const u16* sk = lds + cur * STG;
    const u16* sv = sk + KSZ;
    f32x4 s[8][2];
#pragma unroll
    for (int m = 0; m < 8; ++m)
#pragma unroll
      for (int n = 0; n < 2; ++n) s[m][n] = (f32x4){0.f, 0.f, 0.f, 0.f};
#pragma unroll
    for (int ks = 0; ks < 3; ++ks)
#pragma unroll
      for (int mt = 0; mt < 8; ++mt) {
        bf16x8 kf = *(const bf16x8*)(sk + (mt * 16 + fr) * KS + ks * 32 + fq * 8);
#pragma unroll
        for (int nq = 0; nq < 2; ++nq) s[mt][nq] = __builtin_amdgcn_mfma_f32_16x16x32_bf16(kf, qf[nq][ks], s[mt][nq], 0, 0, 0);
      }
    bf16x8 pb[2][4];
    float mloc[2];
#pragma unroll
    for (int nq = 0; nq < 2; ++nq) {
      float mx = fmaxf(fmaxf(s[0][nq][0], s[0][nq][1]), fmaxf(s[0][nq][2], s[0][nq][3]));
#pragma unroll
      for (int mt = 1; mt < 8; ++mt) mx = fmaxf(fmaxf(mx, s[mt][nq][0]), fmaxf(fmaxf(s[mt][nq][1], s[mt][nq][2]), s[mt][nq][3]));
      mloc[nq] = mx;
    }
    if (__any((mloc[0] > mrun[0] + 8.f) || (mloc[1] > mrun[1] + 8.f))) {
      float m0 = fmaxf(mloc[0], __shfl_xor(mloc[0], 16)), m1 = fmaxf(mloc[1], __shfl_xor(mloc[1], 16));
      m0 = fmaxf(m0, __shfl_xor(m0, 32)); m1 = fmaxf(m1, __shfl_xor(m1, 32));
      const float n0 = fmaxf(mrun[0], m0), n1 = fmaxf(mrun[1], m1);
      const float a0 = __builtin_amdgcn_exp2f(mrun[0] - n0), a1 = __builtin_amdgcn_exp2f(mrun[1] - n1);
      mrun[0] = n0; mrun[1] = n1;
      lrun[0] *= a0; lrun[1] *= a1;
#pragma unroll
      for (int mtv = 0; mtv < 4; ++mtv) {
        o[mtv][0][0] *= a0; o[mtv][0][1] *= a0; o[mtv][0][2] *= a0; o[mtv][0][3] *= a0;
        o[mtv][1][0] *= a1; o[mtv][1][1] *= a1; o[mtv][1][2] *= a1; o[mtv][1][3] *= a1;
      }
    }
#pragma unroll
    for (int nq = 0; nq < 2; ++nq) {
      const float mn = mrun[nq];
      float rs = 0.f;
#pragma unroll
      for (int mt = 0; mt < 8; ++mt)
#pragma unroll
        for (int jj = 0; jj < 4; ++jj) {
          float pv = __builtin_amdgcn_exp2f(s[mt][nq][jj] - mn);
          s[mt][nq][jj] = pv;
          rs += pv;
        }
      lrun[nq] += rs;
#pragma unroll
      for (int sx = 0; sx < 4; ++sx) {
        union { uint4 u; bf16x8 v; } cv;
        cv.u.x = pack2(s[2 * sx][nq][0], s[2 * sx][nq][1]); cv.u.y = pack2(s[2 * sx][nq][2], s[2 * sx][nq][3]);
        cv.u.z = pack2(s[2 * sx + 1][nq][0], s[2 * sx + 1][nq][1]); cv.u.w = pack2(s[2 * sx + 1][nq][2], s[2 * sx + 1][nq][3]);
        pb[nq][sx] = cv.v;
      }
    }
#pragma unroll
    for (int sx = 0; sx < 4; ++sx)
#pragma unroll
      for (int mtv = 0; mtv < 4; ++mtv) {
        const bf16x8 vf = *(const bf16x8*)(sv + (mtv * 16 + fr) * VS + 32 * sx + fq * 8);
#pragma unroll
        for (int nq = 0; nq < 2; ++nq) o[mtv][nq] = __builtin_amdgcn_mfma_f32_16x16x32_bf16(vf, pb[nq][sx], o[mtv][nq], 0, 0, 0);
      }
    if (more) ATT_ST(cur ^ 1);
    __syncthreads();
  }
#undef ATT_LD
#undef ATT_ST
#pragma unroll
  for (int nq = 0; nq < 2; ++nq) {
    float lt = lrun[nq];
    lt += __shfl_xor(lt, 16);
    lt += __shfl_xor(lt, 32);
    float inv = 1.f / lt;
    size_t r = (size_t)b * ST + t0 + wid * 32 + nq * 16 + fr;
#pragma unroll
    for (int mtv = 0; mtv < 4; ++mtv) {
      uint2 ov;
      ov.x = pack2(o[mtv][nq][0] * inv, o[mtv][nq][1] * inv);
      ov.y = pack2(o[mtv][nq][2] * inv, o[mtv][nq][3] * inv);
      *(uint2*)(p.Ycat + r * 2048 + 1536 + h * 64 + mtv * 16 + fq * 4) = ov;
    }
  }
}

#define XB_TMO      128
#define XB_XCNT(j)  (256  + 64 * (j))
#define XB_XSUB(j)  (1280 + 64 * (j))
#define XB_XGEN(j)  (2304 + 64 * (j))
#define XB_TOP      3328
#define XB_TOPGEN   3392
#define XCD_BAR_WORDS 3456
#define XB_SPIN_CAP (1u << 18)
__device__ __forceinline__ unsigned xb_ld(unsigned* p)              { return __hip_atomic_load(p, __ATOMIC_RELAXED, __HIP_MEMORY_SCOPE_AGENT); }
__device__ __forceinline__ unsigned xb_add(unsigned* p, unsigned v) { return __hip_atomic_fetch_add(p, v, __ATOMIC_RELAXED, __HIP_MEMORY_SCOPE_AGENT); }
__device__ __forceinline__ unsigned xb_xcc_id() { return (unsigned)__builtin_amdgcn_s_getreg((3 << 11) | 20) & 0xFu; }
#define XB_SPIN(cond, bar) do { unsigned _sp = 0; while (cond) { __builtin_amdgcn_s_sleep(1); \
    if ((++_sp & 255u) == 0u) { if (xb_ld(&(bar)[XB_TMO])) break; if (_sp > XB_SPIN_CAP) { atomicAdd(&(bar)[XB_TMO], 1u); break; } } } } while (0)
struct XcdBarrier { unsigned* bar; unsigned x; volatile __attribute__((address_space(3))) unsigned* st; };
__device__ __forceinline__ XcdBarrier xcd_barrier_post(unsigned* bar, volatile __attribute__((address_space(3))) unsigned* st) {
  XcdBarrier b; b.bar = bar; b.x = xb_xcc_id(); b.st = st;
  if (threadIdx.x == 0) (void)xb_add(&bar[XB_XCNT(b.x)], 1u);
  return b;
}
__device__ __forceinline__ void xcd_barrier_complete(unsigned* bar, unsigned x, unsigned& nloc, unsigned& nx) {
  const unsigned G = gridDim.x * gridDim.y * gridDim.z;
  unsigned sum, cnt, mine, sp = 0u;
  for (;;) {
    sum = 0u; cnt = 0u; mine = 0u;
#pragma unroll
    for (unsigned j = 0; j < 16; ++j) { const unsigned c = xb_ld(&bar[XB_XCNT(j)]); sum += c; cnt += (c > 0u) ? 1u : 0u; mine = (j == x) ? c : mine; }
    if (sum == G) break;
    __builtin_amdgcn_s_sleep(1);
    if ((++sp & 255u) == 0u) { if (xb_ld(&bar[XB_TMO])) break; if (sp > XB_SPIN_CAP) { atomicAdd(&bar[XB_TMO], 1u); break; } }
  }
  nloc = mine > 0u ? mine : 1u; nx = cnt > 0u ? cnt : 1u;
}
__device__ __forceinline__ void xcd_barrier(const XcdBarrier& b) {
  asm volatile("s_waitcnt vmcnt(0)" ::: "memory");
  __syncthreads();
  if (threadIdx.x == 0) {
    unsigned* bar = b.bar;
    __builtin_amdgcn_s_waitcnt(0);
    unsigned nloc = b.st[0], nx = b.st[1];
    if (nloc == 0u) { xcd_barrier_complete(bar, b.x, nloc, nx); b.st[0] = nloc; b.st[1] = nx; }
    const unsigned old = xb_add(&bar[XB_XSUB(b.x)], 1u);
    const unsigned gen = old / nloc;
    if (old + 1u == (gen + 1u) * nloc) {
      __builtin_amdgcn_fence(__ATOMIC_RELEASE, "agent");
      asm volatile("s_waitcnt vmcnt(0)" ::: "memory");
      const unsigned og = xb_add(&bar[XB_TOP], 1u);
      const unsigned tg = og / nx;
      if (og + 1u == (tg + 1u) * nx) xb_add(&bar[XB_TOPGEN], 1u);
      else XB_SPIN(xb_ld(&bar[XB_TOPGEN]) == tg, bar);
      __builtin_amdgcn_fence(__ATOMIC_ACQUIRE, "agent");
      xb_add(&bar[XB_XGEN(b.x)], 1u);
      asm volatile("s_waitcnt vmcnt(0)" ::: "memory");
    } else {
      XB_SPIN(xb_ld(&bar[XB_XGEN(b.x)]) == gen, bar);
      __builtin_amdgcn_fence(__ATOMIC_ACQUIRE, "agent");
      asm volatile("s_waitcnt vmcnt(0)" ::: "memory");
    }
  }
  __syncthreads();
}

__global__ void __launch_bounds__(NTHR) mega(P p) {
  extern __shared__ __attribute__((aligned(16))) unsigned char smem[];
  __shared__ uint4 xb_words;
  cg::grid_group grid = cg::this_grid();
  if (threadIdx.x == 0) xb_words = make_uint4(0u, 0u, 0u, 0u);
  __syncthreads();
  XcdBarrier xb = xcd_barrier_post(p.bar, (volatile __attribute__((address_space(3))) unsigned*)&xb_words);
  u16* lds = (u16*)smem;
  float* sInv = (float*)(smem + 131072);
  LAS3 unsigned char* lds3 = (LAS3 unsigned char*)smem;
  const int bid = blockIdx.x, nblk = gridDim.x;
  auto nopre = [](int) {};

#ifndef NO_P0
  phase0(p, smem);
#endif
  grid.sync();

#pragma unroll 1
  for (int l = 0; l < 4; ++l) {
    int tid = threadIdx.x; asm volatile("" : "+v"(tid));
    const int lane = tid & 63, wid = tid >> 6, wr = wid >> 1, wc = wid & 1, fr = lane & 15, fq = lane >> 4;
    (void)lane; (void)wid; (void)wr; (void)wc; (void)fr; (void)fq;
#ifndef NO_CW
    convert_weights(p, l, (float*)smem);
#endif
    norm_mod(p, l, p.norm1_g + l * 1024, 0, 1024);
    GSYNC();

    {
      u16* Zb1 = p.R1;
      auto epi = [=](const f32x4(&acc)[2][2][4][2], const g8::Unit& u, int wr, int wc, int fr, int fq, int) {
#pragma unroll
        for (int ai = 0; ai < 2; ++ai)
#pragma unroll
          for (int m = 0; m < 4; ++m) {
            u16* rowp = Zb1 + (size_t)(u.pm * 256 + ai * 128 + wr * 64 + m * 16 + fr) * 2560 + u.pn * 256 + wc * 32 + 8 * fq;
#pragma unroll
            for (int bj = 0; bj < 2; ++bj) {
              uint4 w;
              w.x = g8::cvt_pk_bf16(acc[ai][bj][m][0][0], acc[ai][bj][m][0][1]); w.y = g8::cvt_pk_bf16(acc[ai][bj][m][0][2], acc[ai][bj][m][0][3]);
              w.z = g8::cvt_pk_bf16(acc[ai][bj][m][1][0], acc[ai][bj][m][1][1]); w.w = g8::cvt_pk_bf16(acc[ai][bj][m][1][2], acc[ai][bj][m][1][3]);
              *(uint4*)(rowp + bj * 128) = w;
            }
          }
      };
      g8::Simple S; S.o.init(l == 3 ? 128 : 136, 10, nblk, bid); S.A = p.H; S.Bt = p.W + OFF_WINA; S.lda = 1024; S.K = 1024;
      g8::gemm_phase<true>(lds3, S, epi);
    }
    GSYNC();

    for (int rep = 0; rep < DUP_C1; ++rep)
    for (int it = bid; it < 1088 + 136; it += nblk) {
#ifndef NO_CMLP
      if (it < 1088) cmlp_item(p, l, it, smem);
#endif
#ifndef NO_CONVA
      if (it >= 1088) conva_item(p, l, it - 1088);
#endif
    }
    GSYNC();

    {
      u16* Zb2 = p.R1;
      auto epi = [=](const f32x4(&acc)[2][2][4][2], const g8::Unit& u, int wr, int wc, int fr, int fq, int) {
#pragma unroll
        for (int ai = 0; ai < 2; ++ai)
#pragma unroll
          for (int m = 0; m < 4; ++m) {
            u16* rowp = Zb2 + (size_t)(u.pm * 256 + ai * 128 + wr * 64 + m * 16 + fr) * 1792 + u.pn * 256 + wc * 32 + 8 * fq;
#pragma unroll
            for (int bj = 0; bj < 2; ++bj) {
              uint4 w;
              w.x = g8::cvt_pk_bf16(acc[ai][bj][m][0][0], acc[ai][bj][m][0][1]); w.y = g8::cvt_pk_bf16(acc[ai][bj][m][0][2], acc[ai][bj][m][0][3]);
              w.z = g8::cvt_pk_bf16(acc[ai][bj][m][1][0], acc[ai][bj][m][1][1]); w.w = g8::cvt_pk_bf16(acc[ai][bj][m][1][2], acc[ai][bj][m][1][3]);
              *(uint4*)(rowp + bj * 128) = w;
            }
          }
        const int pn = u.pn;
        if (pn == 2 || pn == 5 || pn == 6) {
          const bool inc0 = (pn != 5) || (wc >= 1);
          const bool inc1 = (pn == 2) || (pn == 5) || (wc == 0);
          float* dst = p.ssq + (size_t)(u.pm * 256 + wr * 64 + fr) * 12 + (pn == 2 ? 0 : (pn == 5 ? 4 : 8)) + wc;
#pragma unroll
          for (int ai = 0; ai < 2; ++ai)
#pragma unroll
            for (int m = 0; m < 4; ++m) {
              float ss = 0.f;
#pragma unroll
              for (int n = 0; n < 2; ++n)
#pragma unroll
                for (int jj = 0; jj < 4; ++jj) {
                  const float v0 = acc[ai][0][m][n][jj], v1 = acc[ai][1][m][n][jj];
                  ss += (inc0 ? v0 * v0 : 0.f) + (inc1 ? v1 * v1 : 0.f);
                }
              ss += __shfl_xor(ss, 16);
              ss += __shfl_xor(ss, 32);
              if (fq == 0) dst[(ai * 128 + m * 16) * 12] = ss;
              asm volatile("" ::: "memory");
            }
        }
      };
      g8::Simple S; S.o.init(136, 7, nblk, bid); S.A = p.H; S.Bt = p.W + OFF_WINB; S.lda = 1024; S.K = 1024;
      g8::gemm_phase<true>(lds3, S, epi);
    }
    GSYNC();

    for (int rep = 0; rep < DUP_C2; ++rep)
    {
      const u16* Zb2 = p.R1;
      for (int r2 = 0; r2 < DUP_LRU1; ++r2) lru_run<1>(p, l, bid, nblk, smem);
      for (int r2 = 0; r2 < DUP_PROJ; ++r2) {
      {
        struct ProjSched {
          g8::Order o; const u16* Zb2; const u16* Wq; const u16* Wkv;
          __device__ bool next(int i, g8::Unit& u) const {
            int pm, pn; if (!o.tile(i, pm, pn)) return false;
            u.pm = pm; u.lda = 1792;
            if (pn < 3) { u.pn = pn; u.aux = 0; u.K = 384; u.A = (const char*)(Zb2 + (size_t)pm * 256 * 1792 + 1312); u.B = (const char*)(Wq + (size_t)pn * 256 * 384); }
            else { u.pn = pn - 3; u.aux = 1; u.K = 256; u.A = (const char*)(Zb2 + (size_t)pm * 256 * 1792 + 512); u.B = (const char*)(Wkv + (size_t)(pn - 3) * 256 * 256); }
            return true;
          }
        };
        ProjSched S; S.o.init(136, 7, nblk, bid); S.Zb2 = Zb2; S.Wq = p.W + OFF_WQUP; S.Wkv = p.W + OFF_WKVUP;
        auto epi = [=](const f32x4(&acc)[2][2][4][2], const g8::Unit& u, int wr, int wc, int fr, int fq, int) {
          const int row0 = u.pm * 256, b = row0 / ST, tb = row0 - b * ST;
          const int kv = u.aux;
          const float* sq = p.ssq + (size_t)row0 * 12;
          const float invn = kv ? (1.f / 256.f) : (1.f / 384.f);
#pragma unroll
          for (int ai = 0; ai < 2; ++ai)
#pragma unroll
            for (int m = 0; m < 4; ++m) {
              const int rl = ai * 128 + wr * 64 + m * 16 + fr;
              const float4 p0 = *(const float4*)(sq + rl * 12), p1 = *(const float4*)(sq + rl * 12 + 4), p2 = *(const float4*)(sq + rl * 12 + 8);
              const float ssum = kv ? ((p0.x + p0.y) + (p0.z + p0.w)) : (((p1.x + p1.y) + (p1.z + p1.w)) + ((p2.x + p2.y) + (p2.z + p2.w)));
              const float inv = rsqrtf(ssum * invn + EPS);
              const int t = tb + rl;
#pragma unroll
              for (int bj = 0; bj < 2; ++bj) {
                const int c8 = u.pn * 256 + bj * 128 + wc * 32 + 8 * fq;
                float v[8];
#pragma unroll
                for (int n = 0; n < 2; ++n)
#pragma unroll
                  for (int jj = 0; jj < 4; ++jj) v[n * 4 + jj] = acc[ai][bj][m][n][jj] * inv;
                if (!kv) {
                  const int head = c8 / 96, d = c8 - head * 96;
                  *(uint4*)(p.Q + ((size_t)(b * 8 + head) * ST + t) * 96 + d) = pack8(v);
                } else {
                  const int head = c8 >> 7, w = c8 & 127;
                  if (wc < 2) {
                    *(uint4*)(p.K + ((size_t)(b * 8 + head) * ST + t) * 96 + w) = pack8(v);
                  } else {
                    u16* vp = p.Vt + ((size_t)(b * 8 + head) * 64 + (w - 64)) * ST + t;
#pragma unroll
                    for (int e = 0; e < 8; ++e) vp[(size_t)e * ST] = f2bf(v[e]);
                  }
                }
              }
              asm volatile("" ::: "memory");
            }
        };
        g8::gemm_phase<true>(lds3, S, epi);
      }
      {
        const int off = 2176;
        int first = bid;
        if (first < off) { int kk = (off - first + nblk - 1) / nblk; first += kk * nblk; }
        for (int it = first; it < off + 136; it += nblk) krope_item(p, it - off);
      }
      }
    }
    GSYNC();

    for (int rep = 0; rep < DUP_ATTN; ++rep)
    {
      int it = bid;
      for (; it < 1088; it += nblk) attn_item(p, it, smem);
      for (int r2 = 0; r2 < DUP_LRU3; ++r2) lru_run<3>(p, l, it - 1088, nblk, smem);
    }
    GSYNC();

    {
      u16* Mg = p.R1;
      const int ntile = 272 * 8;
      int te = threadIdx.x; asm volatile("" : "+v"(te));
      const int lane_e = te & 63, wid_e = te >> 6;
      const int wr = wid_e >> 1, wc = wid_e & 1, fr = lane_e & 15, fq = lane_e >> 4;
      int estr = nblk; asm volatile("" : "+s"(estr));
      const int skipctx = (l == 3);
      for (int id = bid; id < ntile; id += estr) {
        int g = id >> 6, rem = id & 63;
        int ct = rem >> 3, rt = g * 8 + (rem & 7);
        if (skipctx && (rt % 34) >= 32) continue;
        f32x4 mg[2][4];
#pragma unroll
        for (int m = 0; m < 2; ++m)
#pragma unroll
          for (int n = 0; n < 4; ++n) mg[m][n] = (f32x4){0.f, 0.f, 0.f, 0.f};
        for (int nb = 0; nb < 4; ++nb) {
          f32x4 ag[2][4], ay[2][4];
#pragma unroll
          for (int m = 0; m < 2; ++m)
#pragma unroll
            for (int n = 0; n < 4; ++n) { ag[m][n] = (f32x4){0.f, 0.f, 0.f, 0.f}; ay[m][n] = (f32x4){0.f, 0.f, 0.f, 0.f}; }
          gemm_main<2>(p.H + (size_t)rt * 128 * 1024, 1024, p.W + OFF_WGATE + (size_t)(nb * 1024 + ct * 128) * 1024, 1024, 1024,
                       lds, ag);
          gemm_main<2>(p.Ycat + (size_t)rt * 128 * 2048 + nb * 512, 2048, p.W + OFF_WBR + (size_t)(nb * 1024 + ct * 128) * 512, 512,
                       512, lds, ay);
#pragma unroll
          for (int m = 0; m < 2; ++m)
#pragma unroll
            for (int n = 0; n < 4; ++n)
#pragma unroll
              for (int jj = 0; jj < 4; ++jj) mg[m][n][jj] += sigmoidf_(ag[m][n][jj]) * ay[m][n][jj];
        }
#pragma unroll
        for (int m = 0; m < 2; ++m) {
          u16* dst = Mg + (size_t)(rt * 128 + wr * 32 + m * 16 + fq * 4) * 1024 + ct * 128 + wc * 64 + fr;
#pragma unroll
          for (int n = 0; n < 4; ++n)
#pragma unroll
            for (int jj = 0; jj < 4; ++jj) dst[jj * 1024 + n * 16] = f2bf(mg[m][n][jj]);
          asm volatile("" ::: "memory");
        }
        __syncthreads();
      }
    }
    GSYNC();

    {
      auto epi = [=](const f32x4(&acc)[2][2][4][2], const g8::Unit& u, int wr, int wc, int fr, int fq, int) {
        float* xb = xrow_ptr(p, u.pm * 256);
        const float* gate = p.mod + ((size_t)l * 9 + mod_idx(u.pm * 256)) * 6144 + 2048 + u.pn * 256 + wc * 32 + 4 * fq;
        f32x4 gv[2][2];
#pragma unroll
        for (int bj = 0; bj < 2; ++bj)
#pragma unroll
          for (int n = 0; n < 2; ++n) gv[bj][n] = *(const f32x4*)(gate + bj * 128 + n * 16);
#pragma unroll
        for (int ai = 0; ai < 2; ++ai)
#pragma unroll
          for (int m = 0; m < 4; ++m) {
            float* rowp = xb + (size_t)(ai * 128 + wr * 64 + m * 16 + fr) * DM + u.pn * 256 + wc * 32 + 4 * fq;
#pragma unroll
            for (int bj = 0; bj < 2; ++bj)
#pragma unroll
              for (int n = 0; n < 2; ++n) {
                f32x4 xv = *(const f32x4*)(rowp + bj * 128 + n * 16);
                xv += gv[bj][n] * acc[ai][bj][m][n];
                *(f32x4*)(rowp + bj * 128 + n * 16) = xv;
              }
          }
      };
      g8::Simple S; S.o.init(l == 3 ? 128 : 136, 4, nblk, bid); S.A = p.R1; S.Bt = p.W + OFF_WOUT; S.lda = 1024; S.K = 1024;
      g8::gemm_phase<false>(lds3, S, epi);
    }
    GSYNC();

    norm_mod(p, l, p.norm2_g + l * 1024, 3072, 4096);
    GSYNC();

    {
      u16* U = p.R1;
      auto epi = [=](const f32x4(&acc)[2][2][4][2], const g8::Unit& u, int wr, int wc, int fr, int fq, int) {
#pragma unroll
        for (int ai = 0; ai < 2; ++ai)
#pragma unroll
          for (int m = 0; m < 4; ++m) {
            u16* rowp = U + (size_t)(u.pm * 256 + ai * 128 + wr * 64 + m * 16 + fr) * 2816 + u.pn * 128 + wc * 32 + 8 * fq;
            float v[8];
#pragma unroll
            for (int n = 0; n < 2; ++n)
#pragma unroll
              for (int jj = 0; jj < 4; ++jj) v[n * 4 + jj] = siluf_(acc[ai][0][m][n][jj]) * acc[ai][1][m][n][jj];
            uint4 w;
            w.x = g8::cvt_pk_bf16(v[0], v[1]); w.y = g8::cvt_pk_bf16(v[2], v[3]); w.z = g8::cvt_pk_bf16(v[4], v[5]); w.w = g8::cvt_pk_bf16(v[6], v[7]);
            *(uint4*)rowp = w;
          }
      };
      g8::Simple S; S.o.init(l == 3 ? 128 : 136, 22, nblk, bid); S.A = p.H; S.Bt = p.W + OFF_WFF13; S.lda = 1024; S.K = 1024;
      g8::gemm_phase<true>(lds3, S, epi);
    }
    GSYNC();

    {
      auto epi = [=](const f32x4(&acc)[2][2][4][2], const g8::Unit& u, int wr, int wc, int fr, int fq, int) {
        float* xb = xrow_ptr(p, u.pm * 256);
        const float* gate = p.mod + ((size_t)l * 9 + mod_idx(u.pm * 256)) * 6144 + 5120 + u.pn * 256 + wc * 32 + 4 * fq;
        f32x4 gv[2][2];
#pragma unroll
        for (int bj = 0; bj < 2; ++bj)
#pragma unroll
          for (int n = 0; n < 2; ++n) gv[bj][n] = *(const f32x4*)(gate + bj * 128 + n * 16);
#pragma unroll
        for (int ai = 0; ai < 2; ++ai)
#pragma unroll
          for (int m = 0; m < 4; ++m) {
            float* rowp = xb + (size_t)(ai * 128 + wr * 64 + m * 16 + fr) * DM + u.pn * 256 + wc * 32 + 4 * fq;
#pragma unroll
            for (int bj = 0; bj < 2; ++bj)
#pragma unroll
              for (int n = 0; n < 2; ++n) {
                f32x4 xv = *(const f32x4*)(rowp + bj * 128 + n * 16);
                xv += gv[bj][n] * acc[ai][bj][m][n];
                *(f32x4*)(rowp + bj * 128 + n * 16) = xv;
              }
          }
      };
      g8::Simple S; S.o.init(l == 3 ? 128 : 136, 4, nblk, bid); S.A = p.R1; S.Bt = p.W + OFF_WFF2; S.lda = 2816; S.K = 2816;
      g8::gemm_phase<false>(lds3, S, epi);
    }
    GSYNC();

  }

  const int lane = threadIdx.x & 63, wid = threadIdx.x >> 6;
  for (int r = bid * 8 + wid; r < NB * SL; r += nblk * 8) {
    float* xr = p.out + (size_t)r * DM;
    float4 v[4];
    float ss = 0.f;
#pragma unroll
    for (int i = 0; i < 4; ++i) {
      v[i] = *(const float4*)(xr + i * 256 + lane * 4);
      ss += v[i].x * v[i].x + v[i].y * v[i].y + v[i].z * v[i].z + v[i].w * v[i].w;
    }
    ss = wave_sum(ss);
    const float inv = rsqrtf(ss * (1.f / 1024.f) + EPS);
#pragma unroll
    for (int i = 0; i < 4; ++i) {
      float4 gg = *(const float4*)(p.final_g + i * 256 + lane * 4);
      float4 ov;
      ov.x = v[i].x * inv * gg.x; ov.y = v[i].y * inv * gg.y; ov.z = v[i].z * inv * gg.z; ov.w = v[i].w * inv * gg.w;
      *(float4*)(xr + i * 256 + lane * 4) = ov;
    }
  }
}

extern "C" void kernel_launch(void* const* d_in, const int* in_sizes, int n_in, void* d_out, int out_size, void* d_ws,
                              size_t ws_size, hipStream_t stream) {
  static int grid_blocks = 0;
  if (!grid_blocks) {
    int dev = 0, cus = 0, per_cu = 0;
    hipGetDevice(&dev);
    hipDeviceGetAttribute(&cus, hipDeviceAttributeMultiprocessorCount, dev);
    hipFuncSetAttribute((const void*)mega, hipFuncAttributeMaxDynamicSharedMemorySize, LDS_BYTES);
    hipOccupancyMaxActiveBlocksPerMultiprocessor(&per_cu, (const void*)mega, NTHR, LDS_BYTES);
    if (per_cu < 1) per_cu = 1;
    if (per_cu > 1) per_cu = 1;
    grid_blocks = cus * per_cu;
    (void)hipGetLastError();
  }
  P p{};
  const float** pf = (const float**)&p;
  for (int i = 0; i < 31; ++i) pf[i] = (const float*)d_in[i];
  p.out = (float*)d_out;
  size_t off = 0;
  auto take = [&](size_t bytes) { void* r = (char*)d_ws + off; off += (bytes + 255) & ~(size_t)255; return r; };
  p.Xc = (float*)take((size_t)NB * SC * DM * 4);
  p.mod = (float*)take((size_t)4 * 9 * 6144 * 4);
  p.rope = (float*)take((size_t)SL * 32 * 4);
  p.summ = (float2*)take((size_t)NB * 2 * 512 * 34 * 8);
  p.ssq = (float*)take((size_t)12 * MTOT * 4);
  p.bar = (unsigned*)take((size_t)XCD_BAR_WORDS * 4);
  p.W = (u16*)take((size_t)W_ELEMS * 2);
  p.H = (u16*)take((size_t)MTOT * 1024 * 2);
  p.Ycat = (u16*)take((size_t)MTOT * 2048 * 2);
  p.R1 = (u16*)take((size_t)MTOT * 2560 * 2);
  p.K = (u16*)take((size_t)MTOT * 768 * 2);
  p.Vt = (u16*)take((size_t)MTOT * 512 * 2);
  p.Q = p.R1 + (size_t)MTOT * 1792;
  if (off > ws_size) { fprintf(stderr, "workspace too small: need %zu have %zu\n", off, ws_size); return; }
  (void)hipMemsetAsync(p.bar, 0, (size_t)XCD_BAR_WORDS * 4, stream);
  void* args[] = {&p};
  hipError_t e = hipLaunchCooperativeKernel((const void*)mega, dim3(grid_blocks), dim3(NTHR), args, LDS_BYTES, stream);
  if (e != hipSuccess) fprintf(stderr, "cooperative launch failed: %s (grid %d)\n", hipGetErrorString(e), grid_blocks);
}
```

```cpp
#include <hip/hip_runtime.h>
#include <hip/hip_bf16.h>
#include <hip/hip_cooperative_groups.h>
#include <cstdio>
#include <cstdint>
namespace cg = cooperative_groups;

typedef unsigned short u16;
using bf16x8 = __attribute__((ext_vector_type(8))) short;
using f32x4 = __attribute__((ext_vector_type(4))) float;

#define NB 8
#define SL 4096
#define SC 256
#define ST 4352
#define MTOT 34816
#define DM 1024
#define NTHR 512
#define EPS 1e-6f
#define LDS_BYTES 159744
#define DUP_ATTN 1
#define DUP_C1 1
#define DUP_C2 1
#define DUP_E 1
#define EXTRA_SYNC 0
#define GSYNC() do { xcd_barrier(xb); for (int q_ = 0; q_ < EXTRA_SYNC; ++q_) xcd_barrier(xb); } while (0)
#define DUP_LRU1 1
#define DUP_LRU3 1
#define DUP_PROJ 1

#define OFF_WINA 0
#define OFF_WINB (OFF_WINA + 2560 * 1024)
#define OFF_WGATE (OFF_WINB + 1792 * 1024)
#define OFF_WBR (OFF_WGATE + 4096 * 1024)
#define OFF_WOUT (OFF_WBR + 4 * 1024 * 512)
#define OFF_WFF13 (OFF_WOUT + 1024 * 1024)
#define OFF_WFF2 (OFF_WFF13 + 5632 * 1024)
#define OFF_WQUP (OFF_WFF2 + 1024 * 2816)
#define OFF_WKVUP (OFF_WQUP + 768 * 384)
#define OFF_WS (OFF_WKVUP + 1024 * 256)
#define OFF_WLRU (OFF_WS + 4 * 128 * 128)
#define W_ELEMS (OFF_WLRU + 2 * 8 * 4 * 32 * 64)

struct P {
  const float *x, *c, *ctx, *c_ctx, *w_mod, *b_mod, *norm1_g, *norm2_g, *w_in, *conv_a_w, *lru_conv_w, *lru_conv_b,
      *lru_w_a, *lru_b_a, *lru_w_x, *lru_b_x, *lru_lam, *cmlp_ln_g, *cmlp_ln_b, *cmlp_w_s, *cmlp_b_s, *q_norm_g,
      *kv_norm_g, *w_q_up, *w_kv_up, *w_branch, *w_out, *w_ff1, *w_ff3, *w_ff2, *final_g;
  float *out, *Xc, *mod, *rope;
  float2* summ;
  float* ssq;
  unsigned* bar;
  u16 *W, *H, *Ycat, *R1, *Q, *K, *Vt;
};

__device__ __forceinline__ uint32_t pack2(float a, float b) { uint32_t r; asm("v_cvt_pk_bf16_f32 %0, %1, %2" : "=v"(r) : "v"(a), "v"(b)); return r; }
__device__ __forceinline__ u16 f2bf(float f) { return (u16)(pack2(f, f) & 0xffffu); }
__device__ __forceinline__ float bf2f(u16 h) { return __uint_as_float(((uint32_t)h) << 16); }
__device__ __forceinline__ float sigmoidf_(float x) { return 1.f / (1.f + __expf(-x)); }
__device__ __forceinline__ float sigmoid_rcp_(float x) { return __builtin_amdgcn_rcpf(1.f + __expf(-x)); }
__device__ __forceinline__ float siluf_(float x) { return x * __builtin_amdgcn_rcpf(1.f + __expf(-x)); }
__device__ __forceinline__ float geluf_(float x) {
  float u = 0.7978845608028654f * (x + 0.044715f * x * x * x);
  return x * __builtin_amdgcn_rcpf(1.f + __expf(-2.f * u));
}
__device__ __forceinline__ void unpack8(const uint4& v, float* f) {
  f[0] = __uint_as_float(v.x << 16); f[1] = __uint_as_float(v.x & 0xffff0000u);
  f[2] = __uint_as_float(v.y << 16); f[3] = __uint_as_float(v.y & 0xffff0000u);
  f[4] = __uint_as_float(v.z << 16); f[5] = __uint_as_float(v.z & 0xffff0000u);
  f[6] = __uint_as_float(v.w << 16); f[7] = __uint_as_float(v.w & 0xffff0000u);
}
__device__ __forceinline__ uint4 pack8(const float* f) {
  uint4 v; v.x = pack2(f[0], f[1]); v.y = pack2(f[2], f[3]); v.z = pack2(f[4], f[5]); v.w = pack2(f[6], f[7]); return v;
}
template <int CTRL, int ROWMASK>
__device__ __forceinline__ float dpp0f(float src) {
  return __int_as_float(__builtin_amdgcn_update_dpp(0, __float_as_int(src), CTRL, ROWMASK, 0xf, false));
}
__device__ __forceinline__ float wave_sum(float v) {
  v += dpp0f<0x111, 0xf>(v); v += dpp0f<0x112, 0xf>(v); v += dpp0f<0x114, 0xf>(v); v += dpp0f<0x118, 0xf>(v);
  v += dpp0f<0x142, 0xa>(v); v += dpp0f<0x143, 0xc>(v);
  return __int_as_float(__builtin_amdgcn_readlane(__float_as_int(v), 63));
}
__device__ __forceinline__ float* xrow_ptr(const P& p, int r) {
  int b = r / ST, t = r - b * ST;
  return t < SL ? p.out + ((size_t)(b * SL + t)) * DM : p.Xc + ((size_t)(b * SC + t - SL)) * DM;
}
__device__ __forceinline__ int mod_idx(int r) { int b = r / ST, t = r - b * ST; return t < SL ? b : 8; }

template <int MT>
__device__ __forceinline__ void gemm_main(const u16* __restrict__ A, int lda, const u16* __restrict__ B, int ldb, int K,
                                          u16* lds, f32x4 (&acc)[MT][4]) {
  constexpr int BM = MT * 64;
  constexpr int ASZ = BM * 72, BSZ = 128 * 72, STG = ASZ + BSZ;
  int tid = threadIdx.x; asm volatile("" : "+v"(tid));
  const int lane = tid & 63, wid = tid >> 6, wr = wid >> 1, wc = wid & 1, fr = lane & 15, fq = lane >> 4;
  uint4 ra[MT], rb[2];
  const int nk = K >> 6;
  const int crow = tid >> 3, ckc = (tid & 7) * 8;
#pragma unroll
  for (int i = 0; i < MT; ++i) ra[i] = *(const uint4*)(A + (size_t)(crow + i * 64) * lda + ckc);
#pragma unroll
  for (int i = 0; i < 2; ++i) rb[i] = *(const uint4*)(B + (size_t)(crow + i * 64) * ldb + ckc);
  {
    u16* sa = lds; u16* sb = lds + ASZ;
#pragma unroll
    for (int i = 0; i < MT; ++i) *(uint4*)(sa + (crow + i * 64) * 72 + ckc) = ra[i];
#pragma unroll
    for (int i = 0; i < 2; ++i) *(uint4*)(sb + (crow + i * 64) * 72 + ckc) = rb[i];
  }
  __syncthreads();
  for (int kt = 0; kt < nk; ++kt) {
    const bool more = (kt + 1 < nk);
    if (more) {
      const int k0 = (kt + 1) * 64 + ckc;
#pragma unroll
      for (int i = 0; i < MT; ++i) ra[i] = *(const uint4*)(A + (size_t)(crow + i * 64) * lda + k0);
#pragma unroll
      for (int i = 0; i < 2; ++i) rb[i] = *(const uint4*)(B + (size_t)(crow + i * 64) * ldb + k0);
    }
    const u16* sa = lds + (kt & 1) * STG;
    const u16* sb = sa + ASZ;
#pragma unroll
    for (int ks = 0; ks < 2; ++ks) {
      bf16x8 a[MT], b[4];
#pragma unroll
      for (int m = 0; m < MT; ++m) a[m] = *(const bf16x8*)(sa + (wr * MT * 16 + m * 16 + fr) * 72 + ks * 32 + fq * 8);
#pragma unroll
      for (int n = 0; n < 4; ++n) b[n] = *(const bf16x8*)(sb + (wc * 64 + n * 16 + fr) * 72 + ks * 32 + fq * 8);
#pragma unroll
      for (int m = 0; m < MT; ++m)
#pragma unroll
        for (int n = 0; n < 4; ++n) acc[m][n] = __builtin_amdgcn_mfma_f32_16x16x32_bf16(a[m], b[n], acc[m][n], 0, 0, 0);
    }
    if (more) {
      u16* wa = lds + ((kt + 1) & 1) * STG; u16* wb = wa + ASZ;
#pragma unroll
      for (int i = 0; i < MT; ++i) *(uint4*)(wa + (crow + i * 64) * 72 + ckc) = ra[i];
#pragma unroll
      for (int i = 0; i < 2; ++i) *(uint4*)(wb + (crow + i * 64) * 72 + ckc) = rb[i];
    }
    __syncthreads();
  }
}

__device__ __forceinline__ void gemm_main128(const u16* __restrict__ A, int lda, const u16* __restrict__ B, int ldb, int K,
                                             u16* lds, f32x4 (&acc)[2][4]) {
  constexpr int RS = 136, ASZ = 128 * RS, BSZ = 128 * RS, STG = ASZ + BSZ;
  int tid = threadIdx.x; asm volatile("" : "+v"(tid));
  const int lane = tid & 63, wid = tid >> 6, wr = wid >> 1, wc = wid & 1, fr = lane & 15, fq = lane >> 4;
  const int r0 = tid >> 4, kc8 = (tid & 15) * 8;
  uint4 a0, a1, a2, a3, b0, b1, b2, b3;
  const int nk = K >> 7;
#define G128_LD(kt) do { const int k0_ = (kt) * 128 + kc8; \
    a0 = *(const uint4*)(A + (size_t)(r0) * lda + k0_); a1 = *(const uint4*)(A + (size_t)(r0 + 32) * lda + k0_); \
    a2 = *(const uint4*)(A + (size_t)(r0 + 64) * lda + k0_); a3 = *(const uint4*)(A + (size_t)(r0 + 96) * lda + k0_); \
    b0 = *(const uint4*)(B + (size_t)(r0) * ldb + k0_); b1 = *(const uint4*)(B + (size_t)(r0 + 32) * ldb + k0_); \
    b2 = *(const uint4*)(B + (size_t)(r0 + 64) * ldb + k0_); b3 = *(const uint4*)(B + (size_t)(r0 + 96) * ldb + k0_); } while (0)
#define G128_ST(st) do { u16* sa_ = lds + (st) * STG; u16* sb_ = sa_ + ASZ; \
    *(uint4*)(sa_ + (r0) * RS + kc8) = a0; *(uint4*)(sa_ + (r0 + 32) * RS + kc8) = a1; *(uint4*)(sa_ + (r0 + 64) * RS + kc8) = a2; *(uint4*)(sa_ + (r0 + 96) * RS + kc8) = a3; \
    *(uint4*)(sb_ + (r0) * RS + kc8) = b0; *(uint4*)(sb_ + (r0 + 32) * RS + kc8) = b1; *(uint4*)(sb_ + (r0 + 64) * RS + kc8) = b2; *(uint4*)(sb_ + (r0 + 96) * RS + kc8) = b3; } while (0)
  G128_LD(0); G128_ST(0);
  __syncthreads();
  for (int kt = 0; kt < nk; ++kt) {
    const bool more = (kt + 1 < nk);
    if (more) G128_LD(kt + 1);
    const u16* sa = lds + (kt & 1) * STG;
    const u16* sb = sa + ASZ;
#pragma unroll
    for (int ks = 0; ks < 4; ++ks) {
      bf16x8 a[2], b[4];
#pragma unroll
      for (int m = 0; m < 2; ++m) a[m] = *(const bf16x8*)(sa + (wr * 32 + m * 16 + fr) * RS + ks * 32 + fq * 8);
#pragma unroll
      for (int n = 0; n < 4; ++n) b[n] = *(const bf16x8*)(sb + (wc * 64 + n * 16 + fr) * RS + ks * 32 + fq * 8);
#pragma unroll
      for (int m = 0; m < 2; ++m)
#pragma unroll
        for (int n = 0; n < 4; ++n) acc[m][n] = __builtin_amdgcn_mfma_f32_16x16x32_bf16(a[m], b[n], acc[m][n], 0, 0, 0);
    }
    if (more) G128_ST((kt + 1) & 1);
    __syncthreads();
  }
#undef G128_LD
#undef G128_ST
}

template <int MT, class Pre, class Epi>
__device__ __forceinline__ void gemm_phase(const u16* A, int lda, const u16* B, int ldb, int K, int nct, u16* lds, Pre pre,
                                           Epi epi, int id0, int idstride, int idoff) {
  constexpr int BM = MT * 64;
  const int nrt = MTOT / BM, ntile = nrt * nct;
  int first = id0;
  if (first < idoff) { int kk = (idoff - first + idstride - 1) / idstride; first += kk * idstride; }
  for (int gid = first; gid < idoff + ntile; gid += idstride) {
    int id = gid - idoff;
    int g = id / (8 * nct), rem = id - g * 8 * nct;
    int ct = rem >> 3, rt = g * 8 + (rem & 7);
    f32x4 acc[MT][4];
#pragma unroll
    for (int m = 0; m < MT; ++m)
#pragma unroll
      for (int n = 0; n < 4; ++n) acc[m][n] = (f32x4){0.f, 0.f, 0.f, 0.f};
    pre(rt * BM);
    gemm_main<MT>(A + (size_t)rt * BM * lda, lda, B + (size_t)ct * 128 * ldb, ldb, K, lds, acc);
    epi(rt * BM, ct * 128, acc);
    __syncthreads();
  }
}

#define LAS3 __attribute__((address_space(3)))
namespace g8 {
constexpr int BM = 256, BK = 64, HALF = 128, HTB = HALF * BK * 2, STAGE_BYTES = 8 * HTB, NXCD = 8, WGM = 8;
__device__ __forceinline__ int lds_byte(int r, int c) { const int st = (r >> 4) * 2 + (c >> 5), rr = r & 15, cc = c & 31, ob = rr * 64 + cc * 2; return st * 1024 + (ob ^ (((ob >> 9) & 1) << 5)); }
__device__ __forceinline__ void stage_rc(int b, int& R, int& C) { const int st = b / 1024, sb = b % 1024, swz = sb ^ (((sb >> 9) & 1) << 5); R = (st >> 1) * 16 + swz / 64; C = (st & 1) * 32 + (swz % 64) / 2; }
__device__ __forceinline__ int perm32(int rho) { const int n = rho >> 4, i = rho & 15; return 8 * (i >> 2) + 4 * n + (i & 3); }
struct Unit { const char* A; const char* B; int lda, K, pm, pn, aux; };
struct Order {
  int nM, nN, nwg, G, c;
  __device__ void init(int nM_, int nN_, int G_, int c_) { nM = nM_; nN = nN_; nwg = nM * nN; G = G_; c = c_; }
  __device__ bool tile(int i, int& pm, int& pn) const {
    const long L = (long)i * G + c; if (L >= nwg) return false;
    int wgid = (int)L; { const int q = nwg / NXCD, r = nwg % NXCD, xcd = wgid % NXCD, off = wgid / NXCD; wgid = (xcd < r ? xcd * (q + 1) : r * (q + 1) + (xcd - r) * q) + off; }
    const int nig = WGM * nN, gid = wgid / nig, fm = gid * WGM, gsz = (nM - fm) < WGM ? (nM - fm) : WGM;
    pm = fm + ((wgid % nig) % gsz); pn = (wgid % nig) / gsz;
    if (nM == 128) pm += pm >> 4;
    return true;
  }
};
struct Simple {
  Order o; const u16* A; const u16* Bt; int lda, K;
  __device__ bool next(int i, Unit& u) const {
    int pm, pn; if (!o.tile(i, pm, pn)) return false;
    u.A = (const char*)(A + (size_t)pm * 256 * lda); u.B = (const char*)(Bt + (size_t)pn * 256 * K); u.lda = lda; u.K = K; u.pm = pm; u.pn = pn; u.aux = 0; return true;
  }
};
__device__ __forceinline__ unsigned cvt_pk_bf16(float lo, float hi) { unsigned r; asm volatile("v_cvt_pk_bf16_f32 %0, %1, %2" : "=v"(r) : "v"(lo), "v"(hi)); return r; }

template <bool PERM, class Sched, class Epi>
__device__ __forceinline__ void gemm_phase(LAS3 unsigned char* lds, const Sched& S, const Epi& E) {
  int tid = threadIdx.x; asm volatile("" : "+v"(tid));
  const int wid = __builtin_amdgcn_readfirstlane(tid >> 6), lane = tid & 63, wr = wid >> 2, wc = wid & 3, fr = lane & 15, fq = lane >> 4;
  const size_t kstep = (size_t)(BK * 2);
#define G8_VOFF(LDA_, K_) do { int _t2 = tid; asm volatile("" : "+v"(_t2)); _Pragma("unroll") for (int _i = 0; _i < 2; ++_i) { int R, C; stage_rc(_t2 * 16 + _i * 8192, R, C); \
    const int Rb = PERM ? ((R & ~31) + perm32(R & 31)) : R; voffA[_i] = (unsigned)(R * (LDA_) + C) * 2u; voffB[_i] = (unsigned)(Rb * (K_) + C) * 2u; } \
    hstepA = (size_t)HALF * (LDA_) * 2; hstepB = (size_t)HALF * (K_) * 2; } while (0)
  const unsigned ldsw = (unsigned)wid * 1024u;
  const int aoff = lds_byte(wr * 64 + fr, fq * 8), boff = lds_byte(wc * 32 + fr, fq * 8);
#define G8_SA(b, h) (((b) * 2 + (h)) * HTB)
#define G8_SB(b, h) ((4 + (b) * 2 + (h)) * HTB)
#define G8_STAGE(bufoff, gbase, voff) do { _Pragma("unroll") for (int _i = 0; _i < 2; ++_i) \
    __builtin_amdgcn_global_load_lds((const unsigned*)((const char*)(gbase) + (voff)[_i]), (LAS3 unsigned*)(lds + (bufoff) + ldsw + _i * 8192), 16, 0, 0); } while (0)
#define G8_LDA(dst, b, h) do { _Pragma("unroll") for (int m = 0; m < 4; ++m) _Pragma("unroll") for (int k = 0; k < 2; ++k) dst[m][k] = *(const LAS3 bf16x8*)(lds + G8_SA(b, h) + aoff + m * 2048 + k * 1024); } while (0)
#define G8_LDB(dst, b, h) do { _Pragma("unroll") for (int n = 0; n < 2; ++n) _Pragma("unroll") for (int k = 0; k < 2; ++k) dst[n][k] = *(const LAS3 bf16x8*)(lds + G8_SB(b, h) + boff + n * 2048 + k * 1024); } while (0)
#define G8_MMA(ai, bj, At, Bt) do { __builtin_amdgcn_s_setprio(1); _Pragma("unroll") for (int m = 0; m < 4; ++m) _Pragma("unroll") for (int n = 0; n < 2; ++n) _Pragma("unroll") for (int k = 0; k < 2; ++k) \
    acc[ai][bj][m][n] = __builtin_amdgcn_mfma_f32_16x16x32_bf16(Bt[n][k], At[m][k], acc[ai][bj][m][n], 0, 0, 0); __builtin_amdgcn_s_setprio(0); } while (0)
#define G8_WAIT_V(n) asm volatile("s_waitcnt vmcnt(" #n ")" ::: "memory")
#define G8_WAIT_L(n) asm volatile("s_waitcnt lgkmcnt(" #n ")" ::: "memory")
#define G8_BAR __builtin_amdgcn_s_barrier()
#define G8_SCHED __builtin_amdgcn_sched_barrier(0)
  Unit cur, nxt; int ui = 0;
  if (!S.next(0, cur)) return;
  f32x4 acc[2][2][4][2];
#pragma unroll
  for (int a = 0; a < 2; ++a)
#pragma unroll
    for (int b = 0; b < 2; ++b)
#pragma unroll
      for (int m = 0; m < 4; ++m)
#pragma unroll
        for (int n = 0; n < 2; ++n) acc[a][b][m][n] = (f32x4){0.f, 0.f, 0.f, 0.f};
  bf16x8 At[4][2], B0[2][2], B1[2][2];
  const char* cA = cur.A; const char* cB = cur.B;
  unsigned voffA[2], voffB[2];
  size_t hstepA, hstepB;
  G8_VOFF(cur.lda, cur.K);
  G8_STAGE(G8_SB(0, 0), cB, voffB); G8_STAGE(G8_SA(0, 0), cA, voffA); G8_STAGE(G8_SB(0, 1), cB + hstepB, voffB); G8_STAGE(G8_SA(0, 1), cA + hstepA, voffA);
  if (wr == 1) G8_BAR;
  G8_WAIT_V(4); G8_BAR;
  G8_STAGE(G8_SB(1, 0), cB + kstep, voffB); G8_STAGE(G8_SA(1, 0), cA + kstep, voffA); G8_STAGE(G8_SB(1, 1), cB + hstepB + kstep, voffB);
  G8_WAIT_V(6); G8_BAR;
  for (;;) {
    const bool has_next = S.next(ui + 1, nxt);
    if (!has_next) nxt = cur;
    const char* nA = nxt.A; const char* nB = nxt.B;
    const int nt = cur.K / BK;
    for (int t = 0; t < nt; t += 2) {
      const bool last = (t == nt - 2);
      const char* a1 = cA + (size_t)(t + 1) * kstep;
      const char* a2 = last ? nA : cA + (size_t)(t + 2) * kstep; const char* b2 = last ? nB : cB + (size_t)(t + 2) * kstep;
      const char* a3 = a2 + kstep; const char* b3 = b2 + kstep;
      G8_LDB(B0, 0, 0); G8_SCHED; G8_LDA(At, 0, 0); G8_STAGE(G8_SA(1, 1), a1 + hstepA, voffA);
      G8_WAIT_L(8); G8_BAR; G8_WAIT_L(0); G8_MMA(0, 0, At, B0); G8_BAR; G8_SCHED;
      if (last) G8_VOFF(nxt.lda, nxt.K);
      G8_LDB(B1, 0, 1); G8_STAGE(G8_SB(0, 0), b2, voffB);
      G8_BAR; G8_WAIT_L(0); G8_MMA(0, 1, At, B1); G8_BAR;
      G8_LDA(At, 0, 1); G8_STAGE(G8_SA(0, 0), a2, voffA);
      G8_BAR; G8_WAIT_L(0); G8_MMA(1, 0, At, B0); G8_BAR; G8_SCHED;
      G8_STAGE(G8_SB(0, 1), b2 + hstepB, voffB);
      G8_WAIT_V(6); G8_BAR; G8_MMA(1, 1, At, B1); G8_BAR;
      G8_LDB(B0, 1, 0); G8_SCHED; G8_LDA(At, 1, 0); G8_STAGE(G8_SA(0, 1), a2 + hstepA, voffA);
      G8_WAIT_L(8); G8_BAR; G8_WAIT_L(0); G8_MMA(0, 0, At, B0); G8_BAR; G8_SCHED;
      G8_LDB(B1, 1, 1); G8_STAGE(G8_SB(1, 0), b3, voffB);
      G8_BAR; G8_WAIT_L(0); G8_MMA(0, 1, At, B1); G8_BAR;
      G8_LDA(At, 1, 1); G8_STAGE(G8_SA(1, 0), a3, voffA);
      G8_BAR; G8_WAIT_L(0); G8_MMA(1, 0, At, B0); G8_BAR; G8_SCHED;
      G8_STAGE(G8_SB(1, 1), b3 + hstepB, voffB);
      G8_WAIT_V(6); G8_BAR; G8_MMA(1, 1, At, B1); G8_BAR;
    }
    E(acc, cur, wr, wc, fr, fq, tid);
    if (!has_next) break;
#pragma unroll
    for (int a = 0; a < 2; ++a)
#pragma unroll
      for (int b = 0; b < 2; ++b)
#pragma unroll
        for (int m = 0; m < 4; ++m)
#pragma unroll
          for (int n = 0; n < 2; ++n) acc[a][b][m][n] = (f32x4){0.f, 0.f, 0.f, 0.f};
    cur = nxt; cA = nA; cB = nB; ++ui;
  }
  G8_WAIT_V(0);
  if (wr == 0) G8_BAR;
  G8_BAR;
#undef G8_VOFF
#undef G8_SA
#undef G8_SB
#undef G8_STAGE
#undef G8_LDA
#undef G8_LDB
#undef G8_MMA
#undef G8_WAIT_V
#undef G8_WAIT_L
#undef G8_BAR
#undef G8_SCHED
}
}

__device__ __forceinline__ void convT_job(const float* src0, const float* src1, int ldsrc, int kind, int off, int nvalid, u16* dst, int K,
                          int Ndst, const float* kscale, float mult, float* lds) {
  int tid = threadIdx.x; asm volatile("" : "+v"(tid));
  const int nkt = K >> 6, nitems = nkt * (Ndst >> 7);
  for (int it = blockIdx.x; it < nitems; it += gridDim.x) {
    const int kt = it % nkt, nt = it / nkt;
    float v[16];
#pragma unroll
    for (int e = 0; e < 16; ++e) {
      int idx = tid + e * 512, i = idx >> 7, j = idx & 127, n = nt * 128 + j, k = kt * 64 + i;
      if (kind == 0) {
        v[e] = (n < nvalid) ? src0[(size_t)k * ldsrc + off + n] : 0.f;
      } else {
        int g = n >> 8, w = n & 255;
        const float* sp = (w < 128) ? src0 : src1;
        v[e] = sp[(size_t)k * ldsrc + g * 128 + (w & 127)];
      }
    }
#pragma unroll
    for (int e = 0; e < 16; ++e) {
      int idx = tid + e * 512, i = idx >> 7, j = idx & 127, k = kt * 64 + i;
      float x = v[e];
      if (kscale) x *= kscale[k];
      lds[j * 65 + i] = x * mult;
    }
    __syncthreads();
#pragma unroll
    for (int e = 0; e < 8; ++e) {
      int idx = tid + e * 512, j = idx >> 5, i2 = (idx & 31) * 2;
      *(uint32_t*)(dst + (size_t)(nt * 128 + j) * K + kt * 64 + i2) = pack2(lds[j * 65 + i2], lds[j * 65 + i2 + 1]);
    }
    __syncthreads();
  }
}

__device__ void convert_weights(const P& p, int l, float* lds) {
  const float* win = p.w_in + (size_t)l * 1024 * 8352;
#pragma unroll 1
  for (int job = 0; job < 12; ++job) {
    const float* s0 = win; const float* s1 = nullptr; const float* ksc = nullptr;
    int ldsrc = 8352, kind = 0, off = 0, nvalid = 0, K = 1024, Ndst = 0; float mult = 1.f; u16* dst = p.W;
    if (job == 0) { off = 1696; nvalid = 2560; dst += OFF_WINA; Ndst = 2560; }
    else if (job == 1) { off = 0; nvalid = 1696; dst += OFF_WINB; Ndst = 1792; }
    else if (job == 2) { off = 4256; nvalid = 4096; dst += OFF_WGATE; Ndst = 4096; }
    else if (job < 7) { const int n = job - 3; s0 = p.w_branch + ((size_t)l * 4 + n) * 512 * 1024; ldsrc = 1024; nvalid = 1024; dst += OFF_WBR + (size_t)n * 1024 * 512; K = 512; Ndst = 1024; }
    else if (job == 7) { s0 = p.w_out + (size_t)l * 1024 * 1024; ldsrc = 1024; nvalid = 1024; dst += OFF_WOUT; Ndst = 1024; }
    else if (job == 8) { s0 = p.w_ff1 + (size_t)l * 1024 * 2816; s1 = p.w_ff3 + (size_t)l * 1024 * 2816; ldsrc = 2816; kind = 1; dst += OFF_WFF13; Ndst = 5632; }
    else if (job == 9) { s0 = p.w_ff2 + (size_t)l * 2816 * 1024; ldsrc = 1024; nvalid = 1024; dst += OFF_WFF2; K = 2816; Ndst = 1024; }
    else if (job == 10) { s0 = p.w_q_up + (size_t)l * 384 * 768; ldsrc = 768; nvalid = 768; dst += OFF_WQUP; K = 384; Ndst = 768; ksc = p.q_norm_g + l * 384; mult = 0.10206207261596575f * 1.4426950408889634f; }
    else { s0 = p.w_kv_up + (size_t)l * 256 * 1024; ldsrc = 1024; nvalid = 1024; dst += OFF_WKVUP; K = 256; Ndst = 1024; ksc = p.kv_norm_g + l * 256; }
    convT_job(s0, s1, ldsrc, kind, off, nvalid, dst, K, Ndst, ksc, mult, lds);
  }
  int tidc = threadIdx.x; asm volatile("" : "+v"(tidc));
  const int gt = blockIdx.x * NTHR + tidc, gs = gridDim.x * NTHR;
  for (int i = gt; i < 4 * 128 * 128; i += gs) p.W[OFF_WS + i] = f2bf(p.cmlp_w_s[(size_t)l * 65536 + i]);
  for (int i = gt; i < 2 * 8 * 128 * 64; i += gs) {
    int k = i & 63, n = (i >> 6) & 127, h = (i >> 13) & 7, d = i >> 16;
    const float* src = (n < 64) ? p.lru_w_a : p.lru_w_x;
    p.W[OFF_WLRU + i] = f2bf(src[((((size_t)l * 2 + d) * 8 + h) * 64 + k) * 64 + (n & 63)]);
  }
}

__device__ void phase0(const P& p, unsigned char* smem) {
  int tid = threadIdx.x; asm volatile("" : "+v"(tid));
  const int gt = blockIdx.x * NTHR + tid, gs = gridDim.x * NTHR;
  {
    const float4* s = (const float4*)p.x; float4* d = (float4*)p.out;
    for (int i = gt; i < NB * SL * DM / 4; i += gs) d[i] = s[i];
    const float4* s2 = (const float4*)p.ctx; float4* d2 = (float4*)p.Xc;
    for (int i = gt; i < NB * SC * DM / 4; i += gs) d2[i] = s2[i];
  }
  for (int idx = gt; idx < SL * 8; idx += gs) {
    int t = idx >> 3, i = idx & 7;
    float inv = exp2f(-(float)i * 0.125f * 13.287712379549449f);
    float ar = (float)(t >> 6) * inv, ac = (float)(t & 63) * inv;
    const float i2pi = 0.15915494309189535f;
    float rr = ar * i2pi; rr -= floorf(rr); rr *= 6.283185307179586f;
    float rc = ac * i2pi; rc -= floorf(rc); rc *= 6.283185307179586f;
    p.rope[t * 32 + i] = __cosf(rr); p.rope[t * 32 + 8 + i] = __sinf(rr);
    p.rope[t * 32 + 16 + i] = __cosf(rc); p.rope[t * 32 + 24 + i] = __sinf(rc);
  }
  float* sS = (float*)smem; float* red = sS + 9 * 1024;
  for (int it = blockIdx.x; it < 4 * 96; it += gridDim.x) {
    const int l = it / 96, cgp = it - l * 96;
    for (int idx = tid; idx < 9216; idx += 512) {
      int m = idx >> 10, k = idx & 1023;
      float v = (m < 8) ? p.c[m * 1024 + k] : p.c_ctx[k];
      sS[idx] = siluf_(v);
    }
    __syncthreads();
    const int cj = tid & 63, kp = tid >> 6, j = cgp * 64 + cj;
    float a[9];
#pragma unroll
    for (int m = 0; m < 9; ++m) a[m] = 0.f;
    for (int k0 = kp * 128; k0 < kp * 128 + 128; k0 += 16) {
      float w[16];
#pragma unroll
      for (int u = 0; u < 16; ++u) w[u] = p.w_mod[((size_t)l * 1024 + k0 + u) * 6144 + j];
#pragma unroll
      for (int u = 0; u < 16; ++u)
#pragma unroll
        for (int m = 0; m < 9; ++m) a[m] += sS[m * 1024 + k0 + u] * w[u];
    }
#pragma unroll
    for (int m = 0; m < 9; ++m) red[(kp * 9 + m) * 64 + cj] = a[m];
    __syncthreads();
    for (int idx = tid; idx < 576; idx += 512) {
      int m = idx >> 6, c2 = idx & 63;
      float s = 0.f;
      for (int q = 0; q < 8; ++q) s += red[(q * 9 + m) * 64 + c2];
      p.mod[((size_t)l * 9 + m) * 6144 + cgp * 64 + c2] = s + p.b_mod[l * 6144 + cgp * 64 + c2];
    }
    __syncthreads();
  }
}

__device__ void norm_mod(const P& p, int l, const float* g, int off_sh, int off_sc) {
  int tid = threadIdx.x; asm volatile("" : "+v"(tid));
  const int lane = tid & 63, wid = tid >> 6;
  for (int r = blockIdx.x * 8 + wid; r < MTOT; r += gridDim.x * 8) {
    const float* xr = xrow_ptr(p, r);
    const float* md = p.mod + ((size_t)l * 9 + mod_idx(r)) * 6144;
    float4 v[4];
    float ss = 0.f;
#pragma unroll
    for (int i = 0; i < 4; ++i) {
      v[i] = *(const float4*)(xr + i * 256 + lane * 4);
      ss += v[i].x * v[i].x + v[i].y * v[i].y + v[i].z * v[i].z + v[i].w * v[i].w;
    }
    ss = wave_sum(ss);
    const float inv = rsqrtf(ss * (1.f / 1024.f) + EPS);
#pragma unroll
    for (int i = 0; i < 4; ++i) {
      const int k = i * 256 + lane * 4;
      float4 gg = *(const float4*)(g + k);
      float4 sh = *(const float4*)(md + off_sh + k);
      float4 sc = *(const float4*)(md + off_sc + k);
      float o0 = v[i].x * inv * gg.x * (1.f + sc.x) + sh.x;
      float o1 = v[i].y * inv * gg.y * (1.f + sc.y) + sh.y;
      float o2 = v[i].z * inv * gg.z * (1.f + sc.z) + sh.z;
      float o3 = v[i].w * inv * gg.w * (1.f + sc.w) + sh.w;
      uint2 o; o.x = pack2(o0, o1); o.y = pack2(o2, o3);
      *(uint2*)(p.H + (size_t)r * 1024 + k) = o;
    }
  }
}

__device__ void conva_item(const P& p, int l, int item) {
  int tid = threadIdx.x; asm volatile("" : "+v"(tid));
  const u16* Zb1 = p.R1;
  const float* cw = p.conv_a_w + (size_t)l * 3 * 512;
  for (int e = 0; e < 32; ++e) {
    int idx = tid + e * 512, rr = idx >> 6, cgp = idx & 63;
    int r = item * 256 + rr;
    int b = r / ST, t = r - b * ST;
    int isctx = t >= SL, pos = isctx ? t - SL : t, seglen = isctx ? SC : SL;
    float acc[8];
#pragma unroll
    for (int i = 0; i < 8; ++i) acc[i] = 0.f;
#pragma unroll
    for (int k = 0; k < 3; ++k) {
      int pos2 = pos - 1 + k;
      if (pos2 >= 0 && pos2 < seglen) {
        size_t r2 = (size_t)(r - 1 + k);
        uint4 vc = *(const uint4*)(Zb1 + r2 * 2560 + 512 + cgp * 8);
        uint4 vx = *(const uint4*)(Zb1 + r2 * 2560 + 1024 + cgp * 8);
        float fc[8], fx[8];
        unpack8(vc, fc); unpack8(vx, fx);
#pragma unroll
        for (int i = 0; i < 8; ++i) acc[i] += cw[k * 512 + cgp * 8 + i] * (fc[i] * fx[i]);
      }
    }
    uint4 vb = *(const uint4*)(Zb1 + (size_t)r * 2560 + cgp * 8);
    float fb[8];
    unpack8(vb, fb);
#pragma unroll
    for (int i = 0; i < 8; ++i) acc[i] *= fb[i];
    *(uint4*)(p.Ycat + (size_t)r * 2048 + cgp * 8) = pack8(acc);
  }
}

__device__ void cmlp_item(const P& p, int l, int item, unsigned char* smem) {
  int tid = threadIdx.x; asm volatile("" : "+v"(tid));
  const int lane = tid & 63, wid = tid >> 6, fr = lane & 15, fq = lane >> 4;
  const int g = item & 3, bj = item >> 2;
  const int rowbase = bj * 128;
  u16* vT = (u16*)smem;
  float* sMu = (float*)(smem + 128 * 136 * 2);
  float* sRs = sMu + 128;
  const u16* Zb1 = p.R1;
  {
    uint4 vv[16];
#pragma unroll
    for (int rr = 0; rr < 16; ++rr) vv[rr] = *(const uint4*)(Zb1 + (size_t)(rowbase + wid * 16 + rr) * 2560 + 2048 + lane * 8);
#pragma unroll
    for (int rr = 0; rr < 16; ++rr) {
      int q = wid * 16 + rr;
      float f[8];
      unpack8(vv[rr], f);
      float s = 0.f;
#pragma unroll
      for (int i = 0; i < 8; ++i) { f[i] = geluf_(f[i]); s += f[i]; }
      s = wave_sum(s);
      float mu = s * (1.f / 512.f);
      float d2 = 0.f;
#pragma unroll
      for (int i = 0; i < 8; ++i) { float d = f[i] - mu; d2 += d * d; }
      d2 = wave_sum(d2);
      if (lane == 0) { sMu[q] = mu; sRs[q] = rsqrtf(d2 * (1.f / 512.f) + EPS); }
    }
  }
  __syncthreads();
  const float* lg = p.cmlp_ln_g + l * 512 + g * 128;
  const float* lb = p.cmlp_ln_b + l * 512 + g * 128;
#pragma unroll
  for (int e = 0; e < 4; ++e) {
    int idx = tid + e * 512, q = idx >> 4, dc = idx & 15;
    uint4 v = *(const uint4*)(Zb1 + (size_t)(rowbase + q) * 2560 + 2048 + g * 128 + dc * 8);
    float f[8];
    unpack8(v, f);
    float mu = sMu[q], rs = sRs[q];
#pragma unroll
    for (int i = 0; i < 8; ++i) {
      float val = (geluf_(f[i]) - mu) * rs * lg[dc * 8 + i] + lb[dc * 8 + i];
      vT[(dc * 8 + i) * 136 + q] = f2bf(val);
    }
  }
  __syncthreads();
  const u16* Ws = p.W + OFF_WS + (size_t)g * 128 * 128;
  f32x4 acc[8];
#pragma unroll
  for (int n = 0; n < 8; ++n) acc[n] = (f32x4){0.f, 0.f, 0.f, 0.f};
#pragma unroll
  for (int ks = 0; ks < 4; ++ks) {
    bf16x8 a = *(const bf16x8*)(Ws + (wid * 16 + fr) * 128 + ks * 32 + fq * 8);
#pragma unroll
    for (int n = 0; n < 8; ++n) {
      bf16x8 bb = *(const bf16x8*)(vT + (n * 16 + fr) * 136 + ks * 32 + fq * 8);
      acc[n] = __builtin_amdgcn_mfma_f32_16x16x32_bf16(bb, a, acc[n], 0, 0, 0);
    }
  }
  {
    const int pp = wid * 16 + fr;
    const size_t r = (size_t)(rowbase + pp);
    const float bsv = p.cmlp_b_s[((size_t)l * 4 + g) * 128 + pp];
    uint2 uu[8];
#pragma unroll
    for (int n = 0; n < 8; ++n) uu[n] = *(const uint2*)(Zb1 + r * 2560 + 1536 + g * 128 + n * 16 + fq * 4);
#pragma unroll
    for (int n = 0; n < 8; ++n) {
      float u0 = __uint_as_float(uu[n].x << 16), u1 = __uint_as_float(uu[n].x & 0xffff0000u);
      float u2 = __uint_as_float(uu[n].y << 16), u3 = __uint_as_float(uu[n].y & 0xffff0000u);
      uint2 ov;
      ov.x = pack2(geluf_(u0) * (acc[n][0] + bsv), geluf_(u1) * (acc[n][1] + bsv));
      ov.y = pack2(geluf_(u2) * (acc[n][2] + bsv), geluf_(u3) * (acc[n][3] + bsv));
      *(uint2*)(p.Ycat + r * 2048 + 1024 + g * 128 + n * 16 + fq * 4) = ov;
    }
  }
  __syncthreads();
}

template <int CTRL, int ROWMASK>
__device__ __forceinline__ float dppf(float old, float src) {
  return __int_as_float(__builtin_amdgcn_update_dpp(__float_as_int(old), __float_as_int(src), CTRL, ROWMASK, 0xf, false));
}
#define LSCAN_STEP(A_, B_, CTRL, RM) do { const float A2_ = dppf<CTRL, RM>(1.f, A_), B2_ = dppf<CTRL, RM>(0.f, B_); B_ = A_ * B2_ + B_; A_ = A_ * A2_; } while (0)
#define LSCAN64(A_, B_) do { LSCAN_STEP(A_, B_, 0x111, 0xf); LSCAN_STEP(A_, B_, 0x112, 0xf); LSCAN_STEP(A_, B_, 0x114, 0xf); LSCAN_STEP(A_, B_, 0x118, 0xf); \
    LSCAN_STEP(A_, B_, 0x142, 0xa); LSCAN_STEP(A_, B_, 0x143, 0xc); } while (0)

template <int PASS>
__device__ void lru_run(const P& p, int l, int it_first, int it_stride, unsigned char* smem) {
  int tid = threadIdx.x; asm volatile("" : "+v"(tid));
  const int lane = tid & 63, wid = tid >> 6, fr = lane & 15, fq = lane >> 4;
  u16* sX = (u16*)smem;
  float* sA = (float*)(smem + 18432);
  float* sB = sA + 64 * 130;
  float* sH = sB + 64 * 130;
  float* sCw = sH + 128 * 65;
  float* sCarry = sCw + 320;
  float* sPar = sCarry + 128;
  u16* sW = (u16*)(sPar + 384);
  const u16* Zb2 = p.R1;
  int cur_h = -1;
  uint4 cv[2][4];
#define LRU_LOADCV(ITEM) do { const int h_ = (ITEM) & 7, bj_ = (ITEM) >> 3; const int b_ = bj_ / 34, j_ = bj_ - b_ * 34; const int ic_ = j_ >= 32; \
    const int p0_ = ic_ ? (j_ - 32) * 128 : j_ * 128, sl_ = ic_ ? SC : SL, rs_ = bj_ * 128 - p0_; \
    _Pragma("unroll") for (int e = 0; e < 2; ++e) { int idx = tid + e * 512, pp = idx >> 3, cgp = idx & 7; \
      _Pragma("unroll") for (int k = 0; k < 4; ++k) { int pos = p0_ + pp - 2 + k; cv[e][k] = make_uint4(0, 0, 0, 0); \
        if (pos >= 0 && pos < sl_) cv[e][k] = *(const uint4*)(Zb2 + (size_t)(rs_ + pos) * 1792 + h_ * 64 + cgp * 8); } } } while (0)
  if (it_first < 2176) LRU_LOADCV(it_first);
  for (int item = it_first; item < 2176; item += it_stride) {
    const int h = item & 7, bj = item >> 3;
    const int b = bj / 34, j = bj - b * 34;
    const int rowbase = bj * 128;
    const int isctx = j >= 32;
    const int ordf = isctx ? j - 32 : j + 2, ordr = 33 - j;
    float cA[16], cB[16];
    uint4 gv[2];
    if (PASS == 3) {
#pragma unroll
      for (int q = 0; q < 16; ++q) {
        const int pi = wid * 16 + q, d = pi >> 6, ch = pi & 63, o = d ? ordr : ordf;
        cA[q] = 1.f; cB[q] = 0.f;
        if (lane < o) { float2 v = p.summ[((size_t)(b * 2 + d) * 512 + h * 64 + ch) * 34 + lane]; cA[q] = v.x; cB[q] = v.y; }
      }
#pragma unroll
      for (int e = 0; e < 2; ++e) {
        int idx = tid + e * 512, pos = idx >> 3, cgp = idx & 7;
        gv[e] = *(const uint4*)(Zb2 + (size_t)(rowbase + pos) * 1792 + 800 + h * 64 + cgp * 8);
      }
    }
    if (h != cur_h) {
      cur_h = h;
      __syncthreads();
      if (tid < 320) {
        int k = tid >> 6, i = tid & 63;
        sCw[tid] = (k < 4) ? p.lru_conv_w[((size_t)l * 4 + k) * 512 + h * 64 + i] : p.lru_conv_b[l * 512 + h * 64 + i];
      }
      if (tid < 128) {
        const int d = tid >> 6, ch = tid & 63;
        const size_t pidx = ((size_t)l * 2 + d) * 512 + h * 64 + ch;
        sPar[tid * 3] = p.lru_b_a[pidx]; sPar[tid * 3 + 1] = p.lru_b_x[pidx];
        sPar[tid * 3 + 2] = 8.f * log1pf(__expf(-p.lru_lam[pidx]));
      }
#pragma unroll
      for (int e = 0; e < 4; ++e) {
        int idx = tid + e * 512, row = idx >> 3, kc = idx & 7;
        const int d = row >> 7, n = row & 127;
        *(uint4*)(sW + row * 72 + kc * 8) = *(const uint4*)(p.W + OFF_WLRU + (size_t)((d * 8 + h) * 128 + n) * 64 + kc * 8);
      }
      __syncthreads();
    }
#pragma unroll
    for (int e = 0; e < 2; ++e) {
      int idx = tid + e * 512, pp = idx >> 3, cgp = idx & 7;
      float a8[8];
#pragma unroll
      for (int i = 0; i < 8; ++i) a8[i] = sCw[256 + cgp * 8 + i];
#pragma unroll
      for (int k = 0; k < 4; ++k) {
        float f[8];
        unpack8(cv[e][k], f);
#pragma unroll
        for (int i = 0; i < 8; ++i) a8[i] += sCw[k * 64 + cgp * 8 + i] * f[i];
      }
      *(uint4*)(sX + pp * 72 + cgp * 8) = pack8(a8);
    }
    if (item + it_stride < 2176) LRU_LOADCV(item + it_stride);
    if (PASS == 3) {
#pragma unroll
      for (int q = 0; q < 16; ++q) LSCAN64(cA[q], cB[q]);
      if (lane == 63) {
#pragma unroll
        for (int q = 0; q < 16; ++q) sCarry[wid * 16 + q] = cB[q];
      }
    }
    __syncthreads();
    for (int d = 0; d < 2; ++d) {
      const u16* Wl = sW + d * 128 * 72;
      f32x4 acc[8];
#pragma unroll
      for (int n = 0; n < 8; ++n) acc[n] = (f32x4){0.f, 0.f, 0.f, 0.f};
      {
        const bf16x8 a0 = *(const bf16x8*)(sX + (wid * 16 + fr) * 72 + fq * 8);
        const bf16x8 a1 = *(const bf16x8*)(sX + (wid * 16 + fr) * 72 + 32 + fq * 8);
#pragma unroll
        for (int n = 0; n < 8; ++n) {
          const bf16x8 b0 = *(const bf16x8*)(Wl + (n * 16 + fr) * 72 + fq * 8);
          const bf16x8 b1 = *(const bf16x8*)(Wl + (n * 16 + fr) * 72 + 32 + fq * 8);
          acc[n] = __builtin_amdgcn_mfma_f32_16x16x32_bf16(a0, b0, acc[n], 0, 0, 0);
          acc[n] = __builtin_amdgcn_mfma_f32_16x16x32_bf16(a1, b1, acc[n], 0, 0, 0);
        }
      }
#pragma unroll
      for (int nt = 0; nt < 4; ++nt) {
        const int ch = nt * 16 + fr;
        const float ba = sPar[(d * 64 + ch) * 3], bx = sPar[(d * 64 + ch) * 3 + 1], sp8 = sPar[(d * 64 + ch) * 3 + 2];
#pragma unroll
        for (int jj = 0; jj < 4; ++jj) {
          const int pos = wid * 16 + fq * 4 + jj;
          const float xl = bf2f(sX[pos * 72 + ch]);
          const float rg = sigmoid_rcp_(acc[nt][jj] + ba), ig = sigmoid_rcp_(acc[nt + 4][jj] + bx);
          const float la = -sp8 * rg;
          const float av = __expf(la);
          const float x2 = 2.f * la;
          const float ser = -x2 * (1.f + x2 * (0.5f + x2 * (0.16666667f + x2 * (0.041666667f + x2 * 0.0083333333f))));
          const float om = (x2 > -0.25f) ? ser : (1.f - av * av);
          const float bb = __builtin_amdgcn_sqrtf(om) * ig * xl;
          const int si = d ? 127 - pos : pos;
          sA[ch * 130 + si] = av;
          sB[ch * 130 + si] = bb;
        }
      }
      __syncthreads();
      {
        float a0[8], b0[8], A[8], B[8];
#pragma unroll
        for (int c = 0; c < 8; ++c) {
          const int ch = wid * 8 + c;
          const float2 va = *(const float2*)(sA + ch * 130 + 2 * lane), vb = *(const float2*)(sB + ch * 130 + 2 * lane);
          a0[c] = va.x; b0[c] = vb.x;
          A[c] = va.x * va.y; B[c] = va.y * vb.x + vb.y;
        }
#pragma unroll
        for (int c = 0; c < 8; ++c) LSCAN64(A[c], B[c]);
#pragma unroll
        for (int c = 0; c < 8; ++c) {
          const int ch = wid * 8 + c;
          if (PASS == 1) {
            if (lane == 63) p.summ[((size_t)(b * 2 + d) * 512 + h * 64 + ch) * 34 + (d ? ordr : ordf)] = make_float2(A[c], B[c]);
          } else {
            const float carry = sCarry[d * 64 + ch];
            const float hincl = A[c] * carry + B[c];
            const float hprev = dppf<0x138, 0xf>(carry, hincl);
            const float heven = a0[c] * hprev + b0[c];
            const int se = 2 * lane, pe = d ? 127 - se : se, po = d ? 126 - se : se + 1;
            if (d == 0) { sH[pe * 65 + ch] = heven; sH[po * 65 + ch] = hincl; }
            else { sH[pe * 65 + ch] += heven; sH[po * 65 + ch] += hincl; }
          }
        }
      }
      __syncthreads();
    }
    if (PASS == 3) {
#pragma unroll
      for (int e = 0; e < 2; ++e) {
        int idx = tid + e * 512, pos = idx >> 3, cgp = idx & 7;
        const size_t r = (size_t)(rowbase + pos);
        float gf[8], y[8];
        unpack8(gv[e], gf);
#pragma unroll
        for (int i = 0; i < 8; ++i) y[i] = geluf_(gf[i]) * sH[pos * 65 + cgp * 8 + i];
        *(uint4*)(p.Ycat + r * 2048 + 512 + h * 64 + cgp * 8) = pack8(y);
      }
      __syncthreads();
    }
  }
}

__device__ void krope_item(const P& p, int item) {
  int tid = threadIdx.x; asm volatile("" : "+v"(tid));
  const u16* Zb2 = p.R1;
#pragma unroll
  for (int e = 0; e < 8; ++e) {
    int idx = tid + e * 512, rr = idx >> 4, pi = idx & 15, axis = pi >> 3, i = pi & 7;
    int r = item * 256 + rr, b = r / ST, t = r - b * ST;
    float x1 = bf2f(Zb2[(size_t)r * 1792 + 768 + axis * 16 + i]);
    float x2 = bf2f(Zb2[(size_t)r * 1792 + 768 + axis * 16 + 8 + i]);
    float o1 = x1, o2 = x2;
    if (t < SL) {
      float cs = p.rope[t * 32 + axis * 16 + i], sn = p.rope[t * 32 + axis * 16 + 8 + i];
      o1 = x1 * cs - x2 * sn;
      o2 = x1 * sn + x2 * cs;
    }
    u16 b1 = f2bf(o1), b2 = f2bf(o2);
#pragma unroll
    for (int h = 0; h < 8; ++h) {
      size_t base = ((size_t)(b * 8 + h) * ST + t) * 96 + 64 + axis * 16 + i;
      p.K[base] = b1;
      p.K[base + 8] = b2;
    }
  }
}

__device__ void attn_item(const P& p, int item, unsigned char* smem) {
  int tid = threadIdx.x; asm volatile("" : "+v"(tid));
  const int lane = tid & 63, wid = tid >> 6, fr = lane & 15, fq = lane >> 4;
  int b, h, t0, kt0, kt1;
  if (item < 1024) { b = item >> 7; h = (item >> 4) & 7; t0 = (item & 15) * 256; kt0 = 0; kt1 = 68; }
  else { int i2 = item - 1024; b = i2 >> 3; h = i2 & 7; t0 = SL; kt0 = 64; kt1 = 68; }
  const u16* Kb = p.K + (size_t)(b * 8 + h) * ST * 96;
  const u16* Vb = p.Vt + (size_t)(b * 8 + h) * 64 * ST;
  const u16* Qb = p.Q + (size_t)(b * 8 + h) * ST * 96;
  constexpr int KS = 104, VS = 136, KSZ = 128 * KS, VSZ = 64 * VS, STG = KSZ + VSZ;
  u16* lds = (u16*)smem;
  bf16x8 qf[2][3];
#pragma unroll
  for (int nq = 0; nq < 2; ++nq)
#pragma unroll
    for (int ks = 0; ks < 3; ++ks)
      qf[nq][ks] = *(const bf16x8*)(Qb + (size_t)(t0 + wid * 32 + nq * 16 + fr) * 96 + ks * 32 + fq * 8);
  if (item < 1024) {
#pragma unroll
    for (int nq = 0; nq < 2; ++nq) {
      const int t = t0 + wid * 32 + nq * 16 + fr;
      const float* rp = p.rope + t * 32 + (fq >> 1) * 16;
      union { bf16x8 v; uint32_t u[4]; } own, oth, res;
      own.v = qf[nq][2];
#pragma unroll
      for (int i = 0; i < 4; ++i) oth.u[i] = __shfl_xor(own.u[i], 16);
      float fo[8], fp[8], fres[8];
      { uint4 t4 = make_uint4(own.u[0], own.u[1], own.u[2], own.u[3]); unpack8(t4, fo); }
      { uint4 t4 = make_uint4(oth.u[0], oth.u[1], oth.u[2], oth.u[3]); unpack8(t4, fp); }
#pragma unroll
      for (int j = 0; j < 8; ++j) {
        float cs = rp[j], sn = rp[8 + j];
        fres[j] = (fq & 1) ? (fp[j] * sn + fo[j] * cs) : (fo[j] * cs - fp[j] * sn);
      }
      uint4 r4 = pack8(fres);
      res.u[0] = r4.x; res.u[1] = r4.y; res.u[2] = r4.z; res.u[3] = r4.w;
      qf[nq][2] = res.v;
    }
  }
  f32x4 o[4][2];
#pragma unroll
  for (int m = 0; m < 4; ++m)
#pragma unroll
    for (int n = 0; n < 2; ++n) o[m][n] = (f32x4){0.f, 0.f, 0.f, 0.f};
  float mrun[2] = {-1e30f, -1e30f}, lrun[2] = {0.f, 0.f};
  const int T0 = kt0 >> 1, T1 = kt1 >> 1;
  uint4 rk0, rk1, rk2, rv0, rv1;
  const int c0_ = tid, c1_ = tid + 512, c2_ = tid + 1024;
  const int kcv0_ = c0_ & 15, kcv1_ = c1_ & 15;
  const int vslot0_ = 32 * (kcv0_ >> 2) + 16 * (kcv0_ & 1) + 4 * ((kcv0_ & 3) >> 1);
  const int vslot1_ = 32 * (kcv1_ >> 2) + 16 * (kcv1_ & 1) + 4 * ((kcv1_ & 3) >> 1);
#define ATT_LD(tt) do { const size_t key0_ = (size_t)(tt) * 128; const u16* kb_ = Kb + key0_ * 96; \
    rk0 = *(const uint4*)(kb_ + (size_t)c0_ * 8); rk1 = *(const uint4*)(kb_ + (size_t)c1_ * 8); rk2 = *(const uint4*)(kb_ + (size_t)c2_ * 8); \
    rv0 = *(const uint4*)(Vb + (size_t)(c0_ >> 4) * ST + key0_ + (c0_ & 15) * 8); \
    rv1 = *(const uint4*)(Vb + (size_t)(c1_ >> 4) * ST + key0_ + (c1_ & 15) * 8); } while (0)
#define ATT_ST(st) do { u16* sk_ = lds + (st) * STG; u16* sv_ = sk_ + KSZ; \
    *(uint4*)(sk_ + (c0_ / 12) * KS + (c0_ % 12) * 8) = rk0; *(uint4*)(sk_ + (c1_ / 12) * KS + (c1_ % 12) * 8) = rk1; *(uint4*)(sk_ + (c2_ / 12) * KS + (c2_ % 12) * 8) = rk2; \
    *(uint2*)(sv_ + (c0_ >> 4) * VS + vslot0_) = make_uint2(rv0.x, rv0.y); *(uint2*)(sv_ + (c0_ >> 4) * VS + vslot0_ + 8) = make_uint2(rv0.z, rv0.w); \
    *(uint2*)(sv_ + (c1_ >> 4) * VS + vslot1_) = make_uint2(rv1.x, rv1.y); *(uint2*)(sv_ + (c1_ >> 4) * VS + vslot1_ + 8) = make_uint2(rv1.z, rv1.w); } while (0)
  ATT_LD(T0); ATT_ST(0);
  __syncthreads();
  for (int kt = T0; kt < T1; ++kt) {
    const bool more = (kt + 1 < T1);
    if (more) ATT_LD(kt + 1);
    const int cur = (kt - T0) & 1;
    const u16* sk = lds + cur * STG;
    const u16* sv = sk + KSZ;
    f32x4 s[8][2];
#pragma unroll
    for (int m = 0; m < 8; ++m)
#pragma unroll
      for (int n = 0; n < 2; ++n) s[m][n] = (f32x4){0.f, 0.f, 0.f, 0.f};
#pragma unroll
    for (int ks = 0; ks < 3; ++ks)
#pragma unroll
      for (int mt = 0; mt < 8; ++mt) {
        bf16x8 kf = *(const bf16x8*)(sk + (mt * 16 + fr) * KS + ks * 32 + fq * 8);
#pragma unroll
        for (int nq = 0; nq < 2; ++nq) s[mt][nq] = __builtin_amdgcn_mfma_f32_16x16x32_bf16(kf, qf[nq][ks], s[mt][nq], 0, 0, 0);
      }
    bf16x8 pb[2][4];
    float mloc[2];
#pragma unroll
    for (int nq = 0; nq < 2; ++nq) {
      float mx = fmaxf(fmaxf(s[0][nq][0], s[0][nq][1]), fmaxf(s[0][nq][2], s[0][nq][3]));
#pragma unroll
      for (int mt = 1; mt < 8; ++mt) mx = fmaxf(fmaxf(mx, s[mt][nq][0]), fmaxf(fmaxf(s[mt][nq][1], s[mt][nq][2]), s[mt][nq][3]));
      mloc[nq] = mx;
    }
    if (__any((mloc[0] > mrun[0] + 8.f) || (mloc[1] > mrun[1] + 8.f))) {
      float m0 = fmaxf(mloc[0], __shfl_xor(mloc[0], 16)), m1 = fmaxf(mloc[1], __shfl_xor(mloc[1], 16));
      m0 = fmaxf(m0, __shfl_xor(m0, 32)); m1 = fmaxf(m1, __shfl_xor(m1, 32));
      const float n0 = fmaxf(mrun[0], m0), n1 = fmaxf(mrun[1], m1);
      const float a0 = __builtin_amdgcn_exp2f(mrun[0] - n0), a1 = __builtin_amdgcn_exp2f(mrun[1] - n1);
      mrun[0] = n0; mrun[1] = n1;
      lrun[0] *= a0; lrun[1] *= a1;
#pragma unroll
      for (int mtv = 0; mtv < 4; ++mtv) {
        o[mtv][0][0] *= a0; o[mtv][0][1] *= a0; o[mtv][0][2] *= a0; o[mtv][0][3] *= a0;
        o[mtv][1][0] *= a1; o[mtv][1][1] *= a1; o[mtv][1][2] *= a1; o[mtv][1][3] *= a1;
      }
    }
#pragma unroll
    for (int nq = 0; nq < 2; ++nq) {
      const float mn = mrun[nq];
      float rs = 0.f;
#pragma unroll
      for (int mt = 0; mt < 8; ++mt)
#pragma unroll
        for (int jj = 0; jj < 4; ++jj) {
          float pv = __builtin_amdgcn_exp2f(s[mt][nq][jj] - mn);
          s[mt][nq][jj] = pv;
          rs += pv;
        }
      lrun[nq] += rs;
#pragma unroll
      for (int sx = 0; sx < 4; ++sx) {
        union { uint4 u; bf16x8 v; } cv;
        cv.u.x = pack2(s[2 * sx][nq][0], s[2 * sx][nq][1]); cv.u.y = pack2(s[2 * sx][nq][2], s[2 * sx][nq][3]);
        cv.u.z = pack2(s[2 * sx + 1][nq][0], s[2 * sx + 1][nq][1]); cv.u.w = pack2(s[2 * sx + 1][nq][2], s[2 * sx + 1][nq][3]);
        pb[nq][sx] = cv.v;
      }
    }
#pragma unroll
    for (int sx = 0; sx < 4; ++sx)
#pragma unroll
      for (int mtv = 0; mtv < 4; ++mtv) {
        const bf16x8 vf = *(const bf16x8*)(sv + (mtv * 16 + fr) * VS + 32 * sx + fq * 8);
#pragma unroll
        for (int nq = 0; nq < 2; ++nq) o[mtv][nq] = __builtin_amdgcn_mfma_f32_16x16x32_bf16(vf, pb[nq][sx], o[mtv][nq], 0, 0, 0);
      }
    if (more) ATT_ST(cur ^ 1);
    __syncthreads();
  }
#undef ATT_LD
#undef ATT_ST
#pragma unroll
  for (int nq = 0; nq < 2; ++nq) {
    float lt = lrun[nq];
    lt += __shfl_xor(lt, 16);
    lt += __shfl_xor(lt, 32);
    float inv = 1.f / lt;
    size_t r = (size_t)b * ST + t0 + wid * 32 + nq * 16 + fr;
#pragma unroll
    for (int mtv = 0; mtv < 4; ++mtv) {
      uint2 ov;
      ov.x = pack2(o[mtv][nq][0] * inv, o[mtv][nq][1] * inv);
      ov.y = pack2(o[mtv][nq][2] * inv, o[mtv][nq][3] * inv);
      *(uint2*)(p.Ycat + r * 2048 + 1536 + h * 64 + mtv * 16 + fq * 4) = ov;
    }
  }
}

#define XB_TMO      128
#define XB_XCNT(j)  (256  + 64 * (j))
#define XB_XSUB(j)  (1280 + 64 * (j))
#define XB_XGEN(j)  (2304 + 64 * (j))
#define XB_TOP      3328
#define XB_TOPGEN   3392
#define XCD_BAR_WORDS 3456
#define XB_SPIN_CAP (1u << 18)
__device__ __forceinline__ unsigned xb_ld(unsigned* p)              { return __hip_atomic_load(p, __ATOMIC_RELAXED, __HIP_MEMORY_SCOPE_AGENT); }
__device__ __forceinline__ unsigned xb_add(unsigned* p, unsigned v) { return __hip_atomic_fetch_add(p, v, __ATOMIC_RELAXED, __HIP_MEMORY_SCOPE_AGENT); }
__device__ __forceinline__ unsigned xb_xcc_id() { return (unsigned)__builtin_amdgcn_s_getreg((3 << 11) | 20) & 0xFu; }
#define XB_SPIN(cond, bar) do { unsigned _sp = 0; while (cond) { __builtin_amdgcn_s_sleep(1); \
    if ((++_sp & 255u) == 0u) { if (xb_ld(&(bar)[XB_TMO])) break; if (_sp > XB_SPIN_CAP) { atomicAdd(&(bar)[XB_TMO], 1u); break; } } } } while (0)
struct XcdBarrier { unsigned* bar; unsigned x; volatile __attribute__((address_space(3))) unsigned* st; };
__device__ __forceinline__ XcdBarrier xcd_barrier_post(unsigned* bar, volatile __attribute__((address_space(3))) unsigned* st) {
  XcdBarrier b; b.bar = bar; b.x = xb_xcc_id(); b.st = st;
  if (threadIdx.x == 0) (void)xb_add(&bar[XB_XCNT(b.x)], 1u);
  return b;
}
__device__ __forceinline__ void xcd_barrier_complete(unsigned* bar, unsigned x, unsigned& nloc, unsigned& nx) {
  const unsigned G = gridDim.x * gridDim.y * gridDim.z;
  unsigned sum, cnt, mine, sp = 0u;
  for (;;) {
    sum = 0u; cnt = 0u; mine = 0u;
#pragma unroll
    for (unsigned j = 0; j < 16; ++j) { const unsigned c = xb_ld(&bar[XB_XCNT(j)]); sum += c; cnt += (c > 0u) ? 1u : 0u; mine = (j == x) ? c : mine; }
    if (sum == G) break;
    __builtin_amdgcn_s_sleep(1);
    if ((++sp & 255u) == 0u) { if (xb_ld(&bar[XB_TMO])) break; if (sp > XB_SPIN_CAP) { atomicAdd(&bar[XB_TMO], 1u); break; } }
  }
  nloc = mine > 0u ? mine : 1u; nx = cnt > 0u ? cnt : 1u;
}
__device__ __forceinline__ void xcd_barrier(const XcdBarrier& b) {
  asm volatile("s_waitcnt vmcnt(0)" ::: "memory");
  __syncthreads();
  if (threadIdx.x == 0) {
    unsigned* bar = b.bar;
    __builtin_amdgcn_s_waitcnt(0);
    unsigned nloc = b.st[0], nx = b.st[1];
    if (nloc == 0u) { xcd_barrier_complete(bar, b.x, nloc, nx); b.st[0] = nloc; b.st[1] = nx; }
    const unsigned old = xb_add(&bar[XB_XSUB(b.x)], 1u);
    const unsigned gen = old / nloc;
    if (old + 1u == (gen + 1u) * nloc) {
      __builtin_amdgcn_fence(__ATOMIC_RELEASE, "agent");
      asm volatile("s_waitcnt vmcnt(0)" ::: "memory");
      const unsigned og = xb_add(&bar[XB_TOP], 1u);
      const unsigned tg = og / nx;
      if (og + 1u == (tg + 1u) * nx) xb_add(&bar[XB_TOPGEN], 1u);
      else XB_SPIN(xb_ld(&bar[XB_TOPGEN]) == tg, bar);
      __builtin_amdgcn_fence(__ATOMIC_ACQUIRE, "agent");
      xb_add(&bar[XB_XGEN(b.x)], 1u);
      asm volatile("s_waitcnt vmcnt(0)" ::: "memory");
    } else {
      XB_SPIN(xb_ld(&bar[XB_XGEN(b.x)]) == gen, bar);
      __builtin_amdgcn_fence(__ATOMIC_ACQUIRE, "agent");
      asm volatile("s_waitcnt vmcnt(0)" ::: "memory");
    }
  }
  __syncthreads();
}

__global__ void __launch_bounds__(NTHR) mega(P p) {
  extern __shared__ __attribute__((aligned(16))) unsigned char smem[];
  __shared__ uint4 xb_words;
  cg::grid_group grid = cg::this_grid();
  if (threadIdx.x == 0) xb_words = make_uint4(0u, 0u, 0u, 0u);
  __syncthreads();
  XcdBarrier xb = xcd_barrier_post(p.bar, (volatile __attribute__((address_space(3))) unsigned*)&xb_words);
  u16* lds = (u16*)smem;
  float* sInv = (float*)(smem + 131072);
  LAS3 unsigned char* lds3 = (LAS3 unsigned char*)smem;
  const int bid = blockIdx.x, nblk = gridDim.x;
  auto nopre = [](int) {};

#ifndef NO_P0
  phase0(p, smem);
#endif
  grid.sync();

#pragma unroll 1
  for (int l = 0; l < 4; ++l) {
    int tid = threadIdx.x; asm volatile("" : "+v"(tid));
    const int lane = tid & 63, wid = tid >> 6, wr = wid >> 1, wc = wid & 1, fr = lane & 15, fq = lane >> 4;
    (void)lane; (void)wid; (void)wr; (void)wc; (void)fr; (void)fq;
#ifndef NO_CW
    convert_weights(p, l, (float*)smem);
#endif
    norm_mod(p, l, p.norm1_g + l * 1024, 0, 1024);
    GSYNC();

    {
      u16* Zb1 = p.R1;
      auto epi = [=](const f32x4(&acc)[2][2][4][2], const g8::Unit& u, int wr, int wc, int fr, int fq, int) {
#pragma unroll
        for (int ai = 0; ai < 2; ++ai)
#pragma unroll
          for (int m = 0; m < 4; ++m) {
            u16* rowp = Zb1 + (size_t)(u.pm * 256 + ai * 128 + wr * 64 + m * 16 + fr) * 2560 + u.pn * 256 + wc * 32 + 8 * fq;
#pragma unroll
            for (int bj = 0; bj < 2; ++bj) {
              uint4 w;
              w.x = g8::cvt_pk_bf16(acc[ai][bj][m][0][0], acc[ai][bj][m][0][1]); w.y = g8::cvt_pk_bf16(acc[ai][bj][m][0][2], acc[ai][bj][m][0][3]);
              w.z = g8::cvt_pk_bf16(acc[ai][bj][m][1][0], acc[ai][bj][m][1][1]); w.w = g8::cvt_pk_bf16(acc[ai][bj][m][1][2], acc[ai][bj][m][1][3]);
              *(uint4*)(rowp + bj * 128) = w;
            }
          }
      };
      g8::Simple S; S.o.init(l == 3 ? 128 : 136, 10, nblk, bid); S.A = p.H; S.Bt = p.W + OFF_WINA; S.lda = 1024; S.K = 1024;
      g8::gemm_phase<true>(lds3, S, epi);
    }
    GSYNC();

    for (int rep = 0; rep < DUP_C1; ++rep)
    for (int it = bid; it < 1088 + 136; it += nblk) {
#ifndef NO_CMLP
      if (it < 1088) cmlp_item(p, l, it, smem);
#endif
#ifndef NO_CONVA
      if (it >= 1088) conva_item(p, l, it - 1088);
#endif
    }
    GSYNC();

    {
      u16* Zb2 = p.R1;
      auto epi = [=](const f32x4(&acc)[2][2][4][2], const g8::Unit& u, int wr, int wc, int fr, int fq, int) {
#pragma unroll
        for (int ai = 0; ai < 2; ++ai)
#pragma unroll
          for (int m = 0; m < 4; ++m) {
            u16* rowp = Zb2 + (size_t)(u.pm * 256 + ai * 128 + wr * 64 + m * 16 + fr) * 1792 + u.pn * 256 + wc * 32 + 8 * fq;
#pragma unroll
            for (int bj = 0; bj < 2; ++bj) {
              uint4 w;
              w.x = g8::cvt_pk_bf16(acc[ai][bj][m][0][0], acc[ai][bj][m][0][1]); w.y = g8::cvt_pk_bf16(acc[ai][bj][m][0][2], acc[ai][bj][m][0][3]);
              w.z = g8::cvt_pk_bf16(acc[ai][bj][m][1][0], acc[ai][bj][m][1][1]); w.w = g8::cvt_pk_bf16(acc[ai][bj][m][1][2], acc[ai][bj][m][1][3]);
              *(uint4*)(rowp + bj * 128) = w;
            }
          }
        const int pn = u.pn;
        if (pn == 2 || pn == 5 || pn == 6) {
          const bool inc0 = (pn != 5) || (wc >= 1);
          const bool inc1 = (pn == 2) || (pn == 5) || (wc == 0);
          float* dst = p.ssq + (size_t)(u.pm * 256 + wr * 64 + fr) * 12 + (pn == 2 ? 0 : (pn == 5 ? 4 : 8)) + wc;
#pragma unroll
          for (int ai = 0; ai < 2; ++ai)
#pragma unroll
            for (int m = 0; m < 4; ++m) {
              float ss = 0.f;
#pragma unroll
              for (int n = 0; n < 2; ++n)
#pragma unroll
                for (int jj = 0; jj < 4; ++jj) {
                  const float v0 = acc[ai][0][m][n][jj], v1 = acc[ai][1][m][n][jj];
                  ss += (inc0 ? v0 * v0 : 0.f) + (inc1 ? v1 * v1 : 0.f);
                }
              ss += __shfl_xor(ss, 16);
              ss += __shfl_xor(ss, 32);
              if (fq == 0) dst[(ai * 128 + m * 16) * 12] = ss;
              asm volatile("" ::: "memory");
            }
        }
      };
      g8::Simple S; S.o.init(136, 7, nblk, bid); S.A = p.H; S.Bt = p.W + OFF_WINB; S.lda = 1024; S.K = 1024;
      g8::gemm_phase<true>(lds3, S, epi);
    }
    GSYNC();

    for (int rep = 0; rep < DUP_C2; ++rep)
    {
      const u16* Zb2 = p.R1;
      for (int r2 = 0; r2 < DUP_LRU1; ++r2) lru_run<1>(p, l, bid, nblk, smem);
      for (int r2 = 0; r2 < DUP_PROJ; ++r2) {
      {
        struct ProjSched {
          g8::Order o; const u16* Zb2; const u16* Wq; const u16* Wkv;
          __device__ bool next(int i, g8::Unit& u) const {
            int pm, pn; if (!o.tile(i, pm, pn)) return false;
            u.pm = pm; u.lda = 1792;
            if (pn < 3) { u.pn = pn; u.aux = 0; u.K = 384; u.A = (const char*)(Zb2 + (size_t)pm * 256 * 1792 + 1312); u.B = (const char*)(Wq + (size_t)pn * 256 * 384); }
            else { u.pn = pn - 3; u.aux = 1; u.K = 256; u.A = (const char*)(Zb2 + (size_t)pm * 256 * 1792 + 512); u.B = (const char*)(Wkv + (size_t)(pn - 3) * 256 * 256); }
            return true;
          }
        };
        ProjSched S; S.o.init(136, 7, nblk, bid); S.Zb2 = Zb2; S.Wq = p.W + OFF_WQUP; S.Wkv = p.W + OFF_WKVUP;
        auto epi = [=](const f32x4(&acc)[2][2][4][2], const g8::Unit& u, int wr, int wc, int fr, int fq, int) {
          const int row0 = u.pm * 256, b = row0 / ST, tb = row0 - b * ST;
          const int kv = u.aux;
          const float* sq = p.ssq + (size_t)row0 * 12;
          const float invn = kv ? (1.f / 256.f) : (1.f / 384.f);
#pragma unroll
          for (int ai = 0; ai < 2; ++ai)
#pragma unroll
            for (int m = 0; m < 4; ++m) {
              const int rl = ai * 128 + wr * 64 + m * 16 + fr;
              const float4 p0 = *(const float4*)(sq + rl * 12), p1 = *(const float4*)(sq + rl * 12 + 4), p2 = *(const float4*)(sq + rl * 12 + 8);
              const float ssum = kv ? ((p0.x + p0.y) + (p0.z + p0.w)) : (((p1.x + p1.y) + (p1.z + p1.w)) + ((p2.x + p2.y) + (p2.z + p2.w)));
              const float inv = rsqrtf(ssum * invn + EPS);
              const int t = tb + rl;
#pragma unroll
              for (int bj = 0; bj < 2; ++bj) {
                const int c8 = u.pn * 256 + bj * 128 + wc * 32 + 8 * fq;
                float v[8];
#pragma unroll
                for (int n = 0; n < 2; ++n)
#pragma unroll
                  for (int jj = 0; jj < 4; ++jj) v[n * 4 + jj] = acc[ai][bj][m][n][jj] * inv;
                if (!kv) {
                  const int head = c8 / 96, d = c8 - head * 96;
                  *(uint4*)(p.Q + ((size_t)(b * 8 + head) * ST + t) * 96 + d) = pack8(v);
                } else {
                  const int head = c8 >> 7, w = c8 & 127;
                  if (wc < 2) {
                    *(uint4*)(p.K + ((size_t)(b * 8 + head) * ST + t) * 96 + w) = pack8(v);
                  } else {
                    u16* vp = p.Vt + ((size_t)(b * 8 + head) * 64 + (w - 64)) * ST + t;
#pragma unroll
                    for (int e = 0; e < 8; ++e) vp[(size_t)e * ST] = f2bf(v[e]);
                  }
                }
              }
              asm volatile("" ::: "memory");
            }
        };
        g8::gemm_phase<true>(lds3, S, epi);
      }
      {
        const int off = 2176;
        int first = bid;
        if (first < off) { int kk = (off - first + nblk - 1) / nblk; first += kk * nblk; }
        for (int it = first; it < off + 136; it += nblk) krope_item(p, it - off);
      }
      }
    }
    GSYNC();

    for (int rep = 0; rep < DUP_ATTN; ++rep)
    {
      int it = bid;
      for (; it < 1088; it += nblk) attn_item(p, it, smem);
      for (int r2 = 0; r2 < DUP_LRU3; ++r2) lru_run<3>(p, l, it - 1088, nblk, smem);
    }
    GSYNC();

    {
      u16* Mg = p.R1;
      const int ntile = 272 * 8;
      int te = threadIdx.x; asm volatile("" : "+v"(te));
      const int lane_e = te & 63, wid_e = te >> 6;
      const int wr = wid_e >> 1, wc = wid_e & 1, fr = lane_e & 15, fq = lane_e >> 4;
      int estr = nblk; asm volatile("" : "+s"(estr));
      const int skipctx = (l == 3);
      for (int id = bid; id < ntile; id += estr) {
        int g = id >> 6, rem = id & 63;
        int ct = rem >> 3, rt = g * 8 + (rem & 7);
        if (skipctx && (rt % 34) >= 32) continue;
        f32x4 mg[2][4];
#pragma unroll
        for (int m = 0; m < 2; ++m)
#pragma unroll
          for (int n = 0; n < 4; ++n) mg[m][n] = (f32x4){0.f, 0.f, 0.f, 0.f};
        for (int nb = 0; nb < 4; ++nb) {
          f32x4 ag[2][4], ay[2][4];
#pragma unroll
          for (int m = 0; m < 2; ++m)
#pragma unroll
            for (int n = 0; n < 4; ++n) { ag[m][n] = (f32x4){0.f, 0.f, 0.f, 0.f}; ay[m][n] = (f32x4){0.f, 0.f, 0.f, 0.f}; }
          gemm_main128(p.H + (size_t)rt * 128 * 1024, 1024, p.W + OFF_WGATE + (size_t)(nb * 1024 + ct * 128) * 1024, 1024, 1024,
                       lds, ag);
          gemm_main128(p.Ycat + (size_t)rt * 128 * 2048 + nb * 512, 2048, p.W + OFF_WBR + (size_t)(nb * 1024 + ct * 128) * 512, 512,
                       512, lds, ay);
#pragma unroll
          for (int m = 0; m < 2; ++m)
#pragma unroll
            for (int n = 0; n < 4; ++n)
#pragma unroll
              for (int jj = 0; jj < 4; ++jj) mg[m][n][jj] += sigmoidf_(ag[m][n][jj]) * ay[m][n][jj];
        }
#pragma unroll
        for (int m = 0; m < 2; ++m) {
          u16* dst = Mg + (size_t)(rt * 128 + wr * 32 + m * 16 + fq * 4) * 1024 + ct * 128 + wc * 64 + fr;
#pragma unroll
          for (int n = 0; n < 4; ++n)
#pragma unroll
            for (int jj = 0; jj < 4; ++jj) dst[jj * 1024 + n * 16] = f2bf(mg[m][n][jj]);
          asm volatile("" ::: "memory");
        }
        __syncthreads();
      }
    }
    GSYNC();

    {
      auto epi = [=](const f32x4(&acc)[2][2][4][2], const g8::Unit& u, int wr, int wc, int fr, int fq, int) {
        float* xb = xrow_ptr(p, u.pm * 256);
        const float* gate = p.mod + ((size_t)l * 9 + mod_idx(u.pm * 256)) * 6144 + 2048 + u.pn * 256 + wc * 32 + 4 * fq;
        f32x4 gv[2][2];
#pragma unroll
        for (int bj = 0; bj < 2; ++bj)
#pragma unroll
          for (int n = 0; n < 2; ++n) gv[bj][n] = *(const f32x4*)(gate + bj * 128 + n * 16);
#pragma unroll
        for (int ai = 0; ai < 2; ++ai)
#pragma unroll
          for (int m = 0; m < 4; ++m) {
            float* rowp = xb + (size_t)(ai * 128 + wr * 64 + m * 16 + fr) * DM + u.pn * 256 + wc * 32 + 4 * fq;
#pragma unroll
            for (int bj = 0; bj < 2; ++bj)
#pragma unroll
              for (int n = 0; n < 2; ++n) {
                f32x4 xv = *(const f32x4*)(rowp + bj * 128 + n * 16);
                xv += gv[bj][n] * acc[ai][bj][m][n];
                *(f32x4*)(rowp + bj * 128 + n * 16) = xv;
              }
          }
      };
      g8::Simple S; S.o.init(l == 3 ? 128 : 136, 4, nblk, bid); S.A = p.R1; S.Bt = p.W + OFF_WOUT; S.lda = 1024; S.K = 1024;
      g8::gemm_phase<false>(lds3, S, epi);
    }
    GSYNC();

    norm_mod(p, l, p.norm2_g + l * 1024, 3072, 4096);
    GSYNC();

    {
      u16* U = p.R1;
      auto epi = [=](const f32x4(&acc)[2][2][4][2], const g8::Unit& u, int wr, int wc, int fr, int fq, int) {
#pragma unroll
        for (int ai = 0; ai < 2; ++ai)
#pragma unroll
          for (int m = 0; m < 4; ++m) {
            u16* rowp = U + (size_t)(u.pm * 256 + ai * 128 + wr * 64 + m * 16 + fr) * 2816 + u.pn * 128 + wc * 32 + 8 * fq;
            float v[8];
#pragma unroll
            for (int n = 0; n < 2; ++n)
#pragma unroll
              for (int jj = 0; jj < 4; ++jj) v[n * 4 + jj] = siluf_(acc[ai][0][m][n][jj]) * acc[ai][1][m][n][jj];
            uint4 w;
            w.x = g8::cvt_pk_bf16(v[0], v[1]); w.y = g8::cvt_pk_bf16(v[2], v[3]); w.z = g8::cvt_pk_bf16(v[4], v[5]); w.w = g8::cvt_pk_bf16(v[6], v[7]);
            *(uint4*)rowp = w;
          }
      };
      g8::Simple S; S.o.init(l == 3 ? 128 : 136, 22, nblk, bid); S.A = p.H; S.Bt = p.W + OFF_WFF13; S.lda = 1024; S.K = 1024;
      g8::gemm_phase<true>(lds3, S, epi);
    }
    GSYNC();

    {
      auto epi = [=](const f32x4(&acc)[2][2][4][2], const g8::Unit& u, int wr, int wc, int fr, int fq, int) {
        float* xb = xrow_ptr(p, u.pm * 256);
        const float* gate = p.mod + ((size_t)l * 9 + mod_idx(u.pm * 256)) * 6144 + 5120 + u.pn * 256 + wc * 32 + 4 * fq;
        f32x4 gv[2][2];
#pragma unroll
        for (int bj = 0; bj < 2; ++bj)
#pragma unroll
          for (int n = 0; n < 2; ++n) gv[bj][n] = *(const f32x4*)(gate + bj * 128 + n * 16);
#pragma unroll
        for (int ai = 0; ai < 2; ++ai)
#pragma unroll
          for (int m = 0; m < 4; ++m) {
            float* rowp = xb + (size_t)(ai * 128 + wr * 64 + m * 16 + fr) * DM + u.pn * 256 + wc * 32 + 4 * fq;
#pragma unroll
            for (int bj = 0; bj < 2; ++bj)
#pragma unroll
              for (int n = 0; n < 2; ++n) {
                f32x4 xv = *(const f32x4*)(rowp + bj * 128 + n * 16);
                xv += gv[bj][n] * acc[ai][bj][m][n];
                *(f32x4*)(rowp + bj * 128 + n * 16) = xv;
              }
          }
      };
      g8::Simple S; S.o.init(l == 3 ? 128 : 136, 4, nblk, bid); S.A = p.R1; S.Bt = p.W + OFF_WFF2; S.lda = 2816; S.K = 2816;
      g8::gemm_phase<false>(lds3, S, epi);
    }
    GSYNC();

  }

  const int lane = threadIdx.x & 63, wid = threadIdx.x >> 6;
  for (int r = bid * 8 + wid; r < NB * SL; r += nblk * 8) {
    float* xr = p.out + (size_t)r * DM;
    float4 v[4];
    float ss = 0.f;
#pragma unroll
    for (int i = 0; i < 4; ++i) {
      v[i] = *(const float4*)(xr + i * 256 + lane * 4);
      ss += v[i].x * v[i].x + v[i].y * v[i].y + v[i].z * v[i].z + v[i].w * v[i].w;
    }
    ss = wave_sum(ss);
    const float inv = rsqrtf(ss * (1.f / 1024.f) + EPS);
#pragma unroll
    for (int i = 0; i < 4; ++i) {
      float4 gg = *(const float4*)(p.final_g + i * 256 + lane * 4);
      float4 ov;
      ov.x = v[i].x * inv * gg.x; ov.y = v[i].y * inv * gg.y; ov.z = v[i].z * inv * gg.z; ov.w = v[i].w * inv * gg.w;
      *(float4*)(xr + i * 256 + lane * 4) = ov;
    }
  }
}

extern "C" void kernel_launch(void* const* d_in, const int* in_sizes, int n_in, void* d_out, int out_size, void* d_ws,
                              size_t ws_size, hipStream_t stream) {
  static int grid_blocks = 0;
  if (!grid_blocks) {
    int dev = 0, cus = 0, per_cu = 0;
    hipGetDevice(&dev);
    hipDeviceGetAttribute(&cus, hipDeviceAttributeMultiprocessorCount, dev);
    hipFuncSetAttribute((const void*)mega, hipFuncAttributeMaxDynamicSharedMemorySize, LDS_BYTES);
    hipOccupancyMaxActiveBlocksPerMultiprocessor(&per_cu, (const void*)mega, NTHR, LDS_BYTES);
    if (per_cu < 1) per_cu = 1;
    if (per_cu > 1) per_cu = 1;
    grid_blocks = cus * per_cu;
    (void)hipGetLastError();
  }
  P p{};
  const float** pf = (const float**)&p;
  for (int i = 0; i < 31; ++i) pf[i] = (const float*)d_in[i];
  p.out = (float*)d_out;
  size_t off = 0;
  auto take = [&](size_t bytes) { void* r = (char*)d_ws + off; off += (bytes + 255) & ~(size_t)255; return r; };
  p.Xc = (float*)take((size_t)NB * SC * DM * 4);
  p.mod = (float*)take((size_t)4 * 9 * 6144 * 4);
  p.rope = (float*)take((size_t)SL * 32 * 4);
  p.summ = (float2*)take((size_t)NB * 2 * 512 * 34 * 8);
  p.ssq = (float*)take((size_t)12 * MTOT * 4);
  p.bar = (unsigned*)take((size_t)XCD_BAR_WORDS * 4);
  p.W = (u16*)take((size_t)W_ELEMS * 2);
  p.H = (u16*)take((size_t)MTOT * 1024 * 2);
  p.Ycat = (u16*)take((size_t)MTOT * 2048 * 2);
  p.R1 = (u16*)take((size_t)MTOT * 2560 * 2);
  p.K = (u16*)take((size_t)MTOT * 768 * 2);
  p.Vt = (u16*)take((size_t)MTOT * 512 * 2);
  p.Q = p.R1 + (size_t)MTOT * 1792;
  if (off > ws_size) { fprintf(stderr, "workspace too small: need %zu have %zu\n", off, ws_size); return; }
  (void)hipMemsetAsync(p.bar, 0, (size_t)XCD_BAR_WORDS * 4, stream);
  void* args[] = {&p};
  hipError_t e = hipLaunchCooperativeKernel((const void*)mega, dim3(grid_blocks), dim3(NTHR), args, LDS_BYTES, stream);
  if (e != hipSuccess) fprintf(stderr, "cooperative launch failed: %s (grid %d)\n", hipGetErrorString(e), grid_blocks);
}
```

```cpp
#include <hip/hip_runtime.h>
#include <hip/hip_bf16.h>
#include <hip/hip_cooperative_groups.h>
#include <cstdio>
#include <cstdint>
namespace cg = cooperative_groups;

typedef unsigned short u16;
using bf16x8 = __attribute__((ext_vector_type(8))) short;
using f32x4 = __attribute__((ext_vector_type(4))) float;

#define NB 8
#define SL 4096
#define SC 256
#define ST 4352
#define MTOT 34816
#define DM 1024
#define NTHR 512
#define EPS 1e-6f
#define LDS_BYTES 159744
#define DUP_ATTN 1
#define DUP_C1 1
#define DUP_C2 1
#define DUP_E 1
#define EXTRA_SYNC 0
#define GSYNC() do { xcd_barrier(xb); for (int q_ = 0; q_ < EXTRA_SYNC; ++q_) xcd_barrier(xb); } while (0)
#define DUP_LRU1 1
#define DUP_LRU3 1
#define DUP_PROJ 1

#define OFF_WINA 0
#define OFF_WINB (OFF_WINA + 2560 * 1024)
#define OFF_WGATE (OFF_WINB + 1792 * 1024)
#define OFF_WBR (OFF_WGATE + 4096 * 1024)
#define OFF_WOUT (OFF_WBR + 4 * 1024 * 512)
#define OFF_WFF13 (OFF_WOUT + 1024 * 1024)
#define OFF_WFF2 (OFF_WFF13 + 5632 * 1024)
#define OFF_WQUP (OFF_WFF2 + 1024 * 2816)
#define OFF_WKVUP (OFF_WQUP + 768 * 384)
#define OFF_WS (OFF_WKVUP + 1024 * 256)
#define OFF_WLRU (OFF_WS + 4 * 128 * 128)
#define W_ELEMS (OFF_WLRU + 2 * 8 * 4 * 32 * 64)

struct P {
  const float *x, *c, *ctx, *c_ctx, *w_mod, *b_mod, *norm1_g, *norm2_g, *w_in, *conv_a_w, *lru_conv_w, *lru_conv_b,
      *lru_w_a, *lru_b_a, *lru_w_x, *lru_b_x, *lru_lam, *cmlp_ln_g, *cmlp_ln_b, *cmlp_w_s, *cmlp_b_s, *q_norm_g,
      *kv_norm_g, *w_q_up, *w_kv_up, *w_branch, *w_out, *w_ff1, *w_ff3, *w_ff2, *final_g;
  float *out, *Xc, *mod, *rope;
  float2* summ;
  float* ssq;
  unsigned* bar;
  u16 *W, *H, *Ycat, *R1, *Q, *K, *Vt;
};

__device__ __forceinline__ uint32_t pack2(float a, float b) { uint32_t r; asm("v_cvt_pk_bf16_f32 %0, %1, %2" : "=v"(r) : "v"(a), "v"(b)); return r; }
__device__ __forceinline__ u16 f2bf(float f) { return (u16)(pack2(f, f) & 0xffffu); }
__device__ __forceinline__ float bf2f(u16 h) { return __uint_as_float(((uint32_t)h) << 16); }
__device__ __forceinline__ float sigmoidf_(float x) { return 1.f / (1.f + __expf(-x)); }
__device__ __forceinline__ float sigmoid_rcp_(float x) { return __builtin_amdgcn_rcpf(1.f + __expf(-x)); }
__device__ __forceinline__ float siluf_(float x) { return x * __builtin_amdgcn_rcpf(1.f + __expf(-x)); }
__device__ __forceinline__ float geluf_(float x) {
  float u = 0.7978845608028654f * (x + 0.044715f * x * x * x);
  return x * __builtin_amdgcn_rcpf(1.f + __expf(-2.f * u));
}
__device__ __forceinline__ void unpack8(const uint4& v, float* f) {
  f[0] = __uint_as_float(v.x << 16); f[1] = __uint_as_float(v.x & 0xffff0000u);
  f[2] = __uint_as_float(v.y << 16); f[3] = __uint_as_float(v.y & 0xffff0000u);
  f[4] = __uint_as_float(v.z << 16); f[5] = __uint_as_float(v.z & 0xffff0000u);
  f[6] = __uint_as_float(v.w << 16); f[7] = __uint_as_float(v.w & 0xffff0000u);
}
__device__ __forceinline__ uint4 pack8(const float* f) {
  uint4 v; v.x = pack2(f[0], f[1]); v.y = pack2(f[2], f[3]); v.z = pack2(f[4], f[5]); v.w = pack2(f[6], f[7]); return v;
}
template <int CTRL, int ROWMASK>
__device__ __forceinline__ float dpp0f(float src) {
  return __int_as_float(__builtin_amdgcn_update_dpp(0, __float_as_int(src), CTRL, ROWMASK, 0xf, false));
}
__device__ __forceinline__ float wave_sum(float v) {
  v += dpp0f<0x111, 0xf>(v); v += dpp0f<0x112, 0xf>(v); v += dpp0f<0x114, 0xf>(v); v += dpp0f<0x118, 0xf>(v);
  v += dpp0f<0x142, 0xa>(v); v += dpp0f<0x143, 0xc>(v);
  return __int_as_float(__builtin_amdgcn_readlane(__float_as_int(v), 63));
}
__device__ __forceinline__ float* xrow_ptr(const P& p, int r) {
  int b = r / ST, t = r - b * ST;
  return t < SL ? p.out + ((size_t)(b * SL + t)) * DM : p.Xc + ((size_t)(b * SC + t - SL)) * DM;
}
__device__ __forceinline__ int mod_idx(int r) { int b = r / ST, t = r - b * ST; return t < SL ? b : 8; }

template <int MT>
__device__ __forceinline__ void gemm_main(const u16* __restrict__ A, int lda, const u16* __restrict__ B, int ldb, int K,
                                          u16* lds, f32x4 (&acc)[MT][4]) {
  constexpr int BM = MT * 64;
  constexpr int ASZ = BM * 72, BSZ = 128 * 72, STG = ASZ + BSZ;
  int tid = threadIdx.x; asm volatile("" : "+v"(tid));
  const int lane = tid & 63, wid = tid >> 6, wr = wid >> 1, wc = wid & 1, fr = lane & 15, fq = lane >> 4;
  uint4 ra[MT], rb[2];
  const int nk = K >> 6;
  const int crow = tid >> 3, ckc = (tid & 7) * 8;
#pragma unroll
  for (int i = 0; i < MT; ++i) ra[i] = *(const uint4*)(A + (size_t)(crow + i * 64) * lda + ckc);
#pragma unroll
  for (int i = 0; i < 2; ++i) rb[i] = *(const uint4*)(B + (size_t)(crow + i * 64) * ldb + ckc);
  {
    u16* sa = lds; u16* sb = lds + ASZ;
#pragma unroll
    for (int i = 0; i < MT; ++i) *(uint4*)(sa + (crow + i * 64) * 72 + ckc) = ra[i];
#pragma unroll
    for (int i = 0; i < 2; ++i) *(uint4*)(sb + (crow + i * 64) * 72 + ckc) = rb[i];
  }
  __syncthreads();
  for (int kt = 0; kt < nk; ++kt) {
    const bool more = (kt + 1 < nk);
    if (more) {
      const int k0 = (kt + 1) * 64 + ckc;
#pragma unroll
      for (int i = 0; i < MT; ++i) ra[i] = *(const uint4*)(A + (size_t)(crow + i * 64) * lda + k0);
#pragma unroll
      for (int i = 0; i < 2; ++i) rb[i] = *(const uint4*)(B + (size_t)(crow + i * 64) * ldb + k0);
    }
    const u16* sa = lds + (kt & 1) * STG;
    const u16* sb = sa + ASZ;
#pragma unroll
    for (int ks = 0; ks < 2; ++ks) {
      bf16x8 a[MT], b[4];
#pragma unroll
      for (int m = 0; m < MT; ++m) a[m] = *(const bf16x8*)(sa + (wr * MT * 16 + m * 16 + fr) * 72 + ks * 32 + fq * 8);
#pragma unroll
      for (int n = 0; n < 4; ++n) b[n] = *(const bf16x8*)(sb + (wc * 64 + n * 16 + fr) * 72 + ks * 32 + fq * 8);
#pragma unroll
      for (int m = 0; m < MT; ++m)
#pragma unroll
        for (int n = 0; n < 4; ++n) acc[m][n] = __builtin_amdgcn_mfma_f32_16x16x32_bf16(a[m], b[n], acc[m][n], 0, 0, 0);
    }
    if (more) {
      u16* wa = lds + ((kt + 1) & 1) * STG; u16* wb = wa + ASZ;
#pragma unroll
      for (int i = 0; i < MT; ++i) *(uint4*)(wa + (crow + i * 64) * 72 + ckc) = ra[i];
#pragma unroll
      for (int i = 0; i < 2; ++i) *(uint4*)(wb + (crow + i * 64) * 72 + ckc) = rb[i];
    }
    __syncthreads();
  }
}

__device__ __forceinline__ void gemm_main128(const u16* __restrict__ A, int lda, const u16* __restrict__ B, int ldb, int K,
                                             u16* lds, f32x4 (&acc)[2][4]) {
  constexpr int RS = 136, ASZ = 128 * RS, BSZ = 128 * RS, STG = ASZ + BSZ;
  int tid = threadIdx.x; asm volatile("" : "+v"(tid));
  const int lane = tid & 63, wid = tid >> 6, wr = wid >> 1, wc = wid & 1, fr = lane & 15, fq = lane >> 4;
  const int r0 = tid >> 4, kc8 = (tid & 15) * 8;
  uint4 pa0, pa1, pa2, pa3, pb0, pb1, pb2, pb3, qa0, qa1, qa2, qa3, qb0, qb1, qb2, qb3;
  const int nk = K >> 7;
#define G128_LD(X, kt) do { const int k0_ = (kt) * 128 + kc8; \
    X##a0 = *(const uint4*)(A + (size_t)(r0) * lda + k0_); X##a1 = *(const uint4*)(A + (size_t)(r0 + 32) * lda + k0_); \
    X##a2 = *(const uint4*)(A + (size_t)(r0 + 64) * lda + k0_); X##a3 = *(const uint4*)(A + (size_t)(r0 + 96) * lda + k0_); \
    X##b0 = *(const uint4*)(B + (size_t)(r0) * ldb + k0_); X##b1 = *(const uint4*)(B + (size_t)(r0 + 32) * ldb + k0_); \
    X##b2 = *(const uint4*)(B + (size_t)(r0 + 64) * ldb + k0_); X##b3 = *(const uint4*)(B + (size_t)(r0 + 96) * ldb + k0_); } while (0)
#define G128_ST(X, st) do { u16* sa_ = lds + (st) * STG; u16* sb_ = sa_ + ASZ; \
    *(uint4*)(sa_ + (r0) * RS + kc8) = X##a0; *(uint4*)(sa_ + (r0 + 32) * RS + kc8) = X##a1; *(uint4*)(sa_ + (r0 + 64) * RS + kc8) = X##a2; *(uint4*)(sa_ + (r0 + 96) * RS + kc8) = X##a3; \
    *(uint4*)(sb_ + (r0) * RS + kc8) = X##b0; *(uint4*)(sb_ + (r0 + 32) * RS + kc8) = X##b1; *(uint4*)(sb_ + (r0 + 64) * RS + kc8) = X##b2; *(uint4*)(sb_ + (r0 + 96) * RS + kc8) = X##b3; } while (0)
#define G128_MMA(st) do { const u16* sa = lds + (st) * STG; const u16* sb = sa + ASZ; \
    _Pragma("unroll") for (int ks = 0; ks < 4; ++ks) { bf16x8 a[2], b[4]; \
      _Pragma("unroll") for (int m = 0; m < 2; ++m) a[m] = *(const bf16x8*)(sa + (wr * 32 + m * 16 + fr) * RS + ks * 32 + fq * 8); \
      _Pragma("unroll") for (int n = 0; n < 4; ++n) b[n] = *(const bf16x8*)(sb + (wc * 64 + n * 16 + fr) * RS + ks * 32 + fq * 8); \
      _Pragma("unroll") for (int m = 0; m < 2; ++m) _Pragma("unroll") for (int n = 0; n < 4; ++n) \
        acc[m][n] = __builtin_amdgcn_mfma_f32_16x16x32_bf16(a[m], b[n], acc[m][n], 0, 0, 0); } } while (0)
  G128_LD(p, 0); G128_ST(p, 0);
  if (nk > 1) G128_LD(p, 1);
  __syncthreads();
  for (int kt = 0; kt < nk; kt += 2) {
    if (kt + 2 < nk) G128_LD(q, kt + 2);
    if (kt + 1 < nk) G128_ST(p, 1);
    G128_MMA(0);
    __syncthreads();
    if (kt + 1 < nk) {
      if (kt + 3 < nk) G128_LD(p, kt + 3);
      if (kt + 2 < nk) G128_ST(q, 0);
      G128_MMA(1);
      __syncthreads();
    }
  }
#undef G128_LD
#undef G128_ST
#undef G128_MMA
}

template <int MT, class Pre, class Epi>
__device__ __forceinline__ void gemm_phase(const u16* A, int lda, const u16* B, int ldb, int K, int nct, u16* lds, Pre pre,
                                           Epi epi, int id0, int idstride, int idoff) {
  constexpr int BM = MT * 64;
  const int nrt = MTOT / BM, ntile = nrt * nct;
  int first = id0;
  if (first < idoff) { int kk = (idoff - first + idstride - 1) / idstride; first += kk * idstride; }
  for (int gid = first; gid < idoff + ntile; gid += idstride) {
    int id = gid - idoff;
    int g = id / (8 * nct), rem = id - g * 8 * nct;
    int ct = rem >> 3, rt = g * 8 + (rem & 7);
    f32x4 acc[MT][4];
#pragma unroll
    for (int m = 0; m < MT; ++m)
#pragma unroll
      for (int n = 0; n < 4; ++n) acc[m][n] = (f32x4){0.f, 0.f, 0.f, 0.f};
    pre(rt * BM);
    gemm_main<MT>(A + (size_t)rt * BM * lda, lda, B + (size_t)ct * 128 * ldb, ldb, K, lds, acc);
    epi(rt * BM, ct * 128, acc);
    __syncthreads();
  }
}

#define LAS3 __attribute__((address_space(3)))
namespace g8 {
constexpr int BM = 256, BK = 64, HALF = 128, HTB = HALF * BK * 2, STAGE_BYTES = 8 * HTB, NXCD = 8, WGM = 8;
__device__ __forceinline__ int lds_byte(int r, int c) { const int st = (r >> 4) * 2 + (c >> 5), rr = r & 15, cc = c & 31, ob = rr * 64 + cc * 2; return st * 1024 + (ob ^ (((ob >> 9) & 1) << 5)); }
__device__ __forceinline__ void stage_rc(int b, int& R, int& C) { const int st = b / 1024, sb = b % 1024, swz = sb ^ (((sb >> 9) & 1) << 5); R = (st >> 1) * 16 + swz / 64; C = (st & 1) * 32 + (swz % 64) / 2; }
__device__ __forceinline__ int perm32(int rho) { const int n = rho >> 4, i = rho & 15; return 8 * (i >> 2) + 4 * n + (i & 3); }
struct Unit { const char* A; const char* B; int lda, K, pm, pn, aux; };
struct Order {
  int nM, nN, nwg, G, c;
  __device__ void init(int nM_, int nN_, int G_, int c_) { nM = nM_; nN = nN_; nwg = nM * nN; G = G_; c = c_; }
  __device__ bool tile(int i, int& pm, int& pn) const {
    const long L = (long)i * G + c; if (L >= nwg) return false;
    int wgid = (int)L; { const int q = nwg / NXCD, r = nwg % NXCD, xcd = wgid % NXCD, off = wgid / NXCD; wgid = (xcd < r ? xcd * (q + 1) : r * (q + 1) + (xcd - r) * q) + off; }
    const int nig = WGM * nN, gid = wgid / nig, fm = gid * WGM, gsz = (nM - fm) < WGM ? (nM - fm) : WGM;
    pm = fm + ((wgid % nig) % gsz); pn = (wgid % nig) / gsz;
    if (nM == 128) pm += pm >> 4;
    return true;
  }
};
struct Simple {
  Order o; const u16* A; const u16* Bt; int lda, K;
  __device__ bool next(int i, Unit& u) const {
    int pm, pn; if (!o.tile(i, pm, pn)) return false;
    u.A = (const char*)(A + (size_t)pm * 256 * lda); u.B = (const char*)(Bt + (size_t)pn * 256 * K); u.lda = lda; u.K = K; u.pm = pm; u.pn = pn; u.aux = 0; return true;
  }
};
__device__ __forceinline__ unsigned cvt_pk_bf16(float lo, float hi) { unsigned r; asm volatile("v_cvt_pk_bf16_f32 %0, %1, %2" : "=v"(r) : "v"(lo), "v"(hi)); return r; }

template <bool PERM, class Sched, class Epi>
__device__ __forceinline__ void gemm_phase(LAS3 unsigned char* lds, const Sched& S, const Epi& E) {
  int tid = threadIdx.x; asm volatile("" : "+v"(tid));
  const int wid = __builtin_amdgcn_readfirstlane(tid >> 6), lane = tid & 63, wr = wid >> 2, wc = wid & 3, fr = lane & 15, fq = lane >> 4;
  const size_t kstep = (size_t)(BK * 2);
#define G8_VOFF(LDA_, K_) do { int _t2 = tid; asm volatile("" : "+v"(_t2)); _Pragma("unroll") for (int _i = 0; _i < 2; ++_i) { int R, C; stage_rc(_t2 * 16 + _i * 8192, R, C); \
    const int Rb = PERM ? ((R & ~31) + perm32(R & 31)) : R; voffA[_i] = (unsigned)(R * (LDA_) + C) * 2u; voffB[_i] = (unsigned)(Rb * (K_) + C) * 2u; } \
    hstepA = (size_t)HALF * (LDA_) * 2; hstepB = (size_t)HALF * (K_) * 2; } while (0)
  const unsigned ldsw = (unsigned)wid * 1024u;
  const int aoff = lds_byte(wr * 64 + fr, fq * 8), boff = lds_byte(wc * 32 + fr, fq * 8);
#define G8_SA(b, h) (((b) * 2 + (h)) * HTB)
#define G8_SB(b, h) ((4 + (b) * 2 + (h)) * HTB)
#define G8_STAGE(bufoff, gbase, voff) do { _Pragma("unroll") for (int _i = 0; _i < 2; ++_i) \
    __builtin_amdgcn_global_load_lds((const unsigned*)((const char*)(gbase) + (voff)[_i]), (LAS3 unsigned*)(lds + (bufoff) + ldsw + _i * 8192), 16, 0, 0); } while (0)
#define G8_LDA(dst, b, h) do { _Pragma("unroll") for (int m = 0; m < 4; ++m) _Pragma("unroll") for (int k = 0; k < 2; ++k) dst[m][k] = *(const LAS3 bf16x8*)(lds + G8_SA(b, h) + aoff + m * 2048 + k * 1024); } while (0)
#define G8_LDB(dst, b, h) do { _Pragma("unroll") for (int n = 0; n < 2; ++n) _Pragma("unroll") for (int k = 0; k < 2; ++k) dst[n][k] = *(const LAS3 bf16x8*)(lds + G8_SB(b, h) + boff + n * 2048 + k * 1024); } while (0)
#define G8_MMA(ai, bj, At, Bt) do { __builtin_amdgcn_s_setprio(1); _Pragma("unroll") for (int m = 0; m < 4; ++m) _Pragma("unroll") for (int n = 0; n < 2; ++n) _Pragma("unroll") for (int k = 0; k < 2; ++k) \
    acc[ai][bj][m][n] = __builtin_amdgcn_mfma_f32_16x16x32_bf16(Bt[n][k], At[m][k], acc[ai][bj][m][n], 0, 0, 0); __builtin_amdgcn_s_setprio(0); } while (0)
#define G8_WAIT_V(n) asm volatile("s_waitcnt vmcnt(" #n ")" ::: "memory")
#define G8_WAIT_L(n) asm volatile("s_waitcnt lgkmcnt(" #n ")" ::: "memory")
#define G8_BAR __builtin_amdgcn_s_barrier()
#define G8_SCHED __builtin_amdgcn_sched_barrier(0)
  Unit cur, nxt; int ui = 0;
  if (!S.next(0, cur)) return;
  f32x4 acc[2][2][4][2];
#pragma unroll
  for (int a = 0; a < 2; ++a)
#pragma unroll
    for (int b = 0; b < 2; ++b)
#pragma unroll
      for (int m = 0; m < 4; ++m)
#pragma unroll
        for (int n = 0; n < 2; ++n) acc[a][b][m][n] = (f32x4){0.f, 0.f, 0.f, 0.f};
  bf16x8 At[4][2], B0[2][2], B1[2][2];
  const char* cA = cur.A; const char* cB = cur.B;
  unsigned voffA[2], voffB[2];
  size_t hstepA, hstepB;
  G8_VOFF(cur.lda, cur.K);
  G8_STAGE(G8_SB(0, 0), cB, voffB); G8_STAGE(G8_SA(0, 0), cA, voffA); G8_STAGE(G8_SB(0, 1), cB + hstepB, voffB); G8_STAGE(G8_SA(0, 1), cA + hstepA, voffA);
  if (wr == 1) G8_BAR;
  G8_WAIT_V(4); G8_BAR;
  G8_STAGE(G8_SB(1, 0), cB + kstep, voffB); G8_STAGE(G8_SA(1, 0), cA + kstep, voffA); G8_STAGE(G8_SB(1, 1), cB + hstepB + kstep, voffB);
  G8_WAIT_V(6); G8_BAR;
  for (;;) {
    const bool has_next = S.next(ui + 1, nxt);
    if (!has_next) nxt = cur;
    const char* nA = nxt.A; const char* nB = nxt.B;
    const int nt = cur.K / BK;
    for (int t = 0; t < nt; t += 2) {
      const bool last = (t == nt - 2);
      const char* a1 = cA + (size_t)(t + 1) * kstep;
      const char* a2 = last ? nA : cA + (size_t)(t + 2) * kstep; const char* b2 = last ? nB : cB + (size_t)(t + 2) * kstep;
      const char* a3 = a2 + kstep; const char* b3 = b2 + kstep;
      G8_LDB(B0, 0, 0); G8_SCHED; G8_LDA(At, 0, 0); G8_STAGE(G8_SA(1, 1), a1 + hstepA, voffA);
      G8_WAIT_L(8); G8_BAR; G8_WAIT_L(0); G8_MMA(0, 0, At, B0); G8_BAR; G8_SCHED;
      if (last) G8_VOFF(nxt.lda, nxt.K);
      G8_LDB(B1, 0, 1); G8_STAGE(G8_SB(0, 0), b2, voffB);
      G8_BAR; G8_WAIT_L(0); G8_MMA(0, 1, At, B1); G8_BAR;
      G8_LDA(At, 0, 1); G8_STAGE(G8_SA(0, 0), a2, voffA);
      G8_BAR; G8_WAIT_L(0); G8_MMA(1, 0, At, B0); G8_BAR; G8_SCHED;
      G8_STAGE(G8_SB(0, 1), b2 + hstepB, voffB);
      G8_WAIT_V(6); G8_BAR; G8_MMA(1, 1, At, B1); G8_BAR;
      G8_LDB(B0, 1, 0); G8_SCHED; G8_LDA(At, 1, 0); G8_STAGE(G8_SA(0, 1), a2 + hstepA, voffA);
      G8_WAIT_L(8); G8_BAR; G8_WAIT_L(0); G8_MMA(0, 0, At, B0); G8_BAR; G8_SCHED;
      G8_LDB(B1, 1, 1); G8_STAGE(G8_SB(1, 0), b3, voffB);
      G8_BAR; G8_WAIT_L(0); G8_MMA(0, 1, At, B1); G8_BAR;
      G8_LDA(At, 1, 1); G8_STAGE(G8_SA(1, 0), a3, voffA);
      G8_BAR; G8_WAIT_L(0); G8_MMA(1, 0, At, B0); G8_BAR; G8_SCHED;
      G8_STAGE(G8_SB(1, 1), b3 + hstepB, voffB);
      G8_WAIT_V(6); G8_BAR; G8_MMA(1, 1, At, B1); G8_BAR;
    }
    E(acc, cur, wr, wc, fr, fq, tid);
    if (!has_next) break;
#pragma unroll
    for (int a = 0; a < 2; ++a)
#pragma unroll
      for (int b = 0; b < 2; ++b)
#pragma unroll
        for (int m = 0; m < 4; ++m)
#pragma unroll
          for (int n = 0; n < 2; ++n) acc[a][b][m][n] = (f32x4){0.f, 0.f, 0.f, 0.f};
    cur = nxt; cA = nA; cB = nB; ++ui;
  }
  G8_WAIT_V(0);
  if (wr == 0) G8_BAR;
  G8_BAR;
#undef G8_VOFF
#undef G8_SA
#undef G8_SB
#undef G8_STAGE
#undef G8_LDA
#undef G8_LDB
#undef G8_MMA
#undef G8_WAIT_V
#undef G8_WAIT_L
#undef G8_BAR
#undef G8_SCHED
}
}

__device__ __forceinline__ void convT_job(const float* src0, const float* src1, int ldsrc, int kind, int off, int nvalid, u16* dst, int K,
                          int Ndst, const float* kscale, float mult, float* lds) {
  int tid = threadIdx.x; asm volatile("" : "+v"(tid));
  const int nkt = K >> 6, nitems = nkt * (Ndst >> 7);
  for (int it = blockIdx.x; it < nitems; it += gridDim.x) {
    const int kt = it % nkt, nt = it / nkt;
    float v[16];
#pragma unroll
    for (int e = 0; e < 16; ++e) {
      int idx = tid + e * 512, i = idx >> 7, j = idx & 127, n = nt * 128 + j, k = kt * 64 + i;
      if (kind == 0) {
        v[e] = (n < nvalid) ? src0[(size_t)k * ldsrc + off + n] : 0.f;
      } else {
        int g = n >> 8, w = n & 255;
        const float* sp = (w < 128) ? src0 : src1;
        v[e] = sp[(size_t)k * ldsrc + g * 128 + (w & 127)];
      }
    }
#pragma unroll
    for (int e = 0; e < 16; ++e) {
      int idx = tid + e * 512, i = idx >> 7, j = idx & 127, k = kt * 64 + i;
      float x = v[e];
      if (kscale) x *= kscale[k];
      lds[j * 65 + i] = x * mult;
    }
    __syncthreads();
#pragma unroll
    for (int e = 0; e < 8; ++e) {
      int idx = tid + e * 512, j = idx >> 5, i2 = (idx & 31) * 2;
      *(uint32_t*)(dst + (size_t)(nt * 128 + j) * K + kt * 64 + i2) = pack2(lds[j * 65 + i2], lds[j * 65 + i2 + 1]);
    }
    __syncthreads();
  }
}

__device__ void convert_weights(const P& p, int l, float* lds) {
  const float* win = p.w_in + (size_t)l * 1024 * 8352;
#pragma unroll 1
  for (int job = 0; job < 12; ++job) {
    const float* s0 = win; const float* s1 = nullptr; const float* ksc = nullptr;
    int ldsrc = 8352, kind = 0, off = 0, nvalid = 0, K = 1024, Ndst = 0; float mult = 1.f; u16* dst = p.W;
    if (job == 0) { off = 1696; nvalid = 2560; dst += OFF_WINA; Ndst = 2560; }
    else if (job == 1) { off = 0; nvalid = 1696; dst += OFF_WINB; Ndst = 1792; }
    else if (job == 2) { off = 4256; nvalid = 4096; dst += OFF_WGATE; Ndst = 4096; }
    else if (job < 7) { const int n = job - 3; s0 = p.w_branch + ((size_t)l * 4 + n) * 512 * 1024; ldsrc = 1024; nvalid = 1024; dst += OFF_WBR + (size_t)n * 1024 * 512; K = 512; Ndst = 1024; }
    else if (job == 7) { s0 = p.w_out + (size_t)l * 1024 * 1024; ldsrc = 1024; nvalid = 1024; dst += OFF_WOUT; Ndst = 1024; }
    else if (job == 8) { s0 = p.w_ff1 + (size_t)l * 1024 * 2816; s1 = p.w_ff3 + (size_t)l * 1024 * 2816; ldsrc = 2816; kind = 1; dst += OFF_WFF13; Ndst = 5632; }
    else if (job == 9) { s0 = p.w_ff2 + (size_t)l * 2816 * 1024; ldsrc = 1024; nvalid = 1024; dst += OFF_WFF2; K = 2816; Ndst = 1024; }
    else if (job == 10) { s0 = p.w_q_up + (size_t)l * 384 * 768; ldsrc = 768; nvalid = 768; dst += OFF_WQUP; K = 384; Ndst = 768; ksc = p.q_norm_g + l * 384; mult = 0.10206207261596575f * 1.4426950408889634f; }
    else { s0 = p.w_kv_up + (size_t)l * 256 * 1024; ldsrc = 1024; nvalid = 1024; dst += OFF_WKVUP; K = 256; Ndst = 1024; ksc = p.kv_norm_g + l * 256; }
    convT_job(s0, s1, ldsrc, kind, off, nvalid, dst, K, Ndst, ksc, mult, lds);
  }
  int tidc = threadIdx.x; asm volatile("" : "+v"(tidc));
  const int gt = blockIdx.x * NTHR + tidc, gs = gridDim.x * NTHR;
  for (int i = gt; i < 4 * 128 * 128; i += gs) p.W[OFF_WS + i] = f2bf(p.cmlp_w_s[(size_t)l * 65536 + i]);
  for (int i = gt; i < 2 * 8 * 128 * 64; i += gs) {
    int k = i & 63, n = (i >> 6) & 127, h = (i >> 13) & 7, d = i >> 16;
    const float* src = (n < 64) ? p.lru_w_a : p.lru_w_x;
    p.W[OFF_WLRU + i] = f2bf(src[((((size_t)l * 2 + d) * 8 + h) * 64 + k) * 64 + (n & 63)]);
  }
}

__device__ void phase0(const P& p, unsigned char* smem) {
  int tid = threadIdx.x; asm volatile("" : "+v"(tid));
  const int gt = blockIdx.x * NTHR + tid, gs = gridDim.x * NTHR;
  {
    const float4* s = (const float4*)p.x; float4* d = (float4*)p.out;
    for (int i = gt; i < NB * SL * DM / 4; i += gs) d[i] = s[i];
    const float4* s2 = (const float4*)p.ctx; float4* d2 = (float4*)p.Xc;
    for (int i = gt; i < NB * SC * DM / 4; i += gs) d2[i] = s2[i];
  }
  for (int idx = gt; idx < SL * 8; idx += gs) {
    int t = idx >> 3, i = idx & 7;
    float inv = exp2f(-(float)i * 0.125f * 13.287712379549449f);
    float ar = (float)(t >> 6) * inv, ac = (float)(t & 63) * inv;
    const float i2pi = 0.15915494309189535f;
    float rr = ar * i2pi; rr -= floorf(rr); rr *= 6.283185307179586f;
    float rc = ac * i2pi; rc -= floorf(rc); rc *= 6.283185307179586f;
    p.rope[t * 32 + i] = __cosf(rr); p.rope[t * 32 + 8 + i] = __sinf(rr);
    p.rope[t * 32 + 16 + i] = __cosf(rc); p.rope[t * 32 + 24 + i] = __sinf(rc);
  }
  float* sS = (float*)smem; float* red = sS + 9 * 1024;
  for (int it = blockIdx.x; it < 4 * 96; it += gridDim.x) {
    const int l = it / 96, cgp = it - l * 96;
    for (int idx = tid; idx < 9216; idx += 512) {
      int m = idx >> 10, k = idx & 1023;
      float v = (m < 8) ? p.c[m * 1024 + k] : p.c_ctx[k];
      sS[idx] = siluf_(v);
    }
    __syncthreads();
    const int cj = tid & 63, kp = tid >> 6, j = cgp * 64 + cj;
    float a[9];
#pragma unroll
    for (int m = 0; m < 9; ++m) a[m] = 0.f;
    for (int k0 = kp * 128; k0 < kp * 128 + 128; k0 += 16) {
      float w[16];
#pragma unroll
      for (int u = 0; u < 16; ++u) w[u] = p.w_mod[((size_t)l * 1024 + k0 + u) * 6144 + j];
#pragma unroll
      for (int u = 0; u < 16; ++u)
#pragma unroll
        for (int m = 0; m < 9; ++m) a[m] += sS[m * 1024 + k0 + u] * w[u];
    }
#pragma unroll
    for (int m = 0; m < 9; ++m) red[(kp * 9 + m) * 64 + cj] = a[m];
    __syncthreads();
    for (int idx = tid; idx < 576; idx += 512) {
      int m = idx >> 6, c2 = idx & 63;
      float s = 0.f;
      for (int q = 0; q < 8; ++q) s += red[(q * 9 + m) * 64 + c2];
      p.mod[((size_t)l * 9 + m) * 6144 + cgp * 64 + c2] = s + p.b_mod[l * 6144 + cgp * 64 + c2];
    }
    __syncthreads();
  }
}

__device__ void norm_mod(const P& p, int l, const float* g, int off_sh, int off_sc) {
  int tid = threadIdx.x; asm volatile("" : "+v"(tid));
  const int lane = tid & 63, wid = tid >> 6;
  for (int r = blockIdx.x * 8 + wid; r < MTOT; r += gridDim.x * 8) {
    const float* xr = xrow_ptr(p, r);
    const float* md = p.mod + ((size_t)l * 9 + mod_idx(r)) * 6144;
    float4 v[4];
    float ss = 0.f;
#pragma unroll
    for (int i = 0; i < 4; ++i) {
      v[i] = *(const float4*)(xr + i * 256 + lane * 4);
      ss += v[i].x * v[i].x + v[i].y * v[i].y + v[i].z * v[i].z + v[i].w * v[i].w;
    }
    ss = wave_sum(ss);
    const float inv = rsqrtf(ss * (1.f / 1024.f) + EPS);
#pragma unroll
    for (int i = 0; i < 4; ++i) {
      const int k = i * 256 + lane * 4;
      float4 gg = *(const float4*)(g + k);
      float4 sh = *(const float4*)(md + off_sh + k);
      float4 sc = *(const float4*)(md + off_sc + k);
      float o0 = v[i].x * inv * gg.x * (1.f + sc.x) + sh.x;
      float o1 = v[i].y * inv * gg.y * (1.f + sc.y) + sh.y;
      float o2 = v[i].z * inv * gg.z * (1.f + sc.z) + sh.z;
      float o3 = v[i].w * inv * gg.w * (1.f + sc.w) + sh.w;
      uint2 o; o.x = pack2(o0, o1); o.y = pack2(o2, o3);
      *(uint2*)(p.H + (size_t)r * 1024 + k) = o;
    }
  }
}

__device__ void conva_item(const P& p, int l, int item) {
  int tid = threadIdx.x; asm volatile("" : "+v"(tid));
  const u16* Zb1 = p.R1;
  const float* cw = p.conv_a_w + (size_t)l * 3 * 512;
  for (int e = 0; e < 32; ++e) {
    int idx = tid + e * 512, rr = idx >> 6, cgp = idx & 63;
    int r = item * 256 + rr;
    int b = r / ST, t = r - b * ST;
    int isctx = t >= SL, pos = isctx ? t - SL : t, seglen = isctx ? SC : SL;
    float acc[8];
#pragma unroll
    for (int i = 0; i < 8; ++i) acc[i] = 0.f;
#pragma unroll
    for (int k = 0; k < 3; ++k) {
      int pos2 = pos - 1 + k;
      if (pos2 >= 0 && pos2 < seglen) {
        size_t r2 = (size_t)(r - 1 + k);
        uint4 vc = *(const uint4*)(Zb1 + r2 * 2560 + 512 + cgp * 8);
        uint4 vx = *(const uint4*)(Zb1 + r2 * 2560 + 1024 + cgp * 8);
        float fc[8], fx[8];
        unpack8(vc, fc); unpack8(vx, fx);
#pragma unroll
        for (int i = 0; i < 8; ++i) acc[i] += cw[k * 512 + cgp * 8 + i] * (fc[i] * fx[i]);
      }
    }
    uint4 vb = *(const uint4*)(Zb1 + (size_t)r * 2560 + cgp * 8);
    float fb[8];
    unpack8(vb, fb);
#pragma unroll
    for (int i = 0; i < 8; ++i) acc[i] *= fb[i];
    *(uint4*)(p.Ycat + (size_t)r * 2048 + cgp * 8) = pack8(acc);
  }
}

__device__ void cmlp_item(const P& p, int l, int item, unsigned char* smem) {
  int tid = threadIdx.x; asm volatile("" : "+v"(tid));
  const int lane = tid & 63, wid = tid >> 6, fr = lane & 15, fq = lane >> 4;
  const int g = item & 3, bj = item >> 2;
  const int rowbase = bj * 128;
  u16* vT = (u16*)smem;
  float* sMu = (float*)(smem + 128 * 136 * 2);
  float* sRs = sMu + 128;
  const u16* Zb1 = p.R1;
  {
    uint4 vv[16];
#pragma unroll
    for (int rr = 0; rr < 16; ++rr) vv[rr] = *(const uint4*)(Zb1 + (size_t)(rowbase + wid * 16 + rr) * 2560 + 2048 + lane * 8);
#pragma unroll
    for (int rr = 0; rr < 16; ++rr) {
      int q = wid * 16 + rr;
      float f[8];
      unpack8(vv[rr], f);
      float s = 0.f;
#pragma unroll
      for (int i = 0; i < 8; ++i) { f[i] = geluf_(f[i]); s += f[i]; }
      s = wave_sum(s);
      float mu = s * (1.f / 512.f);
      float d2 = 0.f;
#pragma unroll
      for (int i = 0; i < 8; ++i) { float d = f[i] - mu; d2 += d * d; }
      d2 = wave_sum(d2);
      if (lane == 0) { sMu[q] = mu; sRs[q] = rsqrtf(d2 * (1.f / 512.f) + EPS); }
    }
  }
  __syncthreads();
  const float* lg = p.cmlp_ln_g + l * 512 + g * 128;
  const float* lb = p.cmlp_ln_b + l * 512 + g * 128;
#pragma unroll
  for (int e = 0; e < 4; ++e) {
    int idx = tid + e * 512, q = idx >> 4, dc = idx & 15;
    uint4 v = *(const uint4*)(Zb1 + (size_t)(rowbase + q) * 2560 + 2048 + g * 128 + dc * 8);
    float f[8];
    unpack8(v, f);
    float mu = sMu[q], rs = sRs[q];
#pragma unroll
    for (int i = 0; i < 8; ++i) {
      float val = (geluf_(f[i]) - mu) * rs * lg[dc * 8 + i] + lb[dc * 8 + i];
      vT[(dc * 8 + i) * 136 + q] = f2bf(val);
    }
  }
  __syncthreads();
  const u16* Ws = p.W + OFF_WS + (size_t)g * 128 * 128;
  f32x4 acc[8];
#pragma unroll
  for (int n = 0; n < 8; ++n) acc[n] = (f32x4){0.f, 0.f, 0.f, 0.f};
#pragma unroll
  for (int ks = 0; ks < 4; ++ks) {
    bf16x8 a = *(const bf16x8*)(Ws + (wid * 16 + fr) * 128 + ks * 32 + fq * 8);
#pragma unroll
    for (int n = 0; n < 8; ++n) {
      bf16x8 bb = *(const bf16x8*)(vT + (n * 16 + fr) * 136 + ks * 32 + fq * 8);
      acc[n] = __builtin_amdgcn_mfma_f32_16x16x32_bf16(bb, a, acc[n], 0, 0, 0);
    }
  }
  {
    const int pp = wid * 16 + fr;
    const size_t r = (size_t)(rowbase + pp);
    const float bsv = p.cmlp_b_s[((size_t)l * 4 + g) * 128 + pp];
    uint2 uu[8];
#pragma unroll
    for (int n = 0; n < 8; ++n) uu[n] = *(const uint2*)(Zb1 + r * 2560 + 1536 + g * 128 + n * 16 + fq * 4);
#pragma unroll
    for (int n = 0; n < 8; ++n) {
      float u0 = __uint_as_float(uu[n].x << 16), u1 = __uint_as_float(uu[n].x & 0xffff0000u);
      float u2 = __uint_as_float(uu[n].y << 16), u3 = __uint_as_float(uu[n].y & 0xffff0000u);
      uint2 ov;
      ov.x = pack2(geluf_(u0) * (acc[n][0] + bsv), geluf_(u1) * (acc[n][1] + bsv));
      ov.y = pack2(geluf_(u2) * (acc[n][2] + bsv), geluf_(u3) * (acc[n][3] + bsv));
      *(uint2*)(p.Ycat + r * 2048 + 1024 + g * 128 + n * 16 + fq * 4) = ov;
    }
  }
  __syncthreads();
}

template <int CTRL, int ROWMASK>
__device__ __forceinline__ float dppf(float old, float src) {
  return __int_as_float(__builtin_amdgcn_update_dpp(__float_as_int(old), __float_as_int(src), CTRL, ROWMASK, 0xf, false));
}
#define LSCAN_STEP(A_, B_, CTRL, RM) do { const float A2_ = dppf<CTRL, RM>(1.f, A_), B2_ = dppf<CTRL, RM>(0.f, B_); B_ = A_ * B2_ + B_; A_ = A_ * A2_; } while (0)
#define LSCAN64(A_, B_) do { LSCAN_STEP(A_, B_, 0x111, 0xf); LSCAN_STEP(A_, B_, 0x112, 0xf); LSCAN_STEP(A_, B_, 0x114, 0xf); LSCAN_STEP(A_, B_, 0x118, 0xf); \
    LSCAN_STEP(A_, B_, 0x142, 0xa); LSCAN_STEP(A_, B_, 0x143, 0xc); } while (0)

template <int PASS>
__device__ void lru_run(const P& p, int l, int it_first, int it_stride, unsigned char* smem) {
  int tid = threadIdx.x; asm volatile("" : "+v"(tid));
  const int lane = tid & 63, wid = tid >> 6, fr = lane & 15, fq = lane >> 4;
  u16* sX = (u16*)smem;
  float* sA = (float*)(smem + 18432);
  float* sB = sA + 64 * 130;
  float* sH = sB + 64 * 130;
  float* sCw = sH + 128 * 65;
  float* sCarry = sCw + 320;
  float* sPar = sCarry + 128;
  u16* sW = (u16*)(sPar + 384);
  const u16* Zb2 = p.R1;
  int cur_h = -1;
  uint4 cv[2][4];
#define LRU_LOADCV(ITEM) do { const int h_ = (ITEM) & 7, bj_ = (ITEM) >> 3; const int b_ = bj_ / 34, j_ = bj_ - b_ * 34; const int ic_ = j_ >= 32; \
    const int p0_ = ic_ ? (j_ - 32) * 128 : j_ * 128, sl_ = ic_ ? SC : SL, rs_ = bj_ * 128 - p0_; \
    _Pragma("unroll") for (int e = 0; e < 2; ++e) { int idx = tid + e * 512, pp = idx >> 3, cgp = idx & 7; \
      _Pragma("unroll") for (int k = 0; k < 4; ++k) { int pos = p0_ + pp - 2 + k; cv[e][k] = make_uint4(0, 0, 0, 0); \
        if (pos >= 0 && pos < sl_) cv[e][k] = *(const uint4*)(Zb2 + (size_t)(rs_ + pos) * 1792 + h_ * 64 + cgp * 8); } } } while (0)
  if (it_first < 2176) LRU_LOADCV(it_first);
  for (int item = it_first; item < 2176; item += it_stride) {
    const int h = item & 7, bj = item >> 3;
    const int b = bj / 34, j = bj - b * 34;
    const int rowbase = bj * 128;
    const int isctx = j >= 32;
    const int ordf = isctx ? j - 32 : j + 2, ordr = 33 - j;
    float cA[16], cB[16];
    uint4 gv[2];
    if (PASS == 3) {
#pragma unroll
      for (int q = 0; q < 16; ++q) {
        const int pi = wid * 16 + q, d = pi >> 6, ch = pi & 63, o = d ? ordr : ordf;
        cA[q] = 1.f; cB[q] = 0.f;
        if (lane < o) { float2 v = p.summ[((size_t)(b * 2 + d) * 512 + h * 64 + ch) * 34 + lane]; cA[q] = v.x; cB[q] = v.y; }
      }
#pragma unroll
      for (int e = 0; e < 2; ++e) {
        int idx = tid + e * 512, pos = idx >> 3, cgp = idx & 7;
        gv[e] = *(const uint4*)(Zb2 + (size_t)(rowbase + pos) * 1792 + 800 + h * 64 + cgp * 8);
      }
    }
    if (h != cur_h) {
      cur_h = h;
      __syncthreads();
      if (tid < 320) {
        int k = tid >> 6, i = tid & 63;
        sCw[tid] = (k < 4) ? p.lru_conv_w[((size_t)l * 4 + k) * 512 + h * 64 + i] : p.lru_conv_b[l * 512 + h * 64 + i];
      }
      if (tid < 128) {
        const int d = tid >> 6, ch = tid & 63;
        const size_t pidx = ((size_t)l * 2 + d) * 512 + h * 64 + ch;
        sPar[tid * 3] = p.lru_b_a[pidx]; sPar[tid * 3 + 1] = p.lru_b_x[pidx];
        sPar[tid * 3 + 2] = 8.f * log1pf(__expf(-p.lru_lam[pidx]));
      }
#pragma unroll
      for (int e = 0; e < 4; ++e) {
        int idx = tid + e * 512, row = idx >> 3, kc = idx & 7;
        const int d = row >> 7, n = row & 127;
        *(uint4*)(sW + row * 72 + kc * 8) = *(const uint4*)(p.W + OFF_WLRU + (size_t)((d * 8 + h) * 128 + n) * 64 + kc * 8);
      }
      __syncthreads();
    }
#pragma unroll
    for (int e = 0; e < 2; ++e) {
      int idx = tid + e * 512, pp = idx >> 3, cgp = idx & 7;
      float a8[8];
#pragma unroll
      for (int i = 0; i < 8; ++i) a8[i] = sCw[256 + cgp * 8 + i];
#pragma unroll
      for (int k = 0; k < 4; ++k) {
        float f[8];
        unpack8(cv[e][k], f);
#pragma unroll
        for (int i = 0; i < 8; ++i) a8[i] += sCw[k * 64 + cgp * 8 + i] * f[i];
      }
      *(uint4*)(sX + pp * 72 + cgp * 8) = pack8(a8);
    }
    if (item + it_stride < 2176) LRU_LOADCV(item + it_stride);
    if (PASS == 3) {
#pragma unroll
      for (int q = 0; q < 16; ++q) LSCAN64(cA[q], cB[q]);
      if (lane == 63) {
#pragma unroll
        for (int q = 0; q < 16; ++q) sCarry[wid * 16 + q] = cB[q];
      }
    }
    __syncthreads();
    for (int d = 0; d < 2; ++d) {
      const u16* Wl = sW + d * 128 * 72;
      f32x4 acc[8];
#pragma unroll
      for (int n = 0; n < 8; ++n) acc[n] = (f32x4){0.f, 0.f, 0.f, 0.f};
      {
        const bf16x8 a0 = *(const bf16x8*)(sX + (wid * 16 + fr) * 72 + fq * 8);
        const bf16x8 a1 = *(const bf16x8*)(sX + (wid * 16 + fr) * 72 + 32 + fq * 8);
#pragma unroll
        for (int n = 0; n < 8; ++n) {
          const bf16x8 b0 = *(const bf16x8*)(Wl + (n * 16 + fr) * 72 + fq * 8);
          const bf16x8 b1 = *(const bf16x8*)(Wl + (n * 16 + fr) * 72 + 32 + fq * 8);
          acc[n] = __builtin_amdgcn_mfma_f32_16x16x32_bf16(a0, b0, acc[n], 0, 0, 0);
          acc[n] = __builtin_amdgcn_mfma_f32_16x16x32_bf16(a1, b1, acc[n], 0, 0, 0);
        }
      }
#pragma unroll
      for (int nt = 0; nt < 4; ++nt) {
        const int ch = nt * 16 + fr;
        const float ba = sPar[(d * 64 + ch) * 3], bx = sPar[(d * 64 + ch) * 3 + 1], sp8 = sPar[(d * 64 + ch) * 3 + 2];
#pragma unroll
        for (int jj = 0; jj < 4; ++jj) {
          const int pos = wid * 16 + fq * 4 + jj;
          const float xl = bf2f(sX[pos * 72 + ch]);
          const float rg = sigmoid_rcp_(acc[nt][jj] + ba), ig = sigmoid_rcp_(acc[nt + 4][jj] + bx);
          const float la = -sp8 * rg;
          const float av = __expf(la);
          const float x2 = 2.f * la;
          const float ser = -x2 * (1.f + x2 * (0.5f + x2 * (0.16666667f + x2 * (0.041666667f + x2 * 0.0083333333f))));
          const float om = (x2 > -0.25f) ? ser : (1.f - av * av);
          const float bb = __builtin_amdgcn_sqrtf(om) * ig * xl;
          const int si = d ? 127 - pos : pos;
          sA[ch * 130 + si] = av;
          sB[ch * 130 + si] = bb;
        }
      }
      __syncthreads();
      {
        float a0[8], b0[8], A[8], B[8];
#pragma unroll
        for (int c = 0; c < 8; ++c) {
          const int ch = wid * 8 + c;
          const float2 va = *(const float2*)(sA + ch * 130 + 2 * lane), vb = *(const float2*)(sB + ch * 130 + 2 * lane);
          a0[c] = va.x; b0[c] = vb.x;
          A[c] = va.x * va.y; B[c] = va.y * vb.x + vb.y;
        }
#pragma unroll
        for (int c = 0; c < 8; ++c) LSCAN64(A[c], B[c]);
#pragma unroll
        for (int c = 0; c < 8; ++c) {
          const int ch = wid * 8 + c;
          if (PASS == 1) {
            if (lane == 63) p.summ[((size_t)(b * 2 + d) * 512 + h * 64 + ch) * 34 + (d ? ordr : ordf)] = make_float2(A[c], B[c]);
          } else {
            const float carry = sCarry[d * 64 + ch];
            const float hincl = A[c] * carry + B[c];
            const float hprev = dppf<0x138, 0xf>(carry, hincl);
            const float heven = a0[c] * hprev + b0[c];
            const int se = 2 * lane, pe = d ? 127 - se : se, po = d ? 126 - se : se + 1;
            if (d == 0) { sH[pe * 65 + ch] = heven; sH[po * 65 + ch] = hincl; }
            else { sH[pe * 65 + ch] += heven; sH[po * 65 + ch] += hincl; }
          }
        }
      }
      __syncthreads();
    }
    if (PASS == 3) {
#pragma unroll
      for (int e = 0; e < 2; ++e) {
        int idx = tid + e * 512, pos = idx >> 3, cgp = idx & 7;
        const size_t r = (size_t)(rowbase + pos);
        float gf[8], y[8];
        unpack8(gv[e], gf);
#pragma unroll
        for (int i = 0; i < 8; ++i) y[i] = geluf_(gf[i]) * sH[pos * 65 + cgp * 8 + i];
        *(uint4*)(p.Ycat + r * 2048 + 512 + h * 64 + cgp * 8) = pack8(y);
      }
      __syncthreads();
    }
  }
}

__device__ void krope_item(const P& p, int item) {
  int tid = threadIdx.x; asm volatile("" : "+v"(tid));
  const u16* Zb2 = p.R1;
#pragma unroll
  for (int e = 0; e < 8; ++e) {
    int idx = tid + e * 512, rr = idx >> 4, pi = idx & 15, axis = pi >> 3, i = pi & 7;
    int r = item * 256 + rr, b = r / ST, t = r - b * ST;
    float x1 = bf2f(Zb2[(size_t)r * 1792 + 768 + axis * 16 + i]);
    float x2 = bf2f(Zb2[(size_t)r * 1792 + 768 + axis * 16 + 8 + i]);
    float o1 = x1, o2 = x2;
    if (t < SL) {
      float cs = p.rope[t * 32 + axis * 16 + i], sn = p.rope[t * 32 + axis * 16 + 8 + i];
      o1 = x1 * cs - x2 * sn;
      o2 = x1 * sn + x2 * cs;
    }
    u16 b1 = f2bf(o1), b2 = f2bf(o2);
#pragma unroll
    for (int h = 0; h < 8; ++h) {
      size_t base = ((size_t)(b * 8 + h) * ST + t) * 96 + 64 + axis * 16 + i;
      p.K[base] = b1;
      p.K[base + 8] = b2;
    }
  }
}

__device__ void attn_item(const P& p, int item, unsigned char* smem) {
  int tid = threadIdx.x; asm volatile("" : "+v"(tid));
  const int lane = tid & 63, wid = tid >> 6, fr = lane & 15, fq = lane >> 4;
  int b, h, t0, kt0, kt1;
  if (item < 1024) { b = item >> 7; h = (item >> 4) & 7; t0 = (item & 15) * 256; kt0 = 0; kt1 = 68; }
  else { int i2 = item - 1024; b = i2 >> 3; h = i2 & 7; t0 = SL; kt0 = 64; kt1 = 68; }
  const u16* Kb = p.K + (size_t)(b * 8 + h) * ST * 96;
  const u16* Vb = p.Vt + (size_t)(b * 8 + h) * 64 * ST;
  const u16* Qb = p.Q + (size_t)(b * 8 + h) * ST * 96;
  constexpr int KS = 104, VS = 136, KSZ = 128 * KS, VSZ = 64 * VS, STG = KSZ + VSZ;
  u16* lds = (u16*)smem;
  bf16x8 qf[2][3];
#pragma unroll
  for (int nq = 0; nq < 2; ++nq)
#pragma unroll
    for (int ks = 0; ks < 3; ++ks)
      qf[nq][ks] = *(const bf16x8*)(Qb + (size_t)(t0 + wid * 32 + nq * 16 + fr) * 96 + ks * 32 + fq * 8);
  if (item < 1024) {
#pragma unroll
    for (int nq = 0; nq < 2; ++nq) {
      const int t = t0 + wid * 32 + nq * 16 + fr;
      const float* rp = p.rope + t * 32 + (fq >> 1) * 16;
      union { bf16x8 v; uint32_t u[4]; } own, oth, res;
      own.v = qf[nq][2];
#pragma unroll
      for (int i = 0; i < 4; ++i) oth.u[i] = __shfl_xor(own.u[i], 16);
      float fo[8], fp[8], fres[8];
      { uint4 t4 = make_uint4(own.u[0], own.u[1], own.u[2], own.u[3]); unpack8(t4, fo); }
      { uint4 t4 = make_uint4(oth.u[0], oth.u[1], oth.u[2], oth.u[3]); unpack8(t4, fp); }
#pragma unroll
      for (int j = 0; j < 8; ++j) {
        float cs = rp[j], sn = rp[8 + j];
        fres[j] = (fq & 1) ? (fp[j] * sn + fo[j] * cs) : (fo[j] * cs - fp[j] * sn);
      }
      uint4 r4 = pack8(fres);
      res.u[0] = r4.x; res.u[1] = r4.y; res.u[2] = r4.z; res.u[3] = r4.w;
      qf[nq][2] = res.v;
    }
  }
  f32x4 o[4][2];
#pragma unroll
  for (int m = 0; m < 4; ++m)
#pragma unroll
    for (int n = 0; n < 2; ++n) o[m][n] = (f32x4){0.f, 0.f, 0.f, 0.f};
  float mrun[2] = {-1e30f, -1e30f}, lrun[2] = {0.f, 0.f};
  const int T0 = kt0 >> 1, T1 = kt1 >> 1;
  uint4 rk0, rk1, rk2, rv0, rv1;
  const int c0_ = tid, c1_ = tid + 512, c2_ = tid + 1024;
  const int kcv0_ = c0_ & 15, kcv1_ = c1_ & 15;
  const int vslot0_ = 32 * (kcv0_ >> 2) + 16 * (kcv0_ & 1) + 4 * ((kcv0_ & 3) >> 1);
  const int vslot1_ = 32 * (kcv1_ >> 2) + 16 * (kcv1_ & 1) + 4 * ((kcv1_ & 3) >> 1);
#define ATT_LD(tt) do { const size_t key0_ = (size_t)(tt) * 128; const u16* kb_ = Kb + key0_ * 96; \
    rk0 = *(const uint4*)(kb_ + (size_t)c0_ * 8); rk1 = *(const uint4*)(kb_ + (size_t)c1_ * 8); rk2 = *(const uint4*)(kb_ + (size_t)c2_ * 8); \
    rv0 = *(const uint4*)(Vb + (size_t)(c0_ >> 4) * ST + key0_ + (c0_ & 15) * 8); \
    rv1 = *(const uint4*)(Vb + (size_t)(c1_ >> 4) * ST + key0_ + (c1_ & 15) * 8); } while (0)
#define ATT_ST(st) do { u16* sk_ = lds + (st) * STG; u16* sv_ = sk_ + KSZ; \
    *(uint4*)(sk_ + (c0_ / 12) * KS + (c0_ % 12) * 8) = rk0; *(uint4*)(sk_ + (c1_ / 12) * KS + (c1_ % 12) * 8) = rk1; *(uint4*)(sk_ + (c2_ / 12) * KS + (c2_ % 12) * 8) = rk2; \
    *(uint2*)(sv_ + (c0_ >> 4) * VS + vslot0_) = make_uint2(rv0.x, rv0.y); *(uint2*)(sv_ + (c0_ >> 4) * VS + vslot0_ + 8) = make_uint2(rv0.z, rv0.w); \
    *(uint2*)(sv_ + (c1_ >> 4) * VS + vslot1_) = make_uint2(rv1.x, rv1.y); *(uint2*)(sv_ + (c1_ >> 4) * VS + vslot1_ + 8) = make_uint2(rv1.z, rv1.w); } while (0)
  ATT_LD(T0); ATT_ST(0);
  __syncthreads();
  for (int kt = T0; kt < T1; ++kt) {
    const bool more = (kt + 1 < T1);
    if (more) ATT_LD(kt + 1);
    const int cur = (kt - T0) & 1;
    const u16* sk = lds + cur * STG;
    const u16* sv = sk + KSZ;
    f32x4 s[8][2];
#pragma unroll
    for (int m = 0; m < 8; ++m)
#pragma unroll
      for (int n = 0; n < 2; ++n) s[m][n] = (f32x4){0.f, 0.f, 0.f, 0.f};
#pragma unroll
    for (int ks = 0; ks < 3; ++ks)
#pragma unroll
      for (int mt = 0; mt < 8; ++mt) {
        bf16x8 kf = *(const bf16x8*)(sk + (mt * 16 + fr) * KS + ks * 32 + fq * 8);
#pragma unroll
        for (int nq = 0; nq < 2; ++nq) s[mt][nq] = __builtin_amdgcn_mfma_f32_16x16x32_bf16(kf, qf[nq][ks], s[mt][nq], 0, 0, 0);
      }
    bf16x8 pb[2][4];
    float mloc[2];
#pragma unroll
    for (int nq = 0; nq < 2; ++nq) {
      float mx = fmaxf(fmaxf(s[0][nq][0], s[0][nq][1]), fmaxf(s[0][nq][2], s[0][nq][3]));
#pragma unroll
      for (int mt = 1; mt < 8; ++mt) mx = fmaxf(fmaxf(mx, s[mt][nq][0]), fmaxf(fmaxf(s[mt][nq][1], s[mt][nq][2]), s[mt][nq][3]));
      mloc[nq] = mx;
    }
    if (__any((mloc[0] > mrun[0] + 8.f) || (mloc[1] > mrun[1] + 8.f))) {
      float m0 = fmaxf(mloc[0], __shfl_xor(mloc[0], 16)), m1 = fmaxf(mloc[1], __shfl_xor(mloc[1], 16));
      m0 = fmaxf(m0, __shfl_xor(m0, 32)); m1 = fmaxf(m1, __shfl_xor(m1, 32));
      const float n0 = fmaxf(mrun[0], m0), n1 = fmaxf(mrun[1], m1);
      const float a0 = __builtin_amdgcn_exp2f(mrun[0] - n0), a1 = __builtin_amdgcn_exp2f(mrun[1] - n1);
      mrun[0] = n0; mrun[1] = n1;
      lrun[0] *= a0; lrun[1] *= a1;
#pragma unroll
      for (int mtv = 0; mtv < 4; ++mtv) {
        o[mtv][0][0] *= a0; o[mtv][0][1] *= a0; o[mtv][0][2] *= a0; o[mtv][0][3] *= a0;
        o[mtv][1][0] *= a1; o[mtv][1][1] *= a1; o[mtv][1][2] *= a1; o[mtv][1][3] *= a1;
      }
    }
#pragma unroll
    for (int nq = 0; nq < 2; ++nq) {
      const float mn = mrun[nq];
      float rs = 0.f;
#pragma unroll
      for (int mt = 0; mt < 8; ++mt)
#pragma unroll
        for (int jj = 0; jj < 4; ++jj) {
          float pv = __builtin_amdgcn_exp2f(s[mt][nq][jj] - mn);
          s[mt][nq][jj] = pv;
          rs += pv;
        }
      lrun[nq] += rs;
#pragma unroll
      for (int sx = 0; sx < 4; ++sx) {
        union { uint4 u; bf16x8 v; } cv;
        cv.u.x = pack2(s[2 * sx][nq][0], s[2 * sx][nq][1]); cv.u.y = pack2(s[2 * sx][nq][2], s[2 * sx][nq][3]);
        cv.u.z = pack2(s[2 * sx + 1][nq][0], s[2 * sx + 1][nq][1]); cv.u.w = pack2(s[2 * sx + 1][nq][2], s[2 * sx + 1][nq][3]);
        pb[nq][sx] = cv.v;
      }
    }
#pragma unroll
    for (int sx = 0; sx < 4; ++sx)
#pragma unroll
      for (int mtv = 0; mtv < 4; ++mtv) {
        const bf16x8 vf = *(const bf16x8*)(sv + (mtv * 16 + fr) * VS + 32 * sx + fq * 8);
#pragma unroll
        for (int nq = 0; nq < 2; ++nq) o[mtv][nq] = __builtin_amdgcn_mfma_f32_16x16x32_bf16(vf, pb[nq][sx], o[mtv][nq], 0, 0, 0);
      }
    if (more) ATT_ST(cur ^ 1);
    __syncthreads();
  }
#undef ATT_LD
#undef ATT_ST
#pragma unroll
  for (int nq = 0; nq < 2; ++nq) {
    float lt = lrun[nq];
    lt += __shfl_xor(lt, 16);
    lt += __shfl_xor(lt, 32);
    float inv = 1.f / lt;
    size_t r = (size_t)b * ST + t0 + wid * 32 + nq * 16 + fr;
#pragma unroll
    for (int mtv = 0; mtv < 4; ++mtv) {
      uint2 ov;
      ov.x = pack2(o[mtv][nq][0] * inv, o[mtv][nq][1] * inv);
      ov.y = pack2(o[mtv][nq][2] * inv, o[mtv][nq][3] * inv);
      *(uint2*)(p.Ycat + r * 2048 + 1536 + h * 64 + mtv * 16 + fq * 4) = ov;
    }
  }
}

#define XB_TMO      128
#define XB_XCNT(j)  (256  + 64 * (j))
#define XB_XSUB(j)  (1280 + 64 * (j))
#define XB_XGEN(j)  (2304 + 64 * (j))
#define XB_TOP      3328
#define XB_TOPGEN   3392
#define XCD_BAR_WORDS 3456
#define XB_SPIN_CAP (1u << 18)
__device__ __forceinline__ unsigned xb_ld(unsigned* p)              { return __hip_atomic_load(p, __ATOMIC_RELAXED, __HIP_MEMORY_SCOPE_AGENT); }
__device__ __forceinline__ unsigned xb_add(unsigned* p, unsigned v) { return __hip_atomic_fetch_add(p, v, __ATOMIC_RELAXED, __HIP_MEMORY_SCOPE_AGENT); }
__device__ __forceinline__ unsigned xb_xcc_id() { return (unsigned)__builtin_amdgcn_s_getreg((3 << 11) | 20) & 0xFu; }
#define XB_SPIN(cond, bar) do { unsigned _sp = 0; while (cond) { __builtin_amdgcn_s_sleep(1); \
    if ((++_sp & 255u) == 0u) { if (xb_ld(&(bar)[XB_TMO])) break; if (_sp > XB_SPIN_CAP) { atomicAdd(&(bar)[XB_TMO], 1u); break; } } } } while (0)
struct XcdBarrier { unsigned* bar; unsigned x; volatile __attribute__((address_space(3))) unsigned* st; };
__device__ __forceinline__ XcdBarrier xcd_barrier_post(unsigned* bar, volatile __attribute__((address_space(3))) unsigned* st) {
  XcdBarrier b; b.bar = bar; b.x = xb_xcc_id(); b.st = st;
  if (threadIdx.x == 0) (void)xb_add(&bar[XB_XCNT(b.x)], 1u);
  return b;
}
__device__ __forceinline__ void xcd_barrier_complete(unsigned* bar, unsigned x, unsigned& nloc, unsigned& nx) {
  const unsigned G = gridDim.x * gridDim.y * gridDim.z;
  unsigned sum, cnt, mine, sp = 0u;
  for (;;) {
    sum = 0u; cnt = 0u; mine = 0u;
#pragma unroll
    for (unsigned j = 0; j < 16; ++j) { const unsigned c = xb_ld(&bar[XB_XCNT(j)]); sum += c; cnt += (c > 0u) ? 1u : 0u; mine = (j == x) ? c : mine; }
    if (sum == G) break;
    __builtin_amdgcn_s_sleep(1);
    if ((++sp & 255u) == 0u) { if (xb_ld(&bar[XB_TMO])) break; if (sp > XB_SPIN_CAP) { atomicAdd(&bar[XB_TMO], 1u); break; } }
  }
  nloc = mine > 0u ? mine : 1u; nx = cnt > 0u ? cnt : 1u;
}
__device__ __forceinline__ void xcd_barrier(const XcdBarrier& b) {
  asm volatile("s_waitcnt vmcnt(0)" ::: "memory");
  __syncthreads();
  if (threadIdx.x == 0) {
    unsigned* bar = b.bar;
    __builtin_amdgcn_s_waitcnt(0);
    unsigned nloc = b.st[0], nx = b.st[1];
    if (nloc == 0u) { xcd_barrier_complete(bar, b.x, nloc, nx); b.st[0] = nloc; b.st[1] = nx; }
    const unsigned old = xb_add(&bar[XB_XSUB(b.x)], 1u);
    const unsigned gen = old / nloc;
    if (old + 1u == (gen + 1u) * nloc) {
      __builtin_amdgcn_fence(__ATOMIC_RELEASE, "agent");
      asm volatile("s_waitcnt vmcnt(0)" ::: "memory");
      const unsigned og = xb_add(&bar[XB_TOP], 1u);
      const unsigned tg = og / nx;
      if (og + 1u == (tg + 1u) * nx) xb_add(&bar[XB_TOPGEN], 1u);
      else XB_SPIN(xb_ld(&bar[XB_TOPGEN]) == tg, bar);
      __builtin_amdgcn_fence(__ATOMIC_ACQUIRE, "agent");
      xb_add(&bar[XB_XGEN(b.x)], 1u);
      asm volatile("s_waitcnt vmcnt(0)" ::: "memory");
    } else {
      XB_SPIN(xb_ld(&bar[XB_XGEN(b.x)]) == gen, bar);
      __builtin_amdgcn_fence(__ATOMIC_ACQUIRE, "agent");
      asm volatile("s_waitcnt vmcnt(0)" ::: "memory");
    }
  }
  __syncthreads();
}

__global__ void __launch_bounds__(NTHR) mega(P p) {
  extern __shared__ __attribute__((aligned(16))) unsigned char smem[];
  __shared__ uint4 xb_words;
  cg::grid_group grid = cg::this_grid();
  if (threadIdx.x == 0) xb_words = make_uint4(0u, 0u, 0u, 0u);
  __syncthreads();
  XcdBarrier xb = xcd_barrier_post(p.bar, (volatile __attribute__((address_space(3))) unsigned*)&xb_words);
  u16* lds = (u16*)smem;
  float* sInv = (float*)(smem + 131072);
  LAS3 unsigned char* lds3 = (LAS3 unsigned char*)smem;
  const int bid = blockIdx.x, nblk = gridDim.x;
  auto nopre = [](int) {};

#ifndef NO_P0
  phase0(p, smem);
#endif
  grid.sync();

#pragma unroll 1
  for (int l = 0; l < 4; ++l) {
    int tid = threadIdx.x; asm volatile("" : "+v"(tid));
    const int lane = tid & 63, wid = tid >> 6, wr = wid >> 1, wc = wid & 1, fr = lane & 15, fq = lane >> 4;
    (void)lane; (void)wid; (void)wr; (void)wc; (void)fr; (void)fq;
#ifndef NO_CW
    convert_weights(p, l, (float*)smem);
#endif
    norm_mod(p, l, p.norm1_g + l * 1024, 0, 1024);
    GSYNC();

    {
      u16* Zb1 = p.R1;
      auto epi = [=](const f32x4(&acc)[2][2][4][2], const g8::Unit& u, int wr, int wc, int fr, int fq, int) {
#pragma unroll
        for (int ai = 0; ai < 2; ++ai)
#pragma unroll
          for (int m = 0; m < 4; ++m) {
            u16* rowp = Zb1 + (size_t)(u.pm * 256 + ai * 128 + wr * 64 + m * 16 + fr) * 2560 + u.pn * 256 + wc * 32 + 8 * fq;
#pragma unroll
            for (int bj = 0; bj < 2; ++bj) {
              uint4 w;
              w.x = g8::cvt_pk_bf16(acc[ai][bj][m][0][0], acc[ai][bj][m][0][1]); w.y = g8::cvt_pk_bf16(acc[ai][bj][m][0][2], acc[ai][bj][m][0][3]);
              w.z = g8::cvt_pk_bf16(acc[ai][bj][m][1][0], acc[ai][bj][m][1][1]); w.w = g8::cvt_pk_bf16(acc[ai][bj][m][1][2], acc[ai][bj][m][1][3]);
              *(uint4*)(rowp + bj * 128) = w;
            }
          }
      };
      g8::Simple S; S.o.init(l == 3 ? 128 : 136, 10, nblk, bid); S.A = p.H; S.Bt = p.W + OFF_WINA; S.lda = 1024; S.K = 1024;
      g8::gemm_phase<true>(lds3, S, epi);
    }
    GSYNC();

    for (int rep = 0; rep < DUP_C1; ++rep)
    for (int it = bid; it < 1088 + 136; it += nblk) {
#ifndef NO_CMLP
      if (it < 1088) cmlp_item(p, l, it, smem);
#endif
#ifndef NO_CONVA
      if (it >= 1088) conva_item(p, l, it - 1088);
#endif
    }
    GSYNC();

    {
      u16* Zb2 = p.R1;
      auto epi = [=](const f32x4(&acc)[2][2][4][2], const g8::Unit& u, int wr, int wc, int fr, int fq, int) {
#pragma unroll
        for (int ai = 0; ai < 2; ++ai)
#pragma unroll
          for (int m = 0; m < 4; ++m) {
            u16* rowp = Zb2 + (size_t)(u.pm * 256 + ai * 128 + wr * 64 + m * 16 + fr) * 1792 + u.pn * 256 + wc * 32 + 8 * fq;
#pragma unroll
            for (int bj = 0; bj < 2; ++bj) {
              uint4 w;
              w.x = g8::cvt_pk_bf16(acc[ai][bj][m][0][0], acc[ai][bj][m][0][1]); w.y = g8::cvt_pk_bf16(acc[ai][bj][m][0][2], acc[ai][bj][m][0][3]);
              w.z = g8::cvt_pk_bf16(acc[ai][bj][m][1][0], acc[ai][bj][m][1][1]); w.w = g8::cvt_pk_bf16(acc[ai][bj][m][1][2], acc[ai][bj][m][1][3]);
              *(uint4*)(rowp + bj * 128) = w;
            }
          }
        const int pn = u.pn;
        if (pn == 2 || pn == 5 || pn == 6) {
          const bool inc0 = (pn != 5) || (wc >= 1);
          const bool inc1 = (pn == 2) || (pn == 5) || (wc == 0);
          float* dst = p.ssq + (size_t)(u.pm * 256 + wr * 64 + fr) * 12 + (pn == 2 ? 0 : (pn == 5 ? 4 : 8)) + wc;
#pragma unroll
          for (int ai = 0; ai < 2; ++ai)
#pragma unroll
            for (int m = 0; m < 4; ++m) {
              float ss = 0.f;
#pragma unroll
              for (int n = 0; n < 2; ++n)
#pragma unroll
                for (int jj = 0; jj < 4; ++jj) {
                  const float v0 = acc[ai][0][m][n][jj], v1 = acc[ai][1][m][n][jj];
                  ss += (inc0 ? v0 * v0 : 0.f) + (inc1 ? v1 * v1 : 0.f);
                }
              ss += __shfl_xor(ss, 16);
              ss += __shfl_xor(ss, 32);
              if (fq == 0) dst[(ai * 128 + m * 16) * 12] = ss;
              asm volatile("" ::: "memory");
            }
        }
      };
      g8::Simple S; S.o.init(136, 7, nblk, bid); S.A = p.H; S.Bt = p.W + OFF_WINB; S.lda = 1024; S.K = 1024;
      g8::gemm_phase<true>(lds3, S, epi);
    }
    GSYNC();

    for (int rep = 0; rep < DUP_C2; ++rep)
    {
      const u16* Zb2 = p.R1;
      for (int r2 = 0; r2 < DUP_LRU1; ++r2) lru_run<1>(p, l, bid, nblk, smem);
      for (int r2 = 0; r2 < DUP_PROJ; ++r2) {
      {
        struct ProjSched {
          g8::Order o; const u16* Zb2; const u16* Wq; const u16* Wkv;
          __device__ bool next(int i, g8::Unit& u) const {
            int pm, pn; if (!o.tile(i, pm, pn)) return false;
            u.pm = pm; u.lda = 1792;
            if (pn < 3) { u.pn = pn; u.aux = 0; u.K = 384; u.A = (const char*)(Zb2 + (size_t)pm * 256 * 1792 + 1312); u.B = (const char*)(Wq + (size_t)pn * 256 * 384); }
            else { u.pn = pn - 3; u.aux = 1; u.K = 256; u.A = (const char*)(Zb2 + (size_t)pm * 256 * 1792 + 512); u.B = (const char*)(Wkv + (size_t)(pn - 3) * 256 * 256); }
            return true;
          }
        };
        ProjSched S; S.o.init(136, 7, nblk, bid); S.Zb2 = Zb2; S.Wq = p.W + OFF_WQUP; S.Wkv = p.W + OFF_WKVUP;
        auto epi = [=](const f32x4(&acc)[2][2][4][2], const g8::Unit& u, int wr, int wc, int fr, int fq, int) {
          const int row0 = u.pm * 256, b = row0 / ST, tb = row0 - b * ST;
          const int kv = u.aux;
          const float* sq = p.ssq + (size_t)row0 * 12;
          const float invn = kv ? (1.f / 256.f) : (1.f / 384.f);
#pragma unroll
          for (int ai = 0; ai < 2; ++ai)
#pragma unroll
            for (int m = 0; m < 4; ++m) {
              const int rl = ai * 128 + wr * 64 + m * 16 + fr;
              const float4 p0 = *(const float4*)(sq + rl * 12), p1 = *(const float4*)(sq + rl * 12 + 4), p2 = *(const float4*)(sq + rl * 12 + 8);
              const float ssum = kv ? ((p0.x + p0.y) + (p0.z + p0.w)) : (((p1.x + p1.y) + (p1.z + p1.w)) + ((p2.x + p2.y) + (p2.z + p2.w)));
              const float inv = rsqrtf(ssum * invn + EPS);
              const int t = tb + rl;
#pragma unroll
              for (int bj = 0; bj < 2; ++bj) {
                const int c8 = u.pn * 256 + bj * 128 + wc * 32 + 8 * fq;
                float v[8];
#pragma unroll
                for (int n = 0; n < 2; ++n)
#pragma unroll
                  for (int jj = 0; jj < 4; ++jj) v[n * 4 + jj] = acc[ai][bj][m][n][jj] * inv;
                if (!kv) {
                  const int head = c8 / 96, d = c8 - head * 96;
                  *(uint4*)(p.Q + ((size_t)(b * 8 + head) * ST + t) * 96 + d) = pack8(v);
                } else {
                  const int head = c8 >> 7, w = c8 & 127;
                  if (wc < 2) {
                    *(uint4*)(p.K + ((size_t)(b * 8 + head) * ST + t) * 96 + w) = pack8(v);
                  } else {
                    u16* vp = p.Vt + ((size_t)(b * 8 + head) * 64 + (w - 64)) * ST + t;
#pragma unroll
                    for (int e = 0; e < 8; ++e) vp[(size_t)e * ST] = f2bf(v[e]);
                  }
                }
              }
              asm volatile("" ::: "memory");
            }
        };
        g8::gemm_phase<true>(lds3, S, epi);
      }
      {
        const int off = 2176;
        int first = bid;
        if (first < off) { int kk = (off - first + nblk - 1) / nblk; first += kk * nblk; }
        for (int it = first; it < off + 136; it += nblk) krope_item(p, it - off);
      }
      }
    }
    GSYNC();

    for (int rep = 0; rep < DUP_ATTN; ++rep)
    {
      int it = bid;
      for (; it < 1088; it += nblk) attn_item(p, it, smem);
      for (int r2 = 0; r2 < DUP_LRU3; ++r2) lru_run<3>(p, l, it - 1088, nblk, smem);
    }
    GSYNC();

    {
      u16* Mg = p.R1;
      const int ntile = 272 * 8;
      int te = threadIdx.x; asm volatile("" : "+v"(te));
      const int lane_e = te & 63, wid_e = te >> 6;
      const int wr = wid_e >> 1, wc = wid_e & 1, fr = lane_e & 15, fq = lane_e >> 4;
      int estr = nblk; asm volatile("" : "+s"(estr));
      const int skipctx = (l == 3);
      for (int id = bid; id < ntile; id += estr) {
        int g = id >> 6, rem = id & 63;
        int ct = rem >> 3, rt = g * 8 + (rem & 7);
        if (skipctx && (rt % 34) >= 32) continue;
        f32x4 mg[2][4];
#pragma unroll
        for (int m = 0; m < 2; ++m)
#pragma unroll
          for (int n = 0; n < 4; ++n) mg[m][n] = (f32x4){0.f, 0.f, 0.f, 0.f};
        for (int nb = 0; nb < 4; ++nb) {
          f32x4 ag[2][4], ay[2][4];
#pragma unroll
          for (int m = 0; m < 2; ++m)
#pragma unroll
            for (int n = 0; n < 4; ++n) { ag[m][n] = (f32x4){0.f, 0.f, 0.f, 0.f}; ay[m][n] = (f32x4){0.f, 0.f, 0.f, 0.f}; }
          gemm_main128(p.H + (size_t)rt * 128 * 1024, 1024, p.W + OFF_WGATE + (size_t)(nb * 1024 + ct * 128) * 1024, 1024, 1024,
                       lds, ag);
          gemm_main128(p.Ycat + (size_t)rt * 128 * 2048 + nb * 512, 2048, p.W + OFF_WBR + (size_t)(nb * 1024 + ct * 128) * 512, 512,
                       512, lds, ay);
#pragma unroll
          for (int m = 0; m < 2; ++m)
#pragma unroll
            for (int n = 0; n < 4; ++n)
#pragma unroll
              for (int jj = 0; jj < 4; ++jj) mg[m][n][jj] += sigmoidf_(ag[m][n][jj]) * ay[m][n][jj];
        }
#pragma unroll
        for (int m = 0; m < 2; ++m) {
          u16* dst = Mg + (size_t)(rt * 128 + wr * 32 + m * 16 + fq * 4) * 1024 + ct * 128 + wc * 64 + fr;
#pragma unroll
          for (int n = 0; n < 4; ++n)
#pragma unroll
            for (int jj = 0; jj < 4; ++jj) dst[jj * 1024 + n * 16] = f2bf(mg[m][n][jj]);
          asm volatile("" ::: "memory");
        }
        __syncthreads();
      }
    }
    GSYNC();

    {
      auto epi = [=](const f32x4(&acc)[2][2][4][2], const g8::Unit& u, int wr, int wc, int fr, int fq, int) {
        float* xb = xrow_ptr(p, u.pm * 256);
        const float* gate = p.mod + ((size_t)l * 9 + mod_idx(u.pm * 256)) * 6144 + 2048 + u.pn * 256 + wc * 32 + 4 * fq;
        f32x4 gv[2][2];
#pragma unroll
        for (int bj = 0; bj < 2; ++bj)
#pragma unroll
          for (int n = 0; n < 2; ++n) gv[bj][n] = *(const f32x4*)(gate + bj * 128 + n * 16);
#pragma unroll
        for (int ai = 0; ai < 2; ++ai)
#pragma unroll
          for (int m = 0; m < 4; ++m) {
            float* rowp = xb + (size_t)(ai * 128 + wr * 64 + m * 16 + fr) * DM + u.pn * 256 + wc * 32 + 4 * fq;
#pragma unroll
            for (int bj = 0; bj < 2; ++bj)
#pragma unroll
              for (int n = 0; n < 2; ++n) {
                f32x4 xv = *(const f32x4*)(rowp + bj * 128 + n * 16);
                xv += gv[bj][n] * acc[ai][bj][m][n];
                *(f32x4*)(rowp + bj * 128 + n * 16) = xv;
              }
          }
      };
      g8::Simple S; S.o.init(l == 3 ? 128 : 136, 4, nblk, bid); S.A = p.R1; S.Bt = p.W + OFF_WOUT; S.lda = 1024; S.K = 1024;
      g8::gemm_phase<false>(lds3, S, epi);
    }
    GSYNC();

    norm_mod(p, l, p.norm2_g + l * 1024, 3072, 4096);
    GSYNC();

    {
      u16* U = p.R1;
      auto epi = [=](const f32x4(&acc)[2][2][4][2], const g8::Unit& u, int wr, int wc, int fr, int fq, int) {
#pragma unroll
        for (int ai = 0; ai < 2; ++ai)
#pragma unroll
          for (int m = 0; m < 4; ++m) {
            u16* rowp = U + (size_t)(u.pm * 256 + ai * 128 + wr * 64 + m * 16 + fr) * 2816 + u.pn * 128 + wc * 32 + 8 * fq;
            float v[8];
#pragma unroll
            for (int n = 0; n < 2; ++n)
#pragma unroll
              for (int jj = 0; jj < 4; ++jj) v[n * 4 + jj] = siluf_(acc[ai][0][m][n][jj]) * acc[ai][1][m][n][jj];
            uint4 w;
            w.x = g8::cvt_pk_bf16(v[0], v[1]); w.y = g8::cvt_pk_bf16(v[2], v[3]); w.z = g8::cvt_pk_bf16(v[4], v[5]); w.w = g8::cvt_pk_bf16(v[6], v[7]);
            *(uint4*)rowp = w;
          }
      };
      g8::Simple S; S.o.init(l == 3 ? 128 : 136, 22, nblk, bid); S.A = p.H; S.Bt = p.W + OFF_WFF13; S.lda = 1024; S.K = 1024;
      g8::gemm_phase<true>(lds3, S, epi);
    }
    GSYNC();

    {
      auto epi = [=](const f32x4(&acc)[2][2][4][2], const g8::Unit& u, int wr, int wc, int fr, int fq, int) {
        float* xb = xrow_ptr(p, u.pm * 256);
        const float* gate = p.mod + ((size_t)l * 9 + mod_idx(u.pm * 256)) * 6144 + 5120 + u.pn * 256 + wc * 32 + 4 * fq;
        f32x4 gv[2][2];
#pragma unroll
        for (int bj = 0; bj < 2; ++bj)
#pragma unroll
          for (int n = 0; n < 2; ++n) gv[bj][n] = *(const f32x4*)(gate + bj * 128 + n * 16);
#pragma unroll
        for (int ai = 0; ai < 2; ++ai)
#pragma unroll
          for (int m = 0; m < 4; ++m) {
            float* rowp = xb + (size_t)(ai * 128 + wr * 64 + m * 16 + fr) * DM + u.pn * 256 + wc * 32 + 4 * fq;
#pragma unroll
            for (int bj = 0; bj < 2; ++bj)
#pragma unroll
              for (int n = 0; n < 2; ++n) {
                f32x4 xv = *(const f32x4*)(rowp + bj * 128 + n * 16);
                xv += gv[bj][n] * acc[ai][bj][m][n];
                *(f32x4*)(rowp + bj * 128 + n * 16) = xv;
              }
          }
      };
      g8::Simple S; S.o.init(l == 3 ? 128 : 136, 4, nblk, bid); S.A = p.R1; S.Bt = p.W + OFF_WFF2; S.lda = 2816; S.K = 2816;
      g8::gemm_phase<false>(lds3, S, epi);
    }
    GSYNC();

  }

  const int lane = threadIdx.x & 63, wid = threadIdx.x >> 6;
  for (int r = bid * 8 + wid; r < NB * SL; r += nblk * 8) {
    float* xr = p.out + (size_t)r * DM;
    float4 v[4];
    float ss = 0.f;
#pragma unroll
    for (int i = 0; i < 4; ++i) {
      v[i] = *(const float4*)(xr + i * 256 + lane * 4);
      ss += v[i].x * v[i].x + v[i].y * v[i].y + v[i].z * v[i].z + v[i].w * v[i].w;
    }
    ss = wave_sum(ss);
    const float inv = rsqrtf(ss * (1.f / 1024.f) + EPS);
#pragma unroll
    for (int i = 0; i < 4; ++i) {
      float4 gg = *(const float4*)(p.final_g + i * 256 + lane * 4);
      float4 ov;
      ov.x = v[i].x * inv * gg.x; ov.y = v[i].y * inv * gg.y; ov.z = v[i].z * inv * gg.z; ov.w = v[i].w * inv * gg.w;
      *(float4*)(xr + i * 256 + lane * 4) = ov;
    }
  }
}

extern "C" void kernel_launch(void* const* d_in, const int* in_sizes, int n_in, void* d_out, int out_size, void* d_ws,
                              size_t ws_size, hipStream_t stream) {
  static int grid_blocks = 0;
  if (!grid_blocks) {
    int dev = 0, cus = 0, per_cu = 0;
    hipGetDevice(&dev);
    hipDeviceGetAttribute(&cus, hipDeviceAttributeMultiprocessorCount, dev);
    hipFuncSetAttribute((const void*)mega, hipFuncAttributeMaxDynamicSharedMemorySize, LDS_BYTES);
    hipOccupancyMaxActiveBlocksPerMultiprocessor(&per_cu, (const void*)mega, NTHR, LDS_BYTES);
    if (per_cu < 1) per_cu = 1;
    if (per_cu > 1) per_cu = 1;
    grid_blocks = cus * per_cu;
    (void)hipGetLastError();
  }
  P p{};
  const float** pf = (const float**)&p;
  for (int i = 0; i < 31; ++i) pf[i] = (const float*)d_in[i];
  p.out = (float*)d_out;
  size_t off = 0;
  auto take = [&](size_t bytes) { void* r = (char*)d_ws + off; off += (bytes + 255) & ~(size_t)255; return r; };
  p.Xc = (float*)take((size_t)NB * SC * DM * 4);
  p.mod = (float*)take((size_t)4 * 9 * 6144 * 4);
  p.rope = (float*)take((size_t)SL * 32 * 4);
  p.summ = (float2*)take((size_t)NB * 2 * 512 * 34 * 8);
  p.ssq = (float*)take((size_t)12 * MTOT * 4);
  p.bar = (unsigned*)take((size_t)XCD_BAR_WORDS * 4);
  p.W = (u16*)take((size_t)W_ELEMS * 2);
  p.H = (u16*)take((size_t)MTOT * 1024 * 2);
  p.Ycat = (u16*)take((size_t)MTOT * 2048 * 2);
  p.R1 = (u16*)take((size_t)MTOT * 2560 * 2);
  p.K = (u16*)take((size_t)MTOT * 768 * 2);
  p.Vt = (u16*)take((size_t)MTOT * 512 * 2);
  p.Q = p.R1 + (size_t)MTOT * 1792;
  if (off > ws_size) { fprintf(stderr, "workspace too small: need %zu have %zu\n", off, ws_size); return; }
  (void)hipMemsetAsync(p.bar, 0, (size_t)XCD_BAR_WORDS * 4, stream);
  void* args[] = {&p};
  hipError_t e = hipLaunchCooperativeKernel((const void*)mega, dim3(grid_blocks), dim3(NTHR), args, LDS_BYTES, stream);
  if (e != hipSuccess) fprintf(stderr, "cooperative launch failed: %s (grid %d)\n", hipGetErrorString(e), grid_blocks);
}
```

```cpp
#include <hip/hip_runtime.h>
#include <hip/hip_bf16.h>
#include <hip/hip_cooperative_groups.h>
#include <cstdio>
#include <cstdint>
namespace cg = cooperative_groups;

typedef unsigned short u16;
using bf16x8 = __attribute__((ext_vector_type(8))) short;
using f32x4 = __attribute__((ext_vector_type(4))) float;

#define NB 8
#define SL 4096
#define SC 256
#define ST 4352
#define MTOT 34816
#define DM 1024
#define NTHR 512
#define EPS 1e-6f
#define LDS_BYTES 159744
#define DUP_ATTN 1
#define DUP_C1 1
#define DUP_C2 1
#define DUP_E 1
#define EXTRA_SYNC 0
#define GSYNC() do { xcd_barrier(xb); for (int q_ = 0; q_ < EXTRA_SYNC; ++q_) xcd_barrier(xb); } while (0)
#define DUP_LRU1 1
#define DUP_LRU3 1
#define DUP_PROJ 1

#define OFF_WINA 0
#define OFF_WINB (OFF_WINA + 2560 * 1024)
#define OFF_WGATE (OFF_WINB + 1792 * 1024)
#define OFF_WBR (OFF_WGATE + 4096 * 1024)
#define OFF_WOUT (OFF_WBR + 4 * 1024 * 512)
#define OFF_WFF13 (OFF_WOUT + 1024 * 1024)
#define OFF_WFF2 (OFF_WFF13 + 5632 * 1024)
#define OFF_WQUP (OFF_WFF2 + 1024 * 2816)
#define OFF_WKVUP (OFF_WQUP + 768 * 384)
#define OFF_WS (OFF_WKVUP + 1024 * 256)
#define OFF_WLRU (OFF_WS + 4 * 128 * 128)
#define W_ELEMS (OFF_WLRU + 2 * 8 * 4 * 32 * 64)

struct P {
  const float *x, *c, *ctx, *c_ctx, *w_mod, *b_mod, *norm1_g, *norm2_g, *w_in, *conv_a_w, *lru_conv_w, *lru_conv_b,
      *lru_w_a, *lru_b_a, *lru_w_x, *lru_b_x, *lru_lam, *cmlp_ln_g, *cmlp_ln_b, *cmlp_w_s, *cmlp_b_s, *q_norm_g,
      *kv_norm_g, *w_q_up, *w_kv_up, *w_branch, *w_out, *w_ff1, *w_ff3, *w_ff2, *final_g;
  float *out, *Xc, *mod, *rope;
  float2* summ;
  float* ssq;
  unsigned* bar;
  u16 *W, *H, *Ycat, *R1, *Q, *K, *Vt;
};

__device__ __forceinline__ uint32_t pack2(float a, float b) { uint32_t r; asm("v_cvt_pk_bf16_f32 %0, %1, %2" : "=v"(r) : "v"(a), "v"(b)); return r; }
__device__ __forceinline__ u16 f2bf(float f) { return (u16)(pack2(f, f) & 0xffffu); }
__device__ __forceinline__ float bf2f(u16 h) { return __uint_as_float(((uint32_t)h) << 16); }
__device__ __forceinline__ float sigmoidf_(float x) { return 1.f / (1.f + __expf(-x)); }
__device__ __forceinline__ float sigmoid_rcp_(float x) { return __builtin_amdgcn_rcpf(1.f + __expf(-x)); }
__device__ __forceinline__ float siluf_(float x) { return x * __builtin_amdgcn_rcpf(1.f + __expf(-x)); }
__device__ __forceinline__ float geluf_(float x) {
  float u = 0.7978845608028654f * (x + 0.044715f * x * x * x);
  return x * __builtin_amdgcn_rcpf(1.f + __expf(-2.f * u));
}
__device__ __forceinline__ void unpack8(const uint4& v, float* f) {
  f[0] = __uint_as_float(v.x << 16); f[1] = __uint_as_float(v.x & 0xffff0000u);
  f[2] = __uint_as_float(v.y << 16); f[3] = __uint_as_float(v.y & 0xffff0000u);
  f[4] = __uint_as_float(v.z << 16); f[5] = __uint_as_float(v.z & 0xffff0000u);
  f[6] = __uint_as_float(v.w << 16); f[7] = __uint_as_float(v.w & 0xffff0000u);
}
__device__ __forceinline__ uint4 pack8(const float* f) {
  uint4 v; v.x = pack2(f[0], f[1]); v.y = pack2(f[2], f[3]); v.z = pack2(f[4], f[5]); v.w = pack2(f[6], f[7]); return v;
}
template <int CTRL, int ROWMASK>
__device__ __forceinline__ float dpp0f(float src) {
  return __int_as_float(__builtin_amdgcn_update_dpp(0, __float_as_int(src), CTRL, ROWMASK, 0xf, false));
}
__device__ __forceinline__ float wave_sum(float v) {
  v += dpp0f<0x111, 0xf>(v); v += dpp0f<0x112, 0xf>(v); v += dpp0f<0x114, 0xf>(v); v += dpp0f<0x118, 0xf>(v);
  v += dpp0f<0x142, 0xa>(v); v += dpp0f<0x143, 0xc>(v);
  return __int_as_float(__builtin_amdgcn_readlane(__float_as_int(v), 63));
}
__device__ __forceinline__ float* xrow_ptr(const P& p, int r) {
  int b = r / ST, t = r - b * ST;
  return t < SL ? p.out + ((size_t)(b * SL + t)) * DM : p.Xc + ((size_t)(b * SC + t - SL)) * DM;
}
__device__ __forceinline__ int mod_idx(int r) { int b = r / ST, t = r - b * ST; return t < SL ? b : 8; }

template <int MT>
__device__ __forceinline__ void gemm_main(const u16* __restrict__ A, int lda, const u16* __restrict__ B, int ldb, int K,
                                          u16* lds, f32x4 (&acc)[MT][4]) {
  constexpr int BM = MT * 64;
  constexpr int ASZ = BM * 72, BSZ = 128 * 72, STG = ASZ + BSZ;
  int tid = threadIdx.x; asm volatile("" : "+v"(tid));
  const int lane = tid & 63, wid = tid >> 6, wr = wid >> 1, wc = wid & 1, fr = lane & 15, fq = lane >> 4;
  uint4 ra[MT], rb[2];
  const int nk = K >> 6;
  const int crow = tid >> 3, ckc = (tid & 7) * 8;
#pragma unroll
  for (int i = 0; i < MT; ++i) ra[i] = *(const uint4*)(A + (size_t)(crow + i * 64) * lda + ckc);
#pragma unroll
  for (int i = 0; i < 2; ++i) rb[i] = *(const uint4*)(B + (size_t)(crow + i * 64) * ldb + ckc);
  {
    u16* sa = lds; u16* sb = lds + ASZ;
#pragma unroll
    for (int i = 0; i < MT; ++i) *(uint4*)(sa + (crow + i * 64) * 72 + ckc) = ra[i];
#pragma unroll
    for (int i = 0; i < 2; ++i) *(uint4*)(sb + (crow + i * 64) * 72 + ckc) = rb[i];
  }
  __syncthreads();
  for (int kt = 0; kt < nk; ++kt) {
    const bool more = (kt + 1 < nk);
    if (more) {
      const int k0 = (kt + 1) * 64 + ckc;
#pragma unroll
      for (int i = 0; i < MT; ++i) ra[i] = *(const uint4*)(A + (size_t)(crow + i * 64) * lda + k0);
#pragma unroll
      for (int i = 0; i < 2; ++i) rb[i] = *(const uint4*)(B + (size_t)(crow + i * 64) * ldb + k0);
    }
    const u16* sa = lds + (kt & 1) * STG;
    const u16* sb = sa + ASZ;
#pragma unroll
    for (int ks = 0; ks < 2; ++ks) {
      bf16x8 a[MT], b[4];
#pragma unroll
      for (int m = 0; m < MT; ++m) a[m] = *(const bf16x8*)(sa + (wr * MT * 16 + m * 16 + fr) * 72 + ks * 32 + fq * 8);
#pragma unroll
      for (int n = 0; n < 4; ++n) b[n] = *(const bf16x8*)(sb + (wc * 64 + n * 16 + fr) * 72 + ks * 32 + fq * 8);
#pragma unroll
      for (int m = 0; m < MT; ++m)
#pragma unroll
        for (int n = 0; n < 4; ++n) acc[m][n] = __builtin_amdgcn_mfma_f32_16x16x32_bf16(a[m], b[n], acc[m][n], 0, 0, 0);
    }
    if (more) {
      u16* wa = lds + ((kt + 1) & 1) * STG; u16* wb = wa + ASZ;
#pragma unroll
      for (int i = 0; i < MT; ++i) *(uint4*)(wa + (crow + i * 64) * 72 + ckc) = ra[i];
#pragma unroll
      for (int i = 0; i < 2; ++i) *(uint4*)(wb + (crow + i * 64) * 72 + ckc) = rb[i];
    }
    __syncthreads();
  }
}

__device__ __forceinline__ void gemm_main128(const u16* __restrict__ A, int lda, const u16* __restrict__ B, int ldb, int K,
                                             u16* lds, f32x4 (&acc)[2][4]) {
  constexpr int RS = 136, ASZ = 128 * RS, BSZ = 128 * RS, STG = ASZ + BSZ;
  int tid = threadIdx.x; asm volatile("" : "+v"(tid));
  const int lane = tid & 63, wid = tid >> 6, wr = wid >> 1, wc = wid & 1, fr = lane & 15, fq = lane >> 4;
  const int r0 = tid >> 4, kc8 = (tid & 15) * 8;
  uint4 pa0, pa1, pa2, pa3, pb0, pb1, pb2, pb3, qa0, qa1, qa2, qa3, qb0, qb1, qb2, qb3;
  const int nk = K >> 7;
#define G128_LD(X, kt) do { const int k0_ = (kt) * 128 + kc8; \
    X##a0 = *(const uint4*)(A + (size_t)(r0) * lda + k0_); X##a1 = *(const uint4*)(A + (size_t)(r0 + 32) * lda + k0_); \
    X##a2 = *(const uint4*)(A + (size_t)(r0 + 64) * lda + k0_); X##a3 = *(const uint4*)(A + (size_t)(r0 + 96) * lda + k0_); \
    X##b0 = *(const uint4*)(B + (size_t)(r0) * ldb + k0_); X##b1 = *(const uint4*)(B + (size_t)(r0 + 32) * ldb + k0_); \
    X##b2 = *(const uint4*)(B + (size_t)(r0 + 64) * ldb + k0_); X##b3 = *(const uint4*)(B + (size_t)(r0 + 96) * ldb + k0_); } while (0)
#define G128_ST(X, st) do { u16* sa_ = lds + (st) * STG; u16* sb_ = sa_ + ASZ; \
    *(uint4*)(sa_ + (r0) * RS + kc8) = X##a0; *(uint4*)(sa_ + (r0 + 32) * RS + kc8) = X##a1; *(uint4*)(sa_ + (r0 + 64) * RS + kc8) = X##a2; *(uint4*)(sa_ + (r0 + 96) * RS + kc8) = X##a3; \
    *(uint4*)(sb_ + (r0) * RS + kc8) = X##b0; *(uint4*)(sb_ + (r0 + 32) * RS + kc8) = X##b1; *(uint4*)(sb_ + (r0 + 64) * RS + kc8) = X##b2; *(uint4*)(sb_ + (r0 + 96) * RS + kc8) = X##b3; } while (0)
#define G128_MMA(st) do { const u16* sa = lds + (st) * STG; const u16* sb = sa + ASZ; \
    _Pragma("unroll") for (int ks = 0; ks < 4; ++ks) { bf16x8 a[2], b[4]; \
      _Pragma("unroll") for (int m = 0; m < 2; ++m) a[m] = *(const bf16x8*)(sa + (wr * 32 + m * 16 + fr) * RS + ks * 32 + fq * 8); \
      _Pragma("unroll") for (int n = 0; n < 4; ++n) b[n] = *(const bf16x8*)(sb + (wc * 64 + n * 16 + fr) * RS + ks * 32 + fq * 8); \
      __builtin_amdgcn_s_setprio(1); \
      _Pragma("unroll") for (int m = 0; m < 2; ++m) _Pragma("unroll") for (int n = 0; n < 4; ++n) \
        acc[m][n] = __builtin_amdgcn_mfma_f32_16x16x32_bf16(a[m], b[n], acc[m][n], 0, 0, 0); \
      __builtin_amdgcn_s_setprio(0); } } while (0)
  G128_LD(p, 0); G128_ST(p, 0);
  if (nk > 1) G128_LD(p, 1);
  __syncthreads();
  for (int kt = 0; kt < nk; kt += 2) {
    if (kt + 2 < nk) G128_LD(q, kt + 2);
    if (kt + 1 < nk) G128_ST(p, 1);
    G128_MMA(0);
    __syncthreads();
    if (kt + 1 < nk) {
      if (kt + 3 < nk) G128_LD(p, kt + 3);
      if (kt + 2 < nk) G128_ST(q, 0);
      G128_MMA(1);
      __syncthreads();
    }
  }
#undef G128_LD
#undef G128_ST
#undef G128_MMA
}

template <int MT, class Pre, class Epi>
__device__ __forceinline__ void gemm_phase(const u16* A, int lda, const u16* B, int ldb, int K, int nct, u16* lds, Pre pre,
                                           Epi epi, int id0, int idstride, int idoff) {
  constexpr int BM = MT * 64;
  const int nrt = MTOT / BM, ntile = nrt * nct;
  int first = id0;
  if (first < idoff) { int kk = (idoff - first + idstride - 1) / idstride; first += kk * idstride; }
  for (int gid = first; gid < idoff + ntile; gid += idstride) {
    int id = gid - idoff;
    int g = id / (8 * nct), rem = id - g * 8 * nct;
    int ct = rem >> 3, rt = g * 8 + (rem & 7);
    f32x4 acc[MT][4];
#pragma unroll
    for (int m = 0; m < MT; ++m)
#pragma unroll
      for (int n = 0; n < 4; ++n) acc[m][n] = (f32x4){0.f, 0.f, 0.f, 0.f};
    pre(rt * BM);
    gemm_main<MT>(A + (size_t)rt * BM * lda, lda, B + (size_t)ct * 128 * ldb, ldb, K, lds, acc);
    epi(rt * BM, ct * 128, acc);
    __syncthreads();
  }
}

#define LAS3 __attribute__((address_space(3)))
namespace g8 {
constexpr int BM = 256, BK = 64, HALF = 128, HTB = HALF * BK * 2, STAGE_BYTES = 8 * HTB, NXCD = 8, WGM = 8;
__device__ __forceinline__ int lds_byte(int r, int c) { const int st = (r >> 4) * 2 + (c >> 5), rr = r & 15, cc = c & 31, ob = rr * 64 + cc * 2; return st * 1024 + (ob ^ (((ob >> 9) & 1) << 5)); }
__device__ __forceinline__ void stage_rc(int b, int& R, int& C) { const int st = b / 1024, sb = b % 1024, swz = sb ^ (((sb >> 9) & 1) << 5); R = (st >> 1) * 16 + swz / 64; C = (st & 1) * 32 + (swz % 64) / 2; }
__device__ __forceinline__ int perm32(int rho) { const int n = rho >> 4, i = rho & 15; return 8 * (i >> 2) + 4 * n + (i & 3); }
struct Unit { const char* A; const char* B; int lda, K, pm, pn, aux; };
struct Order {
  int nM, nN, nwg, G, c;
  __device__ void init(int nM_, int nN_, int G_, int c_) { nM = nM_; nN = nN_; nwg = nM * nN; G = G_; c = c_; }
  __device__ bool tile(int i, int& pm, int& pn) const {
    const long L = (long)i * G + c; if (L >= nwg) return false;
    int wgid = (int)L; { const int q = nwg / NXCD, r = nwg % NXCD, xcd = wgid % NXCD, off = wgid / NXCD; wgid = (xcd < r ? xcd * (q + 1) : r * (q + 1) + (xcd - r) * q) + off; }
    const int nig = WGM * nN, gid = wgid / nig, fm = gid * WGM, gsz = (nM - fm) < WGM ? (nM - fm) : WGM;
    pm = fm + ((wgid % nig) % gsz); pn = (wgid % nig) / gsz;
    if (nM == 128) pm += pm >> 4;
    return true;
  }
};
struct Simple {
  Order o; const u16* A; const u16* Bt; int lda, K;
  __device__ bool next(int i, Unit& u) const {
    int pm, pn; if (!o.tile(i, pm, pn)) return false;
    u.A = (const char*)(A + (size_t)pm * 256 * lda); u.B = (const char*)(Bt + (size_t)pn * 256 * K); u.lda = lda; u.K = K; u.pm = pm; u.pn = pn; u.aux = 0; return true;
  }
};
__device__ __forceinline__ unsigned cvt_pk_bf16(float lo, float hi) { unsigned r; asm volatile("v_cvt_pk_bf16_f32 %0, %1, %2" : "=v"(r) : "v"(lo), "v"(hi)); return r; }

template <bool PERM, class Sched, class Epi>
__device__ __forceinline__ void gemm_phase(LAS3 unsigned char* lds, const Sched& S, const Epi& E) {
  int tid = threadIdx.x; asm volatile("" : "+v"(tid));
  const int wid = __builtin_amdgcn_readfirstlane(tid >> 6), lane = tid & 63, wr = wid >> 2, wc = wid & 3, fr = lane & 15, fq = lane >> 4;
  const size_t kstep = (size_t)(BK * 2);
#define G8_VOFF(LDA_, K_) do { int _t2 = tid; asm volatile("" : "+v"(_t2)); _Pragma("unroll") for (int _i = 0; _i < 2; ++_i) { int R, C; stage_rc(_t2 * 16 + _i * 8192, R, C); \
    const int Rb = PERM ? ((R & ~31) + perm32(R & 31)) : R; voffA[_i] = (unsigned)(R * (LDA_) + C) * 2u; voffB[_i] = (unsigned)(Rb * (K_) + C) * 2u; } \
    hstepA = (size_t)HALF * (LDA_) * 2; hstepB = (size_t)HALF * (K_) * 2; } while (0)
  const unsigned ldsw = (unsigned)wid * 1024u;
  const int aoff = lds_byte(wr * 64 + fr, fq * 8), boff = lds_byte(wc * 32 + fr, fq * 8);
#define G8_SA(b, h) (((b) * 2 + (h)) * HTB)
#define G8_SB(b, h) ((4 + (b) * 2 + (h)) * HTB)
#define G8_STAGE(bufoff, gbase, voff) do { _Pragma("unroll") for (int _i = 0; _i < 2; ++_i) \
    __builtin_amdgcn_global_load_lds((const unsigned*)((const char*)(gbase) + (voff)[_i]), (LAS3 unsigned*)(lds + (bufoff) + ldsw + _i * 8192), 16, 0, 0); } while (0)
#define G8_LDA(dst, b, h) do { _Pragma("unroll") for (int m = 0; m < 4; ++m) _Pragma("unroll") for (int k = 0; k < 2; ++k) dst[m][k] = *(const LAS3 bf16x8*)(lds + G8_SA(b, h) + aoff + m * 2048 + k * 1024); } while (0)
#define G8_LDB(dst, b, h) do { _Pragma("unroll") for (int n = 0; n < 2; ++n) _Pragma("unroll") for (int k = 0; k < 2; ++k) dst[n][k] = *(const LAS3 bf16x8*)(lds + G8_SB(b, h) + boff + n * 2048 + k * 1024); } while (0)
#define G8_MMA(ai, bj, At, Bt) do { __builtin_amdgcn_s_setprio(1); _Pragma("unroll") for (int m = 0; m < 4; ++m) _Pragma("unroll") for (int n = 0; n < 2; ++n) _Pragma("unroll") for (int k = 0; k < 2; ++k) \
    acc[ai][bj][m][n] = __builtin_amdgcn_mfma_f32_16x16x32_bf16(Bt[n][k], At[m][k], acc[ai][bj][m][n], 0, 0, 0); __builtin_amdgcn_s_setprio(0); } while (0)
#define G8_WAIT_V(n) asm volatile("s_waitcnt vmcnt(" #n ")" ::: "memory")
#define G8_WAIT_L(n) asm volatile("s_waitcnt lgkmcnt(" #n ")" ::: "memory")
#define G8_BAR __builtin_amdgcn_s_barrier()
#define G8_SCHED __builtin_amdgcn_sched_barrier(0)
  Unit cur, nxt; int ui = 0;
  if (!S.next(0, cur)) return;
  f32x4 acc[2][2][4][2];
#pragma unroll
  for (int a = 0; a < 2; ++a)
#pragma unroll
    for (int b = 0; b < 2; ++b)
#pragma unroll
      for (int m = 0; m < 4; ++m)
#pragma unroll
        for (int n = 0; n < 2; ++n) acc[a][b][m][n] = (f32x4){0.f, 0.f, 0.f, 0.f};
  bf16x8 At[4][2], B0[2][2], B1[2][2];
  const char* cA = cur.A; const char* cB = cur.B;
  unsigned voffA[2], voffB[2];
  size_t hstepA, hstepB;
  G8_VOFF(cur.lda, cur.K);
  G8_STAGE(G8_SB(0, 0), cB, voffB); G8_STAGE(G8_SA(0, 0), cA, voffA); G8_STAGE(G8_SB(0, 1), cB + hstepB, voffB); G8_STAGE(G8_SA(0, 1), cA + hstepA, voffA);
  if (wr == 1) G8_BAR;
  G8_WAIT_V(4); G8_BAR;
  G8_STAGE(G8_SB(1, 0), cB + kstep, voffB); G8_STAGE(G8_SA(1, 0), cA + kstep, voffA); G8_STAGE(G8_SB(1, 1), cB + hstepB + kstep, voffB);
  G8_WAIT_V(6); G8_BAR;
  for (;;) {
    const bool has_next = S.next(ui + 1, nxt);
    if (!has_next) nxt = cur;
    const char* nA = nxt.A; const char* nB = nxt.B;
    const int nt = cur.K / BK;
    for (int t = 0; t < nt; t += 2) {
      const bool last = (t == nt - 2);
      const char* a1 = cA + (size_t)(t + 1) * kstep;
      const char* a2 = last ? nA : cA + (size_t)(t + 2) * kstep; const char* b2 = last ? nB : cB + (size_t)(t + 2) * kstep;
      const char* a3 = a2 + kstep; const char* b3 = b2 + kstep;
      G8_LDB(B0, 0, 0); G8_SCHED; G8_LDA(At, 0, 0); G8_STAGE(G8_SA(1, 1), a1 + hstepA, voffA);
      G8_WAIT_L(8); G8_BAR; G8_WAIT_L(0); G8_MMA(0, 0, At, B0); G8_BAR; G8_SCHED;
      if (last) G8_VOFF(nxt.lda, nxt.K);
      G8_LDB(B1, 0, 1); G8_STAGE(G8_SB(0, 0), b2, voffB);
      G8_BAR; G8_WAIT_L(0); G8_MMA(0, 1, At, B1); G8_BAR;
      G8_LDA(At, 0, 1); G8_STAGE(G8_SA(0, 0), a2, voffA);
      G8_BAR; G8_WAIT_L(0); G8_MMA(1, 0, At, B0); G8_BAR; G8_SCHED;
      G8_STAGE(G8_SB(0, 1), b2 + hstepB, voffB);
      G8_WAIT_V(6); G8_BAR; G8_MMA(1, 1, At, B1); G8_BAR;
      G8_LDB(B0, 1, 0); G8_SCHED; G8_LDA(At, 1, 0); G8_STAGE(G8_SA(0, 1), a2 + hstepA, voffA);
      G8_WAIT_L(8); G8_BAR; G8_WAIT_L(0); G8_MMA(0, 0, At, B0); G8_BAR; G8_SCHED;
      G8_LDB(B1, 1, 1); G8_STAGE(G8_SB(1, 0), b3, voffB);
      G8_BAR; G8_WAIT_L(0); G8_MMA(0, 1, At, B1); G8_BAR;
      G8_LDA(At, 1, 1); G8_STAGE(G8_SA(1, 0), a3, voffA);
      G8_BAR; G8_WAIT_L(0); G8_MMA(1, 0, At, B0); G8_BAR; G8_SCHED;
      G8_STAGE(G8_SB(1, 1), b3 + hstepB, voffB);
      G8_WAIT_V(6); G8_BAR; G8_MMA(1, 1, At, B1); G8_BAR;
    }
    E(acc, cur, wr, wc, fr, fq, tid);
    if (!has_next) break;
#pragma unroll
    for (int a = 0; a < 2; ++a)
#pragma unroll
      for (int b = 0; b < 2; ++b)
#pragma unroll
        for (int m = 0; m < 4; ++m)
#pragma unroll
          for (int n = 0; n < 2; ++n) acc[a][b][m][n] = (f32x4){0.f, 0.f, 0.f, 0.f};
    cur = nxt; cA = nA; cB = nB; ++ui;
  }
  G8_WAIT_V(0);
  if (wr == 0) G8_BAR;
  G8_BAR;
#undef G8_VOFF
#undef G8_SA
#undef G8_SB
#undef G8_STAGE
#undef G8_LDA
#undef G8_LDB
#undef G8_MMA
#undef G8_WAIT_V
#undef G8_WAIT_L
#undef G8_BAR
#undef G8_SCHED
}
}

__device__ __forceinline__ void convT_job(const float* src0, const float* src1, int ldsrc, int kind, int off, int nvalid, u16* dst, int K,
                          int Ndst, const float* kscale, float mult, float* lds) {
  int tid = threadIdx.x; asm volatile("" : "+v"(tid));
  const int nkt = K >> 6, nitems = nkt * (Ndst >> 7);
  for (int it = blockIdx.x; it < nitems; it += gridDim.x) {
    const int kt = it % nkt, nt = it / nkt;
    float v[16];
#pragma unroll
    for (int e = 0; e < 16; ++e) {
      int idx = tid + e * 512, i = idx >> 7, j = idx & 127, n = nt * 128 + j, k = kt * 64 + i;
      if (kind == 0) {
        v[e] = (n < nvalid) ? src0[(size_t)k * ldsrc + off + n] : 0.f;
      } else {
        int g = n >> 8, w = n & 255;
        const float* sp = (w < 128) ? src0 : src1;
        v[e] = sp[(size_t)k * ldsrc + g * 128 + (w & 127)];
      }
    }
#pragma unroll
    for (int e = 0; e < 16; ++e) {
      int idx = tid + e * 512, i = idx >> 7, j = idx & 127, k = kt * 64 + i;
      float x = v[e];
      if (kscale) x *= kscale[k];
      lds[j * 65 + i] = x * mult;
    }
    __syncthreads();
#pragma unroll
    for (int e = 0; e < 8; ++e) {
      int idx = tid + e * 512, j = idx >> 5, i2 = (idx & 31) * 2;
      *(uint32_t*)(dst + (size_t)(nt * 128 + j) * K + kt * 64 + i2) = pack2(lds[j * 65 + i2], lds[j * 65 + i2 + 1]);
    }
    __syncthreads();
  }
}

__device__ void convert_weights(const P& p, int l, float* lds) {
  const float* win = p.w_in + (size_t)l * 1024 * 8352;
#pragma unroll 1
  for (int job = 0; job < 12; ++job) {
    const float* s0 = win; const float* s1 = nullptr; const float* ksc = nullptr;
    int ldsrc = 8352, kind = 0, off = 0, nvalid = 0, K = 1024, Ndst = 0; float mult = 1.f; u16* dst = p.W;
    if (job == 0) { off = 1696; nvalid = 2560; dst += OFF_WINA; Ndst = 2560; }
    else if (job == 1) { off = 0; nvalid = 1696; dst += OFF_WINB; Ndst = 1792; }
    else if (job == 2) { off = 4256; nvalid = 4096; dst += OFF_WGATE; Ndst = 4096; }
    else if (job < 7) { const int n = job - 3; s0 = p.w_branch + ((size_t)l * 4 + n) * 512 * 1024; ldsrc = 1024; nvalid = 1024; dst += OFF_WBR + (size_t)n * 1024 * 512; K = 512; Ndst = 1024; }
    else if (job == 7) { s0 = p.w_out + (size_t)l * 1024 * 1024; ldsrc = 1024; nvalid = 1024; dst += OFF_WOUT; Ndst = 1024; }
    else if (job == 8) { s0 = p.w_ff1 + (size_t)l * 1024 * 2816; s1 = p.w_ff3 + (size_t)l * 1024 * 2816; ldsrc = 2816; kind = 1; dst += OFF_WFF13; Ndst = 5632; }
    else if (job == 9) { s0 = p.w_ff2 + (size_t)l * 2816 * 1024; ldsrc = 1024; nvalid = 1024; dst += OFF_WFF2; K = 2816; Ndst = 1024; }
    else if (job == 10) { s0 = p.w_q_up + (size_t)l * 384 * 768; ldsrc = 768; nvalid = 768; dst += OFF_WQUP; K = 384; Ndst = 768; ksc = p.q_norm_g + l * 384; mult = 0.10206207261596575f * 1.4426950408889634f; }
    else { s0 = p.w_kv_up + (size_t)l * 256 * 1024; ldsrc = 1024; nvalid = 1024; dst += OFF_WKVUP; K = 256; Ndst = 1024; ksc = p.kv_norm_g + l * 256; }
    convT_job(s0, s1, ldsrc, kind, off, nvalid, dst, K, Ndst, ksc, mult, lds);
  }
  int tidc = threadIdx.x; asm volatile("" : "+v"(tidc));
  const int gt = blockIdx.x * NTHR + tidc, gs = gridDim.x * NTHR;
  for (int i = gt; i < 4 * 128 * 128; i += gs) p.W[OFF_WS + i] = f2bf(p.cmlp_w_s[(size_t)l * 65536 + i]);
  for (int i = gt; i < 2 * 8 * 128 * 64; i += gs) {
    int k = i & 63, n = (i >> 6) & 127, h = (i >> 13) & 7, d = i >> 16;
    const float* src = (n < 64) ? p.lru_w_a : p.lru_w_x;
    p.W[OFF_WLRU + i] = f2bf(src[((((size_t)l * 2 + d) * 8 + h) * 64 + k) * 64 + (n & 63)]);
  }
}

__device__ void phase0(const P& p, unsigned char* smem) {
  int tid = threadIdx.x; asm volatile("" : "+v"(tid));
  const int gt = blockIdx.x * NTHR + tid, gs = gridDim.x * NTHR;
  {
    const float4* s = (const float4*)p.x; float4* d = (float4*)p.out;
    for (int i = gt; i < NB * SL * DM / 4; i += gs) d[i] = s[i];
    const float4* s2 = (const float4*)p.ctx; float4* d2 = (float4*)p.Xc;
    for (int i = gt; i < NB * SC * DM / 4; i += gs) d2[i] = s2[i];
  }
  for (int idx = gt; idx < SL * 8; idx += gs) {
    int t = idx >> 3, i = idx & 7;
    float inv = exp2f(-(float)i * 0.125f * 13.287712379549449f);
    float ar = (float)(t >> 6) * inv, ac = (float)(t & 63) * inv;
    const float i2pi = 0.15915494309189535f;
    float rr = ar * i2pi; rr -= floorf(rr); rr *= 6.283185307179586f;
    float rc = ac * i2pi; rc -= floorf(rc); rc *= 6.283185307179586f;
    p.rope[t * 32 + i] = __cosf(rr); p.rope[t * 32 + 8 + i] = __sinf(rr);
    p.rope[t * 32 + 16 + i] = __cosf(rc); p.rope[t * 32 + 24 + i] = __sinf(rc);
  }
  float* sS = (float*)smem; float* red = sS + 9 * 1024;
  for (int it = blockIdx.x; it < 4 * 96; it += gridDim.x) {
    const int l = it / 96, cgp = it - l * 96;
    for (int idx = tid; idx < 9216; idx += 512) {
      int m = idx >> 10, k = idx & 1023;
      float v = (m < 8) ? p.c[m * 1024 + k] : p.c_ctx[k];
      sS[idx] = siluf_(v);
    }
    __syncthreads();
    const int cj = tid & 63, kp = tid >> 6, j = cgp * 64 + cj;
    float a[9];
#pragma unroll
    for (int m = 0; m < 9; ++m) a[m] = 0.f;
    for (int k0 = kp * 128; k0 < kp * 128 + 128; k0 += 16) {
      float w[16];
#pragma unroll
      for (int u = 0; u < 16; ++u) w[u] = p.w_mod[((size_t)l * 1024 + k0 + u) * 6144 + j];
#pragma unroll
      for (int u = 0; u < 16; ++u)
#pragma unroll
        for (int m = 0; m < 9; ++m) a[m] += sS[m * 1024 + k0 + u] * w[u];
    }
#pragma unroll
    for (int m = 0; m < 9; ++m) red[(kp * 9 + m) * 64 + cj] = a[m];
    __syncthreads();
    for (int idx = tid; idx < 576; idx += 512) {
      int m = idx >> 6, c2 = idx & 63;
      float s = 0.f;
      for (int q = 0; q < 8; ++q) s += red[(q * 9 + m) * 64 + c2];
      p.mod[((size_t)l * 9 + m) * 6144 + cgp * 64 + c2] = s + p.b_mod[l * 6144 + cgp * 64 + c2];
    }
    __syncthreads();
  }
}

__device__ void norm_mod(const P& p, int l, const float* g, int off_sh, int off_sc) {
  int tid = threadIdx.x; asm volatile("" : "+v"(tid));
  const int lane = tid & 63, wid = tid >> 6;
  for (int r = blockIdx.x * 8 + wid; r < MTOT; r += gridDim.x * 8) {
    const float* xr = xrow_ptr(p, r);
    const float* md = p.mod + ((size_t)l * 9 + mod_idx(r)) * 6144;
    float4 v[4];
    float ss = 0.f;
#pragma unroll
    for (int i = 0; i < 4; ++i) {
      v[i] = *(const float4*)(xr + i * 256 + lane * 4);
      ss += v[i].x * v[i].x + v[i].y * v[i].y + v[i].z * v[i].z + v[i].w * v[i].w;
    }
    ss = wave_sum(ss);
    const float inv = rsqrtf(ss * (1.f / 1024.f) + EPS);
#pragma unroll
    for (int i = 0; i < 4; ++i) {
      const int k = i * 256 + lane * 4;
      float4 gg = *(const float4*)(g + k);
      float4 sh = *(const float4*)(md + off_sh + k);
      float4 sc = *(const float4*)(md + off_sc + k);
      float o0 = v[i].x * inv * gg.x * (1.f + sc.x) + sh.x;
      float o1 = v[i].y * inv * gg.y * (1.f + sc.y) + sh.y;
      float o2 = v[i].z * inv * gg.z * (1.f + sc.z) + sh.z;
      float o3 = v[i].w * inv * gg.w * (1.f + sc.w) + sh.w;
      uint2 o; o.x = pack2(o0, o1); o.y = pack2(o2, o3);
      *(uint2*)(p.H + (size_t)r * 1024 + k) = o;
    }
  }
}

__device__ void conva_item(const P& p, int l, int item) {
  int tid = threadIdx.x; asm volatile("" : "+v"(tid));
  const u16* Zb1 = p.R1;
  const float* cw = p.conv_a_w + (size_t)l * 3 * 512;
  for (int e = 0; e < 32; ++e) {
    int idx = tid + e * 512, rr = idx >> 6, cgp = idx & 63;
    int r = item * 256 + rr;
    int b = r / ST, t = r - b * ST;
    int isctx = t >= SL, pos = isctx ? t - SL : t, seglen = isctx ? SC : SL;
    float acc[8];
#pragma unroll
    for (int i = 0; i < 8; ++i) acc[i] = 0.f;
#pragma unroll
    for (int k = 0; k < 3; ++k) {
      int pos2 = pos - 1 + k;
      if (pos2 >= 0 && pos2 < seglen) {
        size_t r2 = (size_t)(r - 1 + k);
        uint4 vc = *(const uint4*)(Zb1 + r2 * 2560 + 512 + cgp * 8);
        uint4 vx = *(const uint4*)(Zb1 + r2 * 2560 + 1024 + cgp * 8);
        float fc[8], fx[8];
        unpack8(vc, fc); unpack8(vx, fx);
#pragma unroll
        for (int i = 0; i < 8; ++i) acc[i] += cw[k * 512 + cgp * 8 + i] * (fc[i] * fx[i]);
      }
    }
    uint4 vb = *(const uint4*)(Zb1 + (size_t)r * 2560 + cgp * 8);
    float fb[8];
    unpack8(vb, fb);
#pragma unroll
    for (int i = 0; i < 8; ++i) acc[i] *= fb[i];
    *(uint4*)(p.Ycat + (size_t)r * 2048 + cgp * 8) = pack8(acc);
  }
}

__device__ void cmlp_item(const P& p, int l, int item, unsigned char* smem) {
  int tid = threadIdx.x; asm volatile("" : "+v"(tid));
  const int lane = tid & 63, wid = tid >> 6, fr = lane & 15, fq = lane >> 4;
  const int g = item & 3, bj = item >> 2;
  const int rowbase = bj * 128;
  u16* vT = (u16*)smem;
  float* sMu = (float*)(smem + 128 * 136 * 2);
  float* sRs = sMu + 128;
  const u16* Zb1 = p.R1;
  {
    uint4 vv[16];
#pragma unroll
    for (int rr = 0; rr < 16; ++rr) vv[rr] = *(const uint4*)(Zb1 + (size_t)(rowbase + wid * 16 + rr) * 2560 + 2048 + lane * 8);
#pragma unroll
    for (int rr = 0; rr < 16; ++rr) {
      int q = wid * 16 + rr;
      float f[8];
      unpack8(vv[rr], f);
      float s = 0.f;
#pragma unroll
      for (int i = 0; i < 8; ++i) { f[i] = geluf_(f[i]); s += f[i]; }
      s = wave_sum(s);
      float mu = s * (1.f / 512.f);
      float d2 = 0.f;
#pragma unroll
      for (int i = 0; i < 8; ++i) { float d = f[i] - mu; d2 += d * d; }
      d2 = wave_sum(d2);
      if (lane == 0) { sMu[q] = mu; sRs[q] = rsqrtf(d2 * (1.f / 512.f) + EPS); }
    }
  }
  __syncthreads();
  const float* lg = p.cmlp_ln_g + l * 512 + g * 128;
  const float* lb = p.cmlp_ln_b + l * 512 + g * 128;
#pragma unroll
  for (int e = 0; e < 4; ++e) {
    int idx = tid + e * 512, q = idx >> 4, dc = idx & 15;
    uint4 v = *(const uint4*)(Zb1 + (size_t)(rowbase + q) * 2560 + 2048 + g * 128 + dc * 8);
    float f[8];
    unpack8(v, f);
    float mu = sMu[q], rs = sRs[q];
#pragma unroll
    for (int i = 0; i < 8; ++i) {
      float val = (geluf_(f[i]) - mu) * rs * lg[dc * 8 + i] + lb[dc * 8 + i];
      vT[(dc * 8 + i) * 136 + q] = f2bf(val);
    }
  }
  __syncthreads();
  const u16* Ws = p.W + OFF_WS + (size_t)g * 128 * 128;
  f32x4 acc[8];
#pragma unroll
  for (int n = 0; n < 8; ++n) acc[n] = (f32x4){0.f, 0.f, 0.f, 0.f};
#pragma unroll
  for (int ks = 0; ks < 4; ++ks) {
    bf16x8 a = *(const bf16x8*)(Ws + (wid * 16 + fr) * 128 + ks * 32 + fq * 8);
#pragma unroll
    for (int n = 0; n < 8; ++n) {
      bf16x8 bb = *(const bf16x8*)(vT + (n * 16 + fr) * 136 + ks * 32 + fq * 8);
      acc[n] = __builtin_amdgcn_mfma_f32_16x16x32_bf16(bb, a, acc[n], 0, 0, 0);
    }
  }
  {
    const int pp = wid * 16 + fr;
    const size_t r = (size_t)(rowbase + pp);
    const float bsv = p.cmlp_b_s[((size_t)l * 4 + g) * 128 + pp];
    uint2 uu[8];
#pragma unroll
    for (int n = 0; n < 8; ++n) uu[n] = *(const uint2*)(Zb1 + r * 2560 + 1536 + g * 128 + n * 16 + fq * 4);
#pragma unroll
    for (int n = 0; n < 8; ++n) {
      float u0 = __uint_as_float(uu[n].x << 16), u1 = __uint_as_float(uu[n].x & 0xffff0000u);
      float u2 = __uint_as_float(uu[n].y << 16), u3 = __uint_as_float(uu[n].y & 0xffff0000u);
      uint2 ov;
      ov.x = pack2(geluf_(u0) * (acc[n][0] + bsv), geluf_(u1) * (acc[n][1] + bsv));
      ov.y = pack2(geluf_(u2) * (acc[n][2] + bsv), geluf_(u3) * (acc[n][3] + bsv));
      *(uint2*)(p.Ycat + r * 2048 + 1024 + g * 128 + n * 16 + fq * 4) = ov;
    }
  }
  __syncthreads();
}

template <int CTRL, int ROWMASK>
__device__ __forceinline__ float dppf(float old, float src) {
  return __int_as_float(__builtin_amdgcn_update_dpp(__float_as_int(old), __float_as_int(src), CTRL, ROWMASK, 0xf, false));
}
#define LSCAN_STEP(A_, B_, CTRL, RM) do { const float A2_ = dppf<CTRL, RM>(1.f, A_), B2_ = dppf<CTRL, RM>(0.f, B_); B_ = A_ * B2_ + B_; A_ = A_ * A2_; } while (0)
#define LSCAN64(A_, B_) do { LSCAN_STEP(A_, B_, 0x111, 0xf); LSCAN_STEP(A_, B_, 0x112, 0xf); LSCAN_STEP(A_, B_, 0x114, 0xf); LSCAN_STEP(A_, B_, 0x118, 0xf); \
    LSCAN_STEP(A_, B_, 0x142, 0xa); LSCAN_STEP(A_, B_, 0x143, 0xc); } while (0)

template <int PASS>
__device__ void lru_run(const P& p, int l, int it_first, int it_stride, unsigned char* smem) {
  int tid = threadIdx.x; asm volatile("" : "+v"(tid));
  const int lane = tid & 63, wid = tid >> 6, fr = lane & 15, fq = lane >> 4;
  u16* sX = (u16*)smem;
  float* sA = (float*)(smem + 18432);
  float* sB = sA + 64 * 130;
  float* sH = sB + 64 * 130;
  float* sCw = sH + 128 * 65;
  float* sCarry = sCw + 320;
  float* sPar = sCarry + 128;
  u16* sW = (u16*)(sPar + 384);
  const u16* Zb2 = p.R1;
  int cur_h = -1;
  uint4 cv[2][4];
#define LRU_LOADCV(ITEM) do { const int h_ = (ITEM) & 7, bj_ = (ITEM) >> 3; const int b_ = bj_ / 34, j_ = bj_ - b_ * 34; const int ic_ = j_ >= 32; \
    const int p0_ = ic_ ? (j_ - 32) * 128 : j_ * 128, sl_ = ic_ ? SC : SL, rs_ = bj_ * 128 - p0_; \
    _Pragma("unroll") for (int e = 0; e < 2; ++e) { int idx = tid + e * 512, pp = idx >> 3, cgp = idx & 7; \
      _Pragma("unroll") for (int k = 0; k < 4; ++k) { int pos = p0_ + pp - 2 + k; cv[e][k] = make_uint4(0, 0, 0, 0); \
        if (pos >= 0 && pos < sl_) cv[e][k] = *(const uint4*)(Zb2 + (size_t)(rs_ + pos) * 1792 + h_ * 64 + cgp * 8); } } } while (0)
  if (it_first < 2176) LRU_LOADCV(it_first);
  for (int item = it_first; item < 2176; item += it_stride) {
    const int h = item & 7, bj = item >> 3;
    const int b = bj / 34, j = bj - b * 34;
    const int rowbase = bj * 128;
    const int isctx = j >= 32;
    const int ordf = isctx ? j - 32 : j + 2, ordr = 33 - j;
    float cA[16], cB[16];
    uint4 gv[2];
    if (PASS == 3) {
#pragma unroll
      for (int q = 0; q < 16; ++q) {
        const int pi = wid * 16 + q, d = pi >> 6, ch = pi & 63, o = d ? ordr : ordf;
        cA[q] = 1.f; cB[q] = 0.f;
        if (lane < o) { float2 v = p.summ[((size_t)(b * 2 + d) * 512 + h * 64 + ch) * 34 + lane]; cA[q] = v.x; cB[q] = v.y; }
      }
#pragma unroll
      for (int e = 0; e < 2; ++e) {
        int idx = tid + e * 512, pos = idx >> 3, cgp = idx & 7;
        gv[e] = *(const uint4*)(Zb2 + (size_t)(rowbase + pos) * 1792 + 800 + h * 64 + cgp * 8);
      }
    }
    if (h != cur_h) {
      cur_h = h;
      __syncthreads();
      if (tid < 320) {
        int k = tid >> 6, i = tid & 63;
        sCw[tid] = (k < 4) ? p.lru_conv_w[((size_t)l * 4 + k) * 512 + h * 64 + i] : p.lru_conv_b[l * 512 + h * 64 + i];
      }
      if (tid < 128) {
        const int d = tid >> 6, ch = tid & 63;
        const size_t pidx = ((size_t)l * 2 + d) * 512 + h * 64 + ch;
        sPar[tid * 3] = p.lru_b_a[pidx]; sPar[tid * 3 + 1] = p.lru_b_x[pidx];
        sPar[tid * 3 + 2] = 8.f * log1pf(__expf(-p.lru_lam[pidx]));
      }
#pragma unroll
      for (int e = 0; e < 4; ++e) {
        int idx = tid + e * 512, row = idx >> 3, kc = idx & 7;
        const int d = row >> 7, n = row & 127;
        *(uint4*)(sW + row * 72 + kc * 8) = *(const uint4*)(p.W + OFF_WLRU + (size_t)((d * 8 + h) * 128 + n) * 64 + kc * 8);
      }
      __syncthreads();
    }
#pragma unroll
    for (int e = 0; e < 2; ++e) {
      int idx = tid + e * 512, pp = idx >> 3, cgp = idx & 7;
      float a8[8];
#pragma unroll
      for (int i = 0; i < 8; ++i) a8[i] = sCw[256 + cgp * 8 + i];
#pragma unroll
      for (int k = 0; k < 4; ++k) {
        float f[8];
        unpack8(cv[e][k], f);
#pragma unroll
        for (int i = 0; i < 8; ++i) a8[i] += sCw[k * 64 + cgp * 8 + i] * f[i];
      }
      *(uint4*)(sX + pp * 72 + cgp * 8) = pack8(a8);
    }
    if (item + it_stride < 2176) LRU_LOADCV(item + it_stride);
    if (PASS == 3) {
#pragma unroll
      for (int q = 0; q < 16; ++q) LSCAN64(cA[q], cB[q]);
      if (lane == 63) {
#pragma unroll
        for (int q = 0; q < 16; ++q) sCarry[wid * 16 + q] = cB[q];
      }
    }
    __syncthreads();
    for (int d = 0; d < 2; ++d) {
      const u16* Wl = sW + d * 128 * 72;
      f32x4 acc[8];
#pragma unroll
      for (int n = 0; n < 8; ++n) acc[n] = (f32x4){0.f, 0.f, 0.f, 0.f};
      {
        const bf16x8 a0 = *(const bf16x8*)(sX + (wid * 16 + fr) * 72 + fq * 8);
        const bf16x8 a1 = *(const bf16x8*)(sX + (wid * 16 + fr) * 72 + 32 + fq * 8);
#pragma unroll
        for (int n = 0; n < 8; ++n) {
          const bf16x8 b0 = *(const bf16x8*)(Wl + (n * 16 + fr) * 72 + fq * 8);
          const bf16x8 b1 = *(const bf16x8*)(Wl + (n * 16 + fr) * 72 + 32 + fq * 8);
          acc[n] = __builtin_amdgcn_mfma_f32_16x16x32_bf16(a0, b0, acc[n], 0, 0, 0);
          acc[n] = __builtin_amdgcn_mfma_f32_16x16x32_bf16(a1, b1, acc[n], 0, 0, 0);
        }
      }
#pragma unroll
      for (int nt = 0; nt < 4; ++nt) {
        const int ch = nt * 16 + fr;
        const float ba = sPar[(d * 64 + ch) * 3], bx = sPar[(d * 64 + ch) * 3 + 1], sp8 = sPar[(d * 64 + ch) * 3 + 2];
#pragma unroll
        for (int jj = 0; jj < 4; ++jj) {
          const int pos = wid * 16 + fq * 4 + jj;
          const float xl = bf2f(sX[pos * 72 + ch]);
          const float rg = sigmoid_rcp_(acc[nt][jj] + ba), ig = sigmoid_rcp_(acc[nt + 4][jj] + bx);
          const float la = -sp8 * rg;
          const float av = __expf(la);
          const float x2 = 2.f * la;
          const float ser = -x2 * (1.f + x2 * (0.5f + x2 * (0.16666667f + x2 * (0.041666667f + x2 * 0.0083333333f))));
          const float om = (x2 > -0.25f) ? ser : (1.f - av * av);
          const float bb = __builtin_amdgcn_sqrtf(om) * ig * xl;
          const int si = d ? 127 - pos : pos;
          sA[ch * 130 + si] = av;
          sB[ch * 130 + si] = bb;
        }
      }
      __syncthreads();
      {
        float a0[8], b0[8], A[8], B[8];
#pragma unroll
        for (int c = 0; c < 8; ++c) {
          const int ch = wid * 8 + c;
          const float2 va = *(const float2*)(sA + ch * 130 + 2 * lane), vb = *(const float2*)(sB + ch * 130 + 2 * lane);
          a0[c] = va.x; b0[c] = vb.x;
          A[c] = va.x * va.y; B[c] = va.y * vb.x + vb.y;
        }
#pragma unroll
        for (int c = 0; c < 8; ++c) LSCAN64(A[c], B[c]);
#pragma unroll
        for (int c = 0; c < 8; ++c) {
          const int ch = wid * 8 + c;
          if (PASS == 1) {
            if (lane == 63) p.summ[((size_t)(b * 2 + d) * 512 + h * 64 + ch) * 34 + (d ? ordr : ordf)] = make_float2(A[c], B[c]);
          } else {
            const float carry = sCarry[d * 64 + ch];
            const float hincl = A[c] * carry + B[c];
            const float hprev = dppf<0x138, 0xf>(carry, hincl);
            const float heven = a0[c] * hprev + b0[c];
            const int se = 2 * lane, pe = d ? 127 - se : se, po = d ? 126 - se : se + 1;
            if (d == 0) { sH[pe * 65 + ch] = heven; sH[po * 65 + ch] = hincl; }
            else { sH[pe * 65 + ch] += heven; sH[po * 65 + ch] += hincl; }
          }
        }
      }
      __syncthreads();
    }
    if (PASS == 3) {
#pragma unroll
      for (int e = 0; e < 2; ++e) {
        int idx = tid + e * 512, pos = idx >> 3, cgp = idx & 7;
        const size_t r = (size_t)(rowbase + pos);
        float gf[8], y[8];
        unpack8(gv[e], gf);
#pragma unroll
        for (int i = 0; i < 8; ++i) y[i] = geluf_(gf[i]) * sH[pos * 65 + cgp * 8 + i];
        *(uint4*)(p.Ycat + r * 2048 + 512 + h * 64 + cgp * 8) = pack8(y);
      }
      __syncthreads();
    }
  }
}

__device__ void krope_item(const P& p, int item) {
  int tid = threadIdx.x; asm volatile("" : "+v"(tid));
  const u16* Zb2 = p.R1;
#pragma unroll
  for (int e = 0; e < 8; ++e) {
    int idx = tid + e * 512, rr = idx >> 4, pi = idx & 15, axis = pi >> 3, i = pi & 7;
    int r = item * 256 + rr, b = r / ST, t = r - b * ST;
    float x1 = bf2f(Zb2[(size_t)r * 1792 + 768 + axis * 16 + i]);
    float x2 = bf2f(Zb2[(size_t)r * 1792 + 768 + axis * 16 + 8 + i]);
    float o1 = x1, o2 = x2;
    if (t < SL) {
      float cs = p.rope[t * 32 + axis * 16 + i], sn = p.rope[t * 32 + axis * 16 + 8 + i];
      o1 = x1 * cs - x2 * sn;
      o2 = x1 * sn + x2 * cs;
    }
    u16 b1 = f2bf(o1), b2 = f2bf(o2);
#pragma unroll
    for (int h = 0; h < 8; ++h) {
      size_t base = ((size_t)(b * 8 + h) * ST + t) * 96 + 64 + axis * 16 + i;
      p.K[base] = b1;
      p.K[base + 8] = b2;
    }
  }
}

__device__ void attn_item(const P& p, int item, unsigned char* smem) {
  int tid = threadIdx.x; asm volatile("" : "+v"(tid));
  const int lane = tid & 63, wid = tid >> 6, fr = lane & 15, fq = lane >> 4;
  int b, h, t0, kt0, kt1;
  if (item < 1024) { b = item >> 7; h = (item >> 4) & 7; t0 = (item & 15) * 256; kt0 = 0; kt1 = 68; }
  else { int i2 = item - 1024; b = i2 >> 3; h = i2 & 7; t0 = SL; kt0 = 64; kt1 = 68; }
  const u16* Kb = p.K + (size_t)(b * 8 + h) * ST * 96;
  const u16* Vb = p.Vt + (size_t)(b * 8 + h) * 64 * ST;
  const u16* Qb = p.Q + (size_t)(b * 8 + h) * ST * 96;
  constexpr int KS = 104, VS = 136, KSZ = 128 * KS, VSZ = 64 * VS, STG = KSZ + VSZ;
  u16* lds = (u16*)smem;
  bf16x8 qf[2][3];
#pragma unroll
  for (int nq = 0; nq < 2; ++nq)
#pragma unroll
    for (int ks = 0; ks < 3; ++ks)
      qf[nq][ks] = *(const bf16x8*)(Qb + (size_t)(t0 + wid * 32 + nq * 16 + fr) * 96 + ks * 32 + fq * 8);
  if (item < 1024) {
#pragma unroll
    for (int nq = 0; nq < 2; ++nq) {
      const int t = t0 + wid * 32 + nq * 16 + fr;
      const float* rp = p.rope + t * 32 + (fq >> 1) * 16;
      union { bf16x8 v; uint32_t u[4]; } own, oth, res;
      own.v = qf[nq][2];
#pragma unroll
      for (int i = 0; i < 4; ++i) oth.u[i] = __shfl_xor(own.u[i], 16);
      float fo[8], fp[8], fres[8];
      { uint4 t4 = make_uint4(own.u[0], own.u[1], own.u[2], own.u[3]); unpack8(t4, fo); }
      { uint4 t4 = make_uint4(oth.u[0], oth.u[1], oth.u[2], oth.u[3]); unpack8(t4, fp); }
#pragma unroll
      for (int j = 0; j < 8; ++j) {
        float cs = rp[j], sn = rp[8 + j];
        fres[j] = (fq & 1) ? (fp[j] * sn + fo[j] * cs) : (fo[j] * cs - fp[j] * sn);
      }
      uint4 r4 = pack8(fres);
      res.u[0] = r4.x; res.u[1] = r4.y; res.u[2] = r4.z; res.u[3] = r4.w;
      qf[nq][2] = res.v;
    }
  }
  f32x4 o[4][2];
#pragma unroll
  for (int m = 0; m < 4; ++m)
#pragma unroll
    for (int n = 0; n < 2; ++n) o[m][n] = (f32x4){0.f, 0.f, 0.f, 0.f};
  float mrun[2] = {-1e30f, -1e30f}, lrun[2] = {0.f, 0.f};
  const int T0 = kt0 >> 1, T1 = kt1 >> 1;
  uint4 rk0, rk1, rk2, rv0, rv1;
  const int c0_ = tid, c1_ = tid + 512, c2_ = tid + 1024;
  const int kcv0_ = c0_ & 15, kcv1_ = c1_ & 15;
  const int vslot0_ = 32 * (kcv0_ >> 2) + 16 * (kcv0_ & 1) + 4 * ((kcv0_ & 3) >> 1);
  const int vslot1_ = 32 * (kcv1_ >> 2) + 16 * (kcv1_ & 1) + 4 * ((kcv1_ & 3) >> 1);
#define ATT_LD(tt) do { const size_t key0_ = (size_t)(tt) * 128; const u16* kb_ = Kb + key0_ * 96; \
    rk0 = *(const uint4*)(kb_ + (size_t)c0_ * 8); rk1 = *(const uint4*)(kb_ + (size_t)c1_ * 8); rk2 = *(const uint4*)(kb_ + (size_t)c2_ * 8); \
    rv0 = *(const uint4*)(Vb + (size_t)(c0_ >> 4) * ST + key0_ + (c0_ & 15) * 8); \
    rv1 = *(const uint4*)(Vb + (size_t)(c1_ >> 4) * ST + key0_ + (c1_ & 15) * 8); } while (0)
#define ATT_ST(st) do { u16* sk_ = lds + (st) * STG; u16* sv_ = sk_ + KSZ; \
    *(uint4*)(sk_ + (c0_ / 12) * KS + (c0_ % 12) * 8) = rk0; *(uint4*)(sk_ + (c1_ / 12) * KS + (c1_ % 12) * 8) = rk1; *(uint4*)(sk_ + (c2_ / 12) * KS + (c2_ % 12) * 8) = rk2; \
    *(uint2*)(sv_ + (c0_ >> 4) * VS + vslot0_) = make_uint2(rv0.x, rv0.y); *(uint2*)(sv_ + (c0_ >> 4) * VS + vslot0_ + 8) = make_uint2(rv0.z, rv0.w); \
    *(uint2*)(sv_ + (c1_ >> 4) * VS + vslot1_) = make_uint2(rv1.x, rv1.y); *(uint2*)(sv_ + (c1_ >> 4) * VS + vslot1_ + 8) = make_uint2(rv1.z, rv1.w); } while (0)
  ATT_LD(T0); ATT_ST(0);
  __syncthreads();
  for (int kt = T0; kt < T1; ++kt) {
    const bool more = (kt + 1 < T1);
    if (more) ATT_LD(kt + 1);
    const int cur = (kt - T0) & 1;
    const u16* sk = lds + cur * STG;
    const u16* sv = sk + KSZ;
    f32x4 s[8][2];
#pragma unroll
    for (int m = 0; m < 8; ++m)
#pragma unroll
      for (int n = 0; n < 2; ++n) s[m][n] = (f32x4){0.f, 0.f, 0.f, 0.f};
#pragma unroll
    for (int ks = 0; ks < 3; ++ks)
#pragma unroll
      for (int mt = 0; mt < 8; ++mt) {
        bf16x8 kf = *(const bf16x8*)(sk + (mt * 16 + fr) * KS + ks * 32 + fq * 8);
#pragma unroll
        for (int nq = 0; nq < 2; ++nq) s[mt][nq] = __builtin_amdgcn_mfma_f32_16x16x32_bf16(kf, qf[nq][ks], s[mt][nq], 0, 0, 0);
      }
    bf16x8 pb[2][4];
    float mloc[2];
#pragma unroll
    for (int nq = 0; nq < 2; ++nq) {
      float mx = fmaxf(fmaxf(s[0][nq][0], s[0][nq][1]), fmaxf(s[0][nq][2], s[0][nq][3]));
#pragma unroll
      for (int mt = 1; mt < 8; ++mt) mx = fmaxf(fmaxf(mx, s[mt][nq][0]), fmaxf(fmaxf(s[mt][nq][1], s[mt][nq][2]), s[mt][nq][3]));
      mloc[nq] = mx;
    }
    if (__any((mloc[0] > mrun[0] + 8.f) || (mloc[1] > mrun[1] + 8.f))) {
      float m0 = fmaxf(mloc[0], __shfl_xor(mloc[0], 16)), m1 = fmaxf(mloc[1], __shfl_xor(mloc[1], 16));
      m0 = fmaxf(m0, __shfl_xor(m0, 32)); m1 = fmaxf(m1, __shfl_xor(m1, 32));
      const float n0 = fmaxf(mrun[0], m0), n1 = fmaxf(mrun[1], m1);
      const float a0 = __builtin_amdgcn_exp2f(mrun[0] - n0), a1 = __builtin_amdgcn_exp2f(mrun[1] - n1);
      mrun[0] = n0; mrun[1] = n1;
      lrun[0] *= a0; lrun[1] *= a1;
#pragma unroll
      for (int mtv = 0; mtv < 4; ++mtv) {
        o[mtv][0][0] *= a0; o[mtv][0][1] *= a0; o[mtv][0][2] *= a0; o[mtv][0][3] *= a0;
        o[mtv][1][0] *= a1; o[mtv][1][1] *= a1; o[mtv][1][2] *= a1; o[mtv][1][3] *= a1;
      }
    }
#pragma unroll
    for (int nq = 0; nq < 2; ++nq) {
      const float mn = mrun[nq];
      float rs = 0.f;
#pragma unroll
      for (int mt = 0; mt < 8; ++mt)
#pragma unroll
        for (int jj = 0; jj < 4; ++jj) {
          float pv = __builtin_amdgcn_exp2f(s[mt][nq][jj] - mn);
          s[mt][nq][jj] = pv;
          rs += pv;
        }
      lrun[nq] += rs;
#pragma unroll
      for (int sx = 0; sx < 4; ++sx) {
        union { uint4 u; bf16x8 v; } cv;
        cv.u.x = pack2(s[2 * sx][nq][0], s[2 * sx][nq][1]); cv.u.y = pack2(s[2 * sx][nq][2], s[2 * sx][nq][3]);
        cv.u.z = pack2(s[2 * sx + 1][nq][0], s[2 * sx + 1][nq][1]); cv.u.w = pack2(s[2 * sx + 1][nq][2], s[2 * sx + 1][nq][3]);
        pb[nq][sx] = cv.v;
      }
    }
#pragma unroll
    for (int sx = 0; sx < 4; ++sx)
#pragma unroll
      for (int mtv = 0; mtv < 4; ++mtv) {
        const bf16x8 vf = *(const bf16x8*)(sv + (mtv * 16 + fr) * VS + 32 * sx + fq * 8);
#pragma unroll
        for (int nq = 0; nq < 2; ++nq) o[mtv][nq] = __builtin_amdgcn_mfma_f32_16x16x32_bf16(vf, pb[nq][sx], o[mtv][nq], 0, 0, 0);
      }
    if (more) ATT_ST(cur ^ 1);
    __syncthreads();
  }
#undef ATT_LD
#undef ATT_ST
#pragma unroll
  for (int nq = 0; nq < 2; ++nq) {
    float lt = lrun[nq];
    lt += __shfl_xor(lt, 16);
    lt += __shfl_xor(lt, 32);
    float inv = 1.f / lt;
    size_t r = (size_t)b * ST + t0 + wid * 32 + nq * 16 + fr;
#pragma unroll
    for (int mtv = 0; mtv < 4; ++mtv) {
      uint2 ov;
      ov.x = pack2(o[mtv][nq][0] * inv, o[mtv][nq][1] * inv);
      ov.y = pack2(o[mtv][nq][2] * inv, o[mtv][nq][3] * inv);
      *(uint2*)(p.Ycat + r * 2048 + 1536 + h * 64 + mtv * 16 + fq * 4) = ov;
    }
  }
}

#define XB_TMO      128
#define XB_XCNT(j)  (256  + 64 * (j))
#define XB_XSUB(j)  (1280 + 64 * (j))
#define XB_XGEN(j)  (2304 + 64 * (j))
#define XB_TOP      3328
#define XB_TOPGEN   3392
#define XCD_BAR_WORDS 3456
#define XB_SPIN_CAP (1u << 18)
__device__ __forceinline__ unsigned xb_ld(unsigned* p)              { return __hip_atomic_load(p, __ATOMIC_RELAXED, __HIP_MEMORY_SCOPE_AGENT); }
__device__ __forceinline__ unsigned xb_add(unsigned* p, unsigned v) { return __hip_atomic_fetch_add(p, v, __ATOMIC_RELAXED, __HIP_MEMORY_SCOPE_AGENT); }
__device__ __forceinline__ unsigned xb_xcc_id() { return (unsigned)__builtin_amdgcn_s_getreg((3 << 11) | 20) & 0xFu; }
#define XB_SPIN(cond, bar) do { unsigned _sp = 0; while (cond) { __builtin_amdgcn_s_sleep(1); \
    if ((++_sp & 255u) == 0u) { if (xb_ld(&(bar)[XB_TMO])) break; if (_sp > XB_SPIN_CAP) { atomicAdd(&(bar)[XB_TMO], 1u); break; } } } } while (0)
struct XcdBarrier { unsigned* bar; unsigned x; volatile __attribute__((address_space(3))) unsigned* st; };
__device__ __forceinline__ XcdBarrier xcd_barrier_post(unsigned* bar, volatile __attribute__((address_space(3))) unsigned* st) {
  XcdBarrier b; b.bar = bar; b.x = xb_xcc_id(); b.st = st;
  if (threadIdx.x == 0) (void)xb_add(&bar[XB_XCNT(b.x)], 1u);
  return b;
}
__device__ __forceinline__ void xcd_barrier_complete(unsigned* bar, unsigned x, unsigned& nloc, unsigned& nx) {
  const unsigned G = gridDim.x * gridDim.y * gridDim.z;
  unsigned sum, cnt, mine, sp = 0u;
  for (;;) {
    sum = 0u; cnt = 0u; mine = 0u;
#pragma unroll
    for (unsigned j = 0; j < 16; ++j) { const unsigned c = xb_ld(&bar[XB_XCNT(j)]); sum += c; cnt += (c > 0u) ? 1u : 0u; mine = (j == x) ? c : mine; }
    if (sum == G) break;
    __builtin_amdgcn_s_sleep(1);
    if ((++sp & 255u) == 0u) { if (xb_ld(&bar[XB_TMO])) break; if (sp > XB_SPIN_CAP) { atomicAdd(&bar[XB_TMO], 1u); break; } }
  }
  nloc = mine > 0u ? mine : 1u; nx = cnt > 0u ? cnt : 1u;
}
__device__ __forceinline__ void xcd_barrier(const XcdBarrier& b) {
  asm volatile("s_waitcnt vmcnt(0)" ::: "memory");
  __syncthreads();
  if (threadIdx.x == 0) {
    unsigned* bar = b.bar;
    __builtin_amdgcn_s_waitcnt(0);
    unsigned nloc = b.st[0], nx = b.st[1];
    if (nloc == 0u) { xcd_barrier_complete(bar, b.x, nloc, nx); b.st[0] = nloc; b.st[1] = nx; }
    const unsigned old = xb_add(&bar[XB_XSUB(b.x)], 1u);
    const unsigned gen = old / nloc;
    if (old + 1u == (gen + 1u) * nloc) {
      __builtin_amdgcn_fence(__ATOMIC_RELEASE, "agent");
      asm volatile("s_waitcnt vmcnt(0)" ::: "memory");
      const unsigned og = xb_add(&bar[XB_TOP], 1u);
      const unsigned tg = og / nx;
      if (og + 1u == (tg + 1u) * nx) xb_add(&bar[XB_TOPGEN], 1u);
      else XB_SPIN(xb_ld(&bar[XB_TOPGEN]) == tg, bar);
      __builtin_amdgcn_fence(__ATOMIC_ACQUIRE, "agent");
      xb_add(&bar[XB_XGEN(b.x)], 1u);
      asm volatile("s_waitcnt vmcnt(0)" ::: "memory");
    } else {
      XB_SPIN(xb_ld(&bar[XB_XGEN(b.x)]) == gen, bar);
      __builtin_amdgcn_fence(__ATOMIC_ACQUIRE, "agent");
      asm volatile("s_waitcnt vmcnt(0)" ::: "memory");
    }
  }
  __syncthreads();
}

__global__ void __launch_bounds__(NTHR) mega(P p) {
  extern __shared__ __attribute__((aligned(16))) unsigned char smem[];
  __shared__ uint4 xb_words;
  cg::grid_group grid = cg::this_grid();
  if (threadIdx.x == 0) xb_words = make_uint4(0u, 0u, 0u, 0u);
  __syncthreads();
  XcdBarrier xb = xcd_barrier_post(p.bar, (volatile __attribute__((address_space(3))) unsigned*)&xb_words);
  u16* lds = (u16*)smem;
  float* sInv = (float*)(smem + 131072);
  LAS3 unsigned char* lds3 = (LAS3 unsigned char*)smem;
  const int bid = blockIdx.x, nblk = gridDim.x;
  auto nopre = [](int) {};

#ifndef NO_P0
  phase0(p, smem);
#endif
  grid.sync();

#pragma unroll 1
  for (int l = 0; l < 4; ++l) {
    int tid = threadIdx.x; asm volatile("" : "+v"(tid));
    const int lane = tid & 63, wid = tid >> 6, wr = wid >> 1, wc = wid & 1, fr = lane & 15, fq = lane >> 4;
    (void)lane; (void)wid; (void)wr; (void)wc; (void)fr; (void)fq;
#ifndef NO_CW
    convert_weights(p, l, (float*)smem);
#endif
    norm_mod(p, l, p.norm1_g + l * 1024, 0, 1024);
    GSYNC();

    {
      u16* Zb1 = p.R1;
      auto epi = [=](const f32x4(&acc)[2][2][4][2], const g8::Unit& u, int wr, int wc, int fr, int fq, int) {
#pragma unroll
        for (int ai = 0; ai < 2; ++ai)
#pragma unroll
          for (int m = 0; m < 4; ++m) {
            u16* rowp = Zb1 + (size_t)(u.pm * 256 + ai * 128 + wr * 64 + m * 16 + fr) * 2560 + u.pn * 256 + wc * 32 + 8 * fq;
#pragma unroll
            for (int bj = 0; bj < 2; ++bj) {
              uint4 w;
              w.x = g8::cvt_pk_bf16(acc[ai][bj][m][0][0], acc[ai][bj][m][0][1]); w.y = g8::cvt_pk_bf16(acc[ai][bj][m][0][2], acc[ai][bj][m][0][3]);
              w.z = g8::cvt_pk_bf16(acc[ai][bj][m][1][0], acc[ai][bj][m][1][1]); w.w = g8::cvt_pk_bf16(acc[ai][bj][m][1][2], acc[ai][bj][m][1][3]);
              *(uint4*)(rowp + bj * 128) = w;
            }
          }
      };
      g8::Simple S; S.o.init(l == 3 ? 128 : 136, 10, nblk, bid); S.A = p.H; S.Bt = p.W + OFF_WINA; S.lda = 1024; S.K = 1024;
      g8::gemm_phase<true>(lds3, S, epi);
    }
    GSYNC();

    for (int rep = 0; rep < DUP_C1; ++rep)
    for (int it = bid; it < 1088 + 136; it += nblk) {
#ifndef NO_CMLP
      if (it < 1088) cmlp_item(p, l, it, smem);
#endif
#ifndef NO_CONVA
      if (it >= 1088) conva_item(p, l, it - 1088);
#endif
    }
    GSYNC();

    {
      u16* Zb2 = p.R1;
      auto epi = [=](const f32x4(&acc)[2][2][4][2], const g8::Unit& u, int wr, int wc, int fr, int fq, int) {
#pragma unroll
        for (int ai = 0; ai < 2; ++ai)
#pragma unroll
          for (int m = 0; m < 4; ++m) {
            u16* rowp = Zb2 + (size_t)(u.pm * 256 + ai * 128 + wr * 64 + m * 16 + fr) * 1792 + u.pn * 256 + wc * 32 + 8 * fq;
#pragma unroll
            for (int bj = 0; bj < 2; ++bj) {
              uint4 w;
              w.x = g8::cvt_pk_bf16(acc[ai][bj][m][0][0], acc[ai][bj][m][0][1]); w.y = g8::cvt_pk_bf16(acc[ai][bj][m][0][2], acc[ai][bj][m][0][3]);
              w.z = g8::cvt_pk_bf16(acc[ai][bj][m][1][0], acc[ai][bj][m][1][1]); w.w = g8::cvt_pk_bf16(acc[ai][bj][m][1][2], acc[ai][bj][m][1][3]);
              *(uint4*)(rowp + bj * 128) = w;
            }
          }
        const int pn = u.pn;
        if (pn == 2 || pn == 5 || pn == 6) {
          const bool inc0 = (pn != 5) || (wc >= 1);
          const bool inc1 = (pn == 2) || (pn == 5) || (wc == 0);
          float* dst = p.ssq + (size_t)(u.pm * 256 + wr * 64 + fr) * 12 + (pn == 2 ? 0 : (pn == 5 ? 4 : 8)) + wc;
#pragma unroll
          for (int ai = 0; ai < 2; ++ai)
#pragma unroll
            for (int m = 0; m < 4; ++m) {
              float ss = 0.f;
#pragma unroll
              for (int n = 0; n < 2; ++n)
#pragma unroll
                for (int jj = 0; jj < 4; ++jj) {
                  const float v0 = acc[ai][0][m][n][jj], v1 = acc[ai][1][m][n][jj];
                  ss += (inc0 ? v0 * v0 : 0.f) + (inc1 ? v1 * v1 : 0.f);
                }
              ss += __shfl_xor(ss, 16);
              ss += __shfl_xor(ss, 32);
              if (fq == 0) dst[(ai * 128 + m * 16) * 12] = ss;
              asm volatile("" ::: "memory");
            }
        }
      };
      g8::Simple S; S.o.init(136, 7, nblk, bid); S.A = p.H; S.Bt = p.W + OFF_WINB; S.lda = 1024; S.K = 1024;
      g8::gemm_phase<true>(lds3, S, epi);
    }
    GSYNC();

    for (int rep = 0; rep < DUP_C2; ++rep)
    {
      const u16* Zb2 = p.R1;
      for (int r2 = 0; r2 < DUP_LRU1; ++r2) lru_run<1>(p, l, bid, nblk, smem);
      for (int r2 = 0; r2 < DUP_PROJ; ++r2) {
      {
        struct ProjSched {
          g8::Order o; const u16* Zb2; const u16* Wq; const u16* Wkv;
          __device__ bool next(int i, g8::Unit& u) const {
            int pm, pn; if (!o.tile(i, pm, pn)) return false;
            u.pm = pm; u.lda = 1792;
            if (pn < 3) { u.pn = pn; u.aux = 0; u.K = 384; u.A = (const char*)(Zb2 + (size_t)pm * 256 * 1792 + 1312); u.B = (const char*)(Wq + (size_t)pn * 256 * 384); }
            else { u.pn = pn - 3; u.aux = 1; u.K = 256; u.A = (const char*)(Zb2 + (size_t)pm * 256 * 1792 + 512); u.B = (const char*)(Wkv + (size_t)(pn - 3) * 256 * 256); }
            return true;
          }
        };
        ProjSched S; S.o.init(136, 7, nblk, bid); S.Zb2 = Zb2; S.Wq = p.W + OFF_WQUP; S.Wkv = p.W + OFF_WKVUP;
        auto epi = [=](const f32x4(&acc)[2][2][4][2], const g8::Unit& u, int wr, int wc, int fr, int fq, int) {
          const int row0 = u.pm * 256, b = row0 / ST, tb = row0 - b * ST;
          const int kv = u.aux;
          const float* sq = p.ssq + (size_t)row0 * 12;
          const float invn = kv ? (1.f / 256.f) : (1.f / 384.f);
#pragma unroll
          for (int ai = 0; ai < 2; ++ai)
#pragma unroll
            for (int m = 0; m < 4; ++m) {
              const int rl = ai * 128 + wr * 64 + m * 16 + fr;
              const float4 p0 = *(const float4*)(sq + rl * 12), p1 = *(const float4*)(sq + rl * 12 + 4), p2 = *(const float4*)(sq + rl * 12 + 8);
              const float ssum = kv ? ((p0.x + p0.y) + (p0.z + p0.w)) : (((p1.x + p1.y) + (p1.z + p1.w)) + ((p2.x + p2.y) + (p2.z + p2.w)));
              const float inv = rsqrtf(ssum * invn + EPS);
              const int t = tb + rl;
#pragma unroll
              for (int bj = 0; bj < 2; ++bj) {
                const int c8 = u.pn * 256 + bj * 128 + wc * 32 + 8 * fq;
                float v[8];
#pragma unroll
                for (int n = 0; n < 2; ++n)
#pragma unroll
                  for (int jj = 0; jj < 4; ++jj) v[n * 4 + jj] = acc[ai][bj][m][n][jj] * inv;
                if (!kv) {
                  const int head = c8 / 96, d = c8 - head * 96;
                  *(uint4*)(p.Q + ((size_t)(b * 8 + head) * ST + t) * 96 + d) = pack8(v);
                } else {
                  const int head = c8 >> 7, w = c8 & 127;
                  if (wc < 2) {
                    *(uint4*)(p.K + ((size_t)(b * 8 + head) * ST + t) * 96 + w) = pack8(v);
                  } else {
                    u16* vp = p.Vt + ((size_t)(b * 8 + head) * 64 + (w - 64)) * ST + t;
#pragma unroll
                    for (int e = 0; e < 8; ++e) vp[(size_t)e * ST] = f2bf(v[e]);
                  }
                }
              }
              asm volatile("" ::: "memory");
            }
        };
        g8::gemm_phase<true>(lds3, S, epi);
      }
      {
        const int off = 2176;
        int first = bid;
        if (first < off) { int kk = (off - first + nblk - 1) / nblk; first += kk * nblk; }
        for (int it = first; it < off + 136; it += nblk) krope_item(p, it - off);
      }
      }
    }
    GSYNC();

    for (int rep = 0; rep < DUP_ATTN; ++rep)
    {
      int it = bid;
      for (; it < 1088; it += nblk) attn_item(p, it, smem);
      for (int r2 = 0; r2 < DUP_LRU3; ++r2) lru_run<3>(p, l, it - 1088, nblk, smem);
    }
    GSYNC();

    {
      u16* Mg = p.R1;
      const int ntile = 272 * 8;
      int te = threadIdx.x; asm volatile("" : "+v"(te));
      const int lane_e = te & 63, wid_e = te >> 6;
      const int wr = wid_e >> 1, wc = wid_e & 1, fr = lane_e & 15, fq = lane_e >> 4;
      int estr = nblk; asm volatile("" : "+s"(estr));
      const int skipctx = (l == 3);
      for (int id = bid; id < ntile; id += estr) {
        int g = id >> 6, rem = id & 63;
        int ct = rem >> 3, rt = g * 8 + (rem & 7);
        if (skipctx && (rt % 34) >= 32) continue;
        f32x4 mg[2][4];
#pragma unroll
        for (int m = 0; m < 2; ++m)
#pragma unroll
          for (int n = 0; n < 4; ++n) mg[m][n] = (f32x4){0.f, 0.f, 0.f, 0.f};
        for (int nb = 0; nb < 4; ++nb) {
          f32x4 ag[2][4], ay[2][4];
#pragma unroll
          for (int m = 0; m < 2; ++m)
#pragma unroll
            for (int n = 0; n < 4; ++n) { ag[m][n] = (f32x4){0.f, 0.f, 0.f, 0.f}; ay[m][n] = (f32x4){0.f, 0.f, 0.f, 0.f}; }
          gemm_main128(p.H + (size_t)rt * 128 * 1024, 1024, p.W + OFF_WGATE + (size_t)(nb * 1024 + ct * 128) * 1024, 1024, 1024,
                       lds, ag);
          gemm_main128(p.Ycat + (size_t)rt * 128 * 2048 + nb * 512, 2048, p.W + OFF_WBR + (size_t)(nb * 1024 + ct * 128) * 512, 512,
                       512, lds, ay);
#pragma unroll
          for (int m = 0; m < 2; ++m)
#pragma unroll
            for (int n = 0; n < 4; ++n)
#pragma unroll
              for (int jj = 0; jj < 4; ++jj) mg[m][n][jj] += sigmoidf_(ag[m][n][jj]) * ay[m][n][jj];
        }
#pragma unroll
        for (int m = 0; m < 2; ++m) {
          u16* dst = Mg + (size_t)(rt * 128 + wr * 32 + m * 16 + fq * 4) * 1024 + ct * 128 + wc * 64 + fr;
#pragma unroll
          for (int n = 0; n < 4; ++n)
#pragma unroll
            for (int jj = 0; jj < 4; ++jj) dst[jj * 1024 + n * 16] = f2bf(mg[m][n][jj]);
          asm volatile("" ::: "memory");
        }
        __syncthreads();
      }
    }
    GSYNC();

    {
      auto epi = [=](const f32x4(&acc)[2][2][4][2], const g8::Unit& u, int wr, int wc, int fr, int fq, int) {
        float* xb = xrow_ptr(p, u.pm * 256);
        const float* gate = p.mod + ((size_t)l * 9 + mod_idx(u.pm * 256)) * 6144 + 2048 + u.pn * 256 + wc * 32 + 4 * fq;
        f32x4 gv[2][2];
#pragma unroll
        for (int bj = 0; bj < 2; ++bj)
#pragma unroll
          for (int n = 0; n < 2; ++n) gv[bj][n] = *(const f32x4*)(gate + bj * 128 + n * 16);
#pragma unroll
        for (int ai = 0; ai < 2; ++ai)
#pragma unroll
          for (int m = 0; m < 4; ++m) {
            float* rowp = xb + (size_t)(ai * 128 + wr * 64 + m * 16 + fr) * DM + u.pn * 256 + wc * 32 + 4 * fq;
#pragma unroll
            for (int bj = 0; bj < 2; ++bj)
#pragma unroll
              for (int n = 0; n < 2; ++n) {
                f32x4 xv = *(const f32x4*)(rowp + bj * 128 + n * 16);
                xv += gv[bj][n] * acc[ai][bj][m][n];
                *(f32x4*)(rowp + bj * 128 + n * 16) = xv;
              }
          }
      };
      g8::Simple S; S.o.init(l == 3 ? 128 : 136, 4, nblk, bid); S.A = p.R1; S.Bt = p.W + OFF_WOUT; S.lda = 1024; S.K = 1024;
      g8::gemm_phase<false>(lds3, S, epi);
    }
    GSYNC();

    norm_mod(p, l, p.norm2_g + l * 1024, 3072, 4096);
    GSYNC();

    {
      u16* U = p.R1;
      auto epi = [=](const f32x4(&acc)[2][2][4][2], const g8::Unit& u, int wr, int wc, int fr, int fq, int) {
#pragma unroll
        for (int ai = 0; ai < 2; ++ai)
#pragma unroll
          for (int m = 0; m < 4; ++m) {
            u16* rowp = U + (size_t)(u.pm * 256 + ai * 128 + wr * 64 + m * 16 + fr) * 2816 + u.pn * 128 + wc * 32 + 8 * fq;
            float v[8];
#pragma unroll
            for (int n = 0; n < 2; ++n)
#pragma unroll
              for (int jj = 0; jj < 4; ++jj) v[n * 4 + jj] = siluf_(acc[ai][0][m][n][jj]) * acc[ai][1][m][n][jj];
            uint4 w;
            w.x = g8::cvt_pk_bf16(v[0], v[1]); w.y = g8::cvt_pk_bf16(v[2], v[3]); w.z = g8::cvt_pk_bf16(v[4], v[5]); w.w = g8::cvt_pk_bf16(v[6], v[7]);
            *(uint4*)rowp = w;
          }
      };
      g8::Simple S; S.o.init(l == 3 ? 128 : 136, 22, nblk, bid); S.A = p.H; S.Bt = p.W + OFF_WFF13; S.lda = 1024; S.K = 1024;
      g8::gemm_phase<true>(lds3, S, epi);
    }
    GSYNC();

    {
      auto epi = [=](const f32x4(&acc)[2][2][4][2], const g8::Unit& u, int wr, int wc, int fr, int fq, int) {
        float* xb = xrow_ptr(p, u.pm * 256);
        const float* gate = p.mod + ((size_t)l * 9 + mod_idx(u.pm * 256)) * 6144 + 5120 + u.pn * 256 + wc * 32 + 4 * fq;
        f32x4 gv[2][2];
#pragma unroll
        for (int bj = 0; bj < 2; ++bj)
#pragma unroll
          for (int n = 0; n < 2; ++n) gv[bj][n] = *(const f32x4*)(gate + bj * 128 + n * 16);
#pragma unroll
        for (int ai = 0; ai < 2; ++ai)
#pragma unroll
          for (int m = 0; m < 4; ++m) {
            float* rowp = xb + (size_t)(ai * 128 + wr * 64 + m * 16 + fr) * DM + u.pn * 256 + wc * 32 + 4 * fq;
#pragma unroll
            for (int bj = 0; bj < 2; ++bj)
#pragma unroll
              for (int n = 0; n < 2; ++n) {
                f32x4 xv = *(const f32x4*)(rowp + bj * 128 + n * 16);
                xv += gv[bj][n] * acc[ai][bj][m][n];
                *(f32x4*)(rowp + bj * 128 + n * 16) = xv;
              }
          }
      };
      g8::Simple S; S.o.init(l == 3 ? 128 : 136, 4, nblk, bid); S.A = p.R1; S.Bt = p.W + OFF_WFF2; S.lda = 2816; S.K = 2816;
      g8::gemm_phase<false>(lds3, S, epi);
    }
    GSYNC();

  }

  const int lane = threadIdx.x & 63, wid = threadIdx.x >> 6;
  for (int r = bid * 8 + wid; r < NB * SL; r += nblk * 8) {
    float* xr = p.out + (size_t)r * DM;
    float4 v[4];
    float ss = 0.f;
#pragma unroll
    for (int i = 0; i < 4; ++i) {
      v[i] = *(const float4*)(xr + i * 256 + lane * 4);
      ss += v[i].x * v[i].x + v[i].y * v[i].y + v[i].z * v[i].z + v[i].w * v[i].w;
    }
    ss = wave_sum(ss);
    const float inv = rsqrtf(ss * (1.f / 1024.f) + EPS);
#pragma unroll
    for (int i = 0; i < 4; ++i) {
      float4 gg = *(const float4*)(p.final_g + i * 256 + lane * 4);
      float4 ov;
      ov.x = v[i].x * inv * gg.x; ov.y = v[i].y * inv * gg.y; ov.z = v[i].z * inv * gg.z; ov.w = v[i].w * inv * gg.w;
      *(float4*)(xr + i * 256 + lane * 4) = ov;
    }
  }
}

extern "C" void kernel_launch(void* const* d_in, const int* in_sizes, int n_in, void* d_out, int out_size, void* d_ws,
                              size_t ws_size, hipStream_t stream) {
  static int grid_blocks = 0;
  if (!grid_blocks) {
    int dev = 0, cus = 0, per_cu = 0;
    hipGetDevice(&dev);
    hipDeviceGetAttribute(&cus, hipDeviceAttributeMultiprocessorCount, dev);
    hipFuncSetAttribute((const void*)mega, hipFuncAttributeMaxDynamicSharedMemorySize, LDS_BYTES);
    hipOccupancyMaxActiveBlocksPerMultiprocessor(&per_cu, (const void*)mega, NTHR, LDS_BYTES);
    if (per_cu < 1) per_cu = 1;
    if (per_cu > 1) per_cu = 1;
    grid_blocks = cus * per_cu;
    (void)hipGetLastError();
  }
  P p{};
  const float** pf = (const float**)&p;
  for (int i = 0; i < 31; ++i) pf[i] = (const float*)d_in[i];
  p.out = (float*)d_out;
  size_t off = 0;
  auto take = [&](size_t bytes) { void* r = (char*)d_ws + off; off += (bytes + 255) & ~(size_t)255; return r; };
  p.Xc = (float*)take((size_t)NB * SC * DM * 4);
  p.mod = (float*)take((size_t)4 * 9 * 6144 * 4);
  p.rope = (float*)take((size_t)SL * 32 * 4);
  p.summ = (float2*)take((size_t)NB * 2 * 512 * 34 * 8);
  p.ssq = (float*)take((size_t)12 * MTOT * 4);
  p.bar = (unsigned*)take((size_t)XCD_BAR_WORDS * 4);
  p.W = (u16*)take((size_t)W_ELEMS * 2);
  p.H = (u16*)take((size_t)MTOT * 1024 * 2);
  p.Ycat = (u16*)take((size_t)MTOT * 2048 * 2);
  p.R1 = (u16*)take((size_t)MTOT * 2560 * 2);
  p.K = (u16*)take((size_t)MTOT * 768 * 2);
  p.Vt = (u16*)take((size_t)MTOT * 512 * 2);
  p.Q = p.R1 + (size_t)MTOT * 1792;
  if (off > ws_size) { fprintf(stderr, "workspace too small: need %zu have %zu\n", off, ws_size); return; }
  (void)hipMemsetAsync(p.bar, 0, (size_t)XCD_BAR_WORDS * 4, stream);
  void* args[] = {&p};
  hipError_t e = hipLaunchCooperativeKernel((const void*)mega, dim3(grid_blocks), dim3(NTHR), args, LDS_BYTES, stream);
  if (e != hipSuccess) fprintf(stderr, "cooperative launch failed: %s (grid %d)\n", hipGetErrorString(e), grid_blocks);
}
```

```cpp
#include <hip/hip_runtime.h>
#include <hip/hip_bf16.h>
#include <hip/hip_cooperative_groups.h>
#include <cstdio>
#include <cstdint>
namespace cg = cooperative_groups;

typedef unsigned short u16;
using bf16x8 = __attribute__((ext_vector_type(8))) short;
using f32x4 = __attribute__((ext_vector_type(4))) float;

#define NB 8
#define SL 4096
#define SC 256
#define ST 4352
#define MTOT 34816
#define DM 1024
#define NTHR 512
#define EPS 1e-6f
#define LDS_BYTES 159744
#define DUP_ATTN 1
#define DUP_C1 1
#define DUP_C2 1
#define DUP_E 1
#define EXTRA_SYNC 0
#define GSYNC() do { xcd_barrier(xb); for (int q_ = 0; q_ < EXTRA_SYNC; ++q_) xcd_barrier(xb); } while (0)
#define DUP_LRU1 1
#define DUP_LRU3 1
#define DUP_PROJ 1

#define OFF_WINA 0
#define OFF_WINB (OFF_WINA + 2560 * 1024)
#define OFF_WGATE (OFF_WINB + 1792 * 1024)
#define OFF_WBR (OFF_WGATE + 4096 * 1024)
#define OFF_WOUT (OFF_WBR + 4 * 1024 * 512)
#define OFF_WFF13 (OFF_WOUT + 1024 * 1024)
#define OFF_WFF2 (OFF_WFF13 + 5632 * 1024)
#define OFF_WQUP (OFF_WFF2 + 1024 * 2816)
#define OFF_WKVUP (OFF_WQUP + 768 * 384)
#define OFF_WS (OFF_WKVUP + 1024 * 256)
#define OFF_WLRU (OFF_WS + 4 * 128 * 128)
#define W_ELEMS (OFF_WLRU + 2 * 8 * 4 * 32 * 64)

struct P {
  const float *x, *c, *ctx, *c_ctx, *w_mod, *b_mod, *norm1_g, *norm2_g, *w_in, *conv_a_w, *lru_conv_w, *lru_conv_b,
      *lru_w_a, *lru_b_a, *lru_w_x, *lru_b_x, *lru_lam, *cmlp_ln_g, *cmlp_ln_b, *cmlp_w_s, *cmlp_b_s, *q_norm_g,
      *kv_norm_g, *w_q_up, *w_kv_up, *w_branch, *w_out, *w_ff1, *w_ff3, *w_ff2, *final_g;
  float *out, *Xc, *mod, *rope;
  float2* summ;
  float* ssq;
  unsigned* bar;
  u16 *W, *H, *Ycat, *R1, *Q, *K, *Vt;
};

__device__ __forceinline__ uint32_t pack2(float a, float b) { uint32_t r; asm("v_cvt_pk_bf16_f32 %0, %1, %2" : "=v"(r) : "v"(a), "v"(b)); return r; }
__device__ __forceinline__ u16 f2bf(float f) { return (u16)(pack2(f, f) & 0xffffu); }
__device__ __forceinline__ float bf2f(u16 h) { return __uint_as_float(((uint32_t)h) << 16); }
__device__ __forceinline__ float sigmoidf_(float x) { return __builtin_amdgcn_rcpf(1.f + __expf(-x)); }
__device__ __forceinline__ float sigmoid_rcp_(float x) { return __builtin_amdgcn_rcpf(1.f + __expf(-x)); }
__device__ __forceinline__ float siluf_(float x) { return x * __builtin_amdgcn_rcpf(1.f + __expf(-x)); }
__device__ __forceinline__ float geluf_(float x) {
  float u = 0.7978845608028654f * (x + 0.044715f * x * x * x);
  return x * __builtin_amdgcn_rcpf(1.f + __expf(-2.f * u));
}
__device__ __forceinline__ void unpack8(const uint4& v, float* f) {
  f[0] = __uint_as_float(v.x << 16); f[1] = __uint_as_float(v.x & 0xffff0000u);
  f[2] = __uint_as_float(v.y << 16); f[3] = __uint_as_float(v.y & 0xffff0000u);
  f[4] = __uint_as_float(v.z << 16); f[5] = __uint_as_float(v.z & 0xffff0000u);
  f[6] = __uint_as_float(v.w << 16); f[7] = __uint_as_float(v.w & 0xffff0000u);
}
__device__ __forceinline__ uint4 pack8(const float* f) {
  uint4 v; v.x = pack2(f[0], f[1]); v.y = pack2(f[2], f[3]); v.z = pack2(f[4], f[5]); v.w = pack2(f[6], f[7]); return v;
}
template <int CTRL, int ROWMASK>
__device__ __forceinline__ float dpp0f(float src) {
  return __int_as_float(__builtin_amdgcn_update_dpp(0, __float_as_int(src), CTRL, ROWMASK, 0xf, false));
}
__device__ __forceinline__ float wave_sum(float v) {
  v += dpp0f<0x111, 0xf>(v); v += dpp0f<0x112, 0xf>(v); v += dpp0f<0x114, 0xf>(v); v += dpp0f<0x118, 0xf>(v);
  v += dpp0f<0x142, 0xa>(v); v += dpp0f<0x143, 0xc>(v);
  return __int_as_float(__builtin_amdgcn_readlane(__float_as_int(v), 63));
}
__device__ __forceinline__ float* xrow_ptr(const P& p, int r) {
  int b = r / ST, t = r - b * ST;
  return t < SL ? p.out + ((size_t)(b * SL + t)) * DM : p.Xc + ((size_t)(b * SC + t - SL)) * DM;
}
__device__ __forceinline__ int mod_idx(int r) { int b = r / ST, t = r - b * ST; return t < SL ? b : 8; }

template <int MT>
__device__ __forceinline__ void gemm_main(const u16* __restrict__ A, int lda, const u16* __restrict__ B, int ldb, int K,
                                          u16* lds, f32x4 (&acc)[MT][4]) {
  constexpr int BM = MT * 64;
  constexpr int ASZ = BM * 72, BSZ = 128 * 72, STG = ASZ + BSZ;
  int tid = threadIdx.x; asm volatile("" : "+v"(tid));
  const int lane = tid & 63, wid = tid >> 6, wr = wid >> 1, wc = wid & 1, fr = lane & 15, fq = lane >> 4;
  uint4 ra[MT], rb[2];
  const int nk = K >> 6;
  const int crow = tid >> 3, ckc = (tid & 7) * 8;
#pragma unroll
  for (int i = 0; i < MT; ++i) ra[i] = *(const uint4*)(A + (size_t)(crow + i * 64) * lda + ckc);
#pragma unroll
  for (int i = 0; i < 2; ++i) rb[i] = *(const uint4*)(B + (size_t)(crow + i * 64) * ldb + ckc);
  {
    u16* sa = lds; u16* sb = lds + ASZ;
#pragma unroll
    for (int i = 0; i < MT; ++i) *(uint4*)(sa + (crow + i * 64) * 72 + ckc) = ra[i];
#pragma unroll
    for (int i = 0; i < 2; ++i) *(uint4*)(sb + (crow + i * 64) * 72 + ckc) = rb[i];
  }
  __syncthreads();
  for (int kt = 0; kt < nk; ++kt) {
    const bool more = (kt + 1 < nk);
    if (more) {
      const int k0 = (kt + 1) * 64 + ckc;
#pragma unroll
      for (int i = 0; i < MT; ++i) ra[i] = *(const uint4*)(A + (size_t)(crow + i * 64) * lda + k0);
#pragma unroll
      for (int i = 0; i < 2; ++i) rb[i] = *(const uint4*)(B + (size_t)(crow + i * 64) * ldb + k0);
    }
    const u16* sa = lds + (kt & 1) * STG;
    const u16* sb = sa + ASZ;
#pragma unroll
    for (int ks = 0; ks < 2; ++ks) {
      bf16x8 a[MT], b[4];
#pragma unroll
      for (int m = 0; m < MT; ++m) a[m] = *(const bf16x8*)(sa + (wr * MT * 16 + m * 16 + fr) * 72 + ks * 32 + fq * 8);
#pragma unroll
      for (int n = 0; n < 4; ++n) b[n] = *(const bf16x8*)(sb + (wc * 64 + n * 16 + fr) * 72 + ks * 32 + fq * 8);
#pragma unroll
      for (int m = 0; m < MT; ++m)
#pragma unroll
        for (int n = 0; n < 4; ++n) acc[m][n] = __builtin_amdgcn_mfma_f32_16x16x32_bf16(a[m], b[n], acc[m][n], 0, 0, 0);
    }
    if (more) {
      u16* wa = lds + ((kt + 1) & 1) * STG; u16* wb = wa + ASZ;
#pragma unroll
      for (int i = 0; i < MT; ++i) *(uint4*)(wa + (crow + i * 64) * 72 + ckc) = ra[i];
#pragma unroll
      for (int i = 0; i < 2; ++i) *(uint4*)(wb + (crow + i * 64) * 72 + ckc) = rb[i];
    }
    __syncthreads();
  }
}

__device__ __forceinline__ void gemm_main128(const u16* __restrict__ A, int lda, const u16* __restrict__ B, int ldb, int K,
                                             u16* lds, f32x4 (&acc)[2][4]) {
  constexpr int RS = 136, ASZ = 128 * RS, BSZ = 128 * RS, STG = ASZ + BSZ;
  int tid = threadIdx.x; asm volatile("" : "+v"(tid));
  const int lane = tid & 63, wid = tid >> 6, wr = wid >> 1, wc = wid & 1, fr = lane & 15, fq = lane >> 4;
  const int r0 = tid >> 4, kc8 = (tid & 15) * 8;
  uint4 pa0, pa1, pa2, pa3, pb0, pb1, pb2, pb3, qa0, qa1, qa2, qa3, qb0, qb1, qb2, qb3;
  const int nk = K >> 7;
#define G128_LD(X, kt) do { const int k0_ = (kt) * 128 + kc8; \
    X##a0 = *(const uint4*)(A + (size_t)(r0) * lda + k0_); X##a1 = *(const uint4*)(A + (size_t)(r0 + 32) * lda + k0_); \
    X##a2 = *(const uint4*)(A + (size_t)(r0 + 64) * lda + k0_); X##a3 = *(const uint4*)(A + (size_t)(r0 + 96) * lda + k0_); \
    X##b0 = *(const uint4*)(B + (size_t)(r0) * ldb + k0_); X##b1 = *(const uint4*)(B + (size_t)(r0 + 32) * ldb + k0_); \
    X##b2 = *(const uint4*)(B + (size_t)(r0 + 64) * ldb + k0_); X##b3 = *(const uint4*)(B + (size_t)(r0 + 96) * ldb + k0_); } while (0)
#define G128_ST(X, st) do { u16* sa_ = lds + (st) * STG; u16* sb_ = sa_ + ASZ; \
    *(uint4*)(sa_ + (r0) * RS + kc8) = X##a0; *(uint4*)(sa_ + (r0 + 32) * RS + kc8) = X##a1; *(uint4*)(sa_ + (r0 + 64) * RS + kc8) = X##a2; *(uint4*)(sa_ + (r0 + 96) * RS + kc8) = X##a3; \
    *(uint4*)(sb_ + (r0) * RS + kc8) = X##b0; *(uint4*)(sb_ + (r0 + 32) * RS + kc8) = X##b1; *(uint4*)(sb_ + (r0 + 64) * RS + kc8) = X##b2; *(uint4*)(sb_ + (r0 + 96) * RS + kc8) = X##b3; } while (0)
#define G128_MMA(st) do { const u16* sa = lds + (st) * STG; const u16* sb = sa + ASZ; \
    _Pragma("unroll") for (int ks = 0; ks < 4; ++ks) { bf16x8 a[2], b[4]; \
      _Pragma("unroll") for (int m = 0; m < 2; ++m) a[m] = *(const bf16x8*)(sa + (wr * 32 + m * 16 + fr) * RS + ks * 32 + fq * 8); \
      _Pragma("unroll") for (int n = 0; n < 4; ++n) b[n] = *(const bf16x8*)(sb + (wc * 64 + n * 16 + fr) * RS + ks * 32 + fq * 8); \
      __builtin_amdgcn_s_setprio(1); \
      _Pragma("unroll") for (int m = 0; m < 2; ++m) _Pragma("unroll") for (int n = 0; n < 4; ++n) \
        acc[m][n] = __builtin_amdgcn_mfma_f32_16x16x32_bf16(a[m], b[n], acc[m][n], 0, 0, 0); \
      __builtin_amdgcn_s_setprio(0); } } while (0)
  G128_LD(p, 0); G128_ST(p, 0);
  if (nk > 1) G128_LD(p, 1);
  __syncthreads();
  for (int kt = 0; kt < nk; kt += 2) {
    if (kt + 2 < nk) G128_LD(q, kt + 2);
    if (kt + 1 < nk) G128_ST(p, 1);
    G128_MMA(0);
    __syncthreads();
    if (kt + 1 < nk) {
      if (kt + 3 < nk) G128_LD(p, kt + 3);
      if (kt + 2 < nk) G128_ST(q, 0);
      G128_MMA(1);
      __syncthreads();
    }
  }
#undef G128_LD
#undef G128_ST
#undef G128_MMA
}

template <int MT, class Pre, class Epi>
__device__ __forceinline__ void gemm_phase(const u16* A, int lda, const u16* B, int ldb, int K, int nct, u16* lds, Pre pre,
                                           Epi epi, int id0, int idstride, int idoff) {
  constexpr int BM = MT * 64;
  const int nrt = MTOT / BM, ntile = nrt * nct;
  int first = id0;
  if (first < idoff) { int kk = (idoff - first + idstride - 1) / idstride; first += kk * idstride; }
  for (int gid = first; gid < idoff + ntile; gid += idstride) {
    int id = gid - idoff;
    int g = id / (8 * nct), rem = id - g * 8 * nct;
    int ct = rem >> 3, rt = g * 8 + (rem & 7);
    f32x4 acc[MT][4];
#pragma unroll
    for (int m = 0; m < MT; ++m)
#pragma unroll
      for (int n = 0; n < 4; ++n) acc[m][n] = (f32x4){0.f, 0.f, 0.f, 0.f};
    pre(rt * BM);
    gemm_main<MT>(A + (size_t)rt * BM * lda, lda, B + (size_t)ct * 128 * ldb, ldb, K, lds, acc);
    epi(rt * BM, ct * 128, acc);
    __syncthreads();
  }
}

#define LAS3 __attribute__((address_space(3)))
namespace g8 {
constexpr int BM = 256, BK = 64, HALF = 128, HTB = HALF * BK * 2, STAGE_BYTES = 8 * HTB, NXCD = 8, WGM = 8;
__device__ __forceinline__ int lds_byte(int r, int c) { const int st = (r >> 4) * 2 + (c >> 5), rr = r & 15, cc = c & 31, ob = rr * 64 + cc * 2; return st * 1024 + (ob ^ (((ob >> 9) & 1) << 5)); }
__device__ __forceinline__ void stage_rc(int b, int& R, int& C) { const int st = b / 1024, sb = b % 1024, swz = sb ^ (((sb >> 9) & 1) << 5); R = (st >> 1) * 16 + swz / 64; C = (st & 1) * 32 + (swz % 64) / 2; }
__device__ __forceinline__ int perm32(int rho) { const int n = rho >> 4, i = rho & 15; return 8 * (i >> 2) + 4 * n + (i & 3); }
struct Unit { const char* A; const char* B; int lda, K, pm, pn, aux; };
struct Order {
  int nM, nN, nwg, G, c;
  __device__ void init(int nM_, int nN_, int G_, int c_) { nM = nM_; nN = nN_; nwg = nM * nN; G = G_; c = c_; }
  __device__ bool tile(int i, int& pm, int& pn) const {
    const long L = (long)i * G + c; if (L >= nwg) return false;
    int wgid = (int)L; { const int q = nwg / NXCD, r = nwg % NXCD, xcd = wgid % NXCD, off = wgid / NXCD; wgid = (xcd < r ? xcd * (q + 1) : r * (q + 1) + (xcd - r) * q) + off; }
    const int nig = WGM * nN, gid = wgid / nig, fm = gid * WGM, gsz = (nM - fm) < WGM ? (nM - fm) : WGM;
    pm = fm + ((wgid % nig) % gsz); pn = (wgid % nig) / gsz;
    if (nM == 128) pm += pm >> 4;
    return true;
  }
};
struct Simple {
  Order o; const u16* A; const u16* Bt; int lda, K;
  __device__ bool next(int i, Unit& u) const {
    int pm, pn; if (!o.tile(i, pm, pn)) return false;
    u.A = (const char*)(A + (size_t)pm * 256 * lda); u.B = (const char*)(Bt + (size_t)pn * 256 * K); u.lda = lda; u.K = K; u.pm = pm; u.pn = pn; u.aux = 0; return true;
  }
};
__device__ __forceinline__ unsigned cvt_pk_bf16(float lo, float hi) { unsigned r; asm volatile("v_cvt_pk_bf16_f32 %0, %1, %2" : "=v"(r) : "v"(lo), "v"(hi)); return r; }

template <bool PERM, class Sched, class Epi>
__device__ __forceinline__ void gemm_phase(LAS3 unsigned char* lds, const Sched& S, const Epi& E) {
  int tid = threadIdx.x; asm volatile("" : "+v"(tid));
  const int wid = __builtin_amdgcn_readfirstlane(tid >> 6), lane = tid & 63, wr = wid >> 2, wc = wid & 3, fr = lane & 15, fq = lane >> 4;
  const size_t kstep = (size_t)(BK * 2);
#define G8_VOFF(LDA_, K_) do { int _t2 = tid; asm volatile("" : "+v"(_t2)); _Pragma("unroll") for (int _i = 0; _i < 2; ++_i) { int R, C; stage_rc(_t2 * 16 + _i * 8192, R, C); \
    const int Rb = PERM ? ((R & ~31) + perm32(R & 31)) : R; voffA[_i] = (unsigned)(R * (LDA_) + C) * 2u; voffB[_i] = (unsigned)(Rb * (K_) + C) * 2u; } \
    hstepA = (size_t)HALF * (LDA_) * 2; hstepB = (size_t)HALF * (K_) * 2; } while (0)
  const unsigned ldsw = (unsigned)wid * 1024u;
  const int aoff = lds_byte(wr * 64 + fr, fq * 8), boff = lds_byte(wc * 32 + fr, fq * 8);
#define G8_SA(b, h) (((b) * 2 + (h)) * HTB)
#define G8_SB(b, h) ((4 + (b) * 2 + (h)) * HTB)
#define G8_STAGE(bufoff, gbase, voff) do { _Pragma("unroll") for (int _i = 0; _i < 2; ++_i) \
    __builtin_amdgcn_global_load_lds((const unsigned*)((const char*)(gbase) + (voff)[_i]), (LAS3 unsigned*)(lds + (bufoff) + ldsw + _i * 8192), 16, 0, 0); } while (0)
#define G8_LDA(dst, b, h) do { _Pragma("unroll") for (int m = 0; m < 4; ++m) _Pragma("unroll") for (int k = 0; k < 2; ++k) dst[m][k] = *(const LAS3 bf16x8*)(lds + G8_SA(b, h) + aoff + m * 2048 + k * 1024); } while (0)
#define G8_LDB(dst, b, h) do { _Pragma("unroll") for (int n = 0; n < 2; ++n) _Pragma("unroll") for (int k = 0; k < 2; ++k) dst[n][k] = *(const LAS3 bf16x8*)(lds + G8_SB(b, h) + boff + n * 2048 + k * 1024); } while (0)
#define G8_MMA(ai, bj, At, Bt) do { __builtin_amdgcn_s_setprio(1); _Pragma("unroll") for (int m = 0; m < 4; ++m) _Pragma("unroll") for (int n = 0; n < 2; ++n) _Pragma("unroll") for (int k = 0; k < 2; ++k) \
    acc[ai][bj][m][n] = __builtin_amdgcn_mfma_f32_16x16x32_bf16(Bt[n][k], At[m][k], acc[ai][bj][m][n], 0, 0, 0); __builtin_amdgcn_s_setprio(0); } while (0)
#define G8_WAIT_V(n) asm volatile("s_waitcnt vmcnt(" #n ")" ::: "memory")
#define G8_WAIT_L(n) asm volatile("s_waitcnt lgkmcnt(" #n ")" ::: "memory")
#define G8_BAR __builtin_amdgcn_s_barrier()
#define G8_SCHED __builtin_amdgcn_sched_barrier(0)
  Unit cur, nxt; int ui = 0;
  if (!S.next(0, cur)) return;
  f32x4 acc[2][2][4][2];
#pragma unroll
  for (int a = 0; a < 2; ++a)
#pragma unroll
    for (int b = 0; b < 2; ++b)
#pragma unroll
      for (int m = 0; m < 4; ++m)
#pragma unroll
        for (int n = 0; n < 2; ++n) acc[a][b][m][n] = (f32x4){0.f, 0.f, 0.f, 0.f};
  bf16x8 At[4][2], B0[2][2], B1[2][2];
  const char* cA = cur.A; const char* cB = cur.B;
  unsigned voffA[2], voffB[2];
  size_t hstepA, hstepB;
  G8_VOFF(cur.lda, cur.K);
  G8_STAGE(G8_SB(0, 0), cB, voffB); G8_STAGE(G8_SA(0, 0), cA, voffA); G8_STAGE(G8_SB(0, 1), cB + hstepB, voffB); G8_STAGE(G8_SA(0, 1), cA + hstepA, voffA);
  if (wr == 1) G8_BAR;
  G8_WAIT_V(4); G8_BAR;
  G8_STAGE(G8_SB(1, 0), cB + kstep, voffB); G8_STAGE(G8_SA(1, 0), cA + kstep, voffA); G8_STAGE(G8_SB(1, 1), cB + hstepB + kstep, voffB);
  G8_WAIT_V(6); G8_BAR;
  for (;;) {
    const bool has_next = S.next(ui + 1, nxt);
    if (!has_next) nxt = cur;
    const char* nA = nxt.A; const char* nB = nxt.B;
    const int nt = cur.K / BK;
    for (int t = 0; t < nt; t += 2) {
      const bool last = (t == nt - 2);
      const char* a1 = cA + (size_t)(t + 1) * kstep;
      const char* a2 = last ? nA : cA + (size_t)(t + 2) * kstep; const char* b2 = last ? nB : cB + (size_t)(t + 2) * kstep;
      const char* a3 = a2 + kstep; const char* b3 = b2 + kstep;
      G8_LDB(B0, 0, 0); G8_SCHED; G8_LDA(At, 0, 0); G8_STAGE(G8_SA(1, 1), a1 + hstepA, voffA);
      G8_WAIT_L(8); G8_BAR; G8_WAIT_L(0); G8_MMA(0, 0, At, B0); G8_BAR; G8_SCHED;
      if (last) G8_VOFF(nxt.lda, nxt.K);
      G8_LDB(B1, 0, 1); G8_STAGE(G8_SB(0, 0), b2, voffB);
      G8_BAR; G8_WAIT_L(0); G8_MMA(0, 1, At, B1); G8_BAR;
      G8_LDA(At, 0, 1); G8_STAGE(G8_SA(0, 0), a2, voffA);
      G8_BAR; G8_WAIT_L(0); G8_MMA(1, 0, At, B0); G8_BAR; G8_SCHED;
      G8_STAGE(G8_SB(0, 1), b2 + hstepB, voffB);
      G8_WAIT_V(6); G8_BAR; G8_MMA(1, 1, At, B1); G8_BAR;
      G8_LDB(B0, 1, 0); G8_SCHED; G8_LDA(At, 1, 0); G8_STAGE(G8_SA(0, 1), a2 + hstepA, voffA);
      G8_WAIT_L(8); G8_BAR; G8_WAIT_L(0); G8_MMA(0, 0, At, B0); G8_BAR; G8_SCHED;
      G8_LDB(B1, 1, 1); G8_STAGE(G8_SB(1, 0), b3, voffB);
      G8_BAR; G8_WAIT_L(0); G8_MMA(0, 1, At, B1); G8_BAR;
      G8_LDA(At, 1, 1); G8_STAGE(G8_SA(1, 0), a3, voffA);
      G8_BAR; G8_WAIT_L(0); G8_MMA(1, 0, At, B0); G8_BAR; G8_SCHED;
      G8_STAGE(G8_SB(1, 1), b3 + hstepB, voffB);
      G8_WAIT_V(6); G8_BAR; G8_MMA(1, 1, At, B1); G8_BAR;
    }
    E(acc, cur, wr, wc, fr, fq, tid);
    if (!has_next) break;
#pragma unroll
    for (int a = 0; a < 2; ++a)
#pragma unroll
      for (int b = 0; b < 2; ++b)
#pragma unroll
        for (int m = 0; m < 4; ++m)
#pragma unroll
          for (int n = 0; n < 2; ++n) acc[a][b][m][n] = (f32x4){0.f, 0.f, 0.f, 0.f};
    cur = nxt; cA = nA; cB = nB; ++ui;
  }
  G8_WAIT_V(0);
  if (wr == 0) G8_BAR;
  G8_BAR;
#undef G8_VOFF
#undef G8_SA
#undef G8_SB
#undef G8_STAGE
#undef G8_LDA
#undef G8_LDB
#undef G8_MMA
#undef G8_WAIT_V
#undef G8_WAIT_L
#undef G8_BAR
#undef G8_SCHED
}
}

__device__ __forceinline__ void convT_job(const float* src0, const float* src1, int ldsrc, int kind, int off, int nvalid, u16* dst, int K,
                          int Ndst, const float* kscale, float mult, float* lds) {
  int tid = threadIdx.x; asm volatile("" : "+v"(tid));
  const int nkt = K >> 6, nitems = nkt * (Ndst >> 7);
  for (int it = blockIdx.x; it < nitems; it += gridDim.x) {
    const int kt = it % nkt, nt = it / nkt;
    float v[16];
#pragma unroll
    for (int e = 0; e < 16; ++e) {
      int idx = tid + e * 512, i = idx >> 7, j = idx & 127, n = nt * 128 + j, k = kt * 64 + i;
      if (kind == 0) {
        v[e] = (n < nvalid) ? src0[(size_t)k * ldsrc + off + n] : 0.f;
      } else {
        int g = n >> 8, w = n & 255;
        const float* sp = (w < 128) ? src0 : src1;
        v[e] = sp[(size_t)k * ldsrc + g * 128 + (w & 127)];
      }
    }
#pragma unroll
    for (int e = 0; e < 16; ++e) {
      int idx = tid + e * 512, i = idx >> 7, j = idx & 127, k = kt * 64 + i;
      float x = v[e];
      if (kscale) x *= kscale[k];
      lds[j * 65 + i] = x * mult;
    }
    __syncthreads();
#pragma unroll
    for (int e = 0; e < 8; ++e) {
      int idx = tid + e * 512, j = idx >> 5, i2 = (idx & 31) * 2;
      *(uint32_t*)(dst + (size_t)(nt * 128 + j) * K + kt * 64 + i2) = pack2(lds[j * 65 + i2], lds[j * 65 + i2 + 1]);
    }
    __syncthreads();
  }
}

__device__ void convert_weights(const P& p, int l, float* lds) {
  const float* win = p.w_in + (size_t)l * 1024 * 8352;
#pragma unroll 1
  for (int job = 0; job < 12; ++job) {
    const float* s0 = win; const float* s1 = nullptr; const float* ksc = nullptr;
    int ldsrc = 8352, kind = 0, off = 0, nvalid = 0, K = 1024, Ndst = 0; float mult = 1.f; u16* dst = p.W;
    if (job == 0) { off = 1696; nvalid = 2560; dst += OFF_WINA; Ndst = 2560; }
    else if (job == 1) { off = 0; nvalid = 1696; dst += OFF_WINB; Ndst = 1792; }
    else if (job == 2) { off = 4256; nvalid = 4096; dst += OFF_WGATE; Ndst = 4096; }
    else if (job < 7) { const int n = job - 3; s0 = p.w_branch + ((size_t)l * 4 + n) * 512 * 1024; ldsrc = 1024; nvalid = 1024; dst += OFF_WBR + (size_t)n * 1024 * 512; K = 512; Ndst = 1024; }
    else if (job == 7) { s0 = p.w_out + (size_t)l * 1024 * 1024; ldsrc = 1024; nvalid = 1024; dst += OFF_WOUT; Ndst = 1024; }
    else if (job == 8) { s0 = p.w_ff1 + (size_t)l * 1024 * 2816; s1 = p.w_ff3 + (size_t)l * 1024 * 2816; ldsrc = 2816; kind = 1; dst += OFF_WFF13; Ndst = 5632; }
    else if (job == 9) { s0 = p.w_ff2 + (size_t)l * 2816 * 1024; ldsrc = 1024; nvalid = 1024; dst += OFF_WFF2; K = 2816; Ndst = 1024; }
    else if (job == 10) { s0 = p.w_q_up + (size_t)l * 384 * 768; ldsrc = 768; nvalid = 768; dst += OFF_WQUP; K = 384; Ndst = 768; ksc = p.q_norm_g + l * 384; mult = 0.10206207261596575f * 1.4426950408889634f; }
    else { s0 = p.w_kv_up + (size_t)l * 256 * 1024; ldsrc = 1024; nvalid = 1024; dst += OFF_WKVUP; K = 256; Ndst = 1024; ksc = p.kv_norm_g + l * 256; }
    convT_job(s0, s1, ldsrc, kind, off, nvalid, dst, K, Ndst, ksc, mult, lds);
  }
  int tidc = threadIdx.x; asm volatile("" : "+v"(tidc));
  const int gt = blockIdx.x * NTHR + tidc, gs = gridDim.x * NTHR;
  for (int i = gt; i < 4 * 128 * 128; i += gs) p.W[OFF_WS + i] = f2bf(p.cmlp_w_s[(size_t)l * 65536 + i]);
  for (int i = gt; i < 2 * 8 * 128 * 64; i += gs) {
    int k = i & 63, n = (i >> 6) & 127, h = (i >> 13) & 7, d = i >> 16;
    const float* src = (n < 64) ? p.lru_w_a : p.lru_w_x;
    p.W[OFF_WLRU + i] = f2bf(src[((((size_t)l * 2 + d) * 8 + h) * 64 + k) * 64 + (n & 63)]);
  }
}

__device__ void phase0(const P& p, unsigned char* smem) {
  int tid = threadIdx.x; asm volatile("" : "+v"(tid));
  const int gt = blockIdx.x * NTHR + tid, gs = gridDim.x * NTHR;
  {
    const float4* s = (const float4*)p.x; float4* d = (float4*)p.out;
    for (int i = gt; i < NB * SL * DM / 4; i += gs) d[i] = s[i];
    const float4* s2 = (const float4*)p.ctx; float4* d2 = (float4*)p.Xc;
    for (int i = gt; i < NB * SC * DM / 4; i += gs) d2[i] = s2[i];
  }
  for (int idx = gt; idx < SL * 8; idx += gs) {
    int t = idx >> 3, i = idx & 7;
    float inv = exp2f(-(float)i * 0.125f * 13.287712379549449f);
    float ar = (float)(t >> 6) * inv, ac = (float)(t & 63) * inv;
    const float i2pi = 0.15915494309189535f;
    float rr = ar * i2pi; rr -= floorf(rr); rr *= 6.283185307179586f;
    float rc = ac * i2pi; rc -= floorf(rc); rc *= 6.283185307179586f;
    p.rope[t * 32 + i] = __cosf(rr); p.rope[t * 32 + 8 + i] = __sinf(rr);
    p.rope[t * 32 + 16 + i] = __cosf(rc); p.rope[t * 32 + 24 + i] = __sinf(rc);
  }
  float* sS = (float*)smem; float* red = sS + 9 * 1024;
  for (int it = blockIdx.x; it < 4 * 96; it += gridDim.x) {
    const int l = it / 96, cgp = it - l * 96;
    for (int idx = tid; idx < 9216; idx += 512) {
      int m = idx >> 10, k = idx & 1023;
      float v = (m < 8) ? p.c[m * 1024 + k] : p.c_ctx[k];
      sS[idx] = siluf_(v);
    }
    __syncthreads();
    const int cj = tid & 63, kp = tid >> 6, j = cgp * 64 + cj;
    float a[9];
#pragma unroll
    for (int m = 0; m < 9; ++m) a[m] = 0.f;
    for (int k0 = kp * 128; k0 < kp * 128 + 128; k0 += 16) {
      float w[16];
#pragma unroll
      for (int u = 0; u < 16; ++u) w[u] = p.w_mod[((size_t)l * 1024 + k0 + u) * 6144 + j];
#pragma unroll
      for (int u = 0; u < 16; ++u)
#pragma unroll
        for (int m = 0; m < 9; ++m) a[m] += sS[m * 1024 + k0 + u] * w[u];
    }
#pragma unroll
    for (int m = 0; m < 9; ++m) red[(kp * 9 + m) * 64 + cj] = a[m];
    __syncthreads();
    for (int idx = tid; idx < 576; idx += 512) {
      int m = idx >> 6, c2 = idx & 63;
      float s = 0.f;
      for (int q = 0; q < 8; ++q) s += red[(q * 9 + m) * 64 + c2];
      p.mod[((size_t)l * 9 + m) * 6144 + cgp * 64 + c2] = s + p.b_mod[l * 6144 + cgp * 64 + c2];
    }
    __syncthreads();
  }
}

__device__ void norm_mod(const P& p, int l, const float* g, int off_sh, int off_sc) {
  int tid = threadIdx.x; asm volatile("" : "+v"(tid));
  const int lane = tid & 63, wid = tid >> 6;
  for (int r = blockIdx.x * 8 + wid; r < MTOT; r += gridDim.x * 8) {
    const float* xr = xrow_ptr(p, r);
    const float* md = p.mod + ((size_t)l * 9 + mod_idx(r)) * 6144;
    float4 v[4];
    float ss = 0.f;
#pragma unroll
    for (int i = 0; i < 4; ++i) {
      v[i] = *(const float4*)(xr + i * 256 + lane * 4);
      ss += v[i].x * v[i].x + v[i].y * v[i].y + v[i].z * v[i].z + v[i].w * v[i].w;
    }
    ss = wave_sum(ss);
    const float inv = rsqrtf(ss * (1.f / 1024.f) + EPS);
#pragma unroll
    for (int i = 0; i < 4; ++i) {
      const int k = i * 256 + lane * 4;
      float4 gg = *(const float4*)(g + k);
      float4 sh = *(const float4*)(md + off_sh + k);
      float4 sc = *(const float4*)(md + off_sc + k);
      float o0 = v[i].x * inv * gg.x * (1.f + sc.x) + sh.x;
      float o1 = v[i].y * inv * gg.y * (1.f + sc.y) + sh.y;
      float o2 = v[i].z * inv * gg.z * (1.f + sc.z) + sh.z;
      float o3 = v[i].w * inv * gg.w * (1.f + sc.w) + sh.w;
      uint2 o; o.x = pack2(o0, o1); o.y = pack2(o2, o3);
      *(uint2*)(p.H + (size_t)r * 1024 + k) = o;
    }
  }
}

__device__ void conva_item(const P& p, int l, int item) {
  int tid = threadIdx.x; asm volatile("" : "+v"(tid));
  const u16* Zb1 = p.R1;
  const float* cw = p.conv_a_w + (size_t)l * 3 * 512;
  for (int e = 0; e < 32; ++e) {
    int idx = tid + e * 512, rr = idx >> 6, cgp = idx & 63;
    int r = item * 256 + rr;
    int b = r / ST, t = r - b * ST;
    int isctx = t >= SL, pos = isctx ? t - SL : t, seglen = isctx ? SC : SL;
    float acc[8];
#pragma unroll
    for (int i = 0; i < 8; ++i) acc[i] = 0.f;
#pragma unroll
    for (int k = 0; k < 3; ++k) {
      int pos2 = pos - 1 + k;
      if (pos2 >= 0 && pos2 < seglen) {
        size_t r2 = (size_t)(r - 1 + k);
        uint4 vc = *(const uint4*)(Zb1 + r2 * 2560 + 512 + cgp * 8);
        uint4 vx = *(const uint4*)(Zb1 + r2 * 2560 + 1024 + cgp * 8);
        float fc[8], fx[8];
        unpack8(vc, fc); unpack8(vx, fx);
#pragma unroll
        for (int i = 0; i < 8; ++i) acc[i] += cw[k * 512 + cgp * 8 + i] * (fc[i] * fx[i]);
      }
    }
    uint4 vb = *(const uint4*)(Zb1 + (size_t)r * 2560 + cgp * 8);
    float fb[8];
    unpack8(vb, fb);
#pragma unroll
    for (int i = 0; i < 8; ++i) acc[i] *= fb[i];
    *(uint4*)(p.Ycat + (size_t)r * 2048 + cgp * 8) = pack8(acc);
  }
}

__device__ void cmlp_item(const P& p, int l, int item, unsigned char* smem) {
  int tid = threadIdx.x; asm volatile("" : "+v"(tid));
  const int lane = tid & 63, wid = tid >> 6, fr = lane & 15, fq = lane >> 4;
  const int g = item & 3, bj = item >> 2;
  const int rowbase = bj * 128;
  u16* vT = (u16*)smem;
  float* sMu = (float*)(smem + 128 * 136 * 2);
  float* sRs = sMu + 128;
  const u16* Zb1 = p.R1;
  {
    uint4 vv[16];
#pragma unroll
    for (int rr = 0; rr < 16; ++rr) vv[rr] = *(const uint4*)(Zb1 + (size_t)(rowbase + wid * 16 + rr) * 2560 + 2048 + lane * 8);
#pragma unroll
    for (int rr = 0; rr < 16; ++rr) {
      int q = wid * 16 + rr;
      float f[8];
      unpack8(vv[rr], f);
      float s = 0.f;
#pragma unroll
      for (int i = 0; i < 8; ++i) { f[i] = geluf_(f[i]); s += f[i]; }
      s = wave_sum(s);
      float mu = s * (1.f / 512.f);
      float d2 = 0.f;
#pragma unroll
      for (int i = 0; i < 8; ++i) { float d = f[i] - mu; d2 += d * d; }
      d2 = wave_sum(d2);
      if (lane == 0) { sMu[q] = mu; sRs[q] = rsqrtf(d2 * (1.f / 512.f) + EPS); }
    }
  }
  __syncthreads();
  const float* lg = p.cmlp_ln_g + l * 512 + g * 128;
  const float* lb = p.cmlp_ln_b + l * 512 + g * 128;
#pragma unroll
  for (int e = 0; e < 4; ++e) {
    int idx = tid + e * 512, q = idx >> 4, dc = idx & 15;
    uint4 v = *(const uint4*)(Zb1 + (size_t)(rowbase + q) * 2560 + 2048 + g * 128 + dc * 8);
    float f[8];
    unpack8(v, f);
    float mu = sMu[q], rs = sRs[q];
#pragma unroll
    for (int i = 0; i < 8; ++i) {
      float val = (geluf_(f[i]) - mu) * rs * lg[dc * 8 + i] + lb[dc * 8 + i];
      vT[(dc * 8 + i) * 136 + q] = f2bf(val);
    }
  }
  __syncthreads();
  const u16* Ws = p.W + OFF_WS + (size_t)g * 128 * 128;
  f32x4 acc[8];
#pragma unroll
  for (int n = 0; n < 8; ++n) acc[n] = (f32x4){0.f, 0.f, 0.f, 0.f};
#pragma unroll
  for (int ks = 0; ks < 4; ++ks) {
    bf16x8 a = *(const bf16x8*)(Ws + (wid * 16 + fr) * 128 + ks * 32 + fq * 8);
#pragma unroll
    for (int n = 0; n < 8; ++n) {
      bf16x8 bb = *(const bf16x8*)(vT + (n * 16 + fr) * 136 + ks * 32 + fq * 8);
      acc[n] = __builtin_amdgcn_mfma_f32_16x16x32_bf16(bb, a, acc[n], 0, 0, 0);
    }
  }
  {
    const int pp = wid * 16 + fr;
    const size_t r = (size_t)(rowbase + pp);
    const float bsv = p.cmlp_b_s[((size_t)l * 4 + g) * 128 + pp];
    uint2 uu[8];
#pragma unroll
    for (int n = 0; n < 8; ++n) uu[n] = *(const uint2*)(Zb1 + r * 2560 + 1536 + g * 128 + n * 16 + fq * 4);
#pragma unroll
    for (int n = 0; n < 8; ++n) {
      float u0 = __uint_as_float(uu[n].x << 16), u1 = __uint_as_float(uu[n].x & 0xffff0000u);
      float u2 = __uint_as_float(uu[n].y << 16), u3 = __uint_as_float(uu[n].y & 0xffff0000u);
      uint2 ov;
      ov.x = pack2(geluf_(u0) * (acc[n][0] + bsv), geluf_(u1) * (acc[n][1] + bsv));
      ov.y = pack2(geluf_(u2) * (acc[n][2] + bsv), geluf_(u3) * (acc[n][3] + bsv));
      *(uint2*)(p.Ycat + r * 2048 + 1024 + g * 128 + n * 16 + fq * 4) = ov;
    }
  }
  __syncthreads();
}

template <int CTRL, int ROWMASK>
__device__ __forceinline__ float dppf(float old, float src) {
  return __int_as_float(__builtin_amdgcn_update_dpp(__float_as_int(old), __float_as_int(src), CTRL, ROWMASK, 0xf, false));
}
#define LSCAN_STEP(A_, B_, CTRL, RM) do { const float A2_ = dppf<CTRL, RM>(1.f, A_), B2_ = dppf<CTRL, RM>(0.f, B_); B_ = A_ * B2_ + B_; A_ = A_ * A2_; } while (0)
#define LSCAN64(A_, B_) do { LSCAN_STEP(A_, B_, 0x111, 0xf); LSCAN_STEP(A_, B_, 0x112, 0xf); LSCAN_STEP(A_, B_, 0x114, 0xf); LSCAN_STEP(A_, B_, 0x118, 0xf); \
    LSCAN_STEP(A_, B_, 0x142, 0xa); LSCAN_STEP(A_, B_, 0x143, 0xc); } while (0)

template <int PASS>
__device__ void lru_run(const P& p, int l, int it_first, int it_stride, unsigned char* smem) {
  int tid = threadIdx.x; asm volatile("" : "+v"(tid));
  const int lane = tid & 63, wid = tid >> 6, fr = lane & 15, fq = lane >> 4;
  u16* sX = (u16*)smem;
  float* sA = (float*)(smem + 18432);
  float* sB = sA + 64 * 130;
  float* sH = sB + 64 * 130;
  float* sCw = sH + 128 * 65;
  float* sCarry = sCw + 320;
  float* sPar = sCarry + 128;
  u16* sW = (u16*)(sPar + 384);
  const u16* Zb2 = p.R1;
  int cur_h = -1;
  uint4 cv[2][4];
#define LRU_LOADCV(ITEM) do { const int h_ = (ITEM) & 7, bj_ = (ITEM) >> 3; const int b_ = bj_ / 34, j_ = bj_ - b_ * 34; const int ic_ = j_ >= 32; \
    const int p0_ = ic_ ? (j_ - 32) * 128 : j_ * 128, sl_ = ic_ ? SC : SL, rs_ = bj_ * 128 - p0_; \
    _Pragma("unroll") for (int e = 0; e < 2; ++e) { int idx = tid + e * 512, pp = idx >> 3, cgp = idx & 7; \
      _Pragma("unroll") for (int k = 0; k < 4; ++k) { int pos = p0_ + pp - 2 + k; cv[e][k] = make_uint4(0, 0, 0, 0); \
        if (pos >= 0 && pos < sl_) cv[e][k] = *(const uint4*)(Zb2 + (size_t)(rs_ + pos) * 1792 + h_ * 64 + cgp * 8); } } } while (0)
  if (it_first < 2176) LRU_LOADCV(it_first);
  for (int item = it_first; item < 2176; item += it_stride) {
    const int h = item & 7, bj = item >> 3;
    const int b = bj / 34, j = bj - b * 34;
    const int rowbase = bj * 128;
    const int isctx = j >= 32;
    const int ordf = isctx ? j - 32 : j + 2, ordr = 33 - j;
    float cA[16], cB[16];
    uint4 gv[2];
    if (PASS == 3) {
#pragma unroll
      for (int q = 0; q < 16; ++q) {
        const int pi = wid * 16 + q, d = pi >> 6, ch = pi & 63, o = d ? ordr : ordf;
        cA[q] = 1.f; cB[q] = 0.f;
        if (lane < o) { float2 v = p.summ[((size_t)(b * 2 + d) * 512 + h * 64 + ch) * 34 + lane]; cA[q] = v.x; cB[q] = v.y; }
      }
#pragma unroll
      for (int e = 0; e < 2; ++e) {
        int idx = tid + e * 512, pos = idx >> 3, cgp = idx & 7;
        gv[e] = *(const uint4*)(Zb2 + (size_t)(rowbase + pos) * 1792 + 800 + h * 64 + cgp * 8);
      }
    }
    if (h != cur_h) {
      cur_h = h;
      __syncthreads();
      if (tid < 320) {
        int k = tid >> 6, i = tid & 63;
        sCw[tid] = (k < 4) ? p.lru_conv_w[((size_t)l * 4 + k) * 512 + h * 64 + i] : p.lru_conv_b[l * 512 + h * 64 + i];
      }
      if (tid < 128) {
        const int d = tid >> 6, ch = tid & 63;
        const size_t pidx = ((size_t)l * 2 + d) * 512 + h * 64 + ch;
        sPar[tid * 3] = p.lru_b_a[pidx]; sPar[tid * 3 + 1] = p.lru_b_x[pidx];
        sPar[tid * 3 + 2] = 8.f * log1pf(__expf(-p.lru_lam[pidx]));
      }
#pragma unroll
      for (int e = 0; e < 4; ++e) {
        int idx = tid + e * 512, row = idx >> 3, kc = idx & 7;
        const int d = row >> 7, n = row & 127;
        *(uint4*)(sW + row * 72 + kc * 8) = *(const uint4*)(p.W + OFF_WLRU + (size_t)((d * 8 + h) * 128 + n) * 64 + kc * 8);
      }
      __syncthreads();
    }
#pragma unroll
    for (int e = 0; e < 2; ++e) {
      int idx = tid + e * 512, pp = idx >> 3, cgp = idx & 7;
      float a8[8];
#pragma unroll
      for (int i = 0; i < 8; ++i) a8[i] = sCw[256 + cgp * 8 + i];
#pragma unroll
      for (int k = 0; k < 4; ++k) {
        float f[8];
        unpack8(cv[e][k], f);
#pragma unroll
        for (int i = 0; i < 8; ++i) a8[i] += sCw[k * 64 + cgp * 8 + i] * f[i];
      }
      *(uint4*)(sX + pp * 72 + cgp * 8) = pack8(a8);
    }
    if (item + it_stride < 2176) LRU_LOADCV(item + it_stride);
    if (PASS == 3) {
#pragma unroll
      for (int q = 0; q < 16; ++q) LSCAN64(cA[q], cB[q]);
      if (lane == 63) {
#pragma unroll
        for (int q = 0; q < 16; ++q) sCarry[wid * 16 + q] = cB[q];
      }
    }
    __syncthreads();
    for (int d = 0; d < 2; ++d) {
      const u16* Wl = sW + d * 128 * 72;
      f32x4 acc[8];
#pragma unroll
      for (int n = 0; n < 8; ++n) acc[n] = (f32x4){0.f, 0.f, 0.f, 0.f};
      {
        const bf16x8 a0 = *(const bf16x8*)(sX + (wid * 16 + fr) * 72 + fq * 8);
        const bf16x8 a1 = *(const bf16x8*)(sX + (wid * 16 + fr) * 72 + 32 + fq * 8);
#pragma unroll
        for (int n = 0; n < 8; ++n) {
          const bf16x8 b0 = *(const bf16x8*)(Wl + (n * 16 + fr) * 72 + fq * 8);
          const bf16x8 b1 = *(const bf16x8*)(Wl + (n * 16 + fr) * 72 + 32 + fq * 8);
          acc[n] = __builtin_amdgcn_mfma_f32_16x16x32_bf16(a0, b0, acc[n], 0, 0, 0);
          acc[n] = __builtin_amdgcn_mfma_f32_16x16x32_bf16(a1, b1, acc[n], 0, 0, 0);
        }
      }
#pragma unroll
      for (int nt = 0; nt < 4; ++nt) {
        const int ch = nt * 16 + fr;
        const float ba = sPar[(d * 64 + ch) * 3], bx = sPar[(d * 64 + ch) * 3 + 1], sp8 = sPar[(d * 64 + ch) * 3 + 2];
#pragma unroll
        for (int jj = 0; jj < 4; ++jj) {
          const int pos = wid * 16 + fq * 4 + jj;
          const float xl = bf2f(sX[pos * 72 + ch]);
          const float rg = sigmoid_rcp_(acc[nt][jj] + ba), ig = sigmoid_rcp_(acc[nt + 4][jj] + bx);
          const float la = -sp8 * rg;
          const float av = __expf(la);
          const float x2 = 2.f * la;
          const float ser = -x2 * (1.f + x2 * (0.5f + x2 * (0.16666667f + x2 * (0.041666667f + x2 * 0.0083333333f))));
          const float om = (x2 > -0.25f) ? ser : (1.f - av * av);
          const float bb = __builtin_amdgcn_sqrtf(om) * ig * xl;
          const int si = d ? 127 - pos : pos;
          sA[ch * 130 + si] = av;
          sB[ch * 130 + si] = bb;
        }
      }
      __syncthreads();
      {
        float a0[8], b0[8], A[8], B[8];
#pragma unroll
        for (int c = 0; c < 8; ++c) {
          const int ch = wid * 8 + c;
          const float2 va = *(const float2*)(sA + ch * 130 + 2 * lane), vb = *(const float2*)(sB + ch * 130 + 2 * lane);
          a0[c] = va.x; b0[c] = vb.x;
          A[c] = va.x * va.y; B[c] = va.y * vb.x + vb.y;
        }
#pragma unroll
        for (int c = 0; c < 8; ++c) LSCAN64(A[c], B[c]);
#pragma unroll
        for (int c = 0; c < 8; ++c) {
          const int ch = wid * 8 + c;
          if (PASS == 1) {
            if (lane == 63) p.summ[((size_t)(b * 2 + d) * 512 + h * 64 + ch) * 34 + (d ? ordr : ordf)] = make_float2(A[c], B[c]);
          } else {
            const float carry = sCarry[d * 64 + ch];
            const float hincl = A[c] * carry + B[c];
            const float hprev = dppf<0x138, 0xf>(carry, hincl);
            const float heven = a0[c] * hprev + b0[c];
            const int se = 2 * lane, pe = d ? 127 - se : se, po = d ? 126 - se : se + 1;
            if (d == 0) { sH[pe * 65 + ch] = heven; sH[po * 65 + ch] = hincl; }
            else { sH[pe * 65 + ch] += heven; sH[po * 65 + ch] += hincl; }
          }
        }
      }
      __syncthreads();
    }
    if (PASS == 3) {
#pragma unroll
      for (int e = 0; e < 2; ++e) {
        int idx = tid + e * 512, pos = idx >> 3, cgp = idx & 7;
        const size_t r = (size_t)(rowbase + pos);
        float gf[8], y[8];
        unpack8(gv[e], gf);
#pragma unroll
        for (int i = 0; i < 8; ++i) y[i] = geluf_(gf[i]) * sH[pos * 65 + cgp * 8 + i];
        *(uint4*)(p.Ycat + r * 2048 + 512 + h * 64 + cgp * 8) = pack8(y);
      }
      __syncthreads();
    }
  }
}

__device__ void krope_item(const P& p, int item) {
  int tid = threadIdx.x; asm volatile("" : "+v"(tid));
  const u16* Zb2 = p.R1;
#pragma unroll
  for (int e = 0; e < 8; ++e) {
    int idx = tid + e * 512, rr = idx >> 4, pi = idx & 15, axis = pi >> 3, i = pi & 7;
    int r = item * 256 + rr, b = r / ST, t = r - b * ST;
    float x1 = bf2f(Zb2[(size_t)r * 1792 + 768 + axis * 16 + i]);
    float x2 = bf2f(Zb2[(size_t)r * 1792 + 768 + axis * 16 + 8 + i]);
    float o1 = x1, o2 = x2;
    if (t < SL) {
      float cs = p.rope[t * 32 + axis * 16 + i], sn = p.rope[t * 32 + axis * 16 + 8 + i];
      o1 = x1 * cs - x2 * sn;
      o2 = x1 * sn + x2 * cs;
    }
    u16 b1 = f2bf(o1), b2 = f2bf(o2);
#pragma unroll
    for (int h = 0; h < 8; ++h) {
      size_t base = ((size_t)(b * 8 + h) * ST + t) * 96 + 64 + axis * 16 + i;
      p.K[base] = b1;
      p.K[base + 8] = b2;
    }
  }
}

__device__ void attn_item(const P& p, int item, unsigned char* smem) {
  int tid = threadIdx.x; asm volatile("" : "+v"(tid));
  const int lane = tid & 63, wid = tid >> 6, fr = lane & 15, fq = lane >> 4;
  int b, h, t0, kt0, kt1;
  if (item < 1024) { b = item >> 7; h = (item >> 4) & 7; t0 = (item & 15) * 256; kt0 = 0; kt1 = 68; }
  else { int i2 = item - 1024; b = i2 >> 3; h = i2 & 7; t0 = SL; kt0 = 64; kt1 = 68; }
  const u16* Kb = p.K + (size_t)(b * 8 + h) * ST * 96;
  const u16* Vb = p.Vt + (size_t)(b * 8 + h) * 64 * ST;
  const u16* Qb = p.Q + (size_t)(b * 8 + h) * ST * 96;
  constexpr int KS = 104, VS = 136, KSZ = 128 * KS, VSZ = 64 * VS, STG = KSZ + VSZ;
  u16* lds = (u16*)smem;
  bf16x8 qf[2][3];
#pragma unroll
  for (int nq = 0; nq < 2; ++nq)
#pragma unroll
    for (int ks = 0; ks < 3; ++ks)
      qf[nq][ks] = *(const bf16x8*)(Qb + (size_t)(t0 + wid * 32 + nq * 16 + fr) * 96 + ks * 32 + fq * 8);
  if (item < 1024) {
#pragma unroll
    for (int nq = 0; nq < 2; ++nq) {
      const int t = t0 + wid * 32 + nq * 16 + fr;
      const float* rp = p.rope + t * 32 + (fq >> 1) * 16;
      union { bf16x8 v; uint32_t u[4]; } own, oth, res;
      own.v = qf[nq][2];
#pragma unroll
      for (int i = 0; i < 4; ++i) oth.u[i] = __shfl_xor(own.u[i], 16);
      float fo[8], fp[8], fres[8];
      { uint4 t4 = make_uint4(own.u[0], own.u[1], own.u[2], own.u[3]); unpack8(t4, fo); }
      { uint4 t4 = make_uint4(oth.u[0], oth.u[1], oth.u[2], oth.u[3]); unpack8(t4, fp); }
#pragma unroll
      for (int j = 0; j < 8; ++j) {
        float cs = rp[j], sn = rp[8 + j];
        fres[j] = (fq & 1) ? (fp[j] * sn + fo[j] * cs) : (fo[j] * cs - fp[j] * sn);
      }
      uint4 r4 = pack8(fres);
      res.u[0] = r4.x; res.u[1] = r4.y; res.u[2] = r4.z; res.u[3] = r4.w;
      qf[nq][2] = res.v;
    }
  }
  f32x4 o[4][2];
#pragma unroll
  for (int m = 0; m < 4; ++m)
#pragma unroll
    for (int n = 0; n < 2; ++n) o[m][n] = (f32x4){0.f, 0.f, 0.f, 0.f};
  float mrun[2] = {-1e30f, -1e30f}, lrun[2] = {0.f, 0.f};
  const int T0 = kt0 >> 1, T1 = kt1 >> 1;
  uint4 rk0, rk1, rk2, rv0, rv1;
  const int c0_ = tid, c1_ = tid + 512, c2_ = tid + 1024;
  const int kcv0_ = c0_ & 15, kcv1_ = c1_ & 15;
  const int vslot0_ = 32 * (kcv0_ >> 2) + 16 * (kcv0_ & 1) + 4 * ((kcv0_ & 3) >> 1);
  const int vslot1_ = 32 * (kcv1_ >> 2) + 16 * (kcv1_ & 1) + 4 * ((kcv1_ & 3) >> 1);
#define ATT_LD(tt) do { const size_t key0_ = (size_t)(tt) * 128; const u16* kb_ = Kb + key0_ * 96; \
    rk0 = *(const uint4*)(kb_ + (size_t)c0_ * 8); rk1 = *(const uint4*)(kb_ + (size_t)c1_ * 8); rk2 = *(const uint4*)(kb_ + (size_t)c2_ * 8); \
    rv0 = *(const uint4*)(Vb + (size_t)(c0_ >> 4) * ST + key0_ + (c0_ & 15) * 8); \
    rv1 = *(const uint4*)(Vb + (size_t)(c1_ >> 4) * ST + key0_ + (c1_ & 15) * 8); } while (0)
#define ATT_ST(st) do { u16* sk_ = lds + (st) * STG; u16* sv_ = sk_ + KSZ; \
    *(uint4*)(sk_ + (c0_ / 12) * KS + (c0_ % 12) * 8) = rk0; *(uint4*)(sk_ + (c1_ / 12) * KS + (c1_ % 12) * 8) = rk1; *(uint4*)(sk_ + (c2_ / 12) * KS + (c2_ % 12) * 8) = rk2; \
    *(uint2*)(sv_ + (c0_ >> 4) * VS + vslot0_) = make_uint2(rv0.x, rv0.y); *(uint2*)(sv_ + (c0_ >> 4) * VS + vslot0_ + 8) = make_uint2(rv0.z, rv0.w); \
    *(uint2*)(sv_ + (c1_ >> 4) * VS + vslot1_) = make_uint2(rv1.x, rv1.y); *(uint2*)(sv_ + (c1_ >> 4) * VS + vslot1_ + 8) = make_uint2(rv1.z, rv1.w); } while (0)
  ATT_LD(T0); ATT_ST(0);
  __syncthreads();
  for (int kt = T0; kt < T1; ++kt) {
    const bool more = (kt + 1 < T1);
    if (more) ATT_LD(kt + 1);
    const int cur = (kt - T0) & 1;
    const u16* sk = lds + cur * STG;
    const u16* sv = sk + KSZ;
    f32x4 s[8][2];
#pragma unroll
    for (int m = 0; m < 8; ++m)
#pragma unroll
      for (int n = 0; n < 2; ++n) s[m][n] = (f32x4){0.f, 0.f, 0.f, 0.f};
#pragma unroll
    for (int ks = 0; ks < 3; ++ks)
#pragma unroll
      for (int mt = 0; mt < 8; ++mt) {
        bf16x8 kf = *(const bf16x8*)(sk + (mt * 16 + fr) * KS + ks * 32 + fq * 8);
#pragma unroll
        for (int nq = 0; nq < 2; ++nq) s[mt][nq] = __builtin_amdgcn_mfma_f32_16x16x32_bf16(kf, qf[nq][ks], s[mt][nq], 0, 0, 0);
      }
    bf16x8 pb[2][4];
    float mloc[2];
#pragma unroll
    for (int nq = 0; nq < 2; ++nq) {
      float mx = fmaxf(fmaxf(s[0][nq][0], s[0][nq][1]), fmaxf(s[0][nq][2], s[0][nq][3]));
#pragma unroll
      for (int mt = 1; mt < 8; ++mt) mx = fmaxf(fmaxf(mx, s[mt][nq][0]), fmaxf(fmaxf(s[mt][nq][1], s[mt][nq][2]), s[mt][nq][3]));
      mloc[nq] = mx;
    }
    if (__any((mloc[0] > mrun[0] + 8.f) || (mloc[1] > mrun[1] + 8.f))) {
      float m0 = fmaxf(mloc[0], __shfl_xor(mloc[0], 16)), m1 = fmaxf(mloc[1], __shfl_xor(mloc[1], 16));
      m0 = fmaxf(m0, __shfl_xor(m0, 32)); m1 = fmaxf(m1, __shfl_xor(m1, 32));
      const float n0 = fmaxf(mrun[0], m0), n1 = fmaxf(mrun[1], m1);
      const float a0 = __builtin_amdgcn_exp2f(mrun[0] - n0), a1 = __builtin_amdgcn_exp2f(mrun[1] - n1);
      mrun[0] = n0; mrun[1] = n1;
      lrun[0] *= a0; lrun[1] *= a1;
#pragma unroll
      for (int mtv = 0; mtv < 4; ++mtv) {
        o[mtv][0][0] *= a0; o[mtv][0][1] *= a0; o[mtv][0][2] *= a0; o[mtv][0][3] *= a0;
        o[mtv][1][0] *= a1; o[mtv][1][1] *= a1; o[mtv][1][2] *= a1; o[mtv][1][3] *= a1;
      }
    }
#pragma unroll
    for (int nq = 0; nq < 2; ++nq) {
      const float mn = mrun[nq];
      float rs = 0.f;
#pragma unroll
      for (int mt = 0; mt < 8; ++mt)
#pragma unroll
        for (int jj = 0; jj < 4; ++jj) {
          float pv = __builtin_amdgcn_exp2f(s[mt][nq][jj] - mn);
          s[mt][nq][jj] = pv;
          rs += pv;
        }
      lrun[nq] += rs;
#pragma unroll
      for (int sx = 0; sx < 4; ++sx) {
        union { uint4 u; bf16x8 v; } cv;
        cv.u.x = pack2(s[2 * sx][nq][0], s[2 * sx][nq][1]); cv.u.y = pack2(s[2 * sx][nq][2], s[2 * sx][nq][3]);
        cv.u.z = pack2(s[2 * sx + 1][nq][0], s[2 * sx + 1][nq][1]); cv.u.w = pack2(s[2 * sx + 1][nq][2], s[2 * sx + 1][nq][3]);
        pb[nq][sx] = cv.v;
      }
    }
#pragma unroll
    for (int sx = 0; sx < 4; ++sx)
#pragma unroll
      for (int mtv = 0; mtv < 4; ++mtv) {
        const bf16x8 vf = *(const bf16x8*)(sv + (mtv * 16 + fr) * VS + 32 * sx + fq * 8);
#pragma unroll
        for (int nq = 0; nq < 2; ++nq) o[mtv][nq] = __builtin_amdgcn_mfma_f32_16x16x32_bf16(vf, pb[nq][sx], o[mtv][nq], 0, 0, 0);
      }
    if (more) ATT_ST(cur ^ 1);
    __syncthreads();
  }
#undef ATT_LD
#undef ATT_ST
#pragma unroll
  for (int nq = 0; nq < 2; ++nq) {
    float lt = lrun[nq];
    lt += __shfl_xor(lt, 16);
    lt += __shfl_xor(lt, 32);
    float inv = 1.f / lt;
    size_t r = (size_t)b * ST + t0 + wid * 32 + nq * 16 + fr;
#pragma unroll
    for (int mtv = 0; mtv < 4; ++mtv) {
      uint2 ov;
      ov.x = pack2(o[mtv][nq][0] * inv, o[mtv][nq][1] * inv);
      ov.y = pack2(o[mtv][nq][2] * inv, o[mtv][nq][3] * inv);
      *(uint2*)(p.Ycat + r * 2048 + 1536 + h * 64 + mtv * 16 + fq * 4) = ov;
    }
  }
}

#define XB_TMO      128
#define XB_XCNT(j)  (256  + 64 * (j))
#define XB_XSUB(j)  (1280 + 64 * (j))
#define XB_XGEN(j)  (2304 + 64 * (j))
#define XB_TOP      3328
#define XB_TOPGEN   3392
#define XCD_BAR_WORDS 3456
#define XB_SPIN_CAP (1u << 18)
__device__ __forceinline__ unsigned xb_ld(unsigned* p)              { return __hip_atomic_load(p, __ATOMIC_RELAXED, __HIP_MEMORY_SCOPE_AGENT); }
__device__ __forceinline__ unsigned xb_add(unsigned* p, unsigned v) { return __hip_atomic_fetch_add(p, v, __ATOMIC_RELAXED, __HIP_MEMORY_SCOPE_AGENT); }
__device__ __forceinline__ unsigned xb_xcc_id() { return (unsigned)__builtin_amdgcn_s_getreg((3 << 11) | 20) & 0xFu; }
#define XB_SPIN(cond, bar) do { unsigned _sp = 0; while (cond) { __builtin_amdgcn_s_sleep(1); \
    if ((++_sp & 255u) == 0u) { if (xb_ld(&(bar)[XB_TMO])) break; if (_sp > XB_SPIN_CAP) { atomicAdd(&(bar)[XB_TMO], 1u); break; } } } } while (0)
struct XcdBarrier { unsigned* bar; unsigned x; volatile __attribute__((address_space(3))) unsigned* st; };
__device__ __forceinline__ XcdBarrier xcd_barrier_post(unsigned* bar, volatile __attribute__((address_space(3))) unsigned* st) {
  XcdBarrier b; b.bar = bar; b.x = xb_xcc_id(); b.st = st;
  if (threadIdx.x == 0) (void)xb_add(&bar[XB_XCNT(b.x)], 1u);
  return b;
}
__device__ __forceinline__ void xcd_barrier_complete(unsigned* bar, unsigned x, unsigned& nloc, unsigned& nx) {
  const unsigned G = gridDim.x * gridDim.y * gridDim.z;
  unsigned sum, cnt, mine, sp = 0u;
  for (;;) {
    sum = 0u; cnt = 0u; mine = 0u;
#pragma unroll
    for (unsigned j = 0; j < 16; ++j) { const unsigned c = xb_ld(&bar[XB_XCNT(j)]); sum += c; cnt += (c > 0u) ? 1u : 0u; mine = (j == x) ? c : mine; }
    if (sum == G) break;
    __builtin_amdgcn_s_sleep(1);
    if ((++sp & 255u) == 0u) { if (xb_ld(&bar[XB_TMO])) break; if (sp > XB_SPIN_CAP) { atomicAdd(&bar[XB_TMO], 1u); break; } }
  }
  nloc = mine > 0u ? mine : 1u; nx = cnt > 0u ? cnt : 1u;
}
__device__ __forceinline__ void xcd_barrier(const XcdBarrier& b) {
  asm volatile("s_waitcnt vmcnt(0)" ::: "memory");
  __syncthreads();
  if (threadIdx.x == 0) {
    unsigned* bar = b.bar;
    __builtin_amdgcn_s_waitcnt(0);
    unsigned nloc = b.st[0], nx = b.st[1];
    if (nloc == 0u) { xcd_barrier_complete(bar, b.x, nloc, nx); b.st[0] = nloc; b.st[1] = nx; }
    const unsigned old = xb_add(&bar[XB_XSUB(b.x)], 1u);
    const unsigned gen = old / nloc;
    if (old + 1u == (gen + 1u) * nloc) {
      __builtin_amdgcn_fence(__ATOMIC_RELEASE, "agent");
      asm volatile("s_waitcnt vmcnt(0)" ::: "memory");
      const unsigned og = xb_add(&bar[XB_TOP], 1u);
      const unsigned tg = og / nx;
      if (og + 1u == (tg + 1u) * nx) xb_add(&bar[XB_TOPGEN], 1u);
      else XB_SPIN(xb_ld(&bar[XB_TOPGEN]) == tg, bar);
      __builtin_amdgcn_fence(__ATOMIC_ACQUIRE, "agent");
      xb_add(&bar[XB_XGEN(b.x)], 1u);
      asm volatile("s_waitcnt vmcnt(0)" ::: "memory");
    } else {
      XB_SPIN(xb_ld(&bar[XB_XGEN(b.x)]) == gen, bar);
      __builtin_amdgcn_fence(__ATOMIC_ACQUIRE, "agent");
      asm volatile("s_waitcnt vmcnt(0)" ::: "memory");
    }
  }
  __syncthreads();
}

__global__ void __launch_bounds__(NTHR) mega(P p) {
  extern __shared__ __attribute__((aligned(16))) unsigned char smem[];
  __shared__ uint4 xb_words;
  cg::grid_group grid = cg::this_grid();
  if (threadIdx.x == 0) xb_words = make_uint4(0u, 0u, 0u, 0u);
  __syncthreads();
  XcdBarrier xb = xcd_barrier_post(p.bar, (volatile __attribute__((address_space(3))) unsigned*)&xb_words);
  u16* lds = (u16*)smem;
  float* sInv = (float*)(smem + 131072);
  LAS3 unsigned char* lds3 = (LAS3 unsigned char*)smem;
  const int bid = blockIdx.x, nblk = gridDim.x;
  auto nopre = [](int) {};

#ifndef NO_P0
  phase0(p, smem);
#endif
  grid.sync();

#pragma unroll 1
  for (int l = 0; l < 4; ++l) {
    int tid = threadIdx.x; asm volatile("" : "+v"(tid));
    const int lane = tid & 63, wid = tid >> 6, wr = wid >> 1, wc = wid & 1, fr = lane & 15, fq = lane >> 4;
    (void)lane; (void)wid; (void)wr; (void)wc; (void)fr; (void)fq;
#ifndef NO_CW
    convert_weights(p, l, (float*)smem);
#endif
    norm_mod(p, l, p.norm1_g + l * 1024, 0, 1024);
    GSYNC();

    {
      u16* Zb1 = p.R1;
      auto epi = [=](const f32x4(&acc)[2][2][4][2], const g8::Unit& u, int wr, int wc, int fr, int fq, int) {
#pragma unroll
        for (int ai = 0; ai < 2; ++ai)
#pragma unroll
          for (int m = 0; m < 4; ++m) {
            u16* rowp = Zb1 + (size_t)(u.pm * 256 + ai * 128 + wr * 64 + m * 16 + fr) * 2560 + u.pn * 256 + wc * 32 + 8 * fq;
#pragma unroll
            for (int bj = 0; bj < 2; ++bj) {
              uint4 w;
              w.x = g8::cvt_pk_bf16(acc[ai][bj][m][0][0], acc[ai][bj][m][0][1]); w.y = g8::cvt_pk_bf16(acc[ai][bj][m][0][2], acc[ai][bj][m][0][3]);
              w.z = g8::cvt_pk_bf16(acc[ai][bj][m][1][0], acc[ai][bj][m][1][1]); w.w = g8::cvt_pk_bf16(acc[ai][bj][m][1][2], acc[ai][bj][m][1][3]);
              *(uint4*)(rowp + bj * 128) = w;
            }
          }
      };
      g8::Simple S; S.o.init(l == 3 ? 128 : 136, 10, nblk, bid); S.A = p.H; S.Bt = p.W + OFF_WINA; S.lda = 1024; S.K = 1024;
      g8::gemm_phase<true>(lds3, S, epi);
    }
    GSYNC();

    for (int rep = 0; rep < DUP_C1; ++rep)
    for (int it = bid; it < 1088 + 136; it += nblk) {
#ifndef NO_CMLP
      if (it < 1088) cmlp_item(p, l, it, smem);
#endif
#ifndef NO_CONVA
      if (it >= 1088) conva_item(p, l, it - 1088);
#endif
    }
    GSYNC();

    {
      u16* Zb2 = p.R1;
      auto epi = [=](const f32x4(&acc)[2][2][4][2], const g8::Unit& u, int wr, int wc, int fr, int fq, int) {
#pragma unroll
        for (int ai = 0; ai < 2; ++ai)
#pragma unroll
          for (int m = 0; m < 4; ++m) {
            u16* rowp = Zb2 + (size_t)(u.pm * 256 + ai * 128 + wr * 64 + m * 16 + fr) * 1792 + u.pn * 256 + wc * 32 + 8 * fq;
#pragma unroll
            for (int bj = 0; bj < 2; ++bj) {
              uint4 w;
              w.x = g8::cvt_pk_bf16(acc[ai][bj][m][0][0], acc[ai][bj][m][0][1]); w.y = g8::cvt_pk_bf16(acc[ai][bj][m][0][2], acc[ai][bj][m][0][3]);
              w.z = g8::cvt_pk_bf16(acc[ai][bj][m][1][0], acc[ai][bj][m][1][1]); w.w = g8::cvt_pk_bf16(acc[ai][bj][m][1][2], acc[ai][bj][m][1][3]);
              *(uint4*)(rowp + bj * 128) = w;
            }
          }
        const int pn = u.pn;
        if (pn == 2 || pn == 5 || pn == 6) {
          const bool inc0 = (pn != 5) || (wc >= 1);
          const bool inc1 = (pn == 2) || (pn == 5) || (wc == 0);
          float* dst = p.ssq + (size_t)(u.pm * 256 + wr * 64 + fr) * 12 + (pn == 2 ? 0 : (pn == 5 ? 4 : 8)) + wc;
#pragma unroll
          for (int ai = 0; ai < 2; ++ai)
#pragma unroll
            for (int m = 0; m < 4; ++m) {
              float ss = 0.f;
#pragma unroll
              for (int n = 0; n < 2; ++n)
#pragma unroll
                for (int jj = 0; jj < 4; ++jj) {
                  const float v0 = acc[ai][0][m][n][jj], v1 = acc[ai][1][m][n][jj];
                  ss += (inc0 ? v0 * v0 : 0.f) + (inc1 ? v1 * v1 : 0.f);
                }
              ss += __shfl_xor(ss, 16);
              ss += __shfl_xor(ss, 32);
              if (fq == 0) dst[(ai * 128 + m * 16) * 12] = ss;
              asm volatile("" ::: "memory");
            }
        }
      };
      g8::Simple S; S.o.init(136, 7, nblk, bid); S.A = p.H; S.Bt = p.W + OFF_WINB; S.lda = 1024; S.K = 1024;
      g8::gemm_phase<true>(lds3, S, epi);
    }
    GSYNC();

    for (int rep = 0; rep < DUP_C2; ++rep)
    {
      const u16* Zb2 = p.R1;
      for (int r2 = 0; r2 < DUP_LRU1; ++r2) lru_run<1>(p, l, bid, nblk, smem);
      for (int r2 = 0; r2 < DUP_PROJ; ++r2) {
      {
        struct ProjSched {
          g8::Order o; const u16* Zb2; const u16* Wq; const u16* Wkv;
          __device__ bool next(int i, g8::Unit& u) const {
            int pm, pn; if (!o.tile(i, pm, pn)) return false;
            u.pm = pm; u.lda = 1792;
            if (pn < 3) { u.pn = pn; u.aux = 0; u.K = 384; u.A = (const char*)(Zb2 + (size_t)pm * 256 * 1792 + 1312); u.B = (const char*)(Wq + (size_t)pn * 256 * 384); }
            else { u.pn = pn - 3; u.aux = 1; u.K = 256; u.A = (const char*)(Zb2 + (size_t)pm * 256 * 1792 + 512); u.B = (const char*)(Wkv + (size_t)(pn - 3) * 256 * 256); }
            return true;
          }
        };
        ProjSched S; S.o.init(136, 7, nblk, bid); S.Zb2 = Zb2; S.Wq = p.W + OFF_WQUP; S.Wkv = p.W + OFF_WKVUP;
        auto epi = [=](const f32x4(&acc)[2][2][4][2], const g8::Unit& u, int wr, int wc, int fr, int fq, int) {
          const int row0 = u.pm * 256, b = row0 / ST, tb = row0 - b * ST;
          const int kv = u.aux;
          const float* sq = p.ssq + (size_t)row0 * 12;
          const float invn = kv ? (1.f / 256.f) : (1.f / 384.f);
#pragma unroll
          for (int ai = 0; ai < 2; ++ai)
#pragma unroll
            for (int m = 0; m < 4; ++m) {
              const int rl = ai * 128 + wr * 64 + m * 16 + fr;
              const float4 p0 = *(const float4*)(sq + rl * 12), p1 = *(const float4*)(sq + rl * 12 + 4), p2 = *(const float4*)(sq + rl * 12 + 8);
              const float ssum = kv ? ((p0.x + p0.y) + (p0.z + p0.w)) : (((p1.x + p1.y) + (p1.z + p1.w)) + ((p2.x + p2.y) + (p2.z + p2.w)));
              const float inv = rsqrtf(ssum * invn + EPS);
              const int t = tb + rl;
#pragma unroll
              for (int bj = 0; bj < 2; ++bj) {
                const int c8 = u.pn * 256 + bj * 128 + wc * 32 + 8 * fq;
                float v[8];
#pragma unroll
                for (int n = 0; n < 2; ++n)
#pragma unroll
                  for (int jj = 0; jj < 4; ++jj) v[n * 4 + jj] = acc[ai][bj][m][n][jj] * inv;
                if (!kv) {
                  const int head = c8 / 96, d = c8 - head * 96;
                  *(uint4*)(p.Q + ((size_t)(b * 8 + head) * ST + t) * 96 + d) = pack8(v);
                } else {
                  const int head = c8 >> 7, w = c8 & 127;
                  if (wc < 2) {
                    *(uint4*)(p.K + ((size_t)(b * 8 + head) * ST + t) * 96 + w) = pack8(v);
                  } else {
                    u16* vp = p.Vt + ((size_t)(b * 8 + head) * 64 + (w - 64)) * ST + t;
#pragma unroll
                    for (int e = 0; e < 8; ++e) vp[(size_t)e * ST] = f2bf(v[e]);
                  }
                }
              }
              asm volatile("" ::: "memory");
            }
        };
        g8::gemm_phase<true>(lds3, S, epi);
      }
      {
        const int off = 2176;
        int first = bid;
        if (first < off) { int kk = (off - first + nblk - 1) / nblk; first += kk * nblk; }
        for (int it = first; it < off + 136; it += nblk) krope_item(p, it - off);
      }
      }
    }
    GSYNC();

    for (int rep = 0; rep < DUP_ATTN; ++rep)
    {
      int it = bid;
      for (; it < 1088; it += nblk) attn_item(p, it, smem);
      for (int r2 = 0; r2 < DUP_LRU3; ++r2) lru_run<3>(p, l, it - 1088, nblk, smem);
    }
    GSYNC();

    {
      u16* Mg = p.R1;
      const int ntile = 272 * 8;
      int te = threadIdx.x; asm volatile("" : "+v"(te));
      const int lane_e = te & 63, wid_e = te >> 6;
      const int wr = wid_e >> 1, wc = wid_e & 1, fr = lane_e & 15, fq = lane_e >> 4;
      int estr = nblk; asm volatile("" : "+s"(estr));
      const int skipctx = (l == 3);
      for (int id = bid; id < ntile; id += estr) {
        int g = id >> 6, rem = id & 63;
        int ct = rem >> 3, rt = g * 8 + (rem & 7);
        if (skipctx && (rt % 34) >= 32) continue;
        f32x4 mg[2][4];
#pragma unroll
        for (int m = 0; m < 2; ++m)
#pragma unroll
          for (int n = 0; n < 4; ++n) mg[m][n] = (f32x4){0.f, 0.f, 0.f, 0.f};
        for (int nb = 0; nb < 4; ++nb) {
          f32x4 ag[2][4], ay[2][4];
#pragma unroll
          for (int m = 0; m < 2; ++m)
#pragma unroll
            for (int n = 0; n < 4; ++n) { ag[m][n] = (f32x4){0.f, 0.f, 0.f, 0.f}; ay[m][n] = (f32x4){0.f, 0.f, 0.f, 0.f}; }
          gemm_main128(p.H + (size_t)rt * 128 * 1024, 1024, p.W + OFF_WGATE + (size_t)(nb * 1024 + ct * 128) * 1024, 1024, 1024,
                       lds, ag);
          gemm_main128(p.Ycat + (size_t)rt * 128 * 2048 + nb * 512, 2048, p.W + OFF_WBR + (size_t)(nb * 1024 + ct * 128) * 512, 512,
                       512, lds, ay);
#pragma unroll
          for (int m = 0; m < 2; ++m)
#pragma unroll
            for (int n = 0; n < 4; ++n)
#pragma unroll
              for (int jj = 0; jj < 4; ++jj) mg[m][n][jj] += sigmoidf_(ag[m][n][jj]) * ay[m][n][jj];
        }
#pragma unroll
        for (int m = 0; m < 2; ++m) {
          u16* dst = Mg + (size_t)(rt * 128 + wr * 32 + m * 16 + fq * 4) * 1024 + ct * 128 + wc * 64 + fr;
#pragma unroll
          for (int n = 0; n < 4; ++n)
#pragma unroll
            for (int jj = 0; jj < 4; ++jj) dst[jj * 1024 + n * 16] = f2bf(mg[m][n][jj]);
          asm volatile("" ::: "memory");
        }
        __syncthreads();
      }
    }
    GSYNC();

    {
      auto epi = [=](const f32x4(&acc)[2][2][4][2], const g8::Unit& u, int wr, int wc, int fr, int fq, int) {
        float* xb = xrow_ptr(p, u.pm * 256);
        const float* gate = p.mod + ((size_t)l * 9 + mod_idx(u.pm * 256)) * 6144 + 2048 + u.pn * 256 + wc * 32 + 4 * fq;
        f32x4 gv[2][2];
#pragma unroll
        for (int bj = 0; bj < 2; ++bj)
#pragma unroll
          for (int n = 0; n < 2; ++n) gv[bj][n] = *(const f32x4*)(gate + bj * 128 + n * 16);
#pragma unroll
        for (int ai = 0; ai < 2; ++ai)
#pragma unroll
          for (int m = 0; m < 4; ++m) {
            float* rowp = xb + (size_t)(ai * 128 + wr * 64 + m * 16 + fr) * DM + u.pn * 256 + wc * 32 + 4 * fq;
#pragma unroll
            for (int bj = 0; bj < 2; ++bj)
#pragma unroll
              for (int n = 0; n < 2; ++n) {
                f32x4 xv = *(const f32x4*)(rowp + bj * 128 + n * 16);
                xv += gv[bj][n] * acc[ai][bj][m][n];
                *(f32x4*)(rowp + bj * 128 + n * 16) = xv;
              }
          }
      };
      g8::Simple S; S.o.init(l == 3 ? 128 : 136, 4, nblk, bid); S.A = p.R1; S.Bt = p.W + OFF_WOUT; S.lda = 1024; S.K = 1024;
      g8::gemm_phase<false>(lds3, S, epi);
    }
    GSYNC();

    norm_mod(p, l, p.norm2_g + l * 1024, 3072, 4096);
    GSYNC();

    {
      u16* U = p.R1;
      auto epi = [=](const f32x4(&acc)[2][2][4][2], const g8::Unit& u, int wr, int wc, int fr, int fq, int) {
#pragma unroll
        for (int ai = 0; ai < 2; ++ai)
#pragma unroll
          for (int m = 0; m < 4; ++m) {
            u16* rowp = U + (size_t)(u.pm * 256 + ai * 128 + wr * 64 + m * 16 + fr) * 2816 + u.pn * 128 + wc * 32 + 8 * fq;
            float v[8];
#pragma unroll
            for (int n = 0; n < 2; ++n)
#pragma unroll
              for (int jj = 0; jj < 4; ++jj) v[n * 4 + jj] = siluf_(acc[ai][0][m][n][jj]) * acc[ai][1][m][n][jj];
            uint4 w;
            w.x = g8::cvt_pk_bf16(v[0], v[1]); w.y = g8::cvt_pk_bf16(v[2], v[3]); w.z = g8::cvt_pk_bf16(v[4], v[5]); w.w = g8::cvt_pk_bf16(v[6], v[7]);
            *(uint4*)rowp = w;
          }
      };
      g8::Simple S; S.o.init(l == 3 ? 128 : 136, 22, nblk, bid); S.A = p.H; S.Bt = p.W + OFF_WFF13; S.lda = 1024; S.K = 1024;
      g8::gemm_phase<true>(lds3, S, epi);
    }
    GSYNC();

    {
      auto epi = [=](const f32x4(&acc)[2][2][4][2], const g8::Unit& u, int wr, int wc, int fr, int fq, int) {
        float* xb = xrow_ptr(p, u.pm * 256);
        const float* gate = p.mod + ((size_t)l * 9 + mod_idx(u.pm * 256)) * 6144 + 5120 + u.pn * 256 + wc * 32 + 4 * fq;
        f32x4 gv[2][2];
#pragma unroll
        for (int bj = 0; bj < 2; ++bj)
#pragma unroll
          for (int n = 0; n < 2; ++n) gv[bj][n] = *(const f32x4*)(gate + bj * 128 + n * 16);
#pragma unroll
        for (int ai = 0; ai < 2; ++ai)
#pragma unroll
          for (int m = 0; m < 4; ++m) {
            float* rowp = xb + (size_t)(ai * 128 + wr * 64 + m * 16 + fr) * DM + u.pn * 256 + wc * 32 + 4 * fq;
#pragma unroll
            for (int bj = 0; bj < 2; ++bj)
#pragma unroll
              for (int n = 0; n < 2; ++n) {
                f32x4 xv = *(const f32x4*)(rowp + bj * 128 + n * 16);
                xv += gv[bj][n] * acc[ai][bj][m][n];
                *(f32x4*)(rowp + bj * 128 + n * 16) = xv;
              }
          }
      };
      g8::Simple S; S.o.init(l == 3 ? 128 : 136, 4, nblk, bid); S.A = p.R1; S.Bt = p.W + OFF_WFF2; S.lda = 2816; S.K = 2816;
      g8::gemm_phase<false>(lds3, S, epi);
    }
    GSYNC();

  }

  const int lane = threadIdx.x & 63, wid = threadIdx.x >> 6;
  for (int r = bid * 8 + wid; r < NB * SL; r += nblk * 8) {
    float* xr = p.out + (size_t)r * DM;
    float4 v[4];
    float ss = 0.f;
#pragma unroll
    for (int i = 0; i < 4; ++i) {
      v[i] = *(const float4*)(xr + i * 256 + lane * 4);
      ss += v[i].x * v[i].x + v[i].y * v[i].y + v[i].z * v[i].z + v[i].w * v[i].w;
    }
    ss = wave_sum(ss);
    const float inv = rsqrtf(ss * (1.f / 1024.f) + EPS);
#pragma unroll
    for (int i = 0; i < 4; ++i) {
      float4 gg = *(const float4*)(p.final_g + i * 256 + lane * 4);
      float4 ov;
      ov.x = v[i].x * inv * gg.x; ov.y = v[i].y * inv * gg.y; ov.z = v[i].z * inv * gg.z; ov.w = v[i].w * inv * gg.w;
      *(float4*)(xr + i * 256 + lane * 4) = ov;
    }
  }
}

extern "C" void kernel_launch(void* const* d_in, const int* in_sizes, int n_in, void* d_out, int out_size, void* d_ws,
                              size_t ws_size, hipStream_t stream) {
  static int grid_blocks = 0;
  if (!grid_blocks) {
    int dev = 0, cus = 0, per_cu = 0;
    hipGetDevice(&dev);
    hipDeviceGetAttribute(&cus, hipDeviceAttributeMultiprocessorCount, dev);
    hipFuncSetAttribute((const void*)mega, hipFuncAttributeMaxDynamicSharedMemorySize, LDS_BYTES);
    hipOccupancyMaxActiveBlocksPerMultiprocessor(&per_cu, (const void*)mega, NTHR, LDS_BYTES);
    if (per_cu < 1) per_cu = 1;
    if (per_cu > 1) per_cu = 1;
    grid_blocks = cus * per_cu;
    (void)hipGetLastError();
  }
  P p{};
  const float** pf = (const float**)&p;
  for (int i = 0; i < 31; ++i) pf[i] = (const float*)d_in[i];
  p.out = (float*)d_out;
  size_t off = 0;
  auto take = [&](size_t bytes) { void* r = (char*)d_ws + off; off += (bytes + 255) & ~(size_t)255; return r; };
  p.Xc = (float*)take((size_t)NB * SC * DM * 4);
  p.mod = (float*)take((size_t)4 * 9 * 6144 * 4);
  p.rope = (float*)take((size_t)SL * 32 * 4);
  p.summ = (float2*)take((size_t)NB * 2 * 512 * 34 * 8);
  p.ssq = (float*)take((size_t)12 * MTOT * 4);
  p.bar = (unsigned*)take((size_t)XCD_BAR_WORDS * 4);
  p.W = (u16*)take((size_t)W_ELEMS * 2);
  p.H = (u16*)take((size_t)MTOT * 1024 * 2);
  p.Ycat = (u16*)take((size_t)MTOT * 2048 * 2);
  p.R1 = (u16*)take((size_t)MTOT * 2560 * 2);
  p.K = (u16*)take((size_t)MTOT * 768 * 2);
  p.Vt = (u16*)take((size_t)MTOT * 512 * 2);
  p.Q = p.R1 + (size_t)MTOT * 1792;
  if (off > ws_size) { fprintf(stderr, "workspace too small: need %zu have %zu\n", off, ws_size); return; }
  (void)hipMemsetAsync(p.bar, 0, (size_t)XCD_BAR_WORDS * 4, stream);
  void* args[] = {&p};
  hipError_t e = hipLaunchCooperativeKernel((const void*)mega, dim3(grid_blocks), dim3(NTHR), args, LDS_BYTES, stream);
  if (e != hipSuccess) fprintf(stderr, "cooperative launch failed: %s (grid %d)\n", hipGetErrorString(e), grid_blocks);
}
```

```cpp
#include <hip/hip_runtime.h>
#include <hip/hip_bf16.h>
#include <hip/hip_cooperative_groups.h>
#include <cstdio>
#include <cstdint>
namespace cg = cooperative_groups;

typedef unsigned short u16;
using bf16x8 = __attribute__((ext_vector_type(8))) short;
using f32x4 = __attribute__((ext_vector_type(4))) float;
#define LAS3 __attribute__((address_space(3)))

#define NB 8
#define SL 4096
#define SC 256
#define ST 4352
#define MTOT 34816
#define DM 1024
#define NTHR 512
#define EPS 1e-6f
#define LDS_BYTES 159744
#define DUP_ATTN 1
#define DUP_C1 1
#define DUP_C2 1
#define DUP_E 1
#define EXTRA_SYNC 0
#define GSYNC() do { xcd_barrier(xb); for (int q_ = 0; q_ < EXTRA_SYNC; ++q_) xcd_barrier(xb); } while (0)
#define DUP_LRU1 1
#define DUP_LRU3 1
#define DUP_PROJ 1

#define OFF_WINA 0
#define OFF_WINB (OFF_WINA + 2560 * 1024)
#define OFF_WGATE (OFF_WINB + 1792 * 1024)
#define OFF_WBR (OFF_WGATE + 4096 * 1024)
#define OFF_WOUT (OFF_WBR + 4 * 1024 * 512)
#define OFF_WFF13 (OFF_WOUT + 1024 * 1024)
#define OFF_WFF2 (OFF_WFF13 + 5632 * 1024)
#define OFF_WQUP (OFF_WFF2 + 1024 * 2816)
#define OFF_WKVUP (OFF_WQUP + 768 * 384)
#define OFF_WS (OFF_WKVUP + 1024 * 256)
#define OFF_WLRU (OFF_WS + 4 * 128 * 128)
#define W_ELEMS (OFF_WLRU + 2 * 8 * 4 * 32 * 64)

struct P {
  const float *x, *c, *ctx, *c_ctx, *w_mod, *b_mod, *norm1_g, *norm2_g, *w_in, *conv_a_w, *lru_conv_w, *lru_conv_b,
      *lru_w_a, *lru_b_a, *lru_w_x, *lru_b_x, *lru_lam, *cmlp_ln_g, *cmlp_ln_b, *cmlp_w_s, *cmlp_b_s, *q_norm_g,
      *kv_norm_g, *w_q_up, *w_kv_up, *w_branch, *w_out, *w_ff1, *w_ff3, *w_ff2, *final_g;
  float *out, *Xc, *mod, *rope;
  float2* summ;
  float* ssq;
  unsigned* bar;
  u16 *W, *H, *Ycat, *R1, *Q, *K, *Vt;
};

__device__ __forceinline__ uint32_t pack2(float a, float b) { uint32_t r; asm("v_cvt_pk_bf16_f32 %0, %1, %2" : "=v"(r) : "v"(a), "v"(b)); return r; }
__device__ __forceinline__ u16 f2bf(float f) { return (u16)(pack2(f, f) & 0xffffu); }
__device__ __forceinline__ float bf2f(u16 h) { return __uint_as_float(((uint32_t)h) << 16); }
__device__ __forceinline__ float sigmoidf_(float x) { return __builtin_amdgcn_rcpf(1.f + __expf(-x)); }
__device__ __forceinline__ float sigmoid_rcp_(float x) { return __builtin_amdgcn_rcpf(1.f + __expf(-x)); }
__device__ __forceinline__ float siluf_(float x) { return x * __builtin_amdgcn_rcpf(1.f + __expf(-x)); }
__device__ __forceinline__ float geluf_(float x) {
  float u = 0.7978845608028654f * (x + 0.044715f * x * x * x);
  return x * __builtin_amdgcn_rcpf(1.f + __expf(-2.f * u));
}
__device__ __forceinline__ void unpack8(const uint4& v, float* f) {
  f[0] = __uint_as_float(v.x << 16); f[1] = __uint_as_float(v.x & 0xffff0000u);
  f[2] = __uint_as_float(v.y << 16); f[3] = __uint_as_float(v.y & 0xffff0000u);
  f[4] = __uint_as_float(v.z << 16); f[5] = __uint_as_float(v.z & 0xffff0000u);
  f[6] = __uint_as_float(v.w << 16); f[7] = __uint_as_float(v.w & 0xffff0000u);
}
__device__ __forceinline__ uint4 pack8(const float* f) {
  uint4 v; v.x = pack2(f[0], f[1]); v.y = pack2(f[2], f[3]); v.z = pack2(f[4], f[5]); v.w = pack2(f[6], f[7]); return v;
}
template <int CTRL, int ROWMASK>
__device__ __forceinline__ float dpp0f(float src) {
  return __int_as_float(__builtin_amdgcn_update_dpp(0, __float_as_int(src), CTRL, ROWMASK, 0xf, false));
}
__device__ __forceinline__ float wave_sum(float v) {
  v += dpp0f<0x111, 0xf>(v); v += dpp0f<0x112, 0xf>(v); v += dpp0f<0x114, 0xf>(v); v += dpp0f<0x118, 0xf>(v);
  v += dpp0f<0x142, 0xa>(v); v += dpp0f<0x143, 0xc>(v);
  return __int_as_float(__builtin_amdgcn_readlane(__float_as_int(v), 63));
}
__device__ __forceinline__ float* xrow_ptr(const P& p, int r) {
  int b = r / ST, t = r - b * ST;
  return t < SL ? p.out + ((size_t)(b * SL + t)) * DM : p.Xc + ((size_t)(b * SC + t - SL)) * DM;
}
__device__ __forceinline__ int mod_idx(int r) { int b = r / ST, t = r - b * ST; return t < SL ? b : 8; }

template <int MT>
__device__ __forceinline__ void gemm_main(const u16* __restrict__ A, int lda, const u16* __restrict__ B, int ldb, int K,
                                          u16* lds, f32x4 (&acc)[MT][4]) {
  constexpr int BM = MT * 64;
  constexpr int ASZ = BM * 72, BSZ = 128 * 72, STG = ASZ + BSZ;
  int tid = threadIdx.x; asm volatile("" : "+v"(tid));
  const int lane = tid & 63, wid = tid >> 6, wr = wid >> 1, wc = wid & 1, fr = lane & 15, fq = lane >> 4;
  uint4 ra[MT], rb[2];
  const int nk = K >> 6;
  const int crow = tid >> 3, ckc = (tid & 7) * 8;
#pragma unroll
  for (int i = 0; i < MT; ++i) ra[i] = *(const uint4*)(A + (size_t)(crow + i * 64) * lda + ckc);
#pragma unroll
  for (int i = 0; i < 2; ++i) rb[i] = *(const uint4*)(B + (size_t)(crow + i * 64) * ldb + ckc);
  {
    u16* sa = lds; u16* sb = lds + ASZ;
#pragma unroll
    for (int i = 0; i < MT; ++i) *(uint4*)(sa + (crow + i * 64) * 72 + ckc) = ra[i];
#pragma unroll
    for (int i = 0; i < 2; ++i) *(uint4*)(sb + (crow + i * 64) * 72 + ckc) = rb[i];
  }
  __syncthreads();
  for (int kt = 0; kt < nk; ++kt) {
    const bool more = (kt + 1 < nk);
    if (more) {
      const int k0 = (kt + 1) * 64 + ckc;
#pragma unroll
      for (int i = 0; i < MT; ++i) ra[i] = *(const uint4*)(A + (size_t)(crow + i * 64) * lda + k0);
#pragma unroll
      for (int i = 0; i < 2; ++i) rb[i] = *(const uint4*)(B + (size_t)(crow + i * 64) * ldb + k0);
    }
    const u16* sa = lds + (kt & 1) * STG;
    const u16* sb = sa + ASZ;
#pragma unroll
    for (int ks = 0; ks < 2; ++ks) {
      bf16x8 a[MT], b[4];
#pragma unroll
      for (int m = 0; m < MT; ++m) a[m] = *(const bf16x8*)(sa + (wr * MT * 16 + m * 16 + fr) * 72 + ks * 32 + fq * 8);
#pragma unroll
      for (int n = 0; n < 4; ++n) b[n] = *(const bf16x8*)(sb + (wc * 64 + n * 16 + fr) * 72 + ks * 32 + fq * 8);
#pragma unroll
      for (int m = 0; m < MT; ++m)
#pragma unroll
        for (int n = 0; n < 4; ++n) acc[m][n] = __builtin_amdgcn_mfma_f32_16x16x32_bf16(a[m], b[n], acc[m][n], 0, 0, 0);
    }
    if (more) {
      u16* wa = lds + ((kt + 1) & 1) * STG; u16* wb = wa + ASZ;
#pragma unroll
      for (int i = 0; i < MT; ++i) *(uint4*)(wa + (crow + i * 64) * 72 + ckc) = ra[i];
#pragma unroll
      for (int i = 0; i < 2; ++i) *(uint4*)(wb + (crow + i * 64) * 72 + ckc) = rb[i];
    }
    __syncthreads();
  }
}

__device__ __forceinline__ void gemm_main128(const u16* __restrict__ A, int lda, const u16* __restrict__ B, int ldb, int K,
                                             LAS3 unsigned char* lds, f32x4 (&acc)[2][4]) {
  constexpr int OPB = 128 * 256, STGB = 2 * OPB;
  int tid = threadIdx.x; asm volatile("" : "+v"(tid));
  const int lane = tid & 63, wid = __builtin_amdgcn_readfirstlane(tid >> 6), wr = wid >> 1, wc = wid & 1, fr = lane & 15, fq = lane >> 4;
  const int drow = wid * 4 + (lane >> 4), dslot = lane & 15;
  const int gch = (dslot ^ (drow & 15)) * 8;
  const unsigned goffA = (unsigned)(drow * lda + gch), goffB = (unsigned)(drow * ldb + gch);
  const unsigned rstepA = (unsigned)(32 * lda), rstepB = (unsigned)(32 * ldb);
  const int nk = K >> 7;
#define G128_DMA(st, kt) do { const int k0_ = (kt) * 128; \
    _Pragma("unroll") for (int i_ = 0; i_ < 4; ++i_) { \
      __builtin_amdgcn_global_load_lds((const unsigned*)(A + goffA + i_ * rstepA + k0_), (LAS3 unsigned*)(lds + (st) * STGB + (i_ * 8 + wid) * 1024), 16, 0, 0); \
      __builtin_amdgcn_global_load_lds((const unsigned*)(B + goffB + i_ * rstepB + k0_), (LAS3 unsigned*)(lds + (st) * STGB + OPB + (i_ * 8 + wid) * 1024), 16, 0, 0); } } while (0)
#define G128_MMA(st) do { LAS3 const unsigned char* sa = lds + (st) * STGB; LAS3 const unsigned char* sb = sa + OPB; \
    _Pragma("unroll") for (int ks = 0; ks < 4; ++ks) { bf16x8 a[2], b[4]; \
      _Pragma("unroll") for (int m = 0; m < 2; ++m) a[m] = *(LAS3 const bf16x8*)(sa + (wr * 32 + m * 16 + fr) * 256 + (((ks * 4 + fq) ^ fr) * 16)); \
      _Pragma("unroll") for (int n = 0; n < 4; ++n) b[n] = *(LAS3 const bf16x8*)(sb + (wc * 64 + n * 16 + fr) * 256 + (((ks * 4 + fq) ^ fr) * 16)); \
      __builtin_amdgcn_s_setprio(1); \
      _Pragma("unroll") for (int m = 0; m < 2; ++m) _Pragma("unroll") for (int n = 0; n < 4; ++n) \
        acc[m][n] = __builtin_amdgcn_mfma_f32_16x16x32_bf16(a[m], b[n], acc[m][n], 0, 0, 0); \
      __builtin_amdgcn_s_setprio(0); } } while (0)
  G128_DMA(0, 0);
  asm volatile("s_waitcnt vmcnt(0)" ::: "memory");
  __syncthreads();
  for (int kt = 0; kt < nk; ++kt) {
    if (kt + 1 < nk) G128_DMA((kt + 1) & 1, kt + 1);
    G128_MMA(kt & 1);
    asm volatile("s_waitcnt vmcnt(0)" ::: "memory");
    __syncthreads();
  }
#undef G128_DMA
#undef G128_MMA
}

template <int MT, class Pre, class Epi>
__device__ __forceinline__ void gemm_phase(const u16* A, int lda, const u16* B, int ldb, int K, int nct, u16* lds, Pre pre,
                                           Epi epi, int id0, int idstride, int idoff) {
  constexpr int BM = MT * 64;
  const int nrt = MTOT / BM, ntile = nrt * nct;
  int first = id0;
  if (first < idoff) { int kk = (idoff - first + idstride - 1) / idstride; first += kk * idstride; }
  for (int gid = first; gid < idoff + ntile; gid += idstride) {
    int id = gid - idoff;
    int g = id / (8 * nct), rem = id - g * 8 * nct;
    int ct = rem >> 3, rt = g * 8 + (rem & 7);
    f32x4 acc[MT][4];
#pragma unroll
    for (int m = 0; m < MT; ++m)
#pragma unroll
      for (int n = 0; n < 4; ++n) acc[m][n] = (f32x4){0.f, 0.f, 0.f, 0.f};
    pre(rt * BM);
    gemm_main<MT>(A + (size_t)rt * BM * lda, lda, B + (size_t)ct * 128 * ldb, ldb, K, lds, acc);
    epi(rt * BM, ct * 128, acc);
    __syncthreads();
  }
}

namespace g8 {
constexpr int BM = 256, BK = 64, HALF = 128, HTB = HALF * BK * 2, STAGE_BYTES = 8 * HTB, NXCD = 8, WGM = 8;
__device__ __forceinline__ int lds_byte(int r, int c) { const int st = (r >> 4) * 2 + (c >> 5), rr = r & 15, cc = c & 31, ob = rr * 64 + cc * 2; return st * 1024 + (ob ^ (((ob >> 9) & 1) << 5)); }
__device__ __forceinline__ void stage_rc(int b, int& R, int& C) { const int st = b / 1024, sb = b % 1024, swz = sb ^ (((sb >> 9) & 1) << 5); R = (st >> 1) * 16 + swz / 64; C = (st & 1) * 32 + (swz % 64) / 2; }
__device__ __forceinline__ int perm32(int rho) { const int n = rho >> 4, i = rho & 15; return 8 * (i >> 2) + 4 * n + (i & 3); }
struct Unit { const char* A; const char* B; int lda, K, pm, pn, aux; };
struct Order {
  int nM, nN, nwg, G, c;
  __device__ void init(int nM_, int nN_, int G_, int c_) { nM = nM_; nN = nN_; nwg = nM * nN; G = G_; c = c_; }
  __device__ bool tile(int i, int& pm, int& pn) const {
    const long L = (long)i * G + c; if (L >= nwg) return false;
    int wgid = (int)L; { const int q = nwg / NXCD, r = nwg % NXCD, xcd = wgid % NXCD, off = wgid / NXCD; wgid = (xcd < r ? xcd * (q + 1) : r * (q + 1) + (xcd - r) * q) + off; }
    const int nig = WGM * nN, gid = wgid / nig, fm = gid * WGM, gsz = (nM - fm) < WGM ? (nM - fm) : WGM;
    pm = fm + ((wgid % nig) % gsz); pn = (wgid % nig) / gsz;
    if (nM == 128) pm += pm >> 4;
    return true;
  }
};
struct Simple {
  Order o; const u16* A; const u16* Bt; int lda, K;
  __device__ bool next(int i, Unit& u) const {
    int pm, pn; if (!o.tile(i, pm, pn)) return false;
    u.A = (const char*)(A + (size_t)pm * 256 * lda); u.B = (const char*)(Bt + (size_t)pn * 256 * K); u.lda = lda; u.K = K; u.pm = pm; u.pn = pn; u.aux = 0; return true;
  }
};
__device__ __forceinline__ unsigned cvt_pk_bf16(float lo, float hi) { unsigned r; asm volatile("v_cvt_pk_bf16_f32 %0, %1, %2" : "=v"(r) : "v"(lo), "v"(hi)); return r; }

template <bool PERM, class Sched, class Epi>
__device__ __forceinline__ void gemm_phase(LAS3 unsigned char* lds, const Sched& S, const Epi& E) {
  int tid = threadIdx.x; asm volatile("" : "+v"(tid));
  const int wid = __builtin_amdgcn_readfirstlane(tid >> 6), lane = tid & 63, wr = wid >> 2, wc = wid & 3, fr = lane & 15, fq = lane >> 4;
  const size_t kstep = (size_t)(BK * 2);
#define G8_VOFF(LDA_, K_) do { int _t2 = tid; asm volatile("" : "+v"(_t2)); _Pragma("unroll") for (int _i = 0; _i < 2; ++_i) { int R, C; stage_rc(_t2 * 16 + _i * 8192, R, C); \
    const int Rb = PERM ? ((R & ~31) + perm32(R & 31)) : R; voffA[_i] = (unsigned)(R * (LDA_) + C) * 2u; voffB[_i] = (unsigned)(Rb * (K_) + C) * 2u; } \
    hstepA = (size_t)HALF * (LDA_) * 2; hstepB = (size_t)HALF * (K_) * 2; } while (0)
  const unsigned ldsw = (unsigned)wid * 1024u;
  const int aoff = lds_byte(wr * 64 + fr, fq * 8), boff = lds_byte(wc * 32 + fr, fq * 8);
#define G8_SA(b, h) (((b) * 2 + (h)) * HTB)
#define G8_SB(b, h) ((4 + (b) * 2 + (h)) * HTB)
#define G8_STAGE(bufoff, gbase, voff) do { _Pragma("unroll") for (int _i = 0; _i < 2; ++_i) \
    __builtin_amdgcn_global_load_lds((const unsigned*)((const char*)(gbase) + (voff)[_i]), (LAS3 unsigned*)(lds + (bufoff) + ldsw + _i * 8192), 16, 0, 0); } while (0)
#define G8_LDA(dst, b, h) do { _Pragma("unroll") for (int m = 0; m < 4; ++m) _Pragma("unroll") for (int k = 0; k < 2; ++k) dst[m][k] = *(const LAS3 bf16x8*)(lds + G8_SA(b, h) + aoff + m * 2048 + k * 1024); } while (0)
#define G8_LDB(dst, b, h) do { _Pragma("unroll") for (int n = 0; n < 2; ++n) _Pragma("unroll") for (int k = 0; k < 2; ++k) dst[n][k] = *(const LAS3 bf16x8*)(lds + G8_SB(b, h) + boff + n * 2048 + k * 1024); } while (0)
#define G8_MMA(ai, bj, At, Bt) do { __builtin_amdgcn_s_setprio(1); _Pragma("unroll") for (int m = 0; m < 4; ++m) _Pragma("unroll") for (int n = 0; n < 2; ++n) _Pragma("unroll") for (int k = 0; k < 2; ++k) \
    acc[ai][bj][m][n] = __builtin_amdgcn_mfma_f32_16x16x32_bf16(Bt[n][k], At[m][k], acc[ai][bj][m][n], 0, 0, 0); __builtin_amdgcn_s_setprio(0); } while (0)
#define G8_WAIT_V(n) asm volatile("s_waitcnt vmcnt(" #n ")" ::: "memory")
#define G8_WAIT_L(n) asm volatile("s_waitcnt lgkmcnt(" #n ")" ::: "memory")
#define G8_BAR __builtin_amdgcn_s_barrier()
#define G8_SCHED __builtin_amdgcn_sched_barrier(0)
  Unit cur, nxt; int ui = 0;
  if (!S.next(0, cur)) return;
  f32x4 acc[2][2][4][2];
#pragma unroll
  for (int a = 0; a < 2; ++a)
#pragma unroll
    for (int b = 0; b < 2; ++b)
#pragma unroll
      for (int m = 0; m < 4; ++m)
#pragma unroll
        for (int n = 0; n < 2; ++n) acc[a][b][m][n] = (f32x4){0.f, 0.f, 0.f, 0.f};
  bf16x8 At[4][2], B0[2][2], B1[2][2];
  const char* cA = cur.A; const char* cB = cur.B;
  unsigned voffA[2], voffB[2];
  size_t hstepA, hstepB;
  G8_VOFF(cur.lda, cur.K);
  G8_STAGE(G8_SB(0, 0), cB, voffB); G8_STAGE(G8_SA(0, 0), cA, voffA); G8_STAGE(G8_SB(0, 1), cB + hstepB, voffB); G8_STAGE(G8_SA(0, 1), cA + hstepA, voffA);
  if (wr == 1) G8_BAR;
  G8_WAIT_V(4); G8_BAR;
  G8_STAGE(G8_SB(1, 0), cB + kstep, voffB); G8_STAGE(G8_SA(1, 0), cA + kstep, voffA); G8_STAGE(G8_SB(1, 1), cB + hstepB + kstep, voffB);
  G8_WAIT_V(6); G8_BAR;
  for (;;) {
    const bool has_next = S.next(ui + 1, nxt);
    if (!has_next) nxt = cur;
    const char* nA = nxt.A; const char* nB = nxt.B;
    const int nt = cur.K / BK;
    for (int t = 0; t < nt; t += 2) {
      const bool last = (t == nt - 2);
      const char* a1 = cA + (size_t)(t + 1) * kstep;
      const char* a2 = last ? nA : cA + (size_t)(t + 2) * kstep; const char* b2 = last ? nB : cB + (size_t)(t + 2) * kstep;
      const char* a3 = a2 + kstep; const char* b3 = b2 + kstep;
      G8_LDB(B0, 0, 0); G8_SCHED; G8_LDA(At, 0, 0); G8_STAGE(G8_SA(1, 1), a1 + hstepA, voffA);
      G8_WAIT_L(8); G8_BAR; G8_WAIT_L(0); G8_MMA(0, 0, At, B0); G8_BAR; G8_SCHED;
      if (last) G8_VOFF(nxt.lda, nxt.K);
      G8_LDB(B1, 0, 1); G8_STAGE(G8_SB(0, 0), b2, voffB);
      G8_BAR; G8_WAIT_L(0); G8_MMA(0, 1, At, B1); G8_BAR;
      G8_LDA(At, 0, 1); G8_STAGE(G8_SA(0, 0), a2, voffA);
      G8_BAR; G8_WAIT_L(0); G8_MMA(1, 0, At, B0); G8_BAR; G8_SCHED;
      G8_STAGE(G8_SB(0, 1), b2 + hstepB, voffB);
      G8_WAIT_V(6); G8_BAR; G8_MMA(1, 1, At, B1); G8_BAR;
      G8_LDB(B0, 1, 0); G8_SCHED; G8_LDA(At, 1, 0); G8_STAGE(G8_SA(0, 1), a2 + hstepA, voffA);
      G8_WAIT_L(8); G8_BAR; G8_WAIT_L(0); G8_MMA(0, 0, At, B0); G8_BAR; G8_SCHED;
      G8_LDB(B1, 1, 1); G8_STAGE(G8_SB(1, 0), b3, voffB);
      G8_BAR; G8_WAIT_L(0); G8_MMA(0, 1, At, B1); G8_BAR;
      G8_LDA(At, 1, 1); G8_STAGE(G8_SA(1, 0), a3, voffA);
      G8_BAR; G8_WAIT_L(0); G8_MMA(1, 0, At, B0); G8_BAR; G8_SCHED;
      G8_STAGE(G8_SB(1, 1), b3 + hstepB, voffB);
      G8_WAIT_V(6); G8_BAR; G8_MMA(1, 1, At, B1); G8_BAR;
    }
    E(acc, cur, wr, wc, fr, fq, tid);
    if (!has_next) break;
#pragma unroll
    for (int a = 0; a < 2; ++a)
#pragma unroll
      for (int b = 0; b < 2; ++b)
#pragma unroll
        for (int m = 0; m < 4; ++m)
#pragma unroll
          for (int n = 0; n < 2; ++n) acc[a][b][m][n] = (f32x4){0.f, 0.f, 0.f, 0.f};
    cur = nxt; cA = nA; cB = nB; ++ui;
  }
  G8_WAIT_V(0);
  if (wr == 0) G8_BAR;
  G8_BAR;
#undef G8_VOFF
#undef G8_SA
#undef G8_SB
#undef G8_STAGE
#undef G8_LDA
#undef G8_LDB
#undef G8_MMA
#undef G8_WAIT_V
#undef G8_WAIT_L
#undef G8_BAR
#undef G8_SCHED
}
}

__device__ __forceinline__ void convT_job(const float* src0, const float* src1, int ldsrc, int kind, int off, int nvalid, u16* dst, int K,
                          int Ndst, const float* kscale, float mult, float* lds) {
  int tid = threadIdx.x; asm volatile("" : "+v"(tid));
  const int nkt = K >> 6, nitems = nkt * (Ndst >> 7);
  for (int it = blockIdx.x; it < nitems; it += gridDim.x) {
    const int kt = it % nkt, nt = it / nkt;
    float v[16];
#pragma unroll
    for (int e = 0; e < 16; ++e) {
      int idx = tid + e * 512, i = idx >> 7, j = idx & 127, n = nt * 128 + j, k = kt * 64 + i;
      if (kind == 0) {
        v[e] = (n < nvalid) ? src0[(size_t)k * ldsrc + off + n] : 0.f;
      } else {
        int g = n >> 8, w = n & 255;
        const float* sp = (w < 128) ? src0 : src1;
        v[e] = sp[(size_t)k * ldsrc + g * 128 + (w & 127)];
      }
    }
#pragma unroll
    for (int e = 0; e < 16; ++e) {
      int idx = tid + e * 512, i = idx >> 7, j = idx & 127, k = kt * 64 + i;
      float x = v[e];
      if (kscale) x *= kscale[k];
      lds[j * 65 + i] = x * mult;
    }
    __syncthreads();
#pragma unroll
    for (int e = 0; e < 8; ++e) {
      int idx = tid + e * 512, j = idx >> 5, i2 = (idx & 31) * 2;
      *(uint32_t*)(dst + (size_t)(nt * 128 + j) * K + kt * 64 + i2) = pack2(lds[j * 65 + i2], lds[j * 65 + i2 + 1]);
    }
    __syncthreads();
  }
}

__device__ void convert_weights(const P& p, int l, float* lds) {
  const float* win = p.w_in + (size_t)l * 1024 * 8352;
#pragma unroll 1
  for (int job = 0; job < 12; ++job) {
    const float* s0 = win; const float* s1 = nullptr; const float* ksc = nullptr;
    int ldsrc = 8352, kind = 0, off = 0, nvalid = 0, K = 1024, Ndst = 0; float mult = 1.f; u16* dst = p.W;
    if (job == 0) { off = 1696; nvalid = 2560; dst += OFF_WINA; Ndst = 2560; }
    else if (job == 1) { off = 0; nvalid = 1696; dst += OFF_WINB; Ndst = 1792; }
    else if (job == 2) { off = 4256; nvalid = 4096; dst += OFF_WGATE; Ndst = 4096; }
    else if (job < 7) { const int n = job - 3; s0 = p.w_branch + ((size_t)l * 4 + n) * 512 * 1024; ldsrc = 1024; nvalid = 1024; dst += OFF_WBR + (size_t)n * 1024 * 512; K = 512; Ndst = 1024; }
    else if (job == 7) { s0 = p.w_out + (size_t)l * 1024 * 1024; ldsrc = 1024; nvalid = 1024; dst += OFF_WOUT; Ndst = 1024; }
    else if (job == 8) { s0 = p.w_ff1 + (size_t)l * 1024 * 2816; s1 = p.w_ff3 + (size_t)l * 1024 * 2816; ldsrc = 2816; kind = 1; dst += OFF_WFF13; Ndst = 5632; }
    else if (job == 9) { s0 = p.w_ff2 + (size_t)l * 2816 * 1024; ldsrc = 1024; nvalid = 1024; dst += OFF_WFF2; K = 2816; Ndst = 1024; }
    else if (job == 10) { s0 = p.w_q_up + (size_t)l * 384 * 768; ldsrc = 768; nvalid = 768; dst += OFF_WQUP; K = 384; Ndst = 768; ksc = p.q_norm_g + l * 384; mult = 0.10206207261596575f * 1.4426950408889634f; }
    else { s0 = p.w_kv_up + (size_t)l * 256 * 1024; ldsrc = 1024; nvalid = 1024; dst += OFF_WKVUP; K = 256; Ndst = 1024; ksc = p.kv_norm_g + l * 256; }
    convT_job(s0, s1, ldsrc, kind, off, nvalid, dst, K, Ndst, ksc, mult, lds);
  }
  int tidc = threadIdx.x; asm volatile("" : "+v"(tidc));
  const int gt = blockIdx.x * NTHR + tidc, gs = gridDim.x * NTHR;
  for (int i = gt; i < 4 * 128 * 128; i += gs) p.W[OFF_WS + i] = f2bf(p.cmlp_w_s[(size_t)l * 65536 + i]);
  for (int i = gt; i < 2 * 8 * 128 * 64; i += gs) {
    int k = i & 63, n = (i >> 6) & 127, h = (i >> 13) & 7, d = i >> 16;
    const float* src = (n < 64) ? p.lru_w_a : p.lru_w_x;
    p.W[OFF_WLRU + i] = f2bf(src[((((size_t)l * 2 + d) * 8 + h) * 64 + k) * 64 + (n & 63)]);
  }
}

__device__ void phase0(const P& p, unsigned char* smem) {
  int tid = threadIdx.x; asm volatile("" : "+v"(tid));
  const int gt = blockIdx.x * NTHR + tid, gs = gridDim.x * NTHR;
  {
    const float4* s = (const float4*)p.x; float4* d = (float4*)p.out;
    for (int i = gt; i < NB * SL * DM / 4; i += gs) d[i] = s[i];
    const float4* s2 = (const float4*)p.ctx; float4* d2 = (float4*)p.Xc;
    for (int i = gt; i < NB * SC * DM / 4; i += gs) d2[i] = s2[i];
  }
  for (int idx = gt; idx < SL * 8; idx += gs) {
    int t = idx >> 3, i = idx & 7;
    float inv = exp2f(-(float)i * 0.125f * 13.287712379549449f);
    float ar = (float)(t >> 6) * inv, ac = (float)(t & 63) * inv;
    const float i2pi = 0.15915494309189535f;
    float rr = ar * i2pi; rr -= floorf(rr); rr *= 6.283185307179586f;
    float rc = ac * i2pi; rc -= floorf(rc); rc *= 6.283185307179586f;
    p.rope[t * 32 + i] = __cosf(rr); p.rope[t * 32 + 8 + i] = __sinf(rr);
    p.rope[t * 32 + 16 + i] = __cosf(rc); p.rope[t * 32 + 24 + i] = __sinf(rc);
  }
  float* sS = (float*)smem; float* red = sS + 9 * 1024;
  for (int it = blockIdx.x; it < 4 * 96; it += gridDim.x) {
    const int l = it / 96, cgp = it - l * 96;
    for (int idx = tid; idx < 9216; idx += 512) {
      int m = idx >> 10, k = idx & 1023;
      float v = (m < 8) ? p.c[m * 1024 + k] : p.c_ctx[k];
      sS[idx] = siluf_(v);
    }
    __syncthreads();
    const int cj = tid & 63, kp = tid >> 6, j = cgp * 64 + cj;
    float a[9];
#pragma unroll
    for (int m = 0; m < 9; ++m) a[m] = 0.f;
    for (int k0 = kp * 128; k0 < kp * 128 + 128; k0 += 16) {
      float w[16];
#pragma unroll
      for (int u = 0; u < 16; ++u) w[u] = p.w_mod[((size_t)l * 1024 + k0 + u) * 6144 + j];
#pragma unroll
      for (int u = 0; u < 16; ++u)
#pragma unroll
        for (int m = 0; m < 9; ++m) a[m] += sS[m * 1024 + k0 + u] * w[u];
    }
#pragma unroll
    for (int m = 0; m < 9; ++m) red[(kp * 9 + m) * 64 + cj] = a[m];
    __syncthreads();
    for (int idx = tid; idx < 576; idx += 512) {
      int m = idx >> 6, c2 = idx & 63;
      float s = 0.f;
      for (int q = 0; q < 8; ++q) s += red[(q * 9 + m) * 64 + c2];
      p.mod[((size_t)l * 9 + m) * 6144 + cgp * 64 + c2] = s + p.b_mod[l * 6144 + cgp * 64 + c2];
    }
    __syncthreads();
  }
}

__device__ void norm_mod(const P& p, int l, const float* g, int off_sh, int off_sc) {
  int tid = threadIdx.x; asm volatile("" : "+v"(tid));
  const int lane = tid & 63, wid = tid >> 6;
  for (int r = blockIdx.x * 8 + wid; r < MTOT; r += gridDim.x * 8) {
    const float* xr = xrow_ptr(p, r);
    const float* md = p.mod + ((size_t)l * 9 + mod_idx(r)) * 6144;
    float4 v[4];
    float ss = 0.f;
#pragma unroll
    for (int i = 0; i < 4; ++i) {
      v[i] = *(const float4*)(xr + i * 256 + lane * 4);
      ss += v[i].x * v[i].x + v[i].y * v[i].y + v[i].z * v[i].z + v[i].w * v[i].w;
    }
    ss = wave_sum(ss);
    const float inv = rsqrtf(ss * (1.f / 1024.f) + EPS);
#pragma unroll
    for (int i = 0; i < 4; ++i) {
      const int k = i * 256 + lane * 4;
      float4 gg = *(const float4*)(g + k);
      float4 sh = *(const float4*)(md + off_sh + k);
      float4 sc = *(const float4*)(md + off_sc + k);
      float o0 = v[i].x * inv * gg.x * (1.f + sc.x) + sh.x;
      float o1 = v[i].y * inv * gg.y * (1.f + sc.y) + sh.y;
      float o2 = v[i].z * inv * gg.z * (1.f + sc.z) + sh.z;
      float o3 = v[i].w * inv * gg.w * (1.f + sc.w) + sh.w;
      uint2 o; o.x = pack2(o0, o1); o.y = pack2(o2, o3);
      *(uint2*)(p.H + (size_t)r * 1024 + k) = o;
    }
  }
}

__device__ void conva_item(const P& p, int l, int item) {
  int tid = threadIdx.x; asm volatile("" : "+v"(tid));
  const u16* Zb1 = p.R1;
  const float* cw = p.conv_a_w + (size_t)l * 3 * 512;
  for (int e = 0; e < 32; ++e) {
    int idx = tid + e * 512, rr = idx >> 6, cgp = idx & 63;
    int r = item * 256 + rr;
    int b = r / ST, t = r - b * ST;
    int isctx = t >= SL, pos = isctx ? t - SL : t, seglen = isctx ? SC : SL;
    float acc[8];
#pragma unroll
    for (int i = 0; i < 8; ++i) acc[i] = 0.f;
#pragma unroll
    for (int k = 0; k < 3; ++k) {
      int pos2 = pos - 1 + k;
      if (pos2 >= 0 && pos2 < seglen) {
        size_t r2 = (size_t)(r - 1 + k);
        uint4 vc = *(const uint4*)(Zb1 + r2 * 2560 + 512 + cgp * 8);
        uint4 vx = *(const uint4*)(Zb1 + r2 * 2560 + 1024 + cgp * 8);
        float fc[8], fx[8];
        unpack8(vc, fc); unpack8(vx, fx);
#pragma unroll
        for (int i = 0; i < 8; ++i) acc[i] += cw[k * 512 + cgp * 8 + i] * (fc[i] * fx[i]);
      }
    }
    uint4 vb = *(const uint4*)(Zb1 + (size_t)r * 2560 + cgp * 8);
    float fb[8];
    unpack8(vb, fb);
#pragma unroll
    for (int i = 0; i < 8; ++i) acc[i] *= fb[i];
    *(uint4*)(p.Ycat + (size_t)r * 2048 + cgp * 8) = pack8(acc);
  }
}

__device__ void cmlp_item(const P& p, int l, int item, unsigned char* smem) {
  int tid = threadIdx.x; asm volatile("" : "+v"(tid));
  const int lane = tid & 63, wid = tid >> 6, fr = lane & 15, fq = lane >> 4;
  const int g = item & 3, bj = item >> 2;
  const int rowbase = bj * 128;
  u16* vT = (u16*)smem;
  float* sMu = (float*)(smem + 128 * 136 * 2);
  float* sRs = sMu + 128;
  const u16* Zb1 = p.R1;
  {
    uint4 vv[16];
#pragma unroll
    for (int rr = 0; rr < 16; ++rr) vv[rr] = *(const uint4*)(Zb1 + (size_t)(rowbase + wid * 16 + rr) * 2560 + 2048 + lane * 8);
#pragma unroll
    for (int rr = 0; rr < 16; ++rr) {
      int q = wid * 16 + rr;
      float f[8];
      unpack8(vv[rr], f);
      float s = 0.f;
#pragma unroll
      for (int i = 0; i < 8; ++i) { f[i] = geluf_(f[i]); s += f[i]; }
      s = wave_sum(s);
      float mu = s * (1.f / 512.f);
      float d2 = 0.f;
#pragma unroll
      for (int i = 0; i < 8; ++i) { float d = f[i] - mu; d2 += d * d; }
      d2 = wave_sum(d2);
      if (lane == 0) { sMu[q] = mu; sRs[q] = rsqrtf(d2 * (1.f / 512.f) + EPS); }
    }
  }
  __syncthreads();
  const float* lg = p.cmlp_ln_g + l * 512 + g * 128;
  const float* lb = p.cmlp_ln_b + l * 512 + g * 128;
#pragma unroll
  for (int e = 0; e < 4; ++e) {
    int idx = tid + e * 512, q = idx >> 4, dc = idx & 15;
    uint4 v = *(const uint4*)(Zb1 + (size_t)(rowbase + q) * 2560 + 2048 + g * 128 + dc * 8);
    float f[8];
    unpack8(v, f);
    float mu = sMu[q], rs = sRs[q];
#pragma unroll
    for (int i = 0; i < 8; ++i) {
      float val = (geluf_(f[i]) - mu) * rs * lg[dc * 8 + i] + lb[dc * 8 + i];
      vT[(dc * 8 + i) * 136 + q] = f2bf(val);
    }
  }
  __syncthreads();
  const u16* Ws = p.W + OFF_WS + (size_t)g * 128 * 128;
  f32x4 acc[8];
#pragma unroll
  for (int n = 0; n < 8; ++n) acc[n] = (f32x4){0.f, 0.f, 0.f, 0.f};
#pragma unroll
  for (int ks = 0; ks < 4; ++ks) {
    bf16x8 a = *(const bf16x8*)(Ws + (wid * 16 + fr) * 128 + ks * 32 + fq * 8);
#pragma unroll
    for (int n = 0; n < 8; ++n) {
      bf16x8 bb = *(const bf16x8*)(vT + (n * 16 + fr) * 136 + ks * 32 + fq * 8);
      acc[n] = __builtin_amdgcn_mfma_f32_16x16x32_bf16(bb, a, acc[n], 0, 0, 0);
    }
  }
  {
    const int pp = wid * 16 + fr;
    const size_t r = (size_t)(rowbase + pp);
    const float bsv = p.cmlp_b_s[((size_t)l * 4 + g) * 128 + pp];
    uint2 uu[8];
#pragma unroll
    for (int n = 0; n < 8; ++n) uu[n] = *(const uint2*)(Zb1 + r * 2560 + 1536 + g * 128 + n * 16 + fq * 4);
#pragma unroll
    for (int n = 0; n < 8; ++n) {
      float u0 = __uint_as_float(uu[n].x << 16), u1 = __uint_as_float(uu[n].x & 0xffff0000u);
      float u2 = __uint_as_float(uu[n].y << 16), u3 = __uint_as_float(uu[n].y & 0xffff0000u);
      uint2 ov;
      ov.x = pack2(geluf_(u0) * (acc[n][0] + bsv), geluf_(u1) * (acc[n][1] + bsv));
      ov.y = pack2(geluf_(u2) * (acc[n][2] + bsv), geluf_(u3) * (acc[n][3] + bsv));
      *(uint2*)(p.Ycat + r * 2048 + 1024 + g * 128 + n * 16 + fq * 4) = ov;
    }
  }
  __syncthreads();
}

template <int CTRL, int ROWMASK>
__device__ __forceinline__ float dppf(float old, float src) {
  return __int_as_float(__builtin_amdgcn_update_dpp(__float_as_int(old), __float_as_int(src), CTRL, ROWMASK, 0xf, false));
}
#define LSCAN_STEP(A_, B_, CTRL, RM) do { const float A2_ = dppf<CTRL, RM>(1.f, A_), B2_ = dppf<CTRL, RM>(0.f, B_); B_ = A_ * B2_ + B_; A_ = A_ * A2_; } while (0)
#define LSCAN64(A_, B_) do { LSCAN_STEP(A_, B_, 0x111, 0xf); LSCAN_STEP(A_, B_, 0x112, 0xf); LSCAN_STEP(A_, B_, 0x114, 0xf); LSCAN_STEP(A_, B_, 0x118, 0xf); \
    LSCAN_STEP(A_, B_, 0x142, 0xa); LSCAN_STEP(A_, B_, 0x143, 0xc); } while (0)

template <int PASS>
__device__ void lru_run(const P& p, int l, int it_first, int it_stride, unsigned char* smem) {
  int tid = threadIdx.x; asm volatile("" : "+v"(tid));
  const int lane = tid & 63, wid = tid >> 6, fr = lane & 15, fq = lane >> 4;
  u16* sX = (u16*)smem;
  float* sA = (float*)(smem + 18432);
  float* sB = sA + 64 * 130;
  float* sH = sB + 64 * 130;
  float* sCw = sH + 128 * 65;
  float* sCarry = sCw + 320;
  float* sPar = sCarry + 128;
  u16* sW = (u16*)(sPar + 384);
  const u16* Zb2 = p.R1;
  int cur_h = -1;
  uint4 cv[2][4];
#define LRU_LOADCV(ITEM) do { const int h_ = (ITEM) & 7, bj_ = (ITEM) >> 3; const int b_ = bj_ / 34, j_ = bj_ - b_ * 34; const int ic_ = j_ >= 32; \
    const int p0_ = ic_ ? (j_ - 32) * 128 : j_ * 128, sl_ = ic_ ? SC : SL, rs_ = bj_ * 128 - p0_; \
    _Pragma("unroll") for (int e = 0; e < 2; ++e) { int idx = tid + e * 512, pp = idx >> 3, cgp = idx & 7; \
      _Pragma("unroll") for (int k = 0; k < 4; ++k) { int pos = p0_ + pp - 2 + k; cv[e][k] = make_uint4(0, 0, 0, 0); \
        if (pos >= 0 && pos < sl_) cv[e][k] = *(const uint4*)(Zb2 + (size_t)(rs_ + pos) * 1792 + h_ * 64 + cgp * 8); } } } while (0)
  if (it_first < 2176) LRU_LOADCV(it_first);
  for (int item = it_first; item < 2176; item += it_stride) {
    const int h = item & 7, bj = item >> 3;
    const int b = bj / 34, j = bj - b * 34;
    const int rowbase = bj * 128;
    const int isctx = j >= 32;
    const int ordf = isctx ? j - 32 : j + 2, ordr = 33 - j;
    float cA[16], cB[16];
    uint4 gv[2];
    if (PASS == 3) {
#pragma unroll
      for (int q = 0; q < 16; ++q) {
        const int pi = wid * 16 + q, d = pi >> 6, ch = pi & 63, o = d ? ordr : ordf;
        cA[q] = 1.f; cB[q] = 0.f;
        if (lane < o) { float2 v = p.summ[((size_t)(b * 2 + d) * 512 + h * 64 + ch) * 34 + lane]; cA[q] = v.x; cB[q] = v.y; }
      }
#pragma unroll
      for (int e = 0; e < 2; ++e) {
        int idx = tid + e * 512, pos = idx >> 3, cgp = idx & 7;
        gv[e] = *(const uint4*)(Zb2 + (size_t)(rowbase + pos) * 1792 + 800 + h * 64 + cgp * 8);
      }
    }
    if (h != cur_h) {
      cur_h = h;
      __syncthreads();
      if (tid < 320) {
        int k = tid >> 6, i = tid & 63;
        sCw[tid] = (k < 4) ? p.lru_conv_w[((size_t)l * 4 + k) * 512 + h * 64 + i] : p.lru_conv_b[l * 512 + h * 64 + i];
      }
      if (tid < 128) {
        const int d = tid >> 6, ch = tid & 63;
        const size_t pidx = ((size_t)l * 2 + d) * 512 + h * 64 + ch;
        sPar[tid * 3] = p.lru_b_a[pidx]; sPar[tid * 3 + 1] = p.lru_b_x[pidx];
        sPar[tid * 3 + 2] = 8.f * log1pf(__expf(-p.lru_lam[pidx]));
      }
#pragma unroll
      for (int e = 0; e < 4; ++e) {
        int idx = tid + e * 512, row = idx >> 3, kc = idx & 7;
        const int d = row >> 7, n = row & 127;
        *(uint4*)(sW + row * 72 + kc * 8) = *(const uint4*)(p.W + OFF_WLRU + (size_t)((d * 8 + h) * 128 + n) * 64 + kc * 8);
      }
      __syncthreads();
    }
#pragma unroll
    for (int e = 0; e < 2; ++e) {
      int idx = tid + e * 512, pp = idx >> 3, cgp = idx & 7;
      float a8[8];
#pragma unroll
      for (int i = 0; i < 8; ++i) a8[i] = sCw[256 + cgp * 8 + i];
#pragma unroll
      for (int k = 0; k < 4; ++k) {
        float f[8];
        unpack8(cv[e][k], f);
#pragma unroll
        for (int i = 0; i < 8; ++i) a8[i] += sCw[k * 64 + cgp * 8 + i] * f[i];
      }
      *(uint4*)(sX + pp * 72 + cgp * 8) = pack8(a8);
    }
    if (item + it_stride < 2176) LRU_LOADCV(item + it_stride);
    if (PASS == 3) {
#pragma unroll
      for (int q = 0; q < 16; ++q) LSCAN64(cA[q], cB[q]);
      if (lane == 63) {
#pragma unroll
        for (int q = 0; q < 16; ++q) sCarry[wid * 16 + q] = cB[q];
      }
    }
    __syncthreads();
    for (int d = 0; d < 2; ++d) {
      const u16* Wl = sW + d * 128 * 72;
      f32x4 acc[8];
#pragma unroll
      for (int n = 0; n < 8; ++n) acc[n] = (f32x4){0.f, 0.f, 0.f, 0.f};
      {
        const bf16x8 a0 = *(const bf16x8*)(sX + (wid * 16 + fr) * 72 + fq * 8);
        const bf16x8 a1 = *(const bf16x8*)(sX + (wid * 16 + fr) * 72 + 32 + fq * 8);
#pragma unroll
        for (int n = 0; n < 8; ++n) {
          const bf16x8 b0 = *(const bf16x8*)(Wl + (n * 16 + fr) * 72 + fq * 8);
          const bf16x8 b1 = *(const bf16x8*)(Wl + (n * 16 + fr) * 72 + 32 + fq * 8);
          acc[n] = __builtin_amdgcn_mfma_f32_16x16x32_bf16(a0, b0, acc[n], 0, 0, 0);
          acc[n] = __builtin_amdgcn_mfma_f32_16x16x32_bf16(a1, b1, acc[n], 0, 0, 0);
        }
      }
#pragma unroll
      for (int nt = 0; nt < 4; ++nt) {
        const int ch = nt * 16 + fr;
        const float ba = sPar[(d * 64 + ch) * 3], bx = sPar[(d * 64 + ch) * 3 + 1], sp8 = sPar[(d * 64 + ch) * 3 + 2];
#pragma unroll
        for (int jj = 0; jj < 4; ++jj) {
          const int pos = wid * 16 + fq * 4 + jj;
          const float xl = bf2f(sX[pos * 72 + ch]);
          const float rg = sigmoid_rcp_(acc[nt][jj] + ba), ig = sigmoid_rcp_(acc[nt + 4][jj] + bx);
          const float la = -sp8 * rg;
          const float av = __expf(la);
          const float x2 = 2.f * la;
          const float ser = -x2 * (1.f + x2 * (0.5f + x2 * (0.16666667f + x2 * (0.041666667f + x2 * 0.0083333333f))));
          const float om = (x2 > -0.25f) ? ser : (1.f - av * av);
          const float bb = __builtin_amdgcn_sqrtf(om) * ig * xl;
          const int si = d ? 127 - pos : pos;
          sA[ch * 130 + si] = av;
          sB[ch * 130 + si] = bb;
        }
      }
      __syncthreads();
      {
        float a0[8], b0[8], A[8], B[8];
#pragma unroll
        for (int c = 0; c < 8; ++c) {
          const int ch = wid * 8 + c;
          const float2 va = *(const float2*)(sA + ch * 130 + 2 * lane), vb = *(const float2*)(sB + ch * 130 + 2 * lane);
          a0[c] = va.x; b0[c] = vb.x;
          A[c] = va.x * va.y; B[c] = va.y * vb.x + vb.y;
        }
#pragma unroll
        for (int c = 0; c < 8; ++c) LSCAN64(A[c], B[c]);
#pragma unroll
        for (int c = 0; c < 8; ++c) {
          const int ch = wid * 8 + c;
          if (PASS == 1) {
            if (lane == 63) p.summ[((size_t)(b * 2 + d) * 512 + h * 64 + ch) * 34 + (d ? ordr : ordf)] = make_float2(A[c], B[c]);
          } else {
            const float carry = sCarry[d * 64 + ch];
            const float hincl = A[c] * carry + B[c];
            const float hprev = dppf<0x138, 0xf>(carry, hincl);
            const float heven = a0[c] * hprev + b0[c];
            const int se = 2 * lane, pe = d ? 127 - se : se, po = d ? 126 - se : se + 1;
            if (d == 0) { sH[pe * 65 + ch] = heven; sH[po * 65 + ch] = hincl; }
            else { sH[pe * 65 + ch] += heven; sH[po * 65 + ch] += hincl; }
          }
        }
      }
      __syncthreads();
    }
    if (PASS == 3) {
#pragma unroll
      for (int e = 0; e < 2; ++e) {
        int idx = tid + e * 512, pos = idx >> 3, cgp = idx & 7;
        const size_t r = (size_t)(rowbase + pos);
        float gf[8], y[8];
        unpack8(gv[e], gf);
#pragma unroll
        for (int i = 0; i < 8; ++i) y[i] = geluf_(gf[i]) * sH[pos * 65 + cgp * 8 + i];
        *(uint4*)(p.Ycat + r * 2048 + 512 + h * 64 + cgp * 8) = pack8(y);
      }
      __syncthreads();
    }
  }
}

__device__ void krope_item(const P& p, int item) {
  int tid = threadIdx.x; asm volatile("" : "+v"(tid));
  const u16* Zb2 = p.R1;
#pragma unroll
  for (int e = 0; e < 8; ++e) {
    int idx = tid + e * 512, rr = idx >> 4, pi = idx & 15, axis = pi >> 3, i = pi & 7;
    int r = item * 256 + rr, b = r / ST, t = r - b * ST;
    float x1 = bf2f(Zb2[(size_t)r * 1792 + 768 + axis * 16 + i]);
    float x2 = bf2f(Zb2[(size_t)r * 1792 + 768 + axis * 16 + 8 + i]);
    float o1 = x1, o2 = x2;
    if (t < SL) {
      float cs = p.rope[t * 32 + axis * 16 + i], sn = p.rope[t * 32 + axis * 16 + 8 + i];
      o1 = x1 * cs - x2 * sn;
      o2 = x1 * sn + x2 * cs;
    }
    u16 b1 = f2bf(o1), b2 = f2bf(o2);
#pragma unroll
    for (int h = 0; h < 8; ++h) {
      size_t base = ((size_t)(b * 8 + h) * ST + t) * 96 + 64 + axis * 16 + i;
      p.K[base] = b1;
      p.K[base + 8] = b2;
    }
  }
}

__device__ void attn_item(const P& p, int item, unsigned char* smem) {
  int tid = threadIdx.x; asm volatile("" : "+v"(tid));
  const int lane = tid & 63, wid = tid >> 6, fr = lane & 15, fq = lane >> 4;
  int b, h, t0, kt0, kt1;
  if (item < 1024) { b = item >> 7; h = (item >> 4) & 7; t0 = (item & 15) * 256; kt0 = 0; kt1 = 68; }
  else { int i2 = item - 1024; b = i2 >> 3; h = i2 & 7; t0 = SL; kt0 = 64; kt1 = 68; }
  const u16* Kb = p.K + (size_t)(b * 8 + h) * ST * 96;
  const u16* Vb = p.Vt + (size_t)(b * 8 + h) * 64 * ST;
  const u16* Qb = p.Q + (size_t)(b * 8 + h) * ST * 96;
  constexpr int KS = 104, VS = 136, KSZ = 128 * KS, VSZ = 64 * VS, STG = KSZ + VSZ;
  u16* lds = (u16*)smem;
  bf16x8 qf[2][3];
#pragma unroll
  for (int nq = 0; nq < 2; ++nq)
#pragma unroll
    for (int ks = 0; ks < 3; ++ks)
      qf[nq][ks] = *(const bf16x8*)(Qb + (size_t)(t0 + wid * 32 + nq * 16 + fr) * 96 + ks * 32 + fq * 8);
  if (item < 1024) {
#pragma unroll
    for (int nq = 0; nq < 2; ++nq) {
      const int t = t0 + wid * 32 + nq * 16 + fr;
      const float* rp = p.rope + t * 32 + (fq >> 1) * 16;
      union { bf16x8 v; uint32_t u[4]; } own, oth, res;
      own.v = qf[nq][2];
#pragma unroll
      for (int i = 0; i < 4; ++i) oth.u[i] = __shfl_xor(own.u[i], 16);
      float fo[8], fp[8], fres[8];
      { uint4 t4 = make_uint4(own.u[0], own.u[1], own.u[2], own.u[3]); unpack8(t4, fo); }
      { uint4 t4 = make_uint4(oth.u[0], oth.u[1], oth.u[2], oth.u[3]); unpack8(t4, fp); }
#pragma unroll
      for (int j = 0; j < 8; ++j) {
        float cs = rp[j], sn = rp[8 + j];
        fres[j] = (fq & 1) ? (fp[j] * sn + fo[j] * cs) : (fo[j] * cs - fp[j] * sn);
      }
      uint4 r4 = pack8(fres);
      res.u[0] = r4.x; res.u[1] = r4.y; res.u[2] = r4.z; res.u[3] = r4.w;
      qf[nq][2] = res.v;
    }
  }
  f32x4 o[4][2];
#pragma unroll
  for (int m = 0; m < 4; ++m)
#pragma unroll
    for (int n = 0; n < 2; ++n) o[m][n] = (f32x4){0.f, 0.f, 0.f, 0.f};
  float mrun[2] = {-1e30f, -1e30f}, lrun[2] = {0.f, 0.f};
  const int T0 = kt0 >> 1, T1 = kt1 >> 1;
  uint4 rk0, rk1, rk2, rv0, rv1;
  const int c0_ = tid, c1_ = tid + 512, c2_ = tid + 1024;
  const int kcv0_ = c0_ & 15, kcv1_ = c1_ & 15;
  const int vslot0_ = 32 * (kcv0_ >> 2) + 16 * (kcv0_ & 1) + 4 * ((kcv0_ & 3) >> 1);
  const int vslot1_ = 32 * (kcv1_ >> 2) + 16 * (kcv1_ & 1) + 4 * ((kcv1_ & 3) >> 1);
#define ATT_LD(tt) do { const size_t key0_ = (size_t)(tt) * 128; const u16* kb_ = Kb + key0_ * 96; \
    rk0 = *(const uint4*)(kb_ + (size_t)c0_ * 8); rk1 = *(const uint4*)(kb_ + (size_t)c1_ * 8); rk2 = *(const uint4*)(kb_ + (size_t)c2_ * 8); \
    rv0 = *(const uint4*)(Vb + (size_t)(c0_ >> 4) * ST + key0_ + (c0_ & 15) * 8); \
    rv1 = *(const uint4*)(Vb + (size_t)(c1_ >> 4) * ST + key0_ + (c1_ & 15) * 8); } while (0)
#define ATT_ST(st) do { u16* sk_ = lds + (st) * STG; u16* sv_ = sk_ + KSZ; \
    *(uint4*)(sk_ + (c0_ / 12) * KS + (c0_ % 12) * 8) = rk0; *(uint4*)(sk_ + (c1_ / 12) * KS + (c1_ % 12) * 8) = rk1; *(uint4*)(sk_ + (c2_ / 12) * KS + (c2_ % 12) * 8) = rk2; \
    *(uint2*)(sv_ + (c0_ >> 4) * VS + vslot0_) = make_uint2(rv0.x, rv0.y); *(uint2*)(sv_ + (c0_ >> 4) * VS + vslot0_ + 8) = make_uint2(rv0.z, rv0.w); \
    *(uint2*)(sv_ + (c1_ >> 4) * VS + vslot1_) = make_uint2(rv1.x, rv1.y); *(uint2*)(sv_ + (c1_ >> 4) * VS + vslot1_ + 8) = make_uint2(rv1.z, rv1.w); } while (0)
  ATT_LD(T0); ATT_ST(0);
  __syncthreads();
  for (int kt = T0; kt < T1; ++kt) {
    const bool more = (kt + 1 < T1);
    if (more) ATT_LD(kt + 1);
    const int cur = (kt - T0) & 1;
    const u16* sk = lds + cur * STG;
    const u16* sv = sk + KSZ;
    f32x4 s[8][2];
#pragma unroll
    for (int m = 0; m < 8; ++m)
#pragma unroll
      for (int n = 0; n < 2; ++n) s[m][n] = (f32x4){0.f, 0.f, 0.f, 0.f};
#pragma unroll
    for (int ks = 0; ks < 3; ++ks)
#pragma unroll
      for (int mt = 0; mt < 8; ++mt) {
        bf16x8 kf = *(const bf16x8*)(sk + (mt * 16 + fr) * KS + ks * 32 + fq * 8);
#pragma unroll
        for (int nq = 0; nq < 2; ++nq) s[mt][nq] = __builtin_amdgcn_mfma_f32_16x16x32_bf16(kf, qf[nq][ks], s[mt][nq], 0, 0, 0);
      }
    bf16x8 pb[2][4];
    float mloc[2];
#pragma unroll
    for (int nq = 0; nq < 2; ++nq) {
      float mx = fmaxf(fmaxf(s[0][nq][0], s[0][nq][1]), fmaxf(s[0][nq][2], s[0][nq][3]));
#pragma unroll
      for (int mt = 1; mt < 8; ++mt) mx = fmaxf(fmaxf(mx, s[mt][nq][0]), fmaxf(fmaxf(s[mt][nq][1], s[mt][nq][2]), s[mt][nq][3]));
      mloc[nq] = mx;
    }
    if (__any((mloc[0] > mrun[0] + 8.f) || (mloc[1] > mrun[1] + 8.f))) {
      float m0 = fmaxf(mloc[0], __shfl_xor(mloc[0], 16)), m1 = fmaxf(mloc[1], __shfl_xor(mloc[1], 16));
      m0 = fmaxf(m0, __shfl_xor(m0, 32)); m1 = fmaxf(m1, __shfl_xor(m1, 32));
      const float n0 = fmaxf(mrun[0], m0), n1 = fmaxf(mrun[1], m1);
      const float a0 = __builtin_amdgcn_exp2f(mrun[0] - n0), a1 = __builtin_amdgcn_exp2f(mrun[1] - n1);
      mrun[0] = n0; mrun[1] = n1;
      lrun[0] *= a0; lrun[1] *= a1;
#pragma unroll
      for (int mtv = 0; mtv < 4; ++mtv) {
        o[mtv][0][0] *= a0; o[mtv][0][1] *= a0; o[mtv][0][2] *= a0; o[mtv][0][3] *= a0;
        o[mtv][1][0] *= a1; o[mtv][1][1] *= a1; o[mtv][1][2] *= a1; o[mtv][1][3] *= a1;
      }
    }
#pragma unroll
    for (int nq = 0; nq < 2; ++nq) {
      const float mn = mrun[nq];
      float rs = 0.f;
#pragma unroll
      for (int mt = 0; mt < 8; ++mt)
#pragma unroll
        for (int jj = 0; jj < 4; ++jj) {
          float pv = __builtin_amdgcn_exp2f(s[mt][nq][jj] - mn);
          s[mt][nq][jj] = pv;
          rs += pv;
        }
      lrun[nq] += rs;
#pragma unroll
      for (int sx = 0; sx < 4; ++sx) {
        union { uint4 u; bf16x8 v; } cv;
        cv.u.x = pack2(s[2 * sx][nq][0], s[2 * sx][nq][1]); cv.u.y = pack2(s[2 * sx][nq][2], s[2 * sx][nq][3]);
        cv.u.z = pack2(s[2 * sx + 1][nq][0], s[2 * sx + 1][nq][1]); cv.u.w = pack2(s[2 * sx + 1][nq][2], s[2 * sx + 1][nq][3]);
        pb[nq][sx] = cv.v;
      }
    }
#pragma unroll
    for (int sx = 0; sx < 4; ++sx)
#pragma unroll
      for (int mtv = 0; mtv < 4; ++mtv) {
        const bf16x8 vf = *(const bf16x8*)(sv + (mtv * 16 + fr) * VS + 32 * sx + fq * 8);
#pragma unroll
        for (int nq = 0; nq < 2; ++nq) o[mtv][nq] = __builtin_amdgcn_mfma_f32_16x16x32_bf16(vf, pb[nq][sx], o[mtv][nq], 0, 0, 0);
      }
    if (more) ATT_ST(cur ^ 1);
    __syncthreads();
  }
#undef ATT_LD
#undef ATT_ST
#pragma unroll
  for (int nq = 0; nq < 2; ++nq) {
    float lt = lrun[nq];
    lt += __shfl_xor(lt, 16);
    lt += __shfl_xor(lt, 32);
    float inv = 1.f / lt;
    size_t r = (size_t)b * ST + t0 + wid * 32 + nq * 16 + fr;
#pragma unroll
    for (int mtv = 0; mtv < 4; ++mtv) {
      uint2 ov;
      ov.x = pack2(o[mtv][nq][0] * inv, o[mtv][nq][1] * inv);
      ov.y = pack2(o[mtv][nq][2] * inv, o[mtv][nq][3] * inv);
      *(uint2*)(p.Ycat + r * 2048 + 1536 + h * 64 + mtv * 16 + fq * 4) = ov;
    }
  }
}

#define XB_TMO      128
#define XB_XCNT(j)  (256  + 64 * (j))
#define XB_XSUB(j)  (1280 + 64 * (j))
#define XB_XGEN(j)  (2304 + 64 * (j))
#define XB_TOP      3328
#define XB_TOPGEN   3392
#define XCD_BAR_WORDS 3456
#define XB_SPIN_CAP (1u << 18)
__device__ __forceinline__ unsigned xb_ld(unsigned* p)              { return __hip_atomic_load(p, __ATOMIC_RELAXED, __HIP_MEMORY_SCOPE_AGENT); }
__device__ __forceinline__ unsigned xb_add(unsigned* p, unsigned v) { return __hip_atomic_fetch_add(p, v, __ATOMIC_RELAXED, __HIP_MEMORY_SCOPE_AGENT); }
__device__ __forceinline__ unsigned xb_xcc_id() { return (unsigned)__builtin_amdgcn_s_getreg((3 << 11) | 20) & 0xFu; }
#define XB_SPIN(cond, bar) do { unsigned _sp = 0; while (cond) { __builtin_amdgcn_s_sleep(1); \
    if ((++_sp & 255u) == 0u) { if (xb_ld(&(bar)[XB_TMO])) break; if (_sp > XB_SPIN_CAP) { atomicAdd(&(bar)[XB_TMO], 1u); break; } } } } while (0)
struct XcdBarrier { unsigned* bar; unsigned x; volatile __attribute__((address_space(3))) unsigned* st; };
__device__ __forceinline__ XcdBarrier xcd_barrier_post(unsigned* bar, volatile __attribute__((address_space(3))) unsigned* st) {
  XcdBarrier b; b.bar = bar; b.x = xb_xcc_id(); b.st = st;
  if (threadIdx.x == 0) (void)xb_add(&bar[XB_XCNT(b.x)], 1u);
  return b;
}
__device__ __forceinline__ void xcd_barrier_complete(unsigned* bar, unsigned x, unsigned& nloc, unsigned& nx) {
  const unsigned G = gridDim.x * gridDim.y * gridDim.z;
  unsigned sum, cnt, mine, sp = 0u;
  for (;;) {
    sum = 0u; cnt = 0u; mine = 0u;
#pragma unroll
    for (unsigned j = 0; j < 16; ++j) { const unsigned c = xb_ld(&bar[XB_XCNT(j)]); sum += c; cnt += (c > 0u) ? 1u : 0u; mine = (j == x) ? c : mine; }
    if (sum == G) break;
    __builtin_amdgcn_s_sleep(1);
    if ((++sp & 255u) == 0u) { if (xb_ld(&bar[XB_TMO])) break; if (sp > XB_SPIN_CAP) { atomicAdd(&bar[XB_TMO], 1u); break; } }
  }
  nloc = mine > 0u ? mine : 1u; nx = cnt > 0u ? cnt : 1u;
}
__device__ __forceinline__ void xcd_barrier(const XcdBarrier& b) {
  asm volatile("s_waitcnt vmcnt(0)" ::: "memory");
  __syncthreads();
  if (threadIdx.x == 0) {
    unsigned* bar = b.bar;
    __builtin_amdgcn_s_waitcnt(0);
    unsigned nloc = b.st[0], nx = b.st[1];
    if (nloc == 0u) { xcd_barrier_complete(bar, b.x, nloc, nx); b.st[0] = nloc; b.st[1] = nx; }
    const unsigned old = xb_add(&bar[XB_XSUB(b.x)], 1u);
    const unsigned gen = old / nloc;
    if (old + 1u == (gen + 1u) * nloc) {
      __builtin_amdgcn_fence(__ATOMIC_RELEASE, "agent");
      asm volatile("s_waitcnt vmcnt(0)" ::: "memory");
      const unsigned og = xb_add(&bar[XB_TOP], 1u);
      const unsigned tg = og / nx;
      if (og + 1u == (tg + 1u) * nx) xb_add(&bar[XB_TOPGEN], 1u);
      else XB_SPIN(xb_ld(&bar[XB_TOPGEN]) == tg, bar);
      __builtin_amdgcn_fence(__ATOMIC_ACQUIRE, "agent");
      xb_add(&bar[XB_XGEN(b.x)], 1u);
      asm volatile("s_waitcnt vmcnt(0)" ::: "memory");
    } else {
      XB_SPIN(xb_ld(&bar[XB_XGEN(b.x)]) == gen, bar);
      __builtin_amdgcn_fence(__ATOMIC_ACQUIRE, "agent");
      asm volatile("s_waitcnt vmcnt(0)" ::: "memory");
    }
  }
  __syncthreads();
}

__global__ void __launch_bounds__(NTHR) mega(P p) {
  extern __shared__ __attribute__((aligned(16))) unsigned char smem[];
  __shared__ uint4 xb_words;
  cg::grid_group grid = cg::this_grid();
  if (threadIdx.x == 0) xb_words = make_uint4(0u, 0u, 0u, 0u);
  __syncthreads();
  XcdBarrier xb = xcd_barrier_post(p.bar, (volatile __attribute__((address_space(3))) unsigned*)&xb_words);
  u16* lds = (u16*)smem;
  float* sInv = (float*)(smem + 131072);
  LAS3 unsigned char* lds3 = (LAS3 unsigned char*)smem;
  const int bid = blockIdx.x, nblk = gridDim.x;
  auto nopre = [](int) {};

#ifndef NO_P0
  phase0(p, smem);
#endif
  grid.sync();

#pragma unroll 1
  for (int l = 0; l < 4; ++l) {
    int tid = threadIdx.x; asm volatile("" : "+v"(tid));
    const int lane = tid & 63, wid = tid >> 6, wr = wid >> 1, wc = wid & 1, fr = lane & 15, fq = lane >> 4;
    (void)lane; (void)wid; (void)wr; (void)wc; (void)fr; (void)fq;
#ifndef NO_CW
    convert_weights(p, l, (float*)smem);
#endif
    norm_mod(p, l, p.norm1_g + l * 1024, 0, 1024);
    GSYNC();

    {
      u16* Zb1 = p.R1;
      auto epi = [=](const f32x4(&acc)[2][2][4][2], const g8::Unit& u, int wr, int wc, int fr, int fq, int) {
#pragma unroll
        for (int ai = 0; ai < 2; ++ai)
#pragma unroll
          for (int m = 0; m < 4; ++m) {
            u16* rowp = Zb1 + (size_t)(u.pm * 256 + ai * 128 + wr * 64 + m * 16 + fr) * 2560 + u.pn * 256 + wc * 32 + 8 * fq;
#pragma unroll
            for (int bj = 0; bj < 2; ++bj) {
              uint4 w;
              w.x = g8::cvt_pk_bf16(acc[ai][bj][m][0][0], acc[ai][bj][m][0][1]); w.y = g8::cvt_pk_bf16(acc[ai][bj][m][0][2], acc[ai][bj][m][0][3]);
              w.z = g8::cvt_pk_bf16(acc[ai][bj][m][1][0], acc[ai][bj][m][1][1]); w.w = g8::cvt_pk_bf16(acc[ai][bj][m][1][2], acc[ai][bj][m][1][3]);
              *(uint4*)(rowp + bj * 128) = w;
            }
          }
      };
      g8::Simple S; S.o.init(l == 3 ? 128 : 136, 10, nblk, bid); S.A = p.H; S.Bt = p.W + OFF_WINA; S.lda = 1024; S.K = 1024;
      g8::gemm_phase<true>(lds3, S, epi);
    }
    GSYNC();

    for (int rep = 0; rep < DUP_C1; ++rep)
    for (int it = bid; it < 1088 + 136; it += nblk) {
#ifndef NO_CMLP
      if (it < 1088) cmlp_item(p, l, it, smem);
#endif
#ifndef NO_CONVA
      if (it >= 1088) conva_item(p, l, it - 1088);
#endif
    }
    GSYNC();

    {
      u16* Zb2 = p.R1;
      auto epi = [=](const f32x4(&acc)[2][2][4][2], const g8::Unit& u, int wr, int wc, int fr, int fq, int) {
#pragma unroll
        for (int ai = 0; ai < 2; ++ai)
#pragma unroll
          for (int m = 0; m < 4; ++m) {
            u16* rowp = Zb2 + (size_t)(u.pm * 256 + ai * 128 + wr * 64 + m * 16 + fr) * 1792 + u.pn * 256 + wc * 32 + 8 * fq;
#pragma unroll
            for (int bj = 0; bj < 2; ++bj) {
              uint4 w;
              w.x = g8::cvt_pk_bf16(acc[ai][bj][m][0][0], acc[ai][bj][m][0][1]); w.y = g8::cvt_pk_bf16(acc[ai][bj][m][0][2], acc[ai][bj][m][0][3]);
              w.z = g8::cvt_pk_bf16(acc[ai][bj][m][1][0], acc[ai][bj][m][1][1]); w.w = g8::cvt_pk_bf16(acc[ai][bj][m][1][2], acc[ai][bj][m][1][3]);
              *(uint4*)(rowp + bj * 128) = w;
            }
          }
        const int pn = u.pn;
        if (pn == 2 || pn == 5 || pn == 6) {
          const bool inc0 = (pn != 5) || (wc >= 1);
          const bool inc1 = (pn == 2) || (pn == 5) || (wc == 0);
          float* dst = p.ssq + (size_t)(u.pm * 256 + wr * 64 + fr) * 12 + (pn == 2 ? 0 : (pn == 5 ? 4 : 8)) + wc;
#pragma unroll
          for (int ai = 0; ai < 2; ++ai)
#pragma unroll
            for (int m = 0; m < 4; ++m) {
              float ss = 0.f;
#pragma unroll
              for (int n = 0; n < 2; ++n)
#pragma unroll
                for (int jj = 0; jj < 4; ++jj) {
                  const float v0 = acc[ai][0][m][n][jj], v1 = acc[ai][1][m][n][jj];
                  ss += (inc0 ? v0 * v0 : 0.f) + (inc1 ? v1 * v1 : 0.f);
                }
              ss += __shfl_xor(ss, 16);
              ss += __shfl_xor(ss, 32);
              if (fq == 0) dst[(ai * 128 + m * 16) * 12] = ss;
              asm volatile("" ::: "memory");
            }
        }
      };
      g8::Simple S; S.o.init(136, 7, nblk, bid); S.A = p.H; S.Bt = p.W + OFF_WINB; S.lda = 1024; S.K = 1024;
      g8::gemm_phase<true>(lds3, S, epi);
    }
    GSYNC();

    for (int rep = 0; rep < DUP_C2; ++rep)
    {
      const u16* Zb2 = p.R1;
      for (int r2 = 0; r2 < DUP_LRU1; ++r2) lru_run<1>(p, l, bid, nblk, smem);
      for (int r2 = 0; r2 < DUP_PROJ; ++r2) {
      {
        struct ProjSched {
          g8::Order o; const u16* Zb2; const u16* Wq; const u16* Wkv;
          __device__ bool next(int i, g8::Unit& u) const {
            int pm, pn; if (!o.tile(i, pm, pn)) return false;
            u.pm = pm; u.lda = 1792;
            if (pn < 3) { u.pn = pn; u.aux = 0; u.K = 384; u.A = (const char*)(Zb2 + (size_t)pm * 256 * 1792 + 1312); u.B = (const char*)(Wq + (size_t)pn * 256 * 384); }
            else { u.pn = pn - 3; u.aux = 1; u.K = 256; u.A = (const char*)(Zb2 + (size_t)pm * 256 * 1792 + 512); u.B = (const char*)(Wkv + (size_t)(pn - 3) * 256 * 256); }
            return true;
          }
        };
        ProjSched S; S.o.init(136, 7, nblk, bid); S.Zb2 = Zb2; S.Wq = p.W + OFF_WQUP; S.Wkv = p.W + OFF_WKVUP;
        auto epi = [=](const f32x4(&acc)[2][2][4][2], const g8::Unit& u, int wr, int wc, int fr, int fq, int) {
          const int row0 = u.pm * 256, b = row0 / ST, tb = row0 - b * ST;
          const int kv = u.aux;
          const float* sq = p.ssq + (size_t)row0 * 12;
          const float invn = kv ? (1.f / 256.f) : (1.f / 384.f);
#pragma unroll
          for (int ai = 0; ai < 2; ++ai)
#pragma unroll
            for (int m = 0; m < 4; ++m) {
              const int rl = ai * 128 + wr * 64 + m * 16 + fr;
              const float4 p0 = *(const float4*)(sq + rl * 12), p1 = *(const float4*)(sq + rl * 12 + 4), p2 = *(const float4*)(sq + rl * 12 + 8);
              const float ssum = kv ? ((p0.x + p0.y) + (p0.z + p0.w)) : (((p1.x + p1.y) + (p1.z + p1.w)) + ((p2.x + p2.y) + (p2.z + p2.w)));
              const float inv = rsqrtf(ssum * invn + EPS);
              const int t = tb + rl;
#pragma unroll
              for (int bj = 0; bj < 2; ++bj) {
                const int c8 = u.pn * 256 + bj * 128 + wc * 32 + 8 * fq;
                float v[8];
#pragma unroll
                for (int n = 0; n < 2; ++n)
#pragma unroll
                  for (int jj = 0; jj < 4; ++jj) v[n * 4 + jj] = acc[ai][bj][m][n][jj] * inv;
                if (!kv) {
                  const int head = c8 / 96, d = c8 - head * 96;
                  *(uint4*)(p.Q + ((size_t)(b * 8 + head) * ST + t) * 96 + d) = pack8(v);
                } else {
                  const int head = c8 >> 7, w = c8 & 127;
                  if (wc < 2) {
                    *(uint4*)(p.K + ((size_t)(b * 8 + head) * ST + t) * 96 + w) = pack8(v);
                  } else {
                    u16* vp = p.Vt + ((size_t)(b * 8 + head) * 64 + (w - 64)) * ST + t;
#pragma unroll
                    for (int e = 0; e < 8; ++e) vp[(size_t)e * ST] = f2bf(v[e]);
                  }
                }
              }
              asm volatile("" ::: "memory");
            }
        };
        g8::gemm_phase<true>(lds3, S, epi);
      }
      {
        const int off = 2176;
        int first = bid;
        if (first < off) { int kk = (off - first + nblk - 1) / nblk; first += kk * nblk; }
        for (int it = first; it < off + 136; it += nblk) krope_item(p, it - off);
      }
      }
    }
    GSYNC();

    for (int rep = 0; rep < DUP_ATTN; ++rep)
    {
      int it = bid;
      for (; it < 1088; it += nblk) attn_item(p, it, smem);
      for (int r2 = 0; r2 < DUP_LRU3; ++r2) lru_run<3>(p, l, it - 1088, nblk, smem);
    }
    GSYNC();

    {
      u16* Mg = p.R1;
      const int ntile = 272 * 8;
      int te = threadIdx.x; asm volatile("" : "+v"(te));
      const int lane_e = te & 63, wid_e = te >> 6;
      const int wr = wid_e >> 1, wc = wid_e & 1, fr = lane_e & 15, fq = lane_e >> 4;
      int estr = nblk; asm volatile("" : "+s"(estr));
      const int skipctx = (l == 3);
      for (int id = bid; id < ntile; id += estr) {
        int g = id >> 6, rem = id & 63;
        int ct = rem >> 3, rt = g * 8 + (rem & 7);
        if (skipctx && (rt % 34) >= 32) continue;
        f32x4 mg[2][4];
#pragma unroll
        for (int m = 0; m < 2; ++m)
#pragma unroll
          for (int n = 0; n < 4; ++n) mg[m][n] = (f32x4){0.f, 0.f, 0.f, 0.f};
        for (int nb = 0; nb < 4; ++nb) {
          f32x4 ag[2][4], ay[2][4];
#pragma unroll
          for (int m = 0; m < 2; ++m)
#pragma unroll
            for (int n = 0; n < 4; ++n) { ag[m][n] = (f32x4){0.f, 0.f, 0.f, 0.f}; ay[m][n] = (f32x4){0.f, 0.f, 0.f, 0.f}; }
          gemm_main128(p.H + (size_t)rt * 128 * 1024, 1024, p.W + OFF_WGATE + (size_t)(nb * 1024 + ct * 128) * 1024, 1024, 1024,
                       lds3, ag);
          gemm_main128(p.Ycat + (size_t)rt * 128 * 2048 + nb * 512, 2048, p.W + OFF_WBR + (size_t)(nb * 1024 + ct * 128) * 512, 512,
                       512, lds3, ay);
#pragma unroll
          for (int m = 0; m < 2; ++m)
#pragma unroll
            for (int n = 0; n < 4; ++n)
#pragma unroll
              for (int jj = 0; jj < 4; ++jj) mg[m][n][jj] += sigmoidf_(ag[m][n][jj]) * ay[m][n][jj];
        }
#pragma unroll
        for (int m = 0; m < 2; ++m) {
          u16* dst = Mg + (size_t)(rt * 128 + wr * 32 + m * 16 + fq * 4) * 1024 + ct * 128 + wc * 64 + fr;
#pragma unroll
          for (int n = 0; n < 4; ++n)
#pragma unroll
            for (int jj = 0; jj < 4; ++jj) dst[jj * 1024 + n * 16] = f2bf(mg[m][n][jj]);
          asm volatile("" ::: "memory");
        }
        __syncthreads();
      }
    }
    GSYNC();

    {
      auto epi = [=](const f32x4(&acc)[2][2][4][2], const g8::Unit& u, int wr, int wc, int fr, int fq, int) {
        float* xb = xrow_ptr(p, u.pm * 256);
        const float* gate = p.mod + ((size_t)l * 9 + mod_idx(u.pm * 256)) * 6144 + 2048 + u.pn * 256 + wc * 32 + 4 * fq;
        f32x4 gv[2][2];
#pragma unroll
        for (int bj = 0; bj < 2; ++bj)
#pragma unroll
          for (int n = 0; n < 2; ++n) gv[bj][n] = *(const f32x4*)(gate + bj * 128 + n * 16);
#pragma unroll
        for (int ai = 0; ai < 2; ++ai)
#pragma unroll
          for (int m = 0; m < 4; ++m) {
            float* rowp = xb + (size_t)(ai * 128 + wr * 64 + m * 16 + fr) * DM + u.pn * 256 + wc * 32 + 4 * fq;
#pragma unroll
            for (int bj = 0; bj < 2; ++bj)
#pragma unroll
              for (int n = 0; n < 2; ++n) {
                f32x4 xv = *(const f32x4*)(rowp + bj * 128 + n * 16);
                xv += gv[bj][n] * acc[ai][bj][m][n];
                *(f32x4*)(rowp + bj * 128 + n * 16) = xv;
              }
          }
      };
      g8::Simple S; S.o.init(l == 3 ? 128 : 136, 4, nblk, bid); S.A = p.R1; S.Bt = p.W + OFF_WOUT; S.lda = 1024; S.K = 1024;
      g8::gemm_phase<false>(lds3, S, epi);
    }
    GSYNC();

    norm_mod(p, l, p.norm2_g + l * 1024, 3072, 4096);
    GSYNC();

    {
      u16* U = p.R1;
      auto epi = [=](const f32x4(&acc)[2][2][4][2], const g8::Unit& u, int wr, int wc, int fr, int fq, int) {
#pragma unroll
        for (int ai = 0; ai < 2; ++ai)
#pragma unroll
          for (int m = 0; m < 4; ++m) {
            u16* rowp = U + (size_t)(u.pm * 256 + ai * 128 + wr * 64 + m * 16 + fr) * 2816 + u.pn * 128 + wc * 32 + 8 * fq;
            float v[8];
#pragma unroll
            for (int n = 0; n < 2; ++n)
#pragma unroll
              for (int jj = 0; jj < 4; ++jj) v[n * 4 + jj] = siluf_(acc[ai][0][m][n][jj]) * acc[ai][1][m][n][jj];
            uint4 w;
            w.x = g8::cvt_pk_bf16(v[0], v[1]); w.y = g8::cvt_pk_bf16(v[2], v[3]); w.z = g8::cvt_pk_bf16(v[4], v[5]); w.w = g8::cvt_pk_bf16(v[6], v[7]);
            *(uint4*)rowp = w;
          }
      };
      g8::Simple S; S.o.init(l == 3 ? 128 : 136, 22, nblk, bid); S.A = p.H; S.Bt = p.W + OFF_WFF13; S.lda = 1024; S.K = 1024;
      g8::gemm_phase<true>(lds3, S, epi);
    }
    GSYNC();

    {
      auto epi = [=](const f32x4(&acc)[2][2][4][2], const g8::Unit& u, int wr, int wc, int fr, int fq, int) {
        float* xb = xrow_ptr(p, u.pm * 256);
        const float* gate = p.mod + ((size_t)l * 9 + mod_idx(u.pm * 256)) * 6144 + 5120 + u.pn * 256 + wc * 32 + 4 * fq;
        f32x4 gv[2][2];
#pragma unroll
        for (int bj = 0; bj < 2; ++bj)
#pragma unroll
          for (int n = 0; n < 2; ++n) gv[bj][n] = *(const f32x4*)(gate + bj * 128 + n * 16);
#pragma unroll
        for (int ai = 0; ai < 2; ++ai)
#pragma unroll
          for (int m = 0; m < 4; ++m) {
            float* rowp = xb + (size_t)(ai * 128 + wr * 64 + m * 16 + fr) * DM + u.pn * 256 + wc * 32 + 4 * fq;
#pragma unroll
            for (int bj = 0; bj < 2; ++bj)
#pragma unroll
              for (int n = 0; n < 2; ++n) {
                f32x4 xv = *(const f32x4*)(rowp + bj * 128 + n * 16);
                xv += gv[bj][n] * acc[ai][bj][m][n];
                *(f32x4*)(rowp + bj * 128 + n * 16) = xv;
              }
          }
      };
      g8::Simple S; S.o.init(l == 3 ? 128 : 136, 4, nblk, bid); S.A = p.R1; S.Bt = p.W + OFF_WFF2; S.lda = 2816; S.K = 2816;
      g8::gemm_phase<false>(lds3, S, epi);
    }
    GSYNC();

  }

  const int lane = threadIdx.x & 63, wid = threadIdx.x >> 6;
  for (int r = bid * 8 + wid; r < NB * SL; r += nblk * 8) {
    float* xr = p.out + (size_t)r * DM;
    float4 v[4];
    float ss = 0.f;
#pragma unroll
    for (int i = 0; i < 4; ++i) {
      v[i] = *(const float4*)(xr + i * 256 + lane * 4);
      ss += v[i].x * v[i].x + v[i].y * v[i].y + v[i].z * v[i].z + v[i].w * v[i].w;
    }
    ss = wave_sum(ss);
    const float inv = rsqrtf(ss * (1.f / 1024.f) + EPS);
#pragma unroll
    for (int i = 0; i < 4; ++i) {
      float4 gg = *(const float4*)(p.final_g + i * 256 + lane * 4);
      float4 ov;
      ov.x = v[i].x * inv * gg.x; ov.y = v[i].y * inv * gg.y; ov.z = v[i].z * inv * gg.z; ov.w = v[i].w * inv * gg.w;
      *(float4*)(xr + i * 256 + lane * 4) = ov;
    }
  }
}

extern "C" void kernel_launch(void* const* d_in, const int* in_sizes, int n_in, void* d_out, int out_size, void* d_ws,
                              size_t ws_size, hipStream_t stream) {
  static int grid_blocks = 0;
  if (!grid_blocks) {
    int dev = 0, cus = 0, per_cu = 0;
    hipGetDevice(&dev);
    hipDeviceGetAttribute(&cus, hipDeviceAttributeMultiprocessorCount, dev);
    hipFuncSetAttribute((const void*)mega, hipFuncAttributeMaxDynamicSharedMemorySize, LDS_BYTES);
    hipOccupancyMaxActiveBlocksPerMultiprocessor(&per_cu, (const void*)mega, NTHR, LDS_BYTES);
    if (per_cu < 1) per_cu = 1;
    if (per_cu > 1) per_cu = 1;
    grid_blocks = cus * per_cu;
    (void)hipGetLastError();
  }
  P p{};
  const float** pf = (const float**)&p;
  for (int i = 0; i < 31; ++i) pf[i] = (const float*)d_in[i];
  p.out = (float*)d_out;
  size_t off = 0;
  auto take = [&](size_t bytes) { void* r = (char*)d_ws + off; off += (bytes + 255) & ~(size_t)255; return r; };
  p.Xc = (float*)take((size_t)NB * SC * DM * 4);
  p.mod = (float*)take((size_t)4 * 9 * 6144 * 4);
  p.rope = (float*)take((size_t)SL * 32 * 4);
  p.summ = (float2*)take((size_t)NB * 2 * 512 * 34 * 8);
  p.ssq = (float*)take((size_t)12 * MTOT * 4);
  p.bar = (unsigned*)take((size_t)XCD_BAR_WORDS * 4);
  p.W = (u16*)take((size_t)W_ELEMS * 2);
  p.H = (u16*)take((size_t)MTOT * 1024 * 2);
  p.Ycat = (u16*)take((size_t)MTOT * 2048 * 2);
  p.R1 = (u16*)take((size_t)MTOT * 2560 * 2);
  p.K = (u16*)take((size_t)MTOT * 768 * 2);
  p.Vt = (u16*)take((size_t)MTOT * 512 * 2);
  p.Q = p.R1 + (size_t)MTOT * 1792;
  if (off > ws_size) { fprintf(stderr, "workspace too small: need %zu have %zu\n", off, ws_size); return; }
  (void)hipMemsetAsync(p.bar, 0, (size_t)XCD_BAR_WORDS * 4, stream);
  void* args[] = {&p};
  hipError_t e = hipLaunchCooperativeKernel((const void*)mega, dim3(grid_blocks), dim3(NTHR), args, LDS_BYTES, stream);
  if (e != hipSuccess) fprintf(stderr, "cooperative launch failed: %s (grid %d)\n", hipGetErrorString(e), grid_blocks);
}
```

```cpp
#include <hip/hip_runtime.h>
#include <hip/hip_bf16.h>
#include <hip/hip_cooperative_groups.h>
#include <cstdio>
#include <cstdint>
namespace cg = cooperative_groups;

typedef unsigned short u16;
using bf16x8 = __attribute__((ext_vector_type(8))) short;
using f32x4 = __attribute__((ext_vector_type(4))) float;
#define LAS3 __attribute__((address_space(3)))

#define NB 8
#define SL 4096
#define SC 256
#define ST 4352
#define MTOT 34816
#define DM 1024
#define NTHR 512
#define EPS 1e-6f
#define LDS_BYTES 159744
#define DUP_ATTN 1
#define DUP_C1 1
#define DUP_C2 1
#define DUP_E 1
#define EXTRA_SYNC 0
#define GSYNC() do { xcd_barrier(xb); for (int q_ = 0; q_ < EXTRA_SYNC; ++q_) xcd_barrier(xb); } while (0)
#define DUP_LRU1 1
#define DUP_LRU3 1
#define DUP_PROJ 1

#define OFF_WINA 0
#define OFF_WINB (OFF_WINA + 2560 * 1024)
#define OFF_WGATE (OFF_WINB + 1792 * 1024)
#define OFF_WBR (OFF_WGATE + 4096 * 1024)
#define OFF_WOUT (OFF_WBR + 4 * 1024 * 512)
#define OFF_WFF13 (OFF_WOUT + 1024 * 1024)
#define OFF_WFF2 (OFF_WFF13 + 5632 * 1024)
#define OFF_WQUP (OFF_WFF2 + 1024 * 2816)
#define OFF_WKVUP (OFF_WQUP + 768 * 384)
#define OFF_WS (OFF_WKVUP + 1024 * 256)
#define OFF_WLRU (OFF_WS + 4 * 128 * 128)
#define W_ELEMS (OFF_WLRU + 2 * 8 * 4 * 32 * 64)

struct P {
  const float *x, *c, *ctx, *c_ctx, *w_mod, *b_mod, *norm1_g, *norm2_g, *w_in, *conv_a_w, *lru_conv_w, *lru_conv_b,
      *lru_w_a, *lru_b_a, *lru_w_x, *lru_b_x, *lru_lam, *cmlp_ln_g, *cmlp_ln_b, *cmlp_w_s, *cmlp_b_s, *q_norm_g,
      *kv_norm_g, *w_q_up, *w_kv_up, *w_branch, *w_out, *w_ff1, *w_ff3, *w_ff2, *final_g;
  float *out, *Xc, *mod, *rope;
  float2* summ;
  float* ssq;
  unsigned* bar;
  u16 *W, *H, *Ycat, *R1, *Q, *K, *Vt;
};

__device__ __forceinline__ uint32_t pack2(float a, float b) { uint32_t r; asm("v_cvt_pk_bf16_f32 %0, %1, %2" : "=v"(r) : "v"(a), "v"(b)); return r; }
__device__ __forceinline__ u16 f2bf(float f) { return (u16)(pack2(f, f) & 0xffffu); }
__device__ __forceinline__ float bf2f(u16 h) { return __uint_as_float(((uint32_t)h) << 16); }
__device__ __forceinline__ float sigmoidf_(float x) { return __builtin_amdgcn_rcpf(1.f + __expf(-x)); }
__device__ __forceinline__ float sigmoid_rcp_(float x) { return __builtin_amdgcn_rcpf(1.f + __expf(-x)); }
__device__ __forceinline__ float siluf_(float x) { return x * __builtin_amdgcn_rcpf(1.f + __expf(-x)); }
__device__ __forceinline__ float geluf_(float x) {
  float u = 0.7978845608028654f * (x + 0.044715f * x * x * x);
  return x * __builtin_amdgcn_rcpf(1.f + __expf(-2.f * u));
}
__device__ __forceinline__ void unpack8(const uint4& v, float* f) {
  f[0] = __uint_as_float(v.x << 16); f[1] = __uint_as_float(v.x & 0xffff0000u);
  f[2] = __uint_as_float(v.y << 16); f[3] = __uint_as_float(v.y & 0xffff0000u);
  f[4] = __uint_as_float(v.z << 16); f[5] = __uint_as_float(v.z & 0xffff0000u);
  f[6] = __uint_as_float(v.w << 16); f[7] = __uint_as_float(v.w & 0xffff0000u);
}
__device__ __forceinline__ uint4 pack8(const float* f) {
  uint4 v; v.x = pack2(f[0], f[1]); v.y = pack2(f[2], f[3]); v.z = pack2(f[4], f[5]); v.w = pack2(f[6], f[7]); return v;
}
template <int CTRL, int ROWMASK>
__device__ __forceinline__ float dpp0f(float src) {
  return __int_as_float(__builtin_amdgcn_update_dpp(0, __float_as_int(src), CTRL, ROWMASK, 0xf, false));
}
__device__ __forceinline__ float wave_sum(float v) {
  v += dpp0f<0x111, 0xf>(v); v += dpp0f<0x112, 0xf>(v); v += dpp0f<0x114, 0xf>(v); v += dpp0f<0x118, 0xf>(v);
  v += dpp0f<0x142, 0xa>(v); v += dpp0f<0x143, 0xc>(v);
  return __int_as_float(__builtin_amdgcn_readlane(__float_as_int(v), 63));
}
__device__ __forceinline__ float* xrow_ptr(const P& p, int r) {
  int b = r / ST, t = r - b * ST;
  return t < SL ? p.out + ((size_t)(b * SL + t)) * DM : p.Xc + ((size_t)(b * SC + t - SL)) * DM;
}
__device__ __forceinline__ int mod_idx(int r) { int b = r / ST, t = r - b * ST; return t < SL ? b : 8; }

template <int MT>
__device__ __forceinline__ void gemm_main(const u16* __restrict__ A, int lda, const u16* __restrict__ B, int ldb, int K,
                                          u16* lds, f32x4 (&acc)[MT][4]) {
  constexpr int BM = MT * 64;
  constexpr int ASZ = BM * 72, BSZ = 128 * 72, STG = ASZ + BSZ;
  int tid = threadIdx.x; asm volatile("" : "+v"(tid));
  const int lane = tid & 63, wid = tid >> 6, wr = wid >> 1, wc = wid & 1, fr = lane & 15, fq = lane >> 4;
  uint4 ra[MT], rb[2];
  const int nk = K >> 6;
  const int crow = tid >> 3, ckc = (tid & 7) * 8;
#pragma unroll
  for (int i = 0; i < MT; ++i) ra[i] = *(const uint4*)(A + (size_t)(crow + i * 64) * lda + ckc);
#pragma unroll
  for (int i = 0; i < 2; ++i) rb[i] = *(const uint4*)(B + (size_t)(crow + i * 64) * ldb + ckc);
  {
    u16* sa = lds; u16* sb = lds + ASZ;
#pragma unroll
    for (int i = 0; i < MT; ++i) *(uint4*)(sa + (crow + i * 64) * 72 + ckc) = ra[i];
#pragma unroll
    for (int i = 0; i < 2; ++i) *(uint4*)(sb + (crow + i * 64) * 72 + ckc) = rb[i];
  }
  __syncthreads();
  for (int kt = 0; kt < nk; ++kt) {
    const bool more = (kt + 1 < nk);
    if (more) {
      const int k0 = (kt + 1) * 64 + ckc;
#pragma unroll
      for (int i = 0; i < MT; ++i) ra[i] = *(const uint4*)(A + (size_t)(crow + i * 64) * lda + k0);
#pragma unroll
      for (int i = 0; i < 2; ++i) rb[i] = *(const uint4*)(B + (size_t)(crow + i * 64) * ldb + k0);
    }
    const u16* sa = lds + (kt & 1) * STG;
    const u16* sb = sa + ASZ;
#pragma unroll
    for (int ks = 0; ks < 2; ++ks) {
      bf16x8 a[MT], b[4];
#pragma unroll
      for (int m = 0; m < MT; ++m) a[m] = *(const bf16x8*)(sa + (wr * MT * 16 + m * 16 + fr) * 72 + ks * 32 + fq * 8);
#pragma unroll
      for (int n = 0; n < 4; ++n) b[n] = *(const bf16x8*)(sb + (wc * 64 + n * 16 + fr) * 72 + ks * 32 + fq * 8);
#pragma unroll
      for (int m = 0; m < MT; ++m)
#pragma unroll
        for (int n = 0; n < 4; ++n) acc[m][n] = __builtin_amdgcn_mfma_f32_16x16x32_bf16(a[m], b[n], acc[m][n], 0, 0, 0);
    }
    if (more) {
      u16* wa = lds + ((kt + 1) & 1) * STG; u16* wb = wa + ASZ;
#pragma unroll
      for (int i = 0; i < MT; ++i) *(uint4*)(wa + (crow + i * 64) * 72 + ckc) = ra[i];
#pragma unroll
      for (int i = 0; i < 2; ++i) *(uint4*)(wb + (crow + i * 64) * 72 + ckc) = rb[i];
    }
    __syncthreads();
  }
}

__device__ __forceinline__ void gemm_main128(const u16* __restrict__ A, int lda, const u16* __restrict__ B, int ldb, int K,
                                             const u16* __restrict__ nA, int nlda, const u16* __restrict__ nB, int nldb, bool has_next, bool primed,
                                             LAS3 unsigned char* lds, f32x4 (&acc)[2][4]) {
  constexpr int OPB = 128 * 256, STGB = 2 * OPB;
  int tid = threadIdx.x; asm volatile("" : "+v"(tid));
  const int lane = tid & 63, wid = __builtin_amdgcn_readfirstlane(tid >> 6), wr = wid >> 1, wc = wid & 1, fr = lane & 15, fq = lane >> 4;
  const int drow = wid * 4 + (lane >> 4), dslot = lane & 15;
  const int gch = (dslot ^ (drow & 15)) * 8;
  const unsigned goffA = (unsigned)(drow * lda + gch), goffB = (unsigned)(drow * ldb + gch);
  const unsigned rstepA = (unsigned)(32 * lda), rstepB = (unsigned)(32 * ldb);
  const int nk = K >> 7;
#define G128_DMA(st, kt) do { const int k0_ = (kt) * 128; \
    _Pragma("unroll") for (int i_ = 0; i_ < 4; ++i_) { \
      __builtin_amdgcn_global_load_lds((const unsigned*)(A + goffA + i_ * rstepA + k0_), (LAS3 unsigned*)(lds + (st) * STGB + (i_ * 8 + wid) * 1024), 16, 0, 0); \
      __builtin_amdgcn_global_load_lds((const unsigned*)(B + goffB + i_ * rstepB + k0_), (LAS3 unsigned*)(lds + (st) * STGB + OPB + (i_ * 8 + wid) * 1024), 16, 0, 0); } } while (0)
#define G128_MMA(st) do { LAS3 const unsigned char* sa = lds + (st) * STGB; LAS3 const unsigned char* sb = sa + OPB; \
    _Pragma("unroll") for (int ks = 0; ks < 4; ++ks) { bf16x8 a[2], b[4]; \
      _Pragma("unroll") for (int m = 0; m < 2; ++m) a[m] = *(LAS3 const bf16x8*)(sa + (wr * 32 + m * 16 + fr) * 256 + (((ks * 4 + fq) ^ fr) * 16)); \
      _Pragma("unroll") for (int n = 0; n < 4; ++n) b[n] = *(LAS3 const bf16x8*)(sb + (wc * 64 + n * 16 + fr) * 256 + (((ks * 4 + fq) ^ fr) * 16)); \
      __builtin_amdgcn_s_setprio(1); \
      _Pragma("unroll") for (int m = 0; m < 2; ++m) _Pragma("unroll") for (int n = 0; n < 4; ++n) \
        acc[m][n] = __builtin_amdgcn_mfma_f32_16x16x32_bf16(a[m], b[n], acc[m][n], 0, 0, 0); \
      __builtin_amdgcn_s_setprio(0); } } while (0)
  if (!primed) {
    G128_DMA(0, 0);
    asm volatile("s_waitcnt vmcnt(0)" ::: "memory");
    __syncthreads();
  }
  for (int kt = 0; kt < nk; ++kt) {
    if (kt + 1 < nk) G128_DMA((kt + 1) & 1, kt + 1);
    else if (has_next) {
      const unsigned ngA = (unsigned)(drow * nlda + gch), ngB = (unsigned)(drow * nldb + gch);
#pragma unroll
      for (int i_ = 0; i_ < 4; ++i_) {
        __builtin_amdgcn_global_load_lds((const unsigned*)(nA + ngA + i_ * 32 * nlda), (LAS3 unsigned*)(lds + (i_ * 8 + wid) * 1024), 16, 0, 0);
        __builtin_amdgcn_global_load_lds((const unsigned*)(nB + ngB + i_ * 32 * nldb), (LAS3 unsigned*)(lds + OPB + (i_ * 8 + wid) * 1024), 16, 0, 0);
      }
    }
    G128_MMA(kt & 1);
    asm volatile("s_waitcnt vmcnt(0)" ::: "memory");
    __syncthreads();
  }
#undef G128_DMA
#undef G128_MMA
}

template <int MT, class Pre, class Epi>
__device__ __forceinline__ void gemm_phase(const u16* A, int lda, const u16* B, int ldb, int K, int nct, u16* lds, Pre pre,
                                           Epi epi, int id0, int idstride, int idoff) {
  constexpr int BM = MT * 64;
  const int nrt = MTOT / BM, ntile = nrt * nct;
  int first = id0;
  if (first < idoff) { int kk = (idoff - first + idstride - 1) / idstride; first += kk * idstride; }
  for (int gid = first; gid < idoff + ntile; gid += idstride) {
    int id = gid - idoff;
    int g = id / (8 * nct), rem = id - g * 8 * nct;
    int ct = rem >> 3, rt = g * 8 + (rem & 7);
    f32x4 acc[MT][4];
#pragma unroll
    for (int m = 0; m < MT; ++m)
#pragma unroll
      for (int n = 0; n < 4; ++n) acc[m][n] = (f32x4){0.f, 0.f, 0.f, 0.f};
    pre(rt * BM);
    gemm_main<MT>(A + (size_t)rt * BM * lda, lda, B + (size_t)ct * 128 * ldb, ldb, K, lds, acc);
    epi(rt * BM, ct * 128, acc);
    __syncthreads();
  }
}

namespace g8 {
constexpr int BM = 256, BK = 64, HALF = 128, HTB = HALF * BK * 2, STAGE_BYTES = 8 * HTB, NXCD = 8, WGM = 8;
__device__ __forceinline__ int lds_byte(int r, int c) { const int st = (r >> 4) * 2 + (c >> 5), rr = r & 15, cc = c & 31, ob = rr * 64 + cc * 2; return st * 1024 + (ob ^ (((ob >> 9) & 1) << 5)); }
__device__ __forceinline__ void stage_rc(int b, int& R, int& C) { const int st = b / 1024, sb = b % 1024, swz = sb ^ (((sb >> 9) & 1) << 5); R = (st >> 1) * 16 + swz / 64; C = (st & 1) * 32 + (swz % 64) / 2; }
__device__ __forceinline__ int perm32(int rho) { const int n = rho >> 4, i = rho & 15; return 8 * (i >> 2) + 4 * n + (i & 3); }
struct Unit { const char* A; const char* B; int lda, K, pm, pn, aux; };
struct Order {
  int nM, nN, nwg, G, c;
  __device__ void init(int nM_, int nN_, int G_, int c_) { nM = nM_; nN = nN_; nwg = nM * nN; G = G_; c = c_; }
  __device__ bool tile(int i, int& pm, int& pn) const {
    const long L = (long)i * G + c; if (L >= nwg) return false;
    int wgid = (int)L; { const int q = nwg / NXCD, r = nwg % NXCD, xcd = wgid % NXCD, off = wgid / NXCD; wgid = (xcd < r ? xcd * (q + 1) : r * (q + 1) + (xcd - r) * q) + off; }
    const int nig = WGM * nN, gid = wgid / nig, fm = gid * WGM, gsz = (nM - fm) < WGM ? (nM - fm) : WGM;
    pm = fm + ((wgid % nig) % gsz); pn = (wgid % nig) / gsz;
    if (nM == 128) pm += pm >> 4;
    return true;
  }
};
struct Simple {
  Order o; const u16* A; const u16* Bt; int lda, K;
  __device__ bool next(int i, Unit& u) const {
    int pm, pn; if (!o.tile(i, pm, pn)) return false;
    u.A = (const char*)(A + (size_t)pm * 256 * lda); u.B = (const char*)(Bt + (size_t)pn * 256 * K); u.lda = lda; u.K = K; u.pm = pm; u.pn = pn; u.aux = 0; return true;
  }
};
__device__ __forceinline__ unsigned cvt_pk_bf16(float lo, float hi) { unsigned r; asm volatile("v_cvt_pk_bf16_f32 %0, %1, %2" : "=v"(r) : "v"(lo), "v"(hi)); return r; }

template <bool PERM, class Sched, class Epi>
__device__ __forceinline__ void gemm_phase(LAS3 unsigned char* lds, const Sched& S, const Epi& E) {
  int tid = threadIdx.x; asm volatile("" : "+v"(tid));
  const int wid = __builtin_amdgcn_readfirstlane(tid >> 6), lane = tid & 63, wr = wid >> 2, wc = wid & 3, fr = lane & 15, fq = lane >> 4;
  const size_t kstep = (size_t)(BK * 2);
#define G8_VOFF(LDA_, K_) do { int _t2 = tid; asm volatile("" : "+v"(_t2)); _Pragma("unroll") for (int _i = 0; _i < 2; ++_i) { int R, C; stage_rc(_t2 * 16 + _i * 8192, R, C); \
    const int Rb = PERM ? ((R & ~31) + perm32(R & 31)) : R; voffA[_i] = (unsigned)(R * (LDA_) + C) * 2u; voffB[_i] = (unsigned)(Rb * (K_) + C) * 2u; } \
    hstepA = (size_t)HALF * (LDA_) * 2; hstepB = (size_t)HALF * (K_) * 2; } while (0)
  const unsigned ldsw = (unsigned)wid * 1024u;
  const int aoff = lds_byte(wr * 64 + fr, fq * 8), boff = lds_byte(wc * 32 + fr, fq * 8);
#define G8_SA(b, h) (((b) * 2 + (h)) * HTB)
#define G8_SB(b, h) ((4 + (b) * 2 + (h)) * HTB)
#define G8_STAGE(bufoff, gbase, voff) do { _Pragma("unroll") for (int _i = 0; _i < 2; ++_i) \
    __builtin_amdgcn_global_load_lds((const unsigned*)((const char*)(gbase) + (voff)[_i]), (LAS3 unsigned*)(lds + (bufoff) + ldsw + _i * 8192), 16, 0, 0); } while (0)
#define G8_LDA(dst, b, h) do { _Pragma("unroll") for (int m = 0; m < 4; ++m) _Pragma("unroll") for (int k = 0; k < 2; ++k) dst[m][k] = *(const LAS3 bf16x8*)(lds + G8_SA(b, h) + aoff + m * 2048 + k * 1024); } while (0)
#define G8_LDB(dst, b, h) do { _Pragma("unroll") for (int n = 0; n < 2; ++n) _Pragma("unroll") for (int k = 0; k < 2; ++k) dst[n][k] = *(const LAS3 bf16x8*)(lds + G8_SB(b, h) + boff + n * 2048 + k * 1024); } while (0)
#define G8_MMA(ai, bj, At, Bt) do { __builtin_amdgcn_s_setprio(1); _Pragma("unroll") for (int m = 0; m < 4; ++m) _Pragma("unroll") for (int n = 0; n < 2; ++n) _Pragma("unroll") for (int k = 0; k < 2; ++k) \
    acc[ai][bj][m][n] = __builtin_amdgcn_mfma_f32_16x16x32_bf16(Bt[n][k], At[m][k], acc[ai][bj][m][n], 0, 0, 0); __builtin_amdgcn_s_setprio(0); } while (0)
#define G8_WAIT_V(n) asm volatile("s_waitcnt vmcnt(" #n ")" ::: "memory")
#define G8_WAIT_L(n) asm volatile("s_waitcnt lgkmcnt(" #n ")" ::: "memory")
#define G8_BAR __builtin_amdgcn_s_barrier()
#define G8_SCHED __builtin_amdgcn_sched_barrier(0)
  Unit cur, nxt; int ui = 0;
  if (!S.next(0, cur)) return;
  f32x4 acc[2][2][4][2];
#pragma unroll
  for (int a = 0; a < 2; ++a)
#pragma unroll
    for (int b = 0; b < 2; ++b)
#pragma unroll
      for (int m = 0; m < 4; ++m)
#pragma unroll
        for (int n = 0; n < 2; ++n) acc[a][b][m][n] = (f32x4){0.f, 0.f, 0.f, 0.f};
  bf16x8 At[4][2], B0[2][2], B1[2][2];
  const char* cA = cur.A; const char* cB = cur.B;
  unsigned voffA[2], voffB[2];
  size_t hstepA, hstepB;
  G8_VOFF(cur.lda, cur.K);
  G8_STAGE(G8_SB(0, 0), cB, voffB); G8_STAGE(G8_SA(0, 0), cA, voffA); G8_STAGE(G8_SB(0, 1), cB + hstepB, voffB); G8_STAGE(G8_SA(0, 1), cA + hstepA, voffA);
  if (wr == 1) G8_BAR;
  G8_WAIT_V(4); G8_BAR;
  G8_STAGE(G8_SB(1, 0), cB + kstep, voffB); G8_STAGE(G8_SA(1, 0), cA + kstep, voffA); G8_STAGE(G8_SB(1, 1), cB + hstepB + kstep, voffB);
  G8_WAIT_V(6); G8_BAR;
  for (;;) {
    const bool has_next = S.next(ui + 1, nxt);
    if (!has_next) nxt = cur;
    const char* nA = nxt.A; const char* nB = nxt.B;
    const int nt = cur.K / BK;
    for (int t = 0; t < nt; t += 2) {
      const bool last = (t == nt - 2);
      const char* a1 = cA + (size_t)(t + 1) * kstep;
      const char* a2 = last ? nA : cA + (size_t)(t + 2) * kstep; const char* b2 = last ? nB : cB + (size_t)(t + 2) * kstep;
      const char* a3 = a2 + kstep; const char* b3 = b2 + kstep;
      G8_LDB(B0, 0, 0); G8_SCHED; G8_LDA(At, 0, 0); G8_STAGE(G8_SA(1, 1), a1 + hstepA, voffA);
      G8_WAIT_L(8); G8_BAR; G8_WAIT_L(0); G8_MMA(0, 0, At, B0); G8_BAR; G8_SCHED;
      if (last) G8_VOFF(nxt.lda, nxt.K);
      G8_LDB(B1, 0, 1); G8_STAGE(G8_SB(0, 0), b2, voffB);
      G8_BAR; G8_WAIT_L(0); G8_MMA(0, 1, At, B1); G8_BAR;
      G8_LDA(At, 0, 1); G8_STAGE(G8_SA(0, 0), a2, voffA);
      G8_BAR; G8_WAIT_L(0); G8_MMA(1, 0, At, B0); G8_BAR; G8_SCHED;
      G8_STAGE(G8_SB(0, 1), b2 + hstepB, voffB);
      G8_WAIT_V(6); G8_BAR; G8_MMA(1, 1, At, B1); G8_BAR;
      G8_LDB(B0, 1, 0); G8_SCHED; G8_LDA(At, 1, 0); G8_STAGE(G8_SA(0, 1), a2 + hstepA, voffA);
      G8_WAIT_L(8); G8_BAR; G8_WAIT_L(0); G8_MMA(0, 0, At, B0); G8_BAR; G8_SCHED;
      G8_LDB(B1, 1, 1); G8_STAGE(G8_SB(1, 0), b3, voffB);
      G8_BAR; G8_WAIT_L(0); G8_MMA(0, 1, At, B1); G8_BAR;
      G8_LDA(At, 1, 1); G8_STAGE(G8_SA(1, 0), a3, voffA);
      G8_BAR; G8_WAIT_L(0); G8_MMA(1, 0, At, B0); G8_BAR; G8_SCHED;
      G8_STAGE(G8_SB(1, 1), b3 + hstepB, voffB);
      G8_WAIT_V(6); G8_BAR; G8_MMA(1, 1, At, B1); G8_BAR;
    }
    E(acc, cur, wr, wc, fr, fq, tid);
    if (!has_next) break;
#pragma unroll
    for (int a = 0; a < 2; ++a)
#pragma unroll
      for (int b = 0; b < 2; ++b)
#pragma unroll
        for (int m = 0; m < 4; ++m)
#pragma unroll
          for (int n = 0; n < 2; ++n) acc[a][b][m][n] = (f32x4){0.f, 0.f, 0.f, 0.f};
    cur = nxt; cA = nA; cB = nB; ++ui;
  }
  G8_WAIT_V(0);
  if (wr == 0) G8_BAR;
  G8_BAR;
#undef G8_VOFF
#undef G8_SA
#undef G8_SB
#undef G8_STAGE
#undef G8_LDA
#undef G8_LDB
#undef G8_MMA
#undef G8_WAIT_V
#undef G8_WAIT_L
#undef G8_BAR
#undef G8_SCHED
}
}

__device__ __forceinline__ void convT_job(const float* src0, const float* src1, int ldsrc, int kind, int off, int nvalid, u16* dst, int K,
                          int Ndst, const float* kscale, float mult, float* lds) {
  int tid = threadIdx.x; asm volatile("" : "+v"(tid));
  const int nkt = K >> 6, nitems = nkt * (Ndst >> 7);
  for (int it = blockIdx.x; it < nitems; it += gridDim.x) {
    const int kt = it % nkt, nt = it / nkt;
    float v[16];
#pragma unroll
    for (int e = 0; e < 16; ++e) {
      int idx = tid + e * 512, i = idx >> 7, j = idx & 127, n = nt * 128 + j, k = kt * 64 + i;
      if (kind == 0) {
        v[e] = (n < nvalid) ? src0[(size_t)k * ldsrc + off + n] : 0.f;
      } else {
        int g = n >> 8, w = n & 255;
        const float* sp = (w < 128) ? src0 : src1;
        v[e] = sp[(size_t)k * ldsrc + g * 128 + (w & 127)];
      }
    }
#pragma unroll
    for (int e = 0; e < 16; ++e) {
      int idx = tid + e * 512, i = idx >> 7, j = idx & 127, k = kt * 64 + i;
      float x = v[e];
      if (kscale) x *= kscale[k];
      lds[j * 65 + i] = x * mult;
    }
    __syncthreads();
#pragma unroll
    for (int e = 0; e < 8; ++e) {
      int idx = tid + e * 512, j = idx >> 5, i2 = (idx & 31) * 2;
      *(uint32_t*)(dst + (size_t)(nt * 128 + j) * K + kt * 64 + i2) = pack2(lds[j * 65 + i2], lds[j * 65 + i2 + 1]);
    }
    __syncthreads();
  }
}

__device__ void convert_weights(const P& p, int l, float* lds) {
  const float* win = p.w_in + (size_t)l * 1024 * 8352;
#pragma unroll 1
  for (int job = 0; job < 12; ++job) {
    const float* s0 = win; const float* s1 = nullptr; const float* ksc = nullptr;
    int ldsrc = 8352, kind = 0, off = 0, nvalid = 0, K = 1024, Ndst = 0; float mult = 1.f; u16* dst = p.W;
    if (job == 0) { off = 1696; nvalid = 2560; dst += OFF_WINA; Ndst = 2560; }
    else if (job == 1) { off = 0; nvalid = 1696; dst += OFF_WINB; Ndst = 1792; }
    else if (job == 2) { off = 4256; nvalid = 4096; dst += OFF_WGATE; Ndst = 4096; }
    else if (job < 7) { const int n = job - 3; s0 = p.w_branch + ((size_t)l * 4 + n) * 512 * 1024; ldsrc = 1024; nvalid = 1024; dst += OFF_WBR + (size_t)n * 1024 * 512; K = 512; Ndst = 1024; }
    else if (job == 7) { s0 = p.w_out + (size_t)l * 1024 * 1024; ldsrc = 1024; nvalid = 1024; dst += OFF_WOUT; Ndst = 1024; }
    else if (job == 8) { s0 = p.w_ff1 + (size_t)l * 1024 * 2816; s1 = p.w_ff3 + (size_t)l * 1024 * 2816; ldsrc = 2816; kind = 1; dst += OFF_WFF13; Ndst = 5632; }
    else if (job == 9) { s0 = p.w_ff2 + (size_t)l * 2816 * 1024; ldsrc = 1024; nvalid = 1024; dst += OFF_WFF2; K = 2816; Ndst = 1024; }
    else if (job == 10) { s0 = p.w_q_up + (size_t)l * 384 * 768; ldsrc = 768; nvalid = 768; dst += OFF_WQUP; K = 384; Ndst = 768; ksc = p.q_norm_g + l * 384; mult = 0.10206207261596575f * 1.4426950408889634f; }
    else { s0 = p.w_kv_up + (size_t)l * 256 * 1024; ldsrc = 1024; nvalid = 1024; dst += OFF_WKVUP; K = 256; Ndst = 1024; ksc = p.kv_norm_g + l * 256; }
    convT_job(s0, s1, ldsrc, kind, off, nvalid, dst, K, Ndst, ksc, mult, lds);
  }
  int tidc = threadIdx.x; asm volatile("" : "+v"(tidc));
  const int gt = blockIdx.x * NTHR + tidc, gs = gridDim.x * NTHR;
  for (int i = gt; i < 4 * 128 * 128; i += gs) p.W[OFF_WS + i] = f2bf(p.cmlp_w_s[(size_t)l * 65536 + i]);
  for (int i = gt; i < 2 * 8 * 128 * 64; i += gs) {
    int k = i & 63, n = (i >> 6) & 127, h = (i >> 13) & 7, d = i >> 16;
    const float* src = (n < 64) ? p.lru_w_a : p.lru_w_x;
    p.W[OFF_WLRU + i] = f2bf(src[((((size_t)l * 2 + d) * 8 + h) * 64 + k) * 64 + (n & 63)]);
  }
}

__device__ void phase0(const P& p, unsigned char* smem) {
  int tid = threadIdx.x; asm volatile("" : "+v"(tid));
  const int gt = blockIdx.x * NTHR + tid, gs = gridDim.x * NTHR;
  {
    const float4* s = (const float4*)p.x; float4* d = (float4*)p.out;
    for (int i = gt; i < NB * SL * DM / 4; i += gs) d[i] = s[i];
    const float4* s2 = (const float4*)p.ctx; float4* d2 = (float4*)p.Xc;
    for (int i = gt; i < NB * SC * DM / 4; i += gs) d2[i] = s2[i];
  }
  for (int idx = gt; idx < SL * 8; idx += gs) {
    int t = idx >> 3, i = idx & 7;
    float inv = exp2f(-(float)i * 0.125f * 13.287712379549449f);
    float ar = (float)(t >> 6) * inv, ac = (float)(t & 63) * inv;
    const float i2pi = 0.15915494309189535f;
    float rr = ar * i2pi; rr -= floorf(rr); rr *= 6.283185307179586f;
    float rc = ac * i2pi; rc -= floorf(rc); rc *= 6.283185307179586f;
    p.rope[t * 32 + i] = __cosf(rr); p.rope[t * 32 + 8 + i] = __sinf(rr);
    p.rope[t * 32 + 16 + i] = __cosf(rc); p.rope[t * 32 + 24 + i] = __sinf(rc);
  }
  float* sS = (float*)smem; float* red = sS + 9 * 1024;
  for (int it = blockIdx.x; it < 4 * 96; it += gridDim.x) {
    const int l = it / 96, cgp = it - l * 96;
    for (int idx = tid; idx < 9216; idx += 512) {
      int m = idx >> 10, k = idx & 1023;
      float v = (m < 8) ? p.c[m * 1024 + k] : p.c_ctx[k];
      sS[idx] = siluf_(v);
    }
    __syncthreads();
    const int cj = tid & 63, kp = tid >> 6, j = cgp * 64 + cj;
    float a[9];
#pragma unroll
    for (int m = 0; m < 9; ++m) a[m] = 0.f;
    for (int k0 = kp * 128; k0 < kp * 128 + 128; k0 += 16) {
      float w[16];
#pragma unroll
      for (int u = 0; u < 16; ++u) w[u] = p.w_mod[((size_t)l * 1024 + k0 + u) * 6144 + j];
#pragma unroll
      for (int u = 0; u < 16; ++u)
#pragma unroll
        for (int m = 0; m < 9; ++m) a[m] += sS[m * 1024 + k0 + u] * w[u];
    }
#pragma unroll
    for (int m = 0; m < 9; ++m) red[(kp * 9 + m) * 64 + cj] = a[m];
    __syncthreads();
    for (int idx = tid; idx < 576; idx += 512) {
      int m = idx >> 6, c2 = idx & 63;
      float s = 0.f;
      for (int q = 0; q < 8; ++q) s += red[(q * 9 + m) * 64 + c2];
      p.mod[((size_t)l * 9 + m) * 6144 + cgp * 64 + c2] = s + p.b_mod[l * 6144 + cgp * 64 + c2];
    }
    __syncthreads();
  }
}

__device__ void norm_mod(const P& p, int l, const float* g, int off_sh, int off_sc) {
  int tid = threadIdx.x; asm volatile("" : "+v"(tid));
  const int lane = tid & 63, wid = tid >> 6;
  for (int r = blockIdx.x * 8 + wid; r < MTOT; r += gridDim.x * 8) {
    const float* xr = xrow_ptr(p, r);
    const float* md = p.mod + ((size_t)l * 9 + mod_idx(r)) * 6144;
    float4 v[4];
    float ss = 0.f;
#pragma unroll
    for (int i = 0; i < 4; ++i) {
      v[i] = *(const float4*)(xr + i * 256 + lane * 4);
      ss += v[i].x * v[i].x + v[i].y * v[i].y + v[i].z * v[i].z + v[i].w * v[i].w;
    }
    ss = wave_sum(ss);
    const float inv = rsqrtf(ss * (1.f / 1024.f) + EPS);
#pragma unroll
    for (int i = 0; i < 4; ++i) {
      const int k = i * 256 + lane * 4;
      float4 gg = *(const float4*)(g + k);
      float4 sh = *(const float4*)(md + off_sh + k);
      float4 sc = *(const float4*)(md + off_sc + k);
      float o0 = v[i].x * inv * gg.x * (1.f + sc.x) + sh.x;
      float o1 = v[i].y * inv * gg.y * (1.f + sc.y) + sh.y;
      float o2 = v[i].z * inv * gg.z * (1.f + sc.z) + sh.z;
      float o3 = v[i].w * inv * gg.w * (1.f + sc.w) + sh.w;
      uint2 o; o.x = pack2(o0, o1); o.y = pack2(o2, o3);
      *(uint2*)(p.H + (size_t)r * 1024 + k) = o;
    }
  }
}

__device__ void conva_item(const P& p, int l, int item) {
  int tid = threadIdx.x; asm volatile("" : "+v"(tid));
  const u16* Zb1 = p.R1;
  const float* cw = p.conv_a_w + (size_t)l * 3 * 512;
  for (int e = 0; e < 32; ++e) {
    int idx = tid + e * 512, rr = idx >> 6, cgp = idx & 63;
    int r = item * 256 + rr;
    int b = r / ST, t = r - b * ST;
    int isctx = t >= SL, pos = isctx ? t - SL : t, seglen = isctx ? SC : SL;
    float acc[8];
#pragma unroll
    for (int i = 0; i < 8; ++i) acc[i] = 0.f;
#pragma unroll
    for (int k = 0; k < 3; ++k) {
      int pos2 = pos - 1 + k;
      if (pos2 >= 0 && pos2 < seglen) {
        size_t r2 = (size_t)(r - 1 + k);
        uint4 vc = *(const uint4*)(Zb1 + r2 * 2560 + 512 + cgp * 8);
        uint4 vx = *(const uint4*)(Zb1 + r2 * 2560 + 1024 + cgp * 8);
        float fc[8], fx[8];
        unpack8(vc, fc); unpack8(vx, fx);
#pragma unroll
        for (int i = 0; i < 8; ++i) acc[i] += cw[k * 512 + cgp * 8 + i] * (fc[i] * fx[i]);
      }
    }
    uint4 vb = *(const uint4*)(Zb1 + (size_t)r * 2560 + cgp * 8);
    float fb[8];
    unpack8(vb, fb);
#pragma unroll
    for (int i = 0; i < 8; ++i) acc[i] *= fb[i];
    *(uint4*)(p.Ycat + (size_t)r * 2048 + cgp * 8) = pack8(acc);
  }
}

__device__ void cmlp_item(const P& p, int l, int item, unsigned char* smem) {
  int tid = threadIdx.x; asm volatile("" : "+v"(tid));
  const int lane = tid & 63, wid = tid >> 6, fr = lane & 15, fq = lane >> 4;
  const int g = item & 3, bj = item >> 2;
  const int rowbase = bj * 128;
  u16* vT = (u16*)smem;
  float* sMu = (float*)(smem + 128 * 136 * 2);
  float* sRs = sMu + 128;
  const u16* Zb1 = p.R1;
  {
    uint4 vv[16];
#pragma unroll
    for (int rr = 0; rr < 16; ++rr) vv[rr] = *(const uint4*)(Zb1 + (size_t)(rowbase + wid * 16 + rr) * 2560 + 2048 + lane * 8);
#pragma unroll
    for (int rr = 0; rr < 16; ++rr) {
      int q = wid * 16 + rr;
      float f[8];
      unpack8(vv[rr], f);
      float s = 0.f;
#pragma unroll
      for (int i = 0; i < 8; ++i) { f[i] = geluf_(f[i]); s += f[i]; }
      s = wave_sum(s);
      float mu = s * (1.f / 512.f);
      float d2 = 0.f;
#pragma unroll
      for (int i = 0; i < 8; ++i) { float d = f[i] - mu; d2 += d * d; }
      d2 = wave_sum(d2);
      if (lane == 0) { sMu[q] = mu; sRs[q] = rsqrtf(d2 * (1.f / 512.f) + EPS); }
    }
  }
  __syncthreads();
  const float* lg = p.cmlp_ln_g + l * 512 + g * 128;
  const float* lb = p.cmlp_ln_b + l * 512 + g * 128;
#pragma unroll
  for (int e = 0; e < 4; ++e) {
    int idx = tid + e * 512, q = idx >> 4, dc = idx & 15;
    uint4 v = *(const uint4*)(Zb1 + (size_t)(rowbase + q) * 2560 + 2048 + g * 128 + dc * 8);
    float f[8];
    unpack8(v, f);
    float mu = sMu[q], rs = sRs[q];
#pragma unroll
    for (int i = 0; i < 8; ++i) {
      float val = (geluf_(f[i]) - mu) * rs * lg[dc * 8 + i] + lb[dc * 8 + i];
      vT[(dc * 8 + i) * 136 + q] = f2bf(val);
    }
  }
  __syncthreads();
  const u16* Ws = p.W + OFF_WS + (size_t)g * 128 * 128;
  f32x4 acc[8];
#pragma unroll
  for (int n = 0; n < 8; ++n) acc[n] = (f32x4){0.f, 0.f, 0.f, 0.f};
#pragma unroll
  for (int ks = 0; ks < 4; ++ks) {
    bf16x8 a = *(const bf16x8*)(Ws + (wid * 16 + fr) * 128 + ks * 32 + fq * 8);
#pragma unroll
    for (int n = 0; n < 8; ++n) {
      bf16x8 bb = *(const bf16x8*)(vT + (n * 16 + fr) * 136 + ks * 32 + fq * 8);
      acc[n] = __builtin_amdgcn_mfma_f32_16x16x32_bf16(bb, a, acc[n], 0, 0, 0);
    }
  }
  {
    const int pp = wid * 16 + fr;
    const size_t r = (size_t)(rowbase + pp);
    const float bsv = p.cmlp_b_s[((size_t)l * 4 + g) * 128 + pp];
    uint2 uu[8];
#pragma unroll
    for (int n = 0; n < 8; ++n) uu[n] = *(const uint2*)(Zb1 + r * 2560 + 1536 + g * 128 + n * 16 + fq * 4);
#pragma unroll
    for (int n = 0; n < 8; ++n) {
      float u0 = __uint_as_float(uu[n].x << 16), u1 = __uint_as_float(uu[n].x & 0xffff0000u);
      float u2 = __uint_as_float(uu[n].y << 16), u3 = __uint_as_float(uu[n].y & 0xffff0000u);
      uint2 ov;
      ov.x = pack2(geluf_(u0) * (acc[n][0] + bsv), geluf_(u1) * (acc[n][1] + bsv));
      ov.y = pack2(geluf_(u2) * (acc[n][2] + bsv), geluf_(u3) * (acc[n][3] + bsv));
      *(uint2*)(p.Ycat + r * 2048 + 1024 + g * 128 + n * 16 + fq * 4) = ov;
    }
  }
  __syncthreads();
}

template <int CTRL, int ROWMASK>
__device__ __forceinline__ float dppf(float old, float src) {
  return __int_as_float(__builtin_amdgcn_update_dpp(__float_as_int(old), __float_as_int(src), CTRL, ROWMASK, 0xf, false));
}
#define LSCAN_STEP(A_, B_, CTRL, RM) do { const float A2_ = dppf<CTRL, RM>(1.f, A_), B2_ = dppf<CTRL, RM>(0.f, B_); B_ = A_ * B2_ + B_; A_ = A_ * A2_; } while (0)
#define LSCAN64(A_, B_) do { LSCAN_STEP(A_, B_, 0x111, 0xf); LSCAN_STEP(A_, B_, 0x112, 0xf); LSCAN_STEP(A_, B_, 0x114, 0xf); LSCAN_STEP(A_, B_, 0x118, 0xf); \
    LSCAN_STEP(A_, B_, 0x142, 0xa); LSCAN_STEP(A_, B_, 0x143, 0xc); } while (0)

template <int PASS>
__device__ void lru_run(const P& p, int l, int it_first, int it_stride, unsigned char* smem) {
  int tid = threadIdx.x; asm volatile("" : "+v"(tid));
  const int lane = tid & 63, wid = tid >> 6, fr = lane & 15, fq = lane >> 4;
  u16* sX = (u16*)smem;
  float* sA = (float*)(smem + 18432);
  float* sB = sA + 64 * 130;
  float* sH = sB + 64 * 130;
  float* sCw = sH + 128 * 65;
  float* sCarry = sCw + 320;
  float* sPar = sCarry + 128;
  u16* sW = (u16*)(sPar + 384);
  const u16* Zb2 = p.R1;
  int cur_h = -1;
  uint4 cv[2][4];
#define LRU_LOADCV(ITEM) do { const int h_ = (ITEM) & 7, bj_ = (ITEM) >> 3; const int b_ = bj_ / 34, j_ = bj_ - b_ * 34; const int ic_ = j_ >= 32; \
    const int p0_ = ic_ ? (j_ - 32) * 128 : j_ * 128, sl_ = ic_ ? SC : SL, rs_ = bj_ * 128 - p0_; \
    _Pragma("unroll") for (int e = 0; e < 2; ++e) { int idx = tid + e * 512, pp = idx >> 3, cgp = idx & 7; \
      _Pragma("unroll") for (int k = 0; k < 4; ++k) { int pos = p0_ + pp - 2 + k; cv[e][k] = make_uint4(0, 0, 0, 0); \
        if (pos >= 0 && pos < sl_) cv[e][k] = *(const uint4*)(Zb2 + (size_t)(rs_ + pos) * 1792 + h_ * 64 + cgp * 8); } } } while (0)
  if (it_first < 2176) LRU_LOADCV(it_first);
  for (int item = it_first; item < 2176; item += it_stride) {
    const int h = item & 7, bj = item >> 3;
    const int b = bj / 34, j = bj - b * 34;
    const int rowbase = bj * 128;
    const int isctx = j >= 32;
    const int ordf = isctx ? j - 32 : j + 2, ordr = 33 - j;
    float cA[16], cB[16];
    uint4 gv[2];
    if (PASS == 3) {
#pragma unroll
      for (int q = 0; q < 16; ++q) {
        const int pi = wid * 16 + q, d = pi >> 6, ch = pi & 63, o = d ? ordr : ordf;
        cA[q] = 1.f; cB[q] = 0.f;
        if (lane < o) { float2 v = p.summ[((size_t)(b * 2 + d) * 512 + h * 64 + ch) * 34 + lane]; cA[q] = v.x; cB[q] = v.y; }
      }
#pragma unroll
      for (int e = 0; e < 2; ++e) {
        int idx = tid + e * 512, pos = idx >> 3, cgp = idx & 7;
        gv[e] = *(const uint4*)(Zb2 + (size_t)(rowbase + pos) * 1792 + 800 + h * 64 + cgp * 8);
      }
    }
    if (h != cur_h) {
      cur_h = h;
      __syncthreads();
      if (tid < 320) {
        int k = tid >> 6, i = tid & 63;
        sCw[tid] = (k < 4) ? p.lru_conv_w[((size_t)l * 4 + k) * 512 + h * 64 + i] : p.lru_conv_b[l * 512 + h * 64 + i];
      }
      if (tid < 128) {
        const int d = tid >> 6, ch = tid & 63;
        const size_t pidx = ((size_t)l * 2 + d) * 512 + h * 64 + ch;
        sPar[tid * 3] = p.lru_b_a[pidx]; sPar[tid * 3 + 1] = p.lru_b_x[pidx];
        sPar[tid * 3 + 2] = 8.f * log1pf(__expf(-p.lru_lam[pidx]));
      }
#pragma unroll
      for (int e = 0; e < 4; ++e) {
        int idx = tid + e * 512, row = idx >> 3, kc = idx & 7;
        const int d = row >> 7, n = row & 127;
        *(uint4*)(sW + row * 72 + kc * 8) = *(const uint4*)(p.W + OFF_WLRU + (size_t)((d * 8 + h) * 128 + n) * 64 + kc * 8);
      }
      __syncthreads();
    }
#pragma unroll
    for (int e = 0; e < 2; ++e) {
      int idx = tid + e * 512, pp = idx >> 3, cgp = idx & 7;
      float a8[8];
#pragma unroll
      for (int i = 0; i < 8; ++i) a8[i] = sCw[256 + cgp * 8 + i];
#pragma unroll
      for (int k = 0; k < 4; ++k) {
        float f[8];
        unpack8(cv[e][k], f);
#pragma unroll
        for (int i = 0; i < 8; ++i) a8[i] += sCw[k * 64 + cgp * 8 + i] * f[i];
      }
      *(uint4*)(sX + pp * 72 + cgp * 8) = pack8(a8);
    }
    if (item + it_stride < 2176) LRU_LOADCV(item + it_stride);
    if (PASS == 3) {
#pragma unroll
      for (int q = 0; q < 16; ++q) LSCAN64(cA[q], cB[q]);
      if (lane == 63) {
#pragma unroll
        for (int q = 0; q < 16; ++q) sCarry[wid * 16 + q] = cB[q];
      }
    }
    __syncthreads();
    for (int d = 0; d < 2; ++d) {
      const u16* Wl = sW + d * 128 * 72;
      f32x4 acc[8];
#pragma unroll
      for (int n = 0; n < 8; ++n) acc[n] = (f32x4){0.f, 0.f, 0.f, 0.f};
      {
        const bf16x8 a0 = *(const bf16x8*)(sX + (wid * 16 + fr) * 72 + fq * 8);
        const bf16x8 a1 = *(const bf16x8*)(sX + (wid * 16 + fr) * 72 + 32 + fq * 8);
#pragma unroll
        for (int n = 0; n < 8; ++n) {
          const bf16x8 b0 = *(const bf16x8*)(Wl + (n * 16 + fr) * 72 + fq * 8);
          const bf16x8 b1 = *(const bf16x8*)(Wl + (n * 16 + fr) * 72 + 32 + fq * 8);
          acc[n] = __builtin_amdgcn_mfma_f32_16x16x32_bf16(a0, b0, acc[n], 0, 0, 0);
          acc[n] = __builtin_amdgcn_mfma_f32_16x16x32_bf16(a1, b1, acc[n], 0, 0, 0);
        }
      }
#pragma unroll
      for (int nt = 0; nt < 4; ++nt) {
        const int ch = nt * 16 + fr;
        const float ba = sPar[(d * 64 + ch) * 3], bx = sPar[(d * 64 + ch) * 3 + 1], sp8 = sPar[(d * 64 + ch) * 3 + 2];
#pragma unroll
        for (int jj = 0; jj < 4; ++jj) {
          const int pos = wid * 16 + fq * 4 + jj;
          const float xl = bf2f(sX[pos * 72 + ch]);
          const float rg = sigmoid_rcp_(acc[nt][jj] + ba), ig = sigmoid_rcp_(acc[nt + 4][jj] + bx);
          const float la = -sp8 * rg;
          const float av = __expf(la);
          const float x2 = 2.f * la;
          const float ser = -x2 * (1.f + x2 * (0.5f + x2 * (0.16666667f + x2 * (0.041666667f + x2 * 0.0083333333f))));
          const float om = (x2 > -0.25f) ? ser : (1.f - av * av);
          const float bb = __builtin_amdgcn_sqrtf(om) * ig * xl;
          const int si = d ? 127 - pos : pos;
          sA[ch * 130 + si] = av;
          sB[ch * 130 + si] = bb;
        }
      }
      __syncthreads();
      {
        float a0[8], b0[8], A[8], B[8];
#pragma unroll
        for (int c = 0; c < 8; ++c) {
          const int ch = wid * 8 + c;
          const float2 va = *(const float2*)(sA + ch * 130 + 2 * lane), vb = *(const float2*)(sB + ch * 130 + 2 * lane);
          a0[c] = va.x; b0[c] = vb.x;
          A[c] = va.x * va.y; B[c] = va.y * vb.x + vb.y;
        }
#pragma unroll
        for (int c = 0; c < 8; ++c) LSCAN64(A[c], B[c]);
#pragma unroll
        for (int c = 0; c < 8; ++c) {
          const int ch = wid * 8 + c;
          if (PASS == 1) {
            if (lane == 63) p.summ[((size_t)(b * 2 + d) * 512 + h * 64 + ch) * 34 + (d ? ordr : ordf)] = make_float2(A[c], B[c]);
          } else {
            const float carry = sCarry[d * 64 + ch];
            const float hincl = A[c] * carry + B[c];
            const float hprev = dppf<0x138, 0xf>(carry, hincl);
            const float heven = a0[c] * hprev + b0[c];
            const int se = 2 * lane, pe = d ? 127 - se : se, po = d ? 126 - se : se + 1;
            if (d == 0) { sH[pe * 65 + ch] = heven; sH[po * 65 + ch] = hincl; }
            else { sH[pe * 65 + ch] += heven; sH[po * 65 + ch] += hincl; }
          }
        }
      }
      __syncthreads();
    }
    if (PASS == 3) {
#pragma unroll
      for (int e = 0; e < 2; ++e) {
        int idx = tid + e * 512, pos = idx >> 3, cgp = idx & 7;
        const size_t r = (size_t)(rowbase + pos);
        float gf[8], y[8];
        unpack8(gv[e], gf);
#pragma unroll
        for (int i = 0; i < 8; ++i) y[i] = geluf_(gf[i]) * sH[pos * 65 + cgp * 8 + i];
        *(uint4*)(p.Ycat + r * 2048 + 512 + h * 64 + cgp * 8) = pack8(y);
      }
      __syncthreads();
    }
  }
}

__device__ void krope_item(const P& p, int item) {
  int tid = threadIdx.x; asm volatile("" : "+v"(tid));
  const u16* Zb2 = p.R1;
#pragma unroll
  for (int e = 0; e < 8; ++e) {
    int idx = tid + e * 512, rr = idx >> 4, pi = idx & 15, axis = pi >> 3, i = pi & 7;
    int r = item * 256 + rr, b = r / ST, t = r - b * ST;
    float x1 = bf2f(Zb2[(size_t)r * 1792 + 768 + axis * 16 + i]);
    float x2 = bf2f(Zb2[(size_t)r * 1792 + 768 + axis * 16 + 8 + i]);
    float o1 = x1, o2 = x2;
    if (t < SL) {
      float cs = p.rope[t * 32 + axis * 16 + i], sn = p.rope[t * 32 + axis * 16 + 8 + i];
      o1 = x1 * cs - x2 * sn;
      o2 = x1 * sn + x2 * cs;
    }
    u16 b1 = f2bf(o1), b2 = f2bf(o2);
#pragma unroll
    for (int h = 0; h < 8; ++h) {
      size_t base = ((size_t)(b * 8 + h) * ST + t) * 96 + 64 + axis * 16 + i;
      p.K[base] = b1;
      p.K[base + 8] = b2;
    }
  }
}

__device__ void attn_item(const P& p, int item, unsigned char* smem) {
  int tid = threadIdx.x; asm volatile("" : "+v"(tid));
  const int lane = tid & 63, wid = tid >> 6, fr = lane & 15, fq = lane >> 4;
  int b, h, t0, kt0, kt1;
  if (item < 1024) { b = item >> 7; h = (item >> 4) & 7; t0 = (item & 15) * 256; kt0 = 0; kt1 = 68; }
  else { int i2 = item - 1024; b = i2 >> 3; h = i2 & 7; t0 = SL; kt0 = 64; kt1 = 68; }
  const u16* Kb = p.K + (size_t)(b * 8 + h) * ST * 96;
  const u16* Vb = p.Vt + (size_t)(b * 8 + h) * 64 * ST;
  const u16* Qb = p.Q + (size_t)(b * 8 + h) * ST * 96;
  constexpr int KS = 104, VS = 136, KSZ = 128 * KS, VSZ = 64 * VS, STG = KSZ + VSZ;
  u16* lds = (u16*)smem;
  bf16x8 qf[2][3];
#pragma unroll
  for (int nq = 0; nq < 2; ++nq)
#pragma unroll
    for (int ks = 0; ks < 3; ++ks)
      qf[nq][ks] = *(const bf16x8*)(Qb + (size_t)(t0 + wid * 32 + nq * 16 + fr) * 96 + ks * 32 + fq * 8);
  if (item < 1024) {
#pragma unroll
    for (int nq = 0; nq < 2; ++nq) {
      const int t = t0 + wid * 32 + nq * 16 + fr;
      const float* rp = p.rope + t * 32 + (fq >> 1) * 16;
      union { bf16x8 v; uint32_t u[4]; } own, oth, res;
      own.v = qf[nq][2];
#pragma unroll
      for (int i = 0; i < 4; ++i) oth.u[i] = __shfl_xor(own.u[i], 16);
      float fo[8], fp[8], fres[8];
      { uint4 t4 = make_uint4(own.u[0], own.u[1], own.u[2], own.u[3]); unpack8(t4, fo); }
      { uint4 t4 = make_uint4(oth.u[0], oth.u[1], oth.u[2], oth.u[3]); unpack8(t4, fp); }
#pragma unroll
      for (int j = 0; j < 8; ++j) {
        float cs = rp[j], sn = rp[8 + j];
        fres[j] = (fq & 1) ? (fp[j] * sn + fo[j] * cs) : (fo[j] * cs - fp[j] * sn);
      }
      uint4 r4 = pack8(fres);
      res.u[0] = r4.x; res.u[1] = r4.y; res.u[2] = r4.z; res.u[3] = r4.w;
      qf[nq][2] = res.v;
    }
  }
  f32x4 o[4][2];
#pragma unroll
  for (int m = 0; m < 4; ++m)
#pragma unroll
    for (int n = 0; n < 2; ++n) o[m][n] = (f32x4){0.f, 0.f, 0.f, 0.f};
  float mrun[2] = {-1e30f, -1e30f}, lrun[2] = {0.f, 0.f};
  const int T0 = kt0 >> 1, T1 = kt1 >> 1;
  uint4 rk0, rk1, rk2, rv0, rv1;
  const int c0_ = tid, c1_ = tid + 512, c2_ = tid + 1024;
  const int kcv0_ = c0_ & 15, kcv1_ = c1_ & 15;
  const int vslot0_ = 32 * (kcv0_ >> 2) + 16 * (kcv0_ & 1) + 4 * ((kcv0_ & 3) >> 1);
  const int vslot1_ = 32 * (kcv1_ >> 2) + 16 * (kcv1_ & 1) + 4 * ((kcv1_ & 3) >> 1);
#define ATT_LD(tt) do { const size_t key0_ = (size_t)(tt) * 128; const u16* kb_ = Kb + key0_ * 96; \
    rk0 = *(const uint4*)(kb_ + (size_t)c0_ * 8); rk1 = *(const uint4*)(kb_ + (size_t)c1_ * 8); rk2 = *(const uint4*)(kb_ + (size_t)c2_ * 8); \
    rv0 = *(const uint4*)(Vb + (size_t)(c0_ >> 4) * ST + key0_ + (c0_ & 15) * 8); \
    rv1 = *(const uint4*)(Vb + (size_t)(c1_ >> 4) * ST + key0_ + (c1_ & 15) * 8); } while (0)
#define ATT_ST(st) do { u16* sk_ = lds + (st) * STG; u16* sv_ = sk_ + KSZ; \
    *(uint4*)(sk_ + (c0_ / 12) * KS + (c0_ % 12) * 8) = rk0; *(uint4*)(sk_ + (c1_ / 12) * KS + (c1_ % 12) * 8) = rk1; *(uint4*)(sk_ + (c2_ / 12) * KS + (c2_ % 12) * 8) = rk2; \
    *(uint2*)(sv_ + (c0_ >> 4) * VS + vslot0_) = make_uint2(rv0.x, rv0.y); *(uint2*)(sv_ + (c0_ >> 4) * VS + vslot0_ + 8) = make_uint2(rv0.z, rv0.w); \
    *(uint2*)(sv_ + (c1_ >> 4) * VS + vslot1_) = make_uint2(rv1.x, rv1.y); *(uint2*)(sv_ + (c1_ >> 4) * VS + vslot1_ + 8) = make_uint2(rv1.z, rv1.w); } while (0)
  ATT_LD(T0); ATT_ST(0);
  __syncthreads();
  for (int kt = T0; kt < T1; ++kt) {
    const bool more = (kt + 1 < T1);
    if (more) ATT_LD(kt + 1);
    const int cur = (kt - T0) & 1;
    const u16* sk = lds + cur * STG;
    const u16* sv = sk + KSZ;
    f32x4 s[8][2];
#pragma unroll
    for (int m = 0; m < 8; ++m)
#pragma unroll
      for (int n = 0; n < 2; ++n) s[m][n] = (f32x4){0.f, 0.f, 0.f, 0.f};
#pragma unroll
    for (int ks = 0; ks < 3; ++ks)
#pragma unroll
      for (int mt = 0; mt < 8; ++mt) {
        bf16x8 kf = *(const bf16x8*)(sk + (mt * 16 + fr) * KS + ks * 32 + fq * 8);
#pragma unroll
        for (int nq = 0; nq < 2; ++nq) s[mt][nq] = __builtin_amdgcn_mfma_f32_16x16x32_bf16(kf, qf[nq][ks], s[mt][nq], 0, 0, 0);
      }
    bf16x8 pb[2][4];
    float mloc[2];
#pragma unroll
    for (int nq = 0; nq < 2; ++nq) {
      float mx = fmaxf(fmaxf(s[0][nq][0], s[0][nq][1]), fmaxf(s[0][nq][2], s[0][nq][3]));
#pragma unroll
      for (int mt = 1; mt < 8; ++mt) mx = fmaxf(fmaxf(mx, s[mt][nq][0]), fmaxf(fmaxf(s[mt][nq][1], s[mt][nq][2]), s[mt][nq][3]));
      mloc[nq] = mx;
    }
    if (__any((mloc[0] > mrun[0] + 8.f) || (mloc[1] > mrun[1] + 8.f))) {
      float m0 = fmaxf(mloc[0], __shfl_xor(mloc[0], 16)), m1 = fmaxf(mloc[1], __shfl_xor(mloc[1], 16));
      m0 = fmaxf(m0, __shfl_xor(m0, 32)); m1 = fmaxf(m1, __shfl_xor(m1, 32));
      const float n0 = fmaxf(mrun[0], m0), n1 = fmaxf(mrun[1], m1);
      const float a0 = __builtin_amdgcn_exp2f(mrun[0] - n0), a1 = __builtin_amdgcn_exp2f(mrun[1] - n1);
      mrun[0] = n0; mrun[1] = n1;
      lrun[0] *= a0; lrun[1] *= a1;
#pragma unroll
      for (int mtv = 0; mtv < 4; ++mtv) {
        o[mtv][0][0] *= a0; o[mtv][0][1] *= a0; o[mtv][0][2] *= a0; o[mtv][0][3] *= a0;
        o[mtv][1][0] *= a1; o[mtv][1][1] *= a1; o[mtv][1][2] *= a1; o[mtv][1][3] *= a1;
      }
    }
#pragma unroll
    for (int nq = 0; nq < 2; ++nq) {
      const float mn = mrun[nq];
      float rs = 0.f;
#pragma unroll
      for (int mt = 0; mt < 8; ++mt)
#pragma unroll
        for (int jj = 0; jj < 4; ++jj) {
          float pv = __builtin_amdgcn_exp2f(s[mt][nq][jj] - mn);
          s[mt][nq][jj] = pv;
          rs += pv;
        }
      lrun[nq] += rs;
#pragma unroll
      for (int sx = 0; sx < 4; ++sx) {
        union { uint4 u; bf16x8 v; } cv;
        cv.u.x = pack2(s[2 * sx][nq][0], s[2 * sx][nq][1]); cv.u.y = pack2(s[2 * sx][nq][2], s[2 * sx][nq][3]);
        cv.u.z = pack2(s[2 * sx + 1][nq][0], s[2 * sx + 1][nq][1]); cv.u.w = pack2(s[2 * sx + 1][nq][2], s[2 * sx + 1][nq][3]);
        pb[nq][sx] = cv.v;
      }
    }
#pragma unroll
    for (int sx = 0; sx < 4; ++sx)
#pragma unroll
      for (int mtv = 0; mtv < 4; ++mtv) {
        const bf16x8 vf = *(const bf16x8*)(sv + (mtv * 16 + fr) * VS + 32 * sx + fq * 8);
#pragma unroll
        for (int nq = 0; nq < 2; ++nq) o[mtv][nq] = __builtin_amdgcn_mfma_f32_16x16x32_bf16(vf, pb[nq][sx], o[mtv][nq], 0, 0, 0);
      }
    if (more) ATT_ST(cur ^ 1);
    __syncthreads();
  }
#undef ATT_LD
#undef ATT_ST
#pragma unroll
  for (int nq = 0; nq < 2; ++nq) {
    float lt = lrun[nq];
    lt += __shfl_xor(lt, 16);
    lt += __shfl_xor(lt, 32);
    float inv = 1.f / lt;
    size_t r = (size_t)b * ST + t0 + wid * 32 + nq * 16 + fr;
#pragma unroll
    for (int mtv = 0; mtv < 4; ++mtv) {
      uint2 ov;
      ov.x = pack2(o[mtv][nq][0] * inv, o[mtv][nq][1] * inv);
      ov.y = pack2(o[mtv][nq][2] * inv, o[mtv][nq][3] * inv);
      *(uint2*)(p.Ycat + r * 2048 + 1536 + h * 64 + mtv * 16 + fq * 4) = ov;
    }
  }
}

#define XB_TMO      128
#define XB_XCNT(j)  (256  + 64 * (j))
#define XB_XSUB(j)  (1280 + 64 * (j))
#define XB_XGEN(j)  (2304 + 64 * (j))
#define XB_TOP      3328
#define XB_TOPGEN   3392
#define XCD_BAR_WORDS 3456
#define XB_SPIN_CAP (1u << 18)
__device__ __forceinline__ unsigned xb_ld(unsigned* p)              { return __hip_atomic_load(p, __ATOMIC_RELAXED, __HIP_MEMORY_SCOPE_AGENT); }
__device__ __forceinline__ unsigned xb_add(unsigned* p, unsigned v) { return __hip_atomic_fetch_add(p, v, __ATOMIC_RELAXED, __HIP_MEMORY_SCOPE_AGENT); }
__device__ __forceinline__ unsigned xb_xcc_id() { return (unsigned)__builtin_amdgcn_s_getreg((3 << 11) | 20) & 0xFu; }
#define XB_SPIN(cond, bar) do { unsigned _sp = 0; while (cond) { __builtin_amdgcn_s_sleep(1); \
    if ((++_sp & 255u) == 0u) { if (xb_ld(&(bar)[XB_TMO])) break; if (_sp > XB_SPIN_CAP) { atomicAdd(&(bar)[XB_TMO], 1u); break; } } } } while (0)
struct XcdBarrier { unsigned* bar; unsigned x; volatile __attribute__((address_space(3))) unsigned* st; };
__device__ __forceinline__ XcdBarrier xcd_barrier_post(unsigned* bar, volatile __attribute__((address_space(3))) unsigned* st) {
  XcdBarrier b; b.bar = bar; b.x = xb_xcc_id(); b.st = st;
  if (threadIdx.x == 0) (void)xb_add(&bar[XB_XCNT(b.x)], 1u);
  return b;
}
__device__ __forceinline__ void xcd_barrier_complete(unsigned* bar, unsigned x, unsigned& nloc, unsigned& nx) {
  const unsigned G = gridDim.x * gridDim.y * gridDim.z;
  unsigned sum, cnt, mine, sp = 0u;
  for (;;) {
    sum = 0u; cnt = 0u; mine = 0u;
#pragma unroll
    for (unsigned j = 0; j < 16; ++j) { const unsigned c = xb_ld(&bar[XB_XCNT(j)]); sum += c; cnt += (c > 0u) ? 1u : 0u; mine = (j == x) ? c : mine; }
    if (sum == G) break;
    __builtin_amdgcn_s_sleep(1);
    if ((++sp & 255u) == 0u) { if (xb_ld(&bar[XB_TMO])) break; if (sp > XB_SPIN_CAP) { atomicAdd(&bar[XB_TMO], 1u); break; } }
  }
  nloc = mine > 0u ? mine : 1u; nx = cnt > 0u ? cnt : 1u;
}
__device__ __forceinline__ void xcd_barrier(const XcdBarrier& b) {
  asm volatile("s_waitcnt vmcnt(0)" ::: "memory");
  __syncthreads();
  if (threadIdx.x == 0) {
    unsigned* bar = b.bar;
    __builtin_amdgcn_s_waitcnt(0);
    unsigned nloc = b.st[0], nx = b.st[1];
    if (nloc == 0u) { xcd_barrier_complete(bar, b.x, nloc, nx); b.st[0] = nloc; b.st[1] = nx; }
    const unsigned old = xb_add(&bar[XB_XSUB(b.x)], 1u);
    const unsigned gen = old / nloc;
    if (old + 1u == (gen + 1u) * nloc) {
      __builtin_amdgcn_fence(__ATOMIC_RELEASE, "agent");
      asm volatile("s_waitcnt vmcnt(0)" ::: "memory");
      const unsigned og = xb_add(&bar[XB_TOP], 1u);
      const unsigned tg = og / nx;
      if (og + 1u == (tg + 1u) * nx) xb_add(&bar[XB_TOPGEN], 1u);
      else XB_SPIN(xb_ld(&bar[XB_TOPGEN]) == tg, bar);
      __builtin_amdgcn_fence(__ATOMIC_ACQUIRE, "agent");
      xb_add(&bar[XB_XGEN(b.x)], 1u);
      asm volatile("s_waitcnt vmcnt(0)" ::: "memory");
    } else {
      XB_SPIN(xb_ld(&bar[XB_XGEN(b.x)]) == gen, bar);
      __builtin_amdgcn_fence(__ATOMIC_ACQUIRE, "agent");
      asm volatile("s_waitcnt vmcnt(0)" ::: "memory");
    }
  }
  __syncthreads();
}

__global__ void __launch_bounds__(NTHR) mega(P p) {
  extern __shared__ __attribute__((aligned(16))) unsigned char smem[];
  __shared__ uint4 xb_words;
  cg::grid_group grid = cg::this_grid();
  if (threadIdx.x == 0) xb_words = make_uint4(0u, 0u, 0u, 0u);
  __syncthreads();
  XcdBarrier xb = xcd_barrier_post(p.bar, (volatile __attribute__((address_space(3))) unsigned*)&xb_words);
  u16* lds = (u16*)smem;
  float* sInv = (float*)(smem + 131072);
  LAS3 unsigned char* lds3 = (LAS3 unsigned char*)smem;
  const int bid = blockIdx.x, nblk = gridDim.x;
  auto nopre = [](int) {};

#ifndef NO_P0
  phase0(p, smem);
#endif
  grid.sync();

#pragma unroll 1
  for (int l = 0; l < 4; ++l) {
    int tid = threadIdx.x; asm volatile("" : "+v"(tid));
    const int lane = tid & 63, wid = tid >> 6, wr = wid >> 1, wc = wid & 1, fr = lane & 15, fq = lane >> 4;
    (void)lane; (void)wid; (void)wr; (void)wc; (void)fr; (void)fq;
#ifndef NO_CW
    convert_weights(p, l, (float*)smem);
#endif
    norm_mod(p, l, p.norm1_g + l * 1024, 0, 1024);
    GSYNC();

    {
      u16* Zb1 = p.R1;
      auto epi = [=](const f32x4(&acc)[2][2][4][2], const g8::Unit& u, int wr, int wc, int fr, int fq, int) {
#pragma unroll
        for (int ai = 0; ai < 2; ++ai)
#pragma unroll
          for (int m = 0; m < 4; ++m) {
            u16* rowp = Zb1 + (size_t)(u.pm * 256 + ai * 128 + wr * 64 + m * 16 + fr) * 2560 + u.pn * 256 + wc * 32 + 8 * fq;
#pragma unroll
            for (int bj = 0; bj < 2; ++bj) {
              uint4 w;
              w.x = g8::cvt_pk_bf16(acc[ai][bj][m][0][0], acc[ai][bj][m][0][1]); w.y = g8::cvt_pk_bf16(acc[ai][bj][m][0][2], acc[ai][bj][m][0][3]);
              w.z = g8::cvt_pk_bf16(acc[ai][bj][m][1][0], acc[ai][bj][m][1][1]); w.w = g8::cvt_pk_bf16(acc[ai][bj][m][1][2], acc[ai][bj][m][1][3]);
              *(uint4*)(rowp + bj * 128) = w;
            }
          }
      };
      g8::Simple S; S.o.init(l == 3 ? 128 : 136, 10, nblk, bid); S.A = p.H; S.Bt = p.W + OFF_WINA; S.lda = 1024; S.K = 1024;
      g8::gemm_phase<true>(lds3, S, epi);
    }
    GSYNC();

    for (int rep = 0; rep < DUP_C1; ++rep)
    for (int it = bid; it < 1088 + 136; it += nblk) {
#ifndef NO_CMLP
      if (it < 1088) cmlp_item(p, l, it, smem);
#endif
#ifndef NO_CONVA
      if (it >= 1088) conva_item(p, l, it - 1088);
#endif
    }
    GSYNC();

    {
      u16* Zb2 = p.R1;
      auto epi = [=](const f32x4(&acc)[2][2][4][2], const g8::Unit& u, int wr, int wc, int fr, int fq, int) {
#pragma unroll
        for (int ai = 0; ai < 2; ++ai)
#pragma unroll
          for (int m = 0; m < 4; ++m) {
            u16* rowp = Zb2 + (size_t)(u.pm * 256 + ai * 128 + wr * 64 + m * 16 + fr) * 1792 + u.pn * 256 + wc * 32 + 8 * fq;
#pragma unroll
            for (int bj = 0; bj < 2; ++bj) {
              uint4 w;
              w.x = g8::cvt_pk_bf16(acc[ai][bj][m][0][0], acc[ai][bj][m][0][1]); w.y = g8::cvt_pk_bf16(acc[ai][bj][m][0][2], acc[ai][bj][m][0][3]);
              w.z = g8::cvt_pk_bf16(acc[ai][bj][m][1][0], acc[ai][bj][m][1][1]); w.w = g8::cvt_pk_bf16(acc[ai][bj][m][1][2], acc[ai][bj][m][1][3]);
              *(uint4*)(rowp + bj * 128) = w;
            }
          }
        const int pn = u.pn;
        if (pn == 2 || pn == 5 || pn == 6) {
          const bool inc0 = (pn != 5) || (wc >= 1);
          const bool inc1 = (pn == 2) || (pn == 5) || (wc == 0);
          float* dst = p.ssq + (size_t)(u.pm * 256 + wr * 64 + fr) * 12 + (pn == 2 ? 0 : (pn == 5 ? 4 : 8)) + wc;
#pragma unroll
          for (int ai = 0; ai < 2; ++ai)
#pragma unroll
            for (int m = 0; m < 4; ++m) {
              float ss = 0.f;
#pragma unroll
              for (int n = 0; n < 2; ++n)
#pragma unroll
                for (int jj = 0; jj < 4; ++jj) {
                  const float v0 = acc[ai][0][m][n][jj], v1 = acc[ai][1][m][n][jj];
                  ss += (inc0 ? v0 * v0 : 0.f) + (inc1 ? v1 * v1 : 0.f);
                }
              ss += __shfl_xor(ss, 16);
              ss += __shfl_xor(ss, 32);
              if (fq == 0) dst[(ai * 128 + m * 16) * 12] = ss;
              asm volatile("" ::: "memory");
            }
        }
      };
      g8::Simple S; S.o.init(136, 7, nblk, bid); S.A = p.H; S.Bt = p.W + OFF_WINB; S.lda = 1024; S.K = 1024;
      g8::gemm_phase<true>(lds3, S, epi);
    }
    GSYNC();

    for (int rep = 0; rep < DUP_C2; ++rep)
    {
      const u16* Zb2 = p.R1;
      for (int r2 = 0; r2 < DUP_LRU1; ++r2) lru_run<1>(p, l, bid, nblk, smem);
      for (int r2 = 0; r2 < DUP_PROJ; ++r2) {
      {
        struct ProjSched {
          g8::Order o; const u16* Zb2; const u16* Wq; const u16* Wkv;
          __device__ bool next(int i, g8::Unit& u) const {
            int pm, pn; if (!o.tile(i, pm, pn)) return false;
            u.pm = pm; u.lda = 1792;
            if (pn < 3) { u.pn = pn; u.aux = 0; u.K = 384; u.A = (const char*)(Zb2 + (size_t)pm * 256 * 1792 + 1312); u.B = (const char*)(Wq + (size_t)pn * 256 * 384); }
            else { u.pn = pn - 3; u.aux = 1; u.K = 256; u.A = (const char*)(Zb2 + (size_t)pm * 256 * 1792 + 512); u.B = (const char*)(Wkv + (size_t)(pn - 3) * 256 * 256); }
            return true;
          }
        };
        ProjSched S; S.o.init(136, 7, nblk, bid); S.Zb2 = Zb2; S.Wq = p.W + OFF_WQUP; S.Wkv = p.W + OFF_WKVUP;
        auto epi = [=](const f32x4(&acc)[2][2][4][2], const g8::Unit& u, int wr, int wc, int fr, int fq, int) {
          const int row0 = u.pm * 256, b = row0 / ST, tb = row0 - b * ST;
          const int kv = u.aux;
          const float* sq = p.ssq + (size_t)row0 * 12;
          const float invn = kv ? (1.f / 256.f) : (1.f / 384.f);
#pragma unroll
          for (int ai = 0; ai < 2; ++ai)
#pragma unroll
            for (int m = 0; m < 4; ++m) {
              const int rl = ai * 128 + wr * 64 + m * 16 + fr;
              const float4 p0 = *(const float4*)(sq + rl * 12), p1 = *(const float4*)(sq + rl * 12 + 4), p2 = *(const float4*)(sq + rl * 12 + 8);
              const float ssum = kv ? ((p0.x + p0.y) + (p0.z + p0.w)) : (((p1.x + p1.y) + (p1.z + p1.w)) + ((p2.x + p2.y) + (p2.z + p2.w)));
              const float inv = rsqrtf(ssum * invn + EPS);
              const int t = tb + rl;
#pragma unroll
              for (int bj = 0; bj < 2; ++bj) {
                const int c8 = u.pn * 256 + bj * 128 + wc * 32 + 8 * fq;
                float v[8];
#pragma unroll
                for (int n = 0; n < 2; ++n)
#pragma unroll
                  for (int jj = 0; jj < 4; ++jj) v[n * 4 + jj] = acc[ai][bj][m][n][jj] * inv;
                if (!kv) {
                  const int head = c8 / 96, d = c8 - head * 96;
                  *(uint4*)(p.Q + ((size_t)(b * 8 + head) * ST + t) * 96 + d) = pack8(v);
                } else {
                  const int head = c8 >> 7, w = c8 & 127;
                  if (wc < 2) {
                    *(uint4*)(p.K + ((size_t)(b * 8 + head) * ST + t) * 96 + w) = pack8(v);
                  } else {
                    u16* vp = p.Vt + ((size_t)(b * 8 + head) * 64 + (w - 64)) * ST + t;
#pragma unroll
                    for (int e = 0; e < 8; ++e) vp[(size_t)e * ST] = f2bf(v[e]);
                  }
                }
              }
              asm volatile("" ::: "memory");
            }
        };
        g8::gemm_phase<true>(lds3, S, epi);
      }
      {
        const int off = 2176;
        int first = bid;
        if (first < off) { int kk = (off - first + nblk - 1) / nblk; first += kk * nblk; }
        for (int it = first; it < off + 136; it += nblk) krope_item(p, it - off);
      }
      }
    }
    GSYNC();

    for (int rep = 0; rep < DUP_ATTN; ++rep)
    {
      int it = bid;
      for (; it < 1088; it += nblk) attn_item(p, it, smem);
      for (int r2 = 0; r2 < DUP_LRU3; ++r2) lru_run<3>(p, l, it - 1088, nblk, smem);
    }
    GSYNC();

    {
      u16* Mg = p.R1;
      const int ntile = 272 * 8;
      int te = threadIdx.x; asm volatile("" : "+v"(te));
      const int lane_e = te & 63, wid_e = te >> 6;
      const int wr = wid_e >> 1, wc = wid_e & 1, fr = lane_e & 15, fq = lane_e >> 4;
      int estr = nblk; asm volatile("" : "+s"(estr));
      const int skipctx = (l == 3);
      int id = bid;
      while (id < ntile && skipctx && (((id >> 6) * 8 + (id & 7)) % 34) >= 32) id += estr;
      bool primed = false;
      while (id < ntile) {
        const int rt = (id >> 6) * 8 + (id & 7), ct = (id & 63) >> 3;
        int nid = id + estr;
        while (nid < ntile && skipctx && (((nid >> 6) * 8 + (nid & 7)) % 34) >= 32) nid += estr;
        const bool more_tiles = nid < ntile;
        const int nrt = (nid >> 6) * 8 + (nid & 7), nct = (nid & 63) >> 3;
        f32x4 mg[2][4];
#pragma unroll
        for (int m = 0; m < 2; ++m)
#pragma unroll
          for (int n = 0; n < 4; ++n) mg[m][n] = (f32x4){0.f, 0.f, 0.f, 0.f};
        for (int nb = 0; nb < 4; ++nb) {
          f32x4 ag[2][4], ay[2][4];
#pragma unroll
          for (int m = 0; m < 2; ++m)
#pragma unroll
            for (int n = 0; n < 4; ++n) { ag[m][n] = (f32x4){0.f, 0.f, 0.f, 0.f}; ay[m][n] = (f32x4){0.f, 0.f, 0.f, 0.f}; }
          const u16* gA = p.H + (size_t)rt * 128 * 1024;
          const u16* gB = p.W + OFF_WGATE + (size_t)(nb * 1024 + ct * 128) * 1024;
          const u16* bA = p.Ycat + (size_t)rt * 128 * 2048 + nb * 512;
          const u16* bB = p.W + OFF_WBR + (size_t)(nb * 1024 + ct * 128) * 512;
          const bool last_nb = (nb == 3);
          const u16* xA = last_nb ? p.H + (size_t)nrt * 128 * 1024 : gA;
          const u16* xB = last_nb ? p.W + OFF_WGATE + (size_t)(nct * 128) * 1024 : p.W + OFF_WGATE + (size_t)((nb + 1) * 1024 + ct * 128) * 1024;
          gemm_main128(gA, 1024, gB, 1024, 1024, bA, 2048, bB, 512, true, primed, lds3, ag);
          gemm_main128(bA, 2048, bB, 512, 512, xA, 1024, xB, 1024, !last_nb || more_tiles, true, lds3, ay);
          primed = true;
#pragma unroll
          for (int m = 0; m < 2; ++m)
#pragma unroll
            for (int n = 0; n < 4; ++n)
#pragma unroll
              for (int jj = 0; jj < 4; ++jj) mg[m][n][jj] += sigmoidf_(ag[m][n][jj]) * ay[m][n][jj];
        }
#pragma unroll
        for (int m = 0; m < 2; ++m) {
          u16* dst = Mg + (size_t)(rt * 128 + wr * 32 + m * 16 + fq * 4) * 1024 + ct * 128 + wc * 64 + fr;
#pragma unroll
          for (int n = 0; n < 4; ++n)
#pragma unroll
            for (int jj = 0; jj < 4; ++jj) dst[jj * 1024 + n * 16] = f2bf(mg[m][n][jj]);
          asm volatile("" ::: "memory");
        }
        id = nid;
      }
    }
    GSYNC();

    {
      auto epi = [=](const f32x4(&acc)[2][2][4][2], const g8::Unit& u, int wr, int wc, int fr, int fq, int) {
        float* xb = xrow_ptr(p, u.pm * 256);
        const float* gate = p.mod + ((size_t)l * 9 + mod_idx(u.pm * 256)) * 6144 + 2048 + u.pn * 256 + wc * 32 + 4 * fq;
        f32x4 gv[2][2];
#pragma unroll
        for (int bj = 0; bj < 2; ++bj)
#pragma unroll
          for (int n = 0; n < 2; ++n) gv[bj][n] = *(const f32x4*)(gate + bj * 128 + n * 16);
#pragma unroll
        for (int ai = 0; ai < 2; ++ai)
#pragma unroll
          for (int m = 0; m < 4; ++m) {
            float* rowp = xb + (size_t)(ai * 128 + wr * 64 + m * 16 + fr) * DM + u.pn * 256 + wc * 32 + 4 * fq;
#pragma unroll
            for (int bj = 0; bj < 2; ++bj)
#pragma unroll
              for (int n = 0; n < 2; ++n) {
                f32x4 xv = *(const f32x4*)(rowp + bj * 128 + n * 16);
                xv += gv[bj][n] * acc[ai][bj][m][n];
                *(f32x4*)(rowp + bj * 128 + n * 16) = xv;
              }
          }
      };
      g8::Simple S; S.o.init(l == 3 ? 128 : 136, 4, nblk, bid); S.A = p.R1; S.Bt = p.W + OFF_WOUT; S.lda = 1024; S.K = 1024;
      g8::gemm_phase<false>(lds3, S, epi);
    }
    GSYNC();

    norm_mod(p, l, p.norm2_g + l * 1024, 3072, 4096);
    GSYNC();

    {
      u16* U = p.R1;
      auto epi = [=](const f32x4(&acc)[2][2][4][2], const g8::Unit& u, int wr, int wc, int fr, int fq, int) {
#pragma unroll
        for (int ai = 0; ai < 2; ++ai)
#pragma unroll
          for (int m = 0; m < 4; ++m) {
            u16* rowp = U + (size_t)(u.pm * 256 + ai * 128 + wr * 64 + m * 16 + fr) * 2816 + u.pn * 128 + wc * 32 + 8 * fq;
            float v[8];
#pragma unroll
            for (int n = 0; n < 2; ++n)
#pragma unroll
              for (int jj = 0; jj < 4; ++jj) v[n * 4 + jj] = siluf_(acc[ai][0][m][n][jj]) * acc[ai][1][m][n][jj];
            uint4 w;
            w.x = g8::cvt_pk_bf16(v[0], v[1]); w.y = g8::cvt_pk_bf16(v[2], v[3]); w.z = g8::cvt_pk_bf16(v[4], v[5]); w.w = g8::cvt_pk_bf16(v[6], v[7]);
            *(uint4*)rowp = w;
          }
      };
      g8::Simple S; S.o.init(l == 3 ? 128 : 136, 22, nblk, bid); S.A = p.H; S.Bt = p.W + OFF_WFF13; S.lda = 1024; S.K = 1024;
      g8::gemm_phase<true>(lds3, S, epi);
    }
    GSYNC();

    {
      auto epi = [=](const f32x4(&acc)[2][2][4][2], const g8::Unit& u, int wr, int wc, int fr, int fq, int) {
        float* xb = xrow_ptr(p, u.pm * 256);
        const float* gate = p.mod + ((size_t)l * 9 + mod_idx(u.pm * 256)) * 6144 + 5120 + u.pn * 256 + wc * 32 + 4 * fq;
        f32x4 gv[2][2];
#pragma unroll
        for (int bj = 0; bj < 2; ++bj)
#pragma unroll
          for (int n = 0; n < 2; ++n) gv[bj][n] = *(const f32x4*)(gate + bj * 128 + n * 16);
#pragma unroll
        for (int ai = 0; ai < 2; ++ai)
#pragma unroll
          for (int m = 0; m < 4; ++m) {
            float* rowp = xb + (size_t)(ai * 128 + wr * 64 + m * 16 + fr) * DM + u.pn * 256 + wc * 32 + 4 * fq;
#pragma unroll
            for (int bj = 0; bj < 2; ++bj)
#pragma unroll
              for (int n = 0; n < 2; ++n) {
                f32x4 xv = *(const f32x4*)(rowp + bj * 128 + n * 16);
                xv += gv[bj][n] * acc[ai][bj][m][n];
                *(f32x4*)(rowp + bj * 128 + n * 16) = xv;
              }
          }
      };
      g8::Simple S; S.o.init(l == 3 ? 128 : 136, 4, nblk, bid); S.A = p.R1; S.Bt = p.W + OFF_WFF2; S.lda = 2816; S.K = 2816;
      g8::gemm_phase<false>(lds3, S, epi);
    }
    GSYNC();

  }

  const int lane = threadIdx.x & 63, wid = threadIdx.x >> 6;
  for (int r = bid * 8 + wid; r < NB * SL; r += nblk * 8) {
    float* xr = p.out + (size_t)r * DM;
    float4 v[4];
    float ss = 0.f;
#pragma unroll
    for (int i = 0; i < 4; ++i) {
      v[i] = *(const float4*)(xr + i * 256 + lane * 4);
      ss += v[i].x * v[i].x + v[i].y * v[i].y + v[i].z * v[i].z + v[i].w * v[i].w;
    }
    ss = wave_sum(ss);
    const float inv = rsqrtf(ss * (1.f / 1024.f) + EPS);
#pragma unroll
    for (int i = 0; i < 4; ++i) {
      float4 gg = *(const float4*)(p.final_g + i * 256 + lane * 4);
      float4 ov;
      ov.x = v[i].x * inv * gg.x; ov.y = v[i].y * inv * gg.y; ov.z = v[i].z * inv * gg.z; ov.w = v[i].w * inv * gg.w;
      *(float4*)(xr + i * 256 + lane * 4) = ov;
    }
  }
}

extern "C" void kernel_launch(void* const* d_in, const int* in_sizes, int n_in, void* d_out, int out_size, void* d_ws,
                              size_t ws_size, hipStream_t stream) {
  static int grid_blocks = 0;
  if (!grid_blocks) {
    int dev = 0, cus = 0, per_cu = 0;
    hipGetDevice(&dev);
    hipDeviceGetAttribute(&cus, hipDeviceAttributeMultiprocessorCount, dev);
    hipFuncSetAttribute((const void*)mega, hipFuncAttributeMaxDynamicSharedMemorySize, LDS_BYTES);
    hipOccupancyMaxActiveBlocksPerMultiprocessor(&per_cu, (const void*)mega, NTHR, LDS_BYTES);
    if (per_cu < 1) per_cu = 1;
    if (per_cu > 1) per_cu = 1;
    grid_blocks = cus * per_cu;
    (void)hipGetLastError();
  }
  P p{};
  const float** pf = (const float**)&p;
  for (int i = 0; i < 31; ++i) pf[i] = (const float*)d_in[i];
  p.out = (float*)d_out;
  size_t off = 0;
  auto take = [&](size_t bytes) { void* r = (char*)d_ws + off; off += (bytes + 255) & ~(size_t)255; return r; };
  p.Xc = (float*)take((size_t)NB * SC * DM * 4);
  p.mod = (float*)take((size_t)4 * 9 * 6144 * 4);
  p.rope = (float*)take((size_t)SL * 32 * 4);
  p.summ = (float2*)take((size_t)NB * 2 * 512 * 34 * 8);
  p.ssq = (float*)take((size_t)12 * MTOT * 4);
  p.bar = (unsigned*)take((size_t)XCD_BAR_WORDS * 4);
  p.W = (u16*)take((size_t)W_ELEMS * 2);
  p.H = (u16*)take((size_t)MTOT * 1024 * 2);
  p.Ycat = (u16*)take((size_t)MTOT * 2048 * 2);
  p.R1 = (u16*)take((size_t)MTOT * 2560 * 2);
  p.K = (u16*)take((size_t)MTOT * 768 * 2);
  p.Vt = (u16*)take((size_t)MTOT * 512 * 2);
  p.Q = p.R1 + (size_t)MTOT * 1792;
  if (off > ws_size) { fprintf(stderr, "workspace too small: need %zu have %zu\n", off, ws_size); return; }
  (void)hipMemsetAsync(p.bar, 0, (size_t)XCD_BAR_WORDS * 4, stream);
  void* args[] = {&p};
  hipError_t e = hipLaunchCooperativeKernel((const void*)mega, dim3(grid_blocks), dim3(NTHR), args, LDS_BYTES, stream);
  if (e != hipSuccess) fprintf(stderr, "cooperative launch failed: %s (grid %d)\n", hipGetErrorString(e), grid_blocks);
}
```

```cpp
#include <hip/hip_runtime.h>
#include <hip/hip_bf16.h>
#include <hip/hip_cooperative_groups.h>
#include <cstdio>
#include <cstdint>
namespace cg = cooperative_groups;

typedef unsigned short u16;
using bf16x8 = __attribute__((ext_vector_type(8))) short;
using f32x4 = __attribute__((ext_vector_type(4))) float;
#define LAS3 __attribute__((address_space(3)))

#define NB 8
#define SL 4096
#define SC 256
#define ST 4352
#define MTOT 34816
#define DM 1024
#define NTHR 512
#define EPS 1e-6f
#define LDS_BYTES 159744
#define DUP_ATTN 1
#define DUP_C1 1
#define DUP_C2 1
#define DUP_E 1
#define EXTRA_SYNC 0
#define GSYNC() do { xcd_barrier(xb); for (int q_ = 0; q_ < EXTRA_SYNC; ++q_) xcd_barrier(xb); } while (0)
#define DUP_LRU1 1
#define DUP_LRU3 1
#define DUP_PROJ 1

#define OFF_WINA 0
#define OFF_WINB (OFF_WINA + 2560 * 1024)
#define OFF_WGATE (OFF_WINB + 1792 * 1024)
#define OFF_WBR (OFF_WGATE + 4096 * 1024)
#define OFF_WOUT (OFF_WBR + 4 * 1024 * 512)
#define OFF_WFF13 (OFF_WOUT + 1024 * 1024)
#define OFF_WFF2 (OFF_WFF13 + 5632 * 1024)
#define OFF_WQUP (OFF_WFF2 + 1024 * 2816)
#define OFF_WKVUP (OFF_WQUP + 768 * 384)
#define OFF_WS (OFF_WKVUP + 1024 * 256)
#define OFF_WLRU (OFF_WS + 4 * 128 * 128)
#define W_ELEMS (OFF_WLRU + 2 * 8 * 4 * 32 * 64)

struct P {
  const float *x, *c, *ctx, *c_ctx, *w_mod, *b_mod, *norm1_g, *norm2_g, *w_in, *conv_a_w, *lru_conv_w, *lru_conv_b,
      *lru_w_a, *lru_b_a, *lru_w_x, *lru_b_x, *lru_lam, *cmlp_ln_g, *cmlp_ln_b, *cmlp_w_s, *cmlp_b_s, *q_norm_g,
      *kv_norm_g, *w_q_up, *w_kv_up, *w_branch, *w_out, *w_ff1, *w_ff3, *w_ff2, *final_g;
  float *out, *Xc, *mod, *rope;
  float2* summ;
  float* ssq;
  unsigned* bar;
  u16 *W, *H, *Ycat, *R1, *Q, *K, *Vt;
};

__device__ __forceinline__ uint32_t pack2(float a, float b) { uint32_t r; asm("v_cvt_pk_bf16_f32 %0, %1, %2" : "=v"(r) : "v"(a), "v"(b)); return r; }
__device__ __forceinline__ u16 f2bf(float f) { return (u16)(pack2(f, f) & 0xffffu); }
__device__ __forceinline__ float bf2f(u16 h) { return __uint_as_float(((uint32_t)h) << 16); }
__device__ __forceinline__ float sigmoidf_(float x) { return __builtin_amdgcn_rcpf(1.f + __expf(-x)); }
__device__ __forceinline__ float sigmoid_rcp_(float x) { return __builtin_amdgcn_rcpf(1.f + __expf(-x)); }
__device__ __forceinline__ float siluf_(float x) { return x * __builtin_amdgcn_rcpf(1.f + __expf(-x)); }
__device__ __forceinline__ float geluf_(float x) {
  float u = 0.7978845608028654f * (x + 0.044715f * x * x * x);
  return x * __builtin_amdgcn_rcpf(1.f + __expf(-2.f * u));
}
__device__ __forceinline__ void unpack8(const uint4& v, float* f) {
  f[0] = __uint_as_float(v.x << 16); f[1] = __uint_as_float(v.x & 0xffff0000u);
  f[2] = __uint_as_float(v.y << 16); f[3] = __uint_as_float(v.y & 0xffff0000u);
  f[4] = __uint_as_float(v.z << 16); f[5] = __uint_as_float(v.z & 0xffff0000u);
  f[6] = __uint_as_float(v.w << 16); f[7] = __uint_as_float(v.w & 0xffff0000u);
}
__device__ __forceinline__ uint4 pack8(const float* f) {
  uint4 v; v.x = pack2(f[0], f[1]); v.y = pack2(f[2], f[3]); v.z = pack2(f[4], f[5]); v.w = pack2(f[6], f[7]); return v;
}
template <int CTRL, int ROWMASK>
__device__ __forceinline__ float dpp0f(float src) {
  return __int_as_float(__builtin_amdgcn_update_dpp(0, __float_as_int(src), CTRL, ROWMASK, 0xf, false));
}
__device__ __forceinline__ float wave_sum(float v) {
  v += dpp0f<0x111, 0xf>(v); v += dpp0f<0x112, 0xf>(v); v += dpp0f<0x114, 0xf>(v); v += dpp0f<0x118, 0xf>(v);
  v += dpp0f<0x142, 0xa>(v); v += dpp0f<0x143, 0xc>(v);
  return __int_as_float(__builtin_amdgcn_readlane(__float_as_int(v), 63));
}
__device__ __forceinline__ float* xrow_ptr(const P& p, int r) {
  int b = r / ST, t = r - b * ST;
  return t < SL ? p.out + ((size_t)(b * SL + t)) * DM : p.Xc + ((size_t)(b * SC + t - SL)) * DM;
}
__device__ __forceinline__ int mod_idx(int r) { int b = r / ST, t = r - b * ST; return t < SL ? b : 8; }

template <int MT>
__device__ __forceinline__ void gemm_main(const u16* __restrict__ A, int lda, const u16* __restrict__ B, int ldb, int K,
                                          u16* lds, f32x4 (&acc)[MT][4]) {
  constexpr int BM = MT * 64;
  constexpr int ASZ = BM * 72, BSZ = 128 * 72, STG = ASZ + BSZ;
  int tid = threadIdx.x; asm volatile("" : "+v"(tid));
  const int lane = tid & 63, wid = tid >> 6, wr = wid >> 1, wc = wid & 1, fr = lane & 15, fq = lane >> 4;
  uint4 ra[MT], rb[2];
  const int nk = K >> 6;
  const int crow = tid >> 3, ckc = (tid & 7) * 8;
#pragma unroll
  for (int i = 0; i < MT; ++i) ra[i] = *(const uint4*)(A + (size_t)(crow + i * 64) * lda + ckc);
#pragma unroll
  for (int i = 0; i < 2; ++i) rb[i] = *(const uint4*)(B + (size_t)(crow + i * 64) * ldb + ckc);
  {
    u16* sa = lds; u16* sb = lds + ASZ;
#pragma unroll
    for (int i = 0; i < MT; ++i) *(uint4*)(sa + (crow + i * 64) * 72 + ckc) = ra[i];
#pragma unroll
    for (int i = 0; i < 2; ++i) *(uint4*)(sb + (crow + i * 64) * 72 + ckc) = rb[i];
  }
  __syncthreads();
  for (int kt = 0; kt < nk; ++kt) {
    const bool more = (kt + 1 < nk);
    if (more) {
      const int k0 = (kt + 1) * 64 + ckc;
#pragma unroll
      for (int i = 0; i < MT; ++i) ra[i] = *(const uint4*)(A + (size_t)(crow + i * 64) * lda + k0);
#pragma unroll
      for (int i = 0; i < 2; ++i) rb[i] = *(const uint4*)(B + (size_t)(crow + i * 64) * ldb + k0);
    }
    const u16* sa = lds + (kt & 1) * STG;
    const u16* sb = sa + ASZ;
#pragma unroll
    for (int ks = 0; ks < 2; ++ks) {
      bf16x8 a[MT], b[4];
#pragma unroll
      for (int m = 0; m < MT; ++m) a[m] = *(const bf16x8*)(sa + (wr * MT * 16 + m * 16 + fr) * 72 + ks * 32 + fq * 8);
#pragma unroll
      for (int n = 0; n < 4; ++n) b[n] = *(const bf16x8*)(sb + (wc * 64 + n * 16 + fr) * 72 + ks * 32 + fq * 8);
#pragma unroll
      for (int m = 0; m < MT; ++m)
#pragma unroll
        for (int n = 0; n < 4; ++n) acc[m][n] = __builtin_amdgcn_mfma_f32_16x16x32_bf16(a[m], b[n], acc[m][n], 0, 0, 0);
    }
    if (more) {
      u16* wa = lds + ((kt + 1) & 1) * STG; u16* wb = wa + ASZ;
#pragma unroll
      for (int i = 0; i < MT; ++i) *(uint4*)(wa + (crow + i * 64) * 72 + ckc) = ra[i];
#pragma unroll
      for (int i = 0; i < 2; ++i) *(uint4*)(wb + (crow + i * 64) * 72 + ckc) = rb[i];
    }
    __syncthreads();
  }
}

__device__ __forceinline__ void gemm_main128(const u16* __restrict__ A, int lda, const u16* __restrict__ B, int ldb, int K,
                                             const u16* __restrict__ nA, int nlda, const u16* __restrict__ nB, int nldb, bool has_next, bool primed,
                                             LAS3 unsigned char* lds, f32x4 (&acc)[2][4]) {
  constexpr int OPB = 128 * 256, STGB = 2 * OPB;
  int tid = threadIdx.x; asm volatile("" : "+v"(tid));
  const int lane = tid & 63, wid = __builtin_amdgcn_readfirstlane(tid >> 6), wr = wid >> 1, wc = wid & 1, fr = lane & 15, fq = lane >> 4;
  const int drow = wid * 4 + (lane >> 4), dslot = lane & 15;
  const int gch = (dslot ^ (drow & 15)) * 8;
  const unsigned goffA = (unsigned)(drow * lda + gch), goffB = (unsigned)(drow * ldb + gch);
  const unsigned rstepA = (unsigned)(32 * lda), rstepB = (unsigned)(32 * ldb);
  const int nk = K >> 7;
#define G128_DMA(st, kt) do { const int k0_ = (kt) * 128; \
    _Pragma("unroll") for (int i_ = 0; i_ < 4; ++i_) { \
      __builtin_amdgcn_global_load_lds((const unsigned*)(A + goffA + i_ * rstepA + k0_), (LAS3 unsigned*)(lds + (st) * STGB + (i_ * 8 + wid) * 1024), 16, 0, 0); \
      __builtin_amdgcn_global_load_lds((const unsigned*)(B + goffB + i_ * rstepB + k0_), (LAS3 unsigned*)(lds + (st) * STGB + OPB + (i_ * 8 + wid) * 1024), 16, 0, 0); } } while (0)
#define G128_MMA(st) do { LAS3 const unsigned char* sa = lds + (st) * STGB; LAS3 const unsigned char* sb = sa + OPB; \
    _Pragma("unroll") for (int ks = 0; ks < 4; ++ks) { bf16x8 a[2], b[4]; \
      _Pragma("unroll") for (int m = 0; m < 2; ++m) a[m] = *(LAS3 const bf16x8*)(sa + (wr * 32 + m * 16 + fr) * 256 + (((ks * 4 + fq) ^ fr) * 16)); \
      _Pragma("unroll") for (int n = 0; n < 4; ++n) b[n] = *(LAS3 const bf16x8*)(sb + (wc * 64 + n * 16 + fr) * 256 + (((ks * 4 + fq) ^ fr) * 16)); \
      __builtin_amdgcn_s_setprio(1); \
      _Pragma("unroll") for (int m = 0; m < 2; ++m) _Pragma("unroll") for (int n = 0; n < 4; ++n) \
        acc[m][n] = __builtin_amdgcn_mfma_f32_16x16x32_bf16(a[m], b[n], acc[m][n], 0, 0, 0); \
      __builtin_amdgcn_s_setprio(0); } } while (0)
  if (!primed) {
    G128_DMA(0, 0);
    asm volatile("s_waitcnt vmcnt(0)" ::: "memory");
    __syncthreads();
  }
  for (int kt = 0; kt < nk; ++kt) {
    if (kt + 1 < nk) G128_DMA((kt + 1) & 1, kt + 1);
    else if (has_next) {
      const unsigned ngA = (unsigned)(drow * nlda + gch), ngB = (unsigned)(drow * nldb + gch);
#pragma unroll
      for (int i_ = 0; i_ < 4; ++i_) {
        __builtin_amdgcn_global_load_lds((const unsigned*)(nA + ngA + i_ * 32 * nlda), (LAS3 unsigned*)(lds + (i_ * 8 + wid) * 1024), 16, 0, 0);
        __builtin_amdgcn_global_load_lds((const unsigned*)(nB + ngB + i_ * 32 * nldb), (LAS3 unsigned*)(lds + OPB + (i_ * 8 + wid) * 1024), 16, 0, 0);
      }
    }
    G128_MMA(kt & 1);
    asm volatile("s_waitcnt vmcnt(0)" ::: "memory");
    __syncthreads();
  }
#undef G128_DMA
#undef G128_MMA
}

template <int MT, class Pre, class Epi>
__device__ __forceinline__ void gemm_phase(const u16* A, int lda, const u16* B, int ldb, int K, int nct, u16* lds, Pre pre,
                                           Epi epi, int id0, int idstride, int idoff) {
  constexpr int BM = MT * 64;
  const int nrt = MTOT / BM, ntile = nrt * nct;
  int first = id0;
  if (first < idoff) { int kk = (idoff - first + idstride - 1) / idstride; first += kk * idstride; }
  for (int gid = first; gid < idoff + ntile; gid += idstride) {
    int id = gid - idoff;
    int g = id / (8 * nct), rem = id - g * 8 * nct;
    int ct = rem >> 3, rt = g * 8 + (rem & 7);
    f32x4 acc[MT][4];
#pragma unroll
    for (int m = 0; m < MT; ++m)
#pragma unroll
      for (int n = 0; n < 4; ++n) acc[m][n] = (f32x4){0.f, 0.f, 0.f, 0.f};
    pre(rt * BM);
    gemm_main<MT>(A + (size_t)rt * BM * lda, lda, B + (size_t)ct * 128 * ldb, ldb, K, lds, acc);
    epi(rt * BM, ct * 128, acc);
    __syncthreads();
  }
}

namespace g8 {
constexpr int BM = 256, BK = 64, HALF = 128, HTB = HALF * BK * 2, STAGE_BYTES = 8 * HTB, NXCD = 8, WGM = 8;
__device__ __forceinline__ int lds_byte(int r, int c) { const int st = (r >> 4) * 2 + (c >> 5), rr = r & 15, cc = c & 31, ob = rr * 64 + cc * 2; return st * 1024 + (ob ^ (((ob >> 9) & 1) << 5)); }
__device__ __forceinline__ void stage_rc(int b, int& R, int& C) { const int st = b / 1024, sb = b % 1024, swz = sb ^ (((sb >> 9) & 1) << 5); R = (st >> 1) * 16 + swz / 64; C = (st & 1) * 32 + (swz % 64) / 2; }
__device__ __forceinline__ int perm32(int rho) { const int n = rho >> 4, i = rho & 15; return 8 * (i >> 2) + 4 * n + (i & 3); }
struct Unit { const char* A; const char* B; int lda, K, pm, pn, aux; };
struct Order {
  int nM, nN, nwg, G, c;
  __device__ void init(int nM_, int nN_, int G_, int c_) { nM = nM_; nN = nN_; nwg = nM * nN; G = G_; c = c_; }
  __device__ bool tile(int i, int& pm, int& pn) const {
    const long L = (long)i * G + c; if (L >= nwg) return false;
    int wgid = (int)L; { const int q = nwg / NXCD, r = nwg % NXCD, xcd = wgid % NXCD, off = wgid / NXCD; wgid = (xcd < r ? xcd * (q + 1) : r * (q + 1) + (xcd - r) * q) + off; }
    const int nig = WGM * nN, gid = wgid / nig, fm = gid * WGM, gsz = (nM - fm) < WGM ? (nM - fm) : WGM;
    pm = fm + ((wgid % nig) % gsz); pn = (wgid % nig) / gsz;
    if (nM == 128) pm += pm >> 4;
    return true;
  }
};
struct Simple {
  Order o; const u16* A; const u16* Bt; int lda, K;
  __device__ bool next(int i, Unit& u) const {
    int pm, pn; if (!o.tile(i, pm, pn)) return false;
    u.A = (const char*)(A + (size_t)pm * 256 * lda); u.B = (const char*)(Bt + (size_t)pn * 256 * K); u.lda = lda; u.K = K; u.pm = pm; u.pn = pn; u.aux = 0; return true;
  }
};
__device__ __forceinline__ unsigned cvt_pk_bf16(float lo, float hi) { unsigned r; asm volatile("v_cvt_pk_bf16_f32 %0, %1, %2" : "=v"(r) : "v"(lo), "v"(hi)); return r; }

template <bool PERM, class Sched, class Epi>
__device__ __forceinline__ void gemm_phase(LAS3 unsigned char* lds, const Sched& S, const Epi& E) {
  int tid = threadIdx.x; asm volatile("" : "+v"(tid));
  const int wid = __builtin_amdgcn_readfirstlane(tid >> 6), lane = tid & 63, wr = wid >> 2, wc = wid & 3, fr = lane & 15, fq = lane >> 4;
  const size_t kstep = (size_t)(BK * 2);
#define G8_VOFF(LDA_, K_) do { int _t2 = tid; asm volatile("" : "+v"(_t2)); _Pragma("unroll") for (int _i = 0; _i < 2; ++_i) { int R, C; stage_rc(_t2 * 16 + _i * 8192, R, C); \
    const int Rb = PERM ? ((R & ~31) + perm32(R & 31)) : R; voffA[_i] = (unsigned)(R * (LDA_) + C) * 2u; voffB[_i] = (unsigned)(Rb * (K_) + C) * 2u; } \
    hstepA = (size_t)HALF * (LDA_) * 2; hstepB = (size_t)HALF * (K_) * 2; } while (0)
  const unsigned ldsw = (unsigned)wid * 1024u;
  const int aoff = lds_byte(wr * 64 + fr, fq * 8), boff = lds_byte(wc * 32 + fr, fq * 8);
#define G8_SA(b, h) (((b) * 2 + (h)) * HTB)
#define G8_SB(b, h) ((4 + (b) * 2 + (h)) * HTB)
#define G8_STAGE(bufoff, gbase, voff) do { _Pragma("unroll") for (int _i = 0; _i < 2; ++_i) \
    __builtin_amdgcn_global_load_lds((const unsigned*)((const char*)(gbase) + (voff)[_i]), (LAS3 unsigned*)(lds + (bufoff) + ldsw + _i * 8192), 16, 0, 0); } while (0)
#define G8_LDA(dst, b, h) do { _Pragma("unroll") for (int m = 0; m < 4; ++m) _Pragma("unroll") for (int k = 0; k < 2; ++k) dst[m][k] = *(const LAS3 bf16x8*)(lds + G8_SA(b, h) + aoff + m * 2048 + k * 1024); } while (0)
#define G8_LDB(dst, b, h) do { _Pragma("unroll") for (int n = 0; n < 2; ++n) _Pragma("unroll") for (int k = 0; k < 2; ++k) dst[n][k] = *(const LAS3 bf16x8*)(lds + G8_SB(b, h) + boff + n * 2048 + k * 1024); } while (0)
#define G8_MMA(ai, bj, At, Bt) do { __builtin_amdgcn_s_setprio(1); _Pragma("unroll") for (int m = 0; m < 4; ++m) _Pragma("unroll") for (int n = 0; n < 2; ++n) _Pragma("unroll") for (int k = 0; k < 2; ++k) \
    acc[ai][bj][m][n] = __builtin_amdgcn_mfma_f32_16x16x32_bf16(Bt[n][k], At[m][k], acc[ai][bj][m][n], 0, 0, 0); __builtin_amdgcn_s_setprio(0); } while (0)
#define G8_WAIT_V(n) asm volatile("s_waitcnt vmcnt(" #n ")" ::: "memory")
#define G8_WAIT_L(n) asm volatile("s_waitcnt lgkmcnt(" #n ")" ::: "memory")
#define G8_BAR __builtin_amdgcn_s_barrier()
#define G8_SCHED __builtin_amdgcn_sched_barrier(0)
  Unit cur, nxt; int ui = 0;
  if (!S.next(0, cur)) return;
  f32x4 acc[2][2][4][2];
#pragma unroll
  for (int a = 0; a < 2; ++a)
#pragma unroll
    for (int b = 0; b < 2; ++b)
#pragma unroll
      for (int m = 0; m < 4; ++m)
#pragma unroll
        for (int n = 0; n < 2; ++n) acc[a][b][m][n] = (f32x4){0.f, 0.f, 0.f, 0.f};
  bf16x8 At[4][2], B0[2][2], B1[2][2];
  const char* cA = cur.A; const char* cB = cur.B;
  unsigned voffA[2], voffB[2];
  size_t hstepA, hstepB;
  G8_VOFF(cur.lda, cur.K);
  G8_STAGE(G8_SB(0, 0), cB, voffB); G8_STAGE(G8_SA(0, 0), cA, voffA); G8_STAGE(G8_SB(0, 1), cB + hstepB, voffB); G8_STAGE(G8_SA(0, 1), cA + hstepA, voffA);
  if (wr == 1) G8_BAR;
  G8_WAIT_V(4); G8_BAR;
  G8_STAGE(G8_SB(1, 0), cB + kstep, voffB); G8_STAGE(G8_SA(1, 0), cA + kstep, voffA); G8_STAGE(G8_SB(1, 1), cB + hstepB + kstep, voffB);
  G8_WAIT_V(6); G8_BAR;
  for (;;) {
    const bool has_next = S.next(ui + 1, nxt);
    if (!has_next) nxt = cur;
    const char* nA = nxt.A; const char* nB = nxt.B;
    const int nt = cur.K / BK;
    for (int t = 0; t < nt; t += 2) {
      const bool last = (t == nt - 2);
      const char* a1 = cA + (size_t)(t + 1) * kstep;
      const char* a2 = last ? nA : cA + (size_t)(t + 2) * kstep; const char* b2 = last ? nB : cB + (size_t)(t + 2) * kstep;
      const char* a3 = a2 + kstep; const char* b3 = b2 + kstep;
      G8_LDB(B0, 0, 0); G8_SCHED; G8_LDA(At, 0, 0); G8_STAGE(G8_SA(1, 1), a1 + hstepA, voffA);
      G8_WAIT_L(8); G8_BAR; G8_WAIT_L(0); G8_MMA(0, 0, At, B0); G8_BAR; G8_SCHED;
      if (last) G8_VOFF(nxt.lda, nxt.K);
      G8_LDB(B1, 0, 1); G8_STAGE(G8_SB(0, 0), b2, voffB);
      G8_BAR; G8_WAIT_L(0); G8_MMA(0, 1, At, B1); G8_BAR;
      G8_LDA(At, 0, 1); G8_STAGE(G8_SA(0, 0), a2, voffA);
      G8_BAR; G8_WAIT_L(0); G8_MMA(1, 0, At, B0); G8_BAR; G8_SCHED;
      G8_STAGE(G8_SB(0, 1), b2 + hstepB, voffB);
      G8_WAIT_V(6); G8_BAR; G8_MMA(1, 1, At, B1); G8_BAR;
      G8_LDB(B0, 1, 0); G8_SCHED; G8_LDA(At, 1, 0); G8_STAGE(G8_SA(0, 1), a2 + hstepA, voffA);
      G8_WAIT_L(8); G8_BAR; G8_WAIT_L(0); G8_MMA(0, 0, At, B0); G8_BAR; G8_SCHED;
      G8_LDB(B1, 1, 1); G8_STAGE(G8_SB(1, 0), b3, voffB);
      G8_BAR; G8_WAIT_L(0); G8_MMA(0, 1, At, B1); G8_BAR;
      G8_LDA(At, 1, 1); G8_STAGE(G8_SA(1, 0), a3, voffA);
      G8_BAR; G8_WAIT_L(0); G8_MMA(1, 0, At, B0); G8_BAR; G8_SCHED;
      G8_STAGE(G8_SB(1, 1), b3 + hstepB, voffB);
      G8_WAIT_V(6); G8_BAR; G8_MMA(1, 1, At, B1); G8_BAR;
    }
    E(acc, cur, wr, wc, fr, fq, tid);
    if (!has_next) break;
#pragma unroll
    for (int a = 0; a < 2; ++a)
#pragma unroll
      for (int b = 0; b < 2; ++b)
#pragma unroll
        for (int m = 0; m < 4; ++m)
#pragma unroll
          for (int n = 0; n < 2; ++n) acc[a][b][m][n] = (f32x4){0.f, 0.f, 0.f, 0.f};
    cur = nxt; cA = nA; cB = nB; ++ui;
  }
  G8_WAIT_V(0);
  if (wr == 0) G8_BAR;
  G8_BAR;
#undef G8_VOFF
#undef G8_SA
#undef G8_SB
#undef G8_STAGE
#undef G8_LDA
#undef G8_LDB
#undef G8_MMA
#undef G8_WAIT_V
#undef G8_WAIT_L
#undef G8_BAR
#undef G8_SCHED
}
}

__device__ __forceinline__ void convT_job(const float* src0, const float* src1, int ldsrc, int kind, int off, int nvalid, u16* dst, int K,
                          int Ndst, const float* kscale, float mult, float* lds, int vb, int vn) {
  int tid = threadIdx.x; asm volatile("" : "+v"(tid));
  const int nkt = K >> 6, nitems = nkt * (Ndst >> 7);
  for (int it = vb; it < nitems; it += vn) {
    const int kt = it % nkt, nt = it / nkt;
    float v[16];
#pragma unroll
    for (int e = 0; e < 16; ++e) {
      int idx = tid + e * 512, i = idx >> 7, j = idx & 127, n = nt * 128 + j, k = kt * 64 + i;
      if (kind == 0) {
        v[e] = (n < nvalid) ? src0[(size_t)k * ldsrc + off + n] : 0.f;
      } else {
        int g = n >> 8, w = n & 255;
        const float* sp = (w < 128) ? src0 : src1;
        v[e] = sp[(size_t)k * ldsrc + g * 128 + (w & 127)];
      }
    }
#pragma unroll
    for (int e = 0; e < 16; ++e) {
      int idx = tid + e * 512, i = idx >> 7, j = idx & 127, k = kt * 64 + i;
      float x = v[e];
      if (kscale) x *= kscale[k];
      lds[j * 65 + i] = x * mult;
    }
    __syncthreads();
#pragma unroll
    for (int e = 0; e < 8; ++e) {
      int idx = tid + e * 512, j = idx >> 5, i2 = (idx & 31) * 2;
      *(uint32_t*)(dst + (size_t)(nt * 128 + j) * K + kt * 64 + i2) = pack2(lds[j * 65 + i2], lds[j * 65 + i2 + 1]);
    }
    __syncthreads();
  }
}

__device__ __forceinline__ void convert_weights(const P& p, int l, float* lds, int job_lo, int job_hi, bool skip_ff2, int vb, int vn, bool do_small) {
  const float* win = p.w_in + (size_t)l * 1024 * 8352;
#pragma unroll 1
  for (int job = job_lo; job < job_hi; ++job) {
    if (skip_ff2 && job == 9) continue;
    const float* s0 = win; const float* s1 = nullptr; const float* ksc = nullptr;
    int ldsrc = 8352, kind = 0, off = 0, nvalid = 0, K = 1024, Ndst = 0; float mult = 1.f; u16* dst = p.W;
    if (job == 0) { off = 1696; nvalid = 2560; dst += OFF_WINA; Ndst = 2560; }
    else if (job == 1) { off = 0; nvalid = 1696; dst += OFF_WINB; Ndst = 1792; }
    else if (job == 2) { off = 4256; nvalid = 4096; dst += OFF_WGATE; Ndst = 4096; }
    else if (job < 7) { const int n = job - 3; s0 = p.w_branch + ((size_t)l * 4 + n) * 512 * 1024; ldsrc = 1024; nvalid = 1024; dst += OFF_WBR + (size_t)n * 1024 * 512; K = 512; Ndst = 1024; }
    else if (job == 7) { s0 = p.w_out + (size_t)l * 1024 * 1024; ldsrc = 1024; nvalid = 1024; dst += OFF_WOUT; Ndst = 1024; }
    else if (job == 8) { s0 = p.w_ff1 + (size_t)l * 1024 * 2816; s1 = p.w_ff3 + (size_t)l * 1024 * 2816; ldsrc = 2816; kind = 1; dst += OFF_WFF13; Ndst = 5632; }
    else if (job == 9) { s0 = p.w_ff2 + (size_t)l * 2816 * 1024; ldsrc = 1024; nvalid = 1024; dst += OFF_WFF2; K = 2816; Ndst = 1024; }
    else if (job == 10) { s0 = p.w_q_up + (size_t)l * 384 * 768; ldsrc = 768; nvalid = 768; dst += OFF_WQUP; K = 384; Ndst = 768; ksc = p.q_norm_g + l * 384; mult = 0.10206207261596575f * 1.4426950408889634f; }
    else { s0 = p.w_kv_up + (size_t)l * 256 * 1024; ldsrc = 1024; nvalid = 1024; dst += OFF_WKVUP; K = 256; Ndst = 1024; ksc = p.kv_norm_g + l * 256; }
    convT_job(s0, s1, ldsrc, kind, off, nvalid, dst, K, Ndst, ksc, mult, lds, vb, vn);
  }
  if (!do_small) return;
  int tidc = threadIdx.x; asm volatile("" : "+v"(tidc));
  const int gt = blockIdx.x * NTHR + tidc, gs = gridDim.x * NTHR;
  for (int i = gt; i < 4 * 128 * 128; i += gs) p.W[OFF_WS + i] = f2bf(p.cmlp_w_s[(size_t)l * 65536 + i]);
  for (int i = gt; i < 2 * 8 * 128 * 64; i += gs) {
    int k = i & 63, n = (i >> 6) & 127, h = (i >> 13) & 7, d = i >> 16;
    const float* src = (n < 64) ? p.lru_w_a : p.lru_w_x;
    p.W[OFF_WLRU + i] = f2bf(src[((((size_t)l * 2 + d) * 8 + h) * 64 + k) * 64 + (n & 63)]);
  }
}

__device__ void phase0(const P& p, unsigned char* smem) {
  int tid = threadIdx.x; asm volatile("" : "+v"(tid));
  const int gt = blockIdx.x * NTHR + tid, gs = gridDim.x * NTHR;
  {
    const float4* s = (const float4*)p.x; float4* d = (float4*)p.out;
    for (int i = gt; i < NB * SL * DM / 4; i += gs) d[i] = s[i];
    const float4* s2 = (const float4*)p.ctx; float4* d2 = (float4*)p.Xc;
    for (int i = gt; i < NB * SC * DM / 4; i += gs) d2[i] = s2[i];
  }
  for (int idx = gt; idx < SL * 8; idx += gs) {
    int t = idx >> 3, i = idx & 7;
    float inv = exp2f(-(float)i * 0.125f * 13.287712379549449f);
    float ar = (float)(t >> 6) * inv, ac = (float)(t & 63) * inv;
    const float i2pi = 0.15915494309189535f;
    float rr = ar * i2pi; rr -= floorf(rr); rr *= 6.283185307179586f;
    float rc = ac * i2pi; rc -= floorf(rc); rc *= 6.283185307179586f;
    p.rope[t * 32 + i] = __cosf(rr); p.rope[t * 32 + 8 + i] = __sinf(rr);
    p.rope[t * 32 + 16 + i] = __cosf(rc); p.rope[t * 32 + 24 + i] = __sinf(rc);
  }
  float* sS = (float*)smem; float* red = sS + 9 * 1024;
  for (int it = blockIdx.x; it < 4 * 96; it += gridDim.x) {
    const int l = it / 96, cgp = it - l * 96;
    for (int idx = tid; idx < 9216; idx += 512) {
      int m = idx >> 10, k = idx & 1023;
      float v = (m < 8) ? p.c[m * 1024 + k] : p.c_ctx[k];
      sS[idx] = siluf_(v);
    }
    __syncthreads();
    const int cj = tid & 63, kp = tid >> 6, j = cgp * 64 + cj;
    float a[9];
#pragma unroll
    for (int m = 0; m < 9; ++m) a[m] = 0.f;
    for (int k0 = kp * 128; k0 < kp * 128 + 128; k0 += 16) {
      float w[16];
#pragma unroll
      for (int u = 0; u < 16; ++u) w[u] = p.w_mod[((size_t)l * 1024 + k0 + u) * 6144 + j];
#pragma unroll
      for (int u = 0; u < 16; ++u)
#pragma unroll
        for (int m = 0; m < 9; ++m) a[m] += sS[m * 1024 + k0 + u] * w[u];
    }
#pragma unroll
    for (int m = 0; m < 9; ++m) red[(kp * 9 + m) * 64 + cj] = a[m];
    __syncthreads();
    for (int idx = tid; idx < 576; idx += 512) {
      int m = idx >> 6, c2 = idx & 63;
      float s = 0.f;
      for (int q = 0; q < 8; ++q) s += red[(q * 9 + m) * 64 + c2];
      p.mod[((size_t)l * 9 + m) * 6144 + cgp * 64 + c2] = s + p.b_mod[l * 6144 + cgp * 64 + c2];
    }
    __syncthreads();
  }
}

__device__ void norm_mod(const P& p, int l, const float* g, int off_sh, int off_sc) {
  int tid = threadIdx.x; asm volatile("" : "+v"(tid));
  const int lane = tid & 63, wid = tid >> 6;
  for (int r = blockIdx.x * 8 + wid; r < MTOT; r += gridDim.x * 8) {
    const float* xr = xrow_ptr(p, r);
    const float* md = p.mod + ((size_t)l * 9 + mod_idx(r)) * 6144;
    float4 v[4];
    float ss = 0.f;
#pragma unroll
    for (int i = 0; i < 4; ++i) {
      v[i] = *(const float4*)(xr + i * 256 + lane * 4);
      ss += v[i].x * v[i].x + v[i].y * v[i].y + v[i].z * v[i].z + v[i].w * v[i].w;
    }
    ss = wave_sum(ss);
    const float inv = rsqrtf(ss * (1.f / 1024.f) + EPS);
#pragma unroll
    for (int i = 0; i < 4; ++i) {
      const int k = i * 256 + lane * 4;
      float4 gg = *(const float4*)(g + k);
      float4 sh = *(const float4*)(md + off_sh + k);
      float4 sc = *(const float4*)(md + off_sc + k);
      float o0 = v[i].x * inv * gg.x * (1.f + sc.x) + sh.x;
      float o1 = v[i].y * inv * gg.y * (1.f + sc.y) + sh.y;
      float o2 = v[i].z * inv * gg.z * (1.f + sc.z) + sh.z;
      float o3 = v[i].w * inv * gg.w * (1.f + sc.w) + sh.w;
      uint2 o; o.x = pack2(o0, o1); o.y = pack2(o2, o3);
      *(uint2*)(p.H + (size_t)r * 1024 + k) = o;
    }
  }
}

__device__ void conva_item(const P& p, int l, int item) {
  int tid = threadIdx.x; asm volatile("" : "+v"(tid));
  const u16* Zb1 = p.R1;
  const float* cw = p.conv_a_w + (size_t)l * 3 * 512;
  for (int e = 0; e < 32; ++e) {
    int idx = tid + e * 512, rr = idx >> 6, cgp = idx & 63;
    int r = item * 256 + rr;
    int b = r / ST, t = r - b * ST;
    int isctx = t >= SL, pos = isctx ? t - SL : t, seglen = isctx ? SC : SL;
    float acc[8];
#pragma unroll
    for (int i = 0; i < 8; ++i) acc[i] = 0.f;
#pragma unroll
    for (int k = 0; k < 3; ++k) {
      int pos2 = pos - 1 + k;
      if (pos2 >= 0 && pos2 < seglen) {
        size_t r2 = (size_t)(r - 1 + k);
        uint4 vc = *(const uint4*)(Zb1 + r2 * 2560 + 512 + cgp * 8);
        uint4 vx = *(const uint4*)(Zb1 + r2 * 2560 + 1024 + cgp * 8);
        float fc[8], fx[8];
        unpack8(vc, fc); unpack8(vx, fx);
#pragma unroll
        for (int i = 0; i < 8; ++i) acc[i] += cw[k * 512 + cgp * 8 + i] * (fc[i] * fx[i]);
      }
    }
    uint4 vb = *(const uint4*)(Zb1 + (size_t)r * 2560 + cgp * 8);
    float fb[8];
    unpack8(vb, fb);
#pragma unroll
    for (int i = 0; i < 8; ++i) acc[i] *= fb[i];
    *(uint4*)(p.Ycat + (size_t)r * 2048 + cgp * 8) = pack8(acc);
  }
}

__device__ void cmlp_item(const P& p, int l, int item, unsigned char* smem) {
  int tid = threadIdx.x; asm volatile("" : "+v"(tid));
  const int lane = tid & 63, wid = tid >> 6, fr = lane & 15, fq = lane >> 4;
  const int g = item & 3, bj = item >> 2;
  const int rowbase = bj * 128;
  u16* vT = (u16*)smem;
  float* sMu = (float*)(smem + 128 * 136 * 2);
  float* sRs = sMu + 128;
  const u16* Zb1 = p.R1;
  {
    uint4 vv[16];
#pragma unroll
    for (int rr = 0; rr < 16; ++rr) vv[rr] = *(const uint4*)(Zb1 + (size_t)(rowbase + wid * 16 + rr) * 2560 + 2048 + lane * 8);
#pragma unroll
    for (int rr = 0; rr < 16; ++rr) {
      int q = wid * 16 + rr;
      float f[8];
      unpack8(vv[rr], f);
      float s = 0.f;
#pragma unroll
      for (int i = 0; i < 8; ++i) { f[i] = geluf_(f[i]); s += f[i]; }
      s = wave_sum(s);
      float mu = s * (1.f / 512.f);
      float d2 = 0.f;
#pragma unroll
      for (int i = 0; i < 8; ++i) { float d = f[i] - mu; d2 += d * d; }
      d2 = wave_sum(d2);
      if (lane == 0) { sMu[q] = mu; sRs[q] = rsqrtf(d2 * (1.f / 512.f) + EPS); }
    }
  }
  __syncthreads();
  const float* lg = p.cmlp_ln_g + l * 512 + g * 128;
  const float* lb = p.cmlp_ln_b + l * 512 + g * 128;
#pragma unroll
  for (int e = 0; e < 4; ++e) {
    int idx = tid + e * 512, q = idx >> 4, dc = idx & 15;
    uint4 v = *(const uint4*)(Zb1 + (size_t)(rowbase + q) * 2560 + 2048 + g * 128 + dc * 8);
    float f[8];
    unpack8(v, f);
    float mu = sMu[q], rs = sRs[q];
#pragma unroll
    for (int i = 0; i < 8; ++i) {
      float val = (geluf_(f[i]) - mu) * rs * lg[dc * 8 + i] + lb[dc * 8 + i];
      vT[(dc * 8 + i) * 136 + q] = f2bf(val);
    }
  }
  __syncthreads();
  const u16* Ws = p.W + OFF_WS + (size_t)g * 128 * 128;
  f32x4 acc[8];
#pragma unroll
  for (int n = 0; n < 8; ++n) acc[n] = (f32x4){0.f, 0.f, 0.f, 0.f};
#pragma unroll
  for (int ks = 0; ks < 4; ++ks) {
    bf16x8 a = *(const bf16x8*)(Ws + (wid * 16 + fr) * 128 + ks * 32 + fq * 8);
#pragma unroll
    for (int n = 0; n < 8; ++n) {
      bf16x8 bb = *(const bf16x8*)(vT + (n * 16 + fr) * 136 + ks * 32 + fq * 8);
      acc[n] = __builtin_amdgcn_mfma_f32_16x16x32_bf16(bb, a, acc[n], 0, 0, 0);
    }
  }
  {
    const int pp = wid * 16 + fr;
    const size_t r = (size_t)(rowbase + pp);
    const float bsv = p.cmlp_b_s[((size_t)l * 4 + g) * 128 + pp];
    uint2 uu[8];
#pragma unroll
    for (int n = 0; n < 8; ++n) uu[n] = *(const uint2*)(Zb1 + r * 2560 + 1536 + g * 128 + n * 16 + fq * 4);
#pragma unroll
    for (int n = 0; n < 8; ++n) {
      float u0 = __uint_as_float(uu[n].x << 16), u1 = __uint_as_float(uu[n].x & 0xffff0000u);
      float u2 = __uint_as_float(uu[n].y << 16), u3 = __uint_as_float(uu[n].y & 0xffff0000u);
      uint2 ov;
      ov.x = pack2(geluf_(u0) * (acc[n][0] + bsv), geluf_(u1) * (acc[n][1] + bsv));
      ov.y = pack2(geluf_(u2) * (acc[n][2] + bsv), geluf_(u3) * (acc[n][3] + bsv));
      *(uint2*)(p.Ycat + r * 2048 + 1024 + g * 128 + n * 16 + fq * 4) = ov;
    }
  }
  __syncthreads();
}

template <int CTRL, int ROWMASK>
__device__ __forceinline__ float dppf(float old, float src) {
  return __int_as_float(__builtin_amdgcn_update_dpp(__float_as_int(old), __float_as_int(src), CTRL, ROWMASK, 0xf, false));
}
#define LSCAN_STEP(A_, B_, CTRL, RM) do { const float A2_ = dppf<CTRL, RM>(1.f, A_), B2_ = dppf<CTRL, RM>(0.f, B_); B_ = A_ * B2_ + B_; A_ = A_ * A2_; } while (0)
#define LSCAN64(A_, B_) do { LSCAN_STEP(A_, B_, 0x111, 0xf); LSCAN_STEP(A_, B_, 0x112, 0xf); LSCAN_STEP(A_, B_, 0x114, 0xf); LSCAN_STEP(A_, B_, 0x118, 0xf); \
    LSCAN_STEP(A_, B_, 0x142, 0xa); LSCAN_STEP(A_, B_, 0x143, 0xc); } while (0)

template <int PASS>
__device__ void lru_run(const P& p, int l, int it_first, int it_stride, unsigned char* smem) {
  int tid = threadIdx.x; asm volatile("" : "+v"(tid));
  const int lane = tid & 63, wid = tid >> 6, fr = lane & 15, fq = lane >> 4;
  u16* sX = (u16*)smem;
  float* sA = (float*)(smem + 18432);
  float* sB = sA + 64 * 130;
  float* sH = sB + 64 * 130;
  float* sCw = sH + 128 * 65;
  float* sCarry = sCw + 320;
  float* sPar = sCarry + 128;
  u16* sW = (u16*)(sPar + 384);
  const u16* Zb2 = p.R1;
  int cur_h = -1;
  uint4 cv[2][4];
#define LRU_LOADCV(ITEM) do { const int h_ = (ITEM) & 7, bj_ = (ITEM) >> 3; const int b_ = bj_ / 34, j_ = bj_ - b_ * 34; const int ic_ = j_ >= 32; \
    const int p0_ = ic_ ? (j_ - 32) * 128 : j_ * 128, sl_ = ic_ ? SC : SL, rs_ = bj_ * 128 - p0_; \
    _Pragma("unroll") for (int e = 0; e < 2; ++e) { int idx = tid + e * 512, pp = idx >> 3, cgp = idx & 7; \
      _Pragma("unroll") for (int k = 0; k < 4; ++k) { int pos = p0_ + pp - 2 + k; cv[e][k] = make_uint4(0, 0, 0, 0); \
        if (pos >= 0 && pos < sl_) cv[e][k] = *(const uint4*)(Zb2 + (size_t)(rs_ + pos) * 1792 + h_ * 64 + cgp * 8); } } } while (0)
  if (it_first < 2176) LRU_LOADCV(it_first);
  for (int item = it_first; item < 2176; item += it_stride) {
    const int h = item & 7, bj = item >> 3;
    const int b = bj / 34, j = bj - b * 34;
    const int rowbase = bj * 128;
    const int isctx = j >= 32;
    const int ordf = isctx ? j - 32 : j + 2, ordr = 33 - j;
    float cA[16], cB[16];
    uint4 gv[2];
    if (PASS == 3) {
#pragma unroll
      for (int q = 0; q < 16; ++q) {
        const int pi = wid * 16 + q, d = pi >> 6, ch = pi & 63, o = d ? ordr : ordf;
        cA[q] = 1.f; cB[q] = 0.f;
        if (lane < o) { float2 v = p.summ[((size_t)(b * 2 + d) * 512 + h * 64 + ch) * 34 + lane]; cA[q] = v.x; cB[q] = v.y; }
      }
#pragma unroll
      for (int e = 0; e < 2; ++e) {
        int idx = tid + e * 512, pos = idx >> 3, cgp = idx & 7;
        gv[e] = *(const uint4*)(Zb2 + (size_t)(rowbase + pos) * 1792 + 800 + h * 64 + cgp * 8);
      }
    }
    if (h != cur_h) {
      cur_h = h;
      __syncthreads();
      if (tid < 320) {
        int k = tid >> 6, i = tid & 63;
        sCw[tid] = (k < 4) ? p.lru_conv_w[((size_t)l * 4 + k) * 512 + h * 64 + i] : p.lru_conv_b[l * 512 + h * 64 + i];
      }
      if (tid < 128) {
        const int d = tid >> 6, ch = tid & 63;
        const size_t pidx = ((size_t)l * 2 + d) * 512 + h * 64 + ch;
        sPar[tid * 3] = p.lru_b_a[pidx]; sPar[tid * 3 + 1] = p.lru_b_x[pidx];
        sPar[tid * 3 + 2] = 8.f * log1pf(__expf(-p.lru_lam[pidx]));
      }
#pragma unroll
      for (int e = 0; e < 4; ++e) {
        int idx = tid + e * 512, row = idx >> 3, kc = idx & 7;
        const int d = row >> 7, n = row & 127;
        *(uint4*)(sW + row * 72 + kc * 8) = *(const uint4*)(p.W + OFF_WLRU + (size_t)((d * 8 + h) * 128 + n) * 64 + kc * 8);
      }
      __syncthreads();
    }
#pragma unroll
    for (int e = 0; e < 2; ++e) {
      int idx = tid + e * 512, pp = idx >> 3, cgp = idx & 7;
      float a8[8];
#pragma unroll
      for (int i = 0; i < 8; ++i) a8[i] = sCw[256 + cgp * 8 + i];
#pragma unroll
      for (int k = 0; k < 4; ++k) {
        float f[8];
        unpack8(cv[e][k], f);
#pragma unroll
        for (int i = 0; i < 8; ++i) a8[i] += sCw[k * 64 + cgp * 8 + i] * f[i];
      }
      *(uint4*)(sX + pp * 72 + cgp * 8) = pack8(a8);
    }
    if (item + it_stride < 2176) LRU_LOADCV(item + it_stride);
    if (PASS == 3) {
#pragma unroll
      for (int q = 0; q < 16; ++q) LSCAN64(cA[q], cB[q]);
      if (lane == 63) {
#pragma unroll
        for (int q = 0; q < 16; ++q) sCarry[wid * 16 + q] = cB[q];
      }
    }
    __syncthreads();
    for (int d = 0; d < 2; ++d) {
      const u16* Wl = sW + d * 128 * 72;
      f32x4 acc[8];
#pragma unroll
      for (int n = 0; n < 8; ++n) acc[n] = (f32x4){0.f, 0.f, 0.f, 0.f};
      {
        const bf16x8 a0 = *(const bf16x8*)(sX + (wid * 16 + fr) * 72 + fq * 8);
        const bf16x8 a1 = *(const bf16x8*)(sX + (wid * 16 + fr) * 72 + 32 + fq * 8);
#pragma unroll
        for (int n = 0; n < 8; ++n) {
          const bf16x8 b0 = *(const bf16x8*)(Wl + (n * 16 + fr) * 72 + fq * 8);
          const bf16x8 b1 = *(const bf16x8*)(Wl + (n * 16 + fr) * 72 + 32 + fq * 8);
          acc[n] = __builtin_amdgcn_mfma_f32_16x16x32_bf16(a0, b0, acc[n], 0, 0, 0);
          acc[n] = __builtin_amdgcn_mfma_f32_16x16x32_bf16(a1, b1, acc[n], 0, 0, 0);
        }
      }
#pragma unroll
      for (int nt = 0; nt < 4; ++nt) {
        const int ch = nt * 16 + fr;
        const float ba = sPar[(d * 64 + ch) * 3], bx = sPar[(d * 64 + ch) * 3 + 1], sp8 = sPar[(d * 64 + ch) * 3 + 2];
#pragma unroll
        for (int jj = 0; jj < 4; ++jj) {
          const int pos = wid * 16 + fq * 4 + jj;
          const float xl = bf2f(sX[pos * 72 + ch]);
          const float rg = sigmoid_rcp_(acc[nt][jj] + ba), ig = sigmoid_rcp_(acc[nt + 4][jj] + bx);
          const float la = -sp8 * rg;
          const float av = __expf(la);
          const float x2 = 2.f * la;
          const float ser = -x2 * (1.f + x2 * (0.5f + x2 * (0.16666667f + x2 * (0.041666667f + x2 * 0.0083333333f))));
          const float om = (x2 > -0.25f) ? ser : (1.f - av * av);
          const float bb = __builtin_amdgcn_sqrtf(om) * ig * xl;
          const int si = d ? 127 - pos : pos;
          sA[ch * 130 + si] = av;
          sB[ch * 130 + si] = bb;
        }
      }
      __syncthreads();
      {
        float a0[8], b0[8], A[8], B[8];
#pragma unroll
        for (int c = 0; c < 8; ++c) {
          const int ch = wid * 8 + c;
          const float2 va = *(const float2*)(sA + ch * 130 + 2 * lane), vb = *(const float2*)(sB + ch * 130 + 2 * lane);
          a0[c] = va.x; b0[c] = vb.x;
          A[c] = va.x * va.y; B[c] = va.y * vb.x + vb.y;
        }
#pragma unroll
        for (int c = 0; c < 8; ++c) LSCAN64(A[c], B[c]);
#pragma unroll
        for (int c = 0; c < 8; ++c) {
          const int ch = wid * 8 + c;
          if (PASS == 1) {
            if (lane == 63) p.summ[((size_t)(b * 2 + d) * 512 + h * 64 + ch) * 34 + (d ? ordr : ordf)] = make_float2(A[c], B[c]);
          } else {
            const float carry = sCarry[d * 64 + ch];
            const float hincl = A[c] * carry + B[c];
            const float hprev = dppf<0x138, 0xf>(carry, hincl);
            const float heven = a0[c] * hprev + b0[c];
            const int se = 2 * lane, pe = d ? 127 - se : se, po = d ? 126 - se : se + 1;
            if (d == 0) { sH[pe * 65 + ch] = heven; sH[po * 65 + ch] = hincl; }
            else { sH[pe * 65 + ch] += heven; sH[po * 65 + ch] += hincl; }
          }
        }
      }
      __syncthreads();
    }
    if (PASS == 3) {
#pragma unroll
      for (int e = 0; e < 2; ++e) {
        int idx = tid + e * 512, pos = idx >> 3, cgp = idx & 7;
        const size_t r = (size_t)(rowbase + pos);
        float gf[8], y[8];
        unpack8(gv[e], gf);
#pragma unroll
        for (int i = 0; i < 8; ++i) y[i] = geluf_(gf[i]) * sH[pos * 65 + cgp * 8 + i];
        *(uint4*)(p.Ycat + r * 2048 + 512 + h * 64 + cgp * 8) = pack8(y);
      }
      __syncthreads();
    }
  }
}

__device__ void krope_item(const P& p, int item) {
  int tid = threadIdx.x; asm volatile("" : "+v"(tid));
  const u16* Zb2 = p.R1;
#pragma unroll
  for (int e = 0; e < 8; ++e) {
    int idx = tid + e * 512, rr = idx >> 4, pi = idx & 15, axis = pi >> 3, i = pi & 7;
    int r = item * 256 + rr, b = r / ST, t = r - b * ST;
    float x1 = bf2f(Zb2[(size_t)r * 1792 + 768 + axis * 16 + i]);
    float x2 = bf2f(Zb2[(size_t)r * 1792 + 768 + axis * 16 + 8 + i]);
    float o1 = x1, o2 = x2;
    if (t < SL) {
      float cs = p.rope[t * 32 + axis * 16 + i], sn = p.rope[t * 32 + axis * 16 + 8 + i];
      o1 = x1 * cs - x2 * sn;
      o2 = x1 * sn + x2 * cs;
    }
    u16 b1 = f2bf(o1), b2 = f2bf(o2);
#pragma unroll
    for (int h = 0; h < 8; ++h) {
      size_t base = ((size_t)(b * 8 + h) * ST + t) * 96 + 64 + axis * 16 + i;
      p.K[base] = b1;
      p.K[base + 8] = b2;
    }
  }
}

__device__ void attn_item(const P& p, int item, unsigned char* smem) {
  int tid = threadIdx.x; asm volatile("" : "+v"(tid));
  const int lane = tid & 63, wid = tid >> 6, fr = lane & 15, fq = lane >> 4;
  int b, h, t0, kt0, kt1;
  if (item < 1024) { b = item >> 7; h = (item >> 4) & 7; t0 = (item & 15) * 256; kt0 = 0; kt1 = 68; }
  else { int i2 = item - 1024; b = i2 >> 3; h = i2 & 7; t0 = SL; kt0 = 64; kt1 = 68; }
  const u16* Kb = p.K + (size_t)(b * 8 + h) * ST * 96;
  const u16* Vb = p.Vt + (size_t)(b * 8 + h) * 64 * ST;
  const u16* Qb = p.Q + (size_t)(b * 8 + h) * ST * 96;
  constexpr int KS = 104, VS = 136, KSZ = 128 * KS, VSZ = 64 * VS, STG = KSZ + VSZ;
  u16* lds = (u16*)smem;
  bf16x8 qf[2][3];
#pragma unroll
  for (int nq = 0; nq < 2; ++nq)
#pragma unroll
    for (int ks = 0; ks < 3; ++ks)
      qf[nq][ks] = *(const bf16x8*)(Qb + (size_t)(t0 + wid * 32 + nq * 16 + fr) * 96 + ks * 32 + fq * 8);
  if (item < 1024) {
#pragma unroll
    for (int nq = 0; nq < 2; ++nq) {
      const int t = t0 + wid * 32 + nq * 16 + fr;
      const float* rp = p.rope + t * 32 + (fq >> 1) * 16;
      union { bf16x8 v; uint32_t u[4]; } own, oth, res;
      own.v = qf[nq][2];
#pragma unroll
      for (int i = 0; i < 4; ++i) oth.u[i] = __shfl_xor(own.u[i], 16);
      float fo[8], fp[8], fres[8];
      { uint4 t4 = make_uint4(own.u[0], own.u[1], own.u[2], own.u[3]); unpack8(t4, fo); }
      { uint4 t4 = make_uint4(oth.u[0], oth.u[1], oth.u[2], oth.u[3]); unpack8(t4, fp); }
#pragma unroll
      for (int j = 0; j < 8; ++j) {
        float cs = rp[j], sn = rp[8 + j];
        fres[j] = (fq & 1) ? (fp[j] * sn + fo[j] * cs) : (fo[j] * cs - fp[j] * sn);
      }
      uint4 r4 = pack8(fres);
      res.u[0] = r4.x; res.u[1] = r4.y; res.u[2] = r4.z; res.u[3] = r4.w;
      qf[nq][2] = res.v;
    }
  }
  f32x4 o[4][2];
#pragma unroll
  for (int m = 0; m < 4; ++m)
#pragma unroll
    for (int n = 0; n < 2; ++n) o[m][n] = (f32x4){0.f, 0.f, 0.f, 0.f};
  float mrun[2] = {-1e30f, -1e30f}, lrun[2] = {0.f, 0.f};
  const int T0 = kt0 >> 1, T1 = kt1 >> 1;
  uint4 rk0, rk1, rk2, rv0, rv1;
  const int c0_ = tid, c1_ = tid + 512, c2_ = tid + 1024;
  const int kcv0_ = c0_ & 15, kcv1_ = c1_ & 15;
  const int vslot0_ = 32 * (kcv0_ >> 2) + 16 * (kcv0_ & 1) + 4 * ((kcv0_ & 3) >> 1);
  const int vslot1_ = 32 * (kcv1_ >> 2) + 16 * (kcv1_ & 1) + 4 * ((kcv1_ & 3) >> 1);
#define ATT_LD(tt) do { const size_t key0_ = (size_t)(tt) * 128; const u16* kb_ = Kb + key0_ * 96; \
    rk0 = *(const uint4*)(kb_ + (size_t)c0_ * 8); rk1 = *(const uint4*)(kb_ + (size_t)c1_ * 8); rk2 = *(const uint4*)(kb_ + (size_t)c2_ * 8); \
    rv0 = *(const uint4*)(Vb + (size_t)(c0_ >> 4) * ST + key0_ + (c0_ & 15) * 8); \
    rv1 = *(const uint4*)(Vb + (size_t)(c1_ >> 4) * ST + key0_ + (c1_ & 15) * 8); } while (0)
#define ATT_ST(st) do { u16* sk_ = lds + (st) * STG; u16* sv_ = sk_ + KSZ; \
    *(uint4*)(sk_ + (c0_ / 12) * KS + (c0_ % 12) * 8) = rk0; *(uint4*)(sk_ + (c1_ / 12) * KS + (c1_ % 12) * 8) = rk1; *(uint4*)(sk_ + (c2_ / 12) * KS + (c2_ % 12) * 8) = rk2; \
    *(uint2*)(sv_ + (c0_ >> 4) * VS + vslot0_) = make_uint2(rv0.x, rv0.y); *(uint2*)(sv_ + (c0_ >> 4) * VS + vslot0_ + 8) = make_uint2(rv0.z, rv0.w); \
    *(uint2*)(sv_ + (c1_ >> 4) * VS + vslot1_) = make_uint2(rv1.x, rv1.y); *(uint2*)(sv_ + (c1_ >> 4) * VS + vslot1_ + 8) = make_uint2(rv1.z, rv1.w); } while (0)
  ATT_LD(T0); ATT_ST(0);
  __syncthreads();
  for (int kt = T0; kt < T1; ++kt) {
    const bool more = (kt + 1 < T1);
    if (more) ATT_LD(kt + 1);
    const int cur = (kt - T0) & 1;
    const u16* sk = lds + cur * STG;
    const u16* sv = sk + KSZ;
    f32x4 s[8][2];
#pragma unroll
    for (int m = 0; m < 8; ++m)
#pragma unroll
      for (int n = 0; n < 2; ++n) s[m][n] = (f32x4){0.f, 0.f, 0.f, 0.f};
#pragma unroll
    for (int ks = 0; ks < 3; ++ks)
#pragma unroll
      for (int mt = 0; mt < 8; ++mt) {
        bf16x8 kf = *(const bf16x8*)(sk + (mt * 16 + fr) * KS + ks * 32 + fq * 8);
#pragma unroll
        for (int nq = 0; nq < 2; ++nq) s[mt][nq] = __builtin_amdgcn_mfma_f32_16x16x32_bf16(kf, qf[nq][ks], s[mt][nq], 0, 0, 0);
      }
    bf16x8 pb[2][4];
    float mloc[2];
#pragma unroll
    for (int nq = 0; nq < 2; ++nq) {
      float mx = fmaxf(fmaxf(s[0][nq][0], s[0][nq][1]), fmaxf(s[0][nq][2], s[0][nq][3]));
#pragma unroll
      for (int mt = 1; mt < 8; ++mt) mx = fmaxf(fmaxf(mx, s[mt][nq][0]), fmaxf(fmaxf(s[mt][nq][1], s[mt][nq][2]), s[mt][nq][3]));
      mloc[nq] = mx;
    }
    if (__any((mloc[0] > mrun[0] + 8.f) || (mloc[1] > mrun[1] + 8.f))) {
      float m0 = fmaxf(mloc[0], __shfl_xor(mloc[0], 16)), m1 = fmaxf(mloc[1], __shfl_xor(mloc[1], 16));
      m0 = fmaxf(m0, __shfl_xor(m0, 32)); m1 = fmaxf(m1, __shfl_xor(m1, 32));
      const float n0 = fmaxf(mrun[0], m0), n1 = fmaxf(mrun[1], m1);
      const float a0 = __builtin_amdgcn_exp2f(mrun[0] - n0), a1 = __builtin_amdgcn_exp2f(mrun[1] - n1);
      mrun[0] = n0; mrun[1] = n1;
      lrun[0] *= a0; lrun[1] *= a1;
#pragma unroll
      for (int mtv = 0; mtv < 4; ++mtv) {
        o[mtv][0][0] *= a0; o[mtv][0][1] *= a0; o[mtv][0][2] *= a0; o[mtv][0][3] *= a0;
        o[mtv][1][0] *= a1; o[mtv][1][1] *= a1; o[mtv][1][2] *= a1; o[mtv][1][3] *= a1;
      }
    }
#pragma unroll
    for (int nq = 0; nq < 2; ++nq) {
      const float mn = mrun[nq];
      float rs = 0.f;
#pragma unroll
      for (int mt = 0; mt < 8; ++mt)
#pragma unroll
        for (int jj = 0; jj < 4; ++jj) {
          float pv = __builtin_amdgcn_exp2f(s[mt][nq][jj] - mn);
          s[mt][nq][jj] = pv;
          rs += pv;
        }
      lrun[nq] += rs;
#pragma unroll
      for (int sx = 0; sx < 4; ++sx) {
        union { uint4 u; bf16x8 v; } cv;
        cv.u.x = pack2(s[2 * sx][nq][0], s[2 * sx][nq][1]); cv.u.y = pack2(s[2 * sx][nq][2], s[2 * sx][nq][3]);
        cv.u.z = pack2(s[2 * sx + 1][nq][0], s[2 * sx + 1][nq][1]); cv.u.w = pack2(s[2 * sx + 1][nq][2], s[2 * sx + 1][nq][3]);
        pb[nq][sx] = cv.v;
      }
    }
#pragma unroll
    for (int sx = 0; sx < 4; ++sx)
#pragma unroll
      for (int mtv = 0; mtv < 4; ++mtv) {
        const bf16x8 vf = *(const bf16x8*)(sv + (mtv * 16 + fr) * VS + 32 * sx + fq * 8);
#pragma unroll
        for (int nq = 0; nq < 2; ++nq) o[mtv][nq] = __builtin_amdgcn_mfma_f32_16x16x32_bf16(vf, pb[nq][sx], o[mtv][nq], 0, 0, 0);
      }
    if (more) ATT_ST(cur ^ 1);
    __syncthreads();
  }
#undef ATT_LD
#undef ATT_ST
#pragma unroll
  for (int nq = 0; nq < 2; ++nq) {
    float lt = lrun[nq];
    lt += __shfl_xor(lt, 16);
    lt += __shfl_xor(lt, 32);
    float inv = 1.f / lt;
    size_t r = (size_t)b * ST + t0 + wid * 32 + nq * 16 + fr;
#pragma unroll
    for (int mtv = 0; mtv < 4; ++mtv) {
      uint2 ov;
      ov.x = pack2(o[mtv][nq][0] * inv, o[mtv][nq][1] * inv);
      ov.y = pack2(o[mtv][nq][2] * inv, o[mtv][nq][3] * inv);
      *(uint2*)(p.Ycat + r * 2048 + 1536 + h * 64 + mtv * 16 + fq * 4) = ov;
    }
  }
}

#define XB_TMO      128
#define XB_XCNT(j)  (256  + 64 * (j))
#define XB_XSUB(j)  (1280 + 64 * (j))
#define XB_XGEN(j)  (2304 + 64 * (j))
#define XB_TOP      3328
#define XB_TOPGEN   3392
#define XCD_BAR_WORDS 3456
#define XB_SPIN_CAP (1u << 18)
__device__ __forceinline__ unsigned xb_ld(unsigned* p)              { return __hip_atomic_load(p, __ATOMIC_RELAXED, __HIP_MEMORY_SCOPE_AGENT); }
__device__ __forceinline__ unsigned xb_add(unsigned* p, unsigned v) { return __hip_atomic_fetch_add(p, v, __ATOMIC_RELAXED, __HIP_MEMORY_SCOPE_AGENT); }
__device__ __forceinline__ unsigned xb_xcc_id() { return (unsigned)__builtin_amdgcn_s_getreg((3 << 11) | 20) & 0xFu; }
#define XB_SPIN(cond, bar) do { unsigned _sp = 0; while (cond) { __builtin_amdgcn_s_sleep(1); \
    if ((++_sp & 255u) == 0u) { if (xb_ld(&(bar)[XB_TMO])) break; if (_sp > XB_SPIN_CAP) { atomicAdd(&(bar)[XB_TMO], 1u); break; } } } } while (0)
struct XcdBarrier { unsigned* bar; unsigned x; volatile __attribute__((address_space(3))) unsigned* st; };
__device__ __forceinline__ XcdBarrier xcd_barrier_post(unsigned* bar, volatile __attribute__((address_space(3))) unsigned* st) {
  XcdBarrier b; b.bar = bar; b.x = xb_xcc_id(); b.st = st;
  if (threadIdx.x == 0) (void)xb_add(&bar[XB_XCNT(b.x)], 1u);
  return b;
}
__device__ __forceinline__ void xcd_barrier_complete(unsigned* bar, unsigned x, unsigned& nloc, unsigned& nx) {
  const unsigned G = gridDim.x * gridDim.y * gridDim.z;
  unsigned sum, cnt, mine, sp = 0u;
  for (;;) {
    sum = 0u; cnt = 0u; mine = 0u;
#pragma unroll
    for (unsigned j = 0; j < 16; ++j) { const unsigned c = xb_ld(&bar[XB_XCNT(j)]); sum += c; cnt += (c > 0u) ? 1u : 0u; mine = (j == x) ? c : mine; }
    if (sum == G) break;
    __builtin_amdgcn_s_sleep(1);
    if ((++sp & 255u) == 0u) { if (xb_ld(&bar[XB_TMO])) break; if (sp > XB_SPIN_CAP) { atomicAdd(&bar[XB_TMO], 1u); break; } }
  }
  nloc = mine > 0u ? mine : 1u; nx = cnt > 0u ? cnt : 1u;
}
__device__ __forceinline__ void xcd_barrier(const XcdBarrier& b) {
  asm volatile("s_waitcnt vmcnt(0)" ::: "memory");
  __syncthreads();
  if (threadIdx.x == 0) {
    unsigned* bar = b.bar;
    __builtin_amdgcn_s_waitcnt(0);
    unsigned nloc = b.st[0], nx = b.st[1];
    if (nloc == 0u) { xcd_barrier_complete(bar, b.x, nloc, nx); b.st[0] = nloc; b.st[1] = nx; }
    const unsigned old = xb_add(&bar[XB_XSUB(b.x)], 1u);
    const unsigned gen = old / nloc;
    if (old + 1u == (gen + 1u) * nloc) {
      __builtin_amdgcn_fence(__ATOMIC_RELEASE, "agent");
      asm volatile("s_waitcnt vmcnt(0)" ::: "memory");
      const unsigned og = xb_add(&bar[XB_TOP], 1u);
      const unsigned tg = og / nx;
      if (og + 1u == (tg + 1u) * nx) xb_add(&bar[XB_TOPGEN], 1u);
      else XB_SPIN(xb_ld(&bar[XB_TOPGEN]) == tg, bar);
      __builtin_amdgcn_fence(__ATOMIC_ACQUIRE, "agent");
      xb_add(&bar[XB_XGEN(b.x)], 1u);
      asm volatile("s_waitcnt vmcnt(0)" ::: "memory");
    } else {
      XB_SPIN(xb_ld(&bar[XB_XGEN(b.x)]) == gen, bar);
      __builtin_amdgcn_fence(__ATOMIC_ACQUIRE, "agent");
      asm volatile("s_waitcnt vmcnt(0)" ::: "memory");
    }
  }
  __syncthreads();
}

__global__ void __launch_bounds__(NTHR) mega(P p) {
  extern __shared__ __attribute__((aligned(16))) unsigned char smem[];
  __shared__ uint4 xb_words;
  cg::grid_group grid = cg::this_grid();
  if (threadIdx.x == 0) xb_words = make_uint4(0u, 0u, 0u, 0u);
  __syncthreads();
  XcdBarrier xb = xcd_barrier_post(p.bar, (volatile __attribute__((address_space(3))) unsigned*)&xb_words);
  u16* lds = (u16*)smem;
  float* sInv = (float*)(smem + 131072);
  LAS3 unsigned char* lds3 = (LAS3 unsigned char*)smem;
  const int bid = blockIdx.x, nblk = gridDim.x;
  auto nopre = [](int) {};

#ifndef NO_P0
  phase0(p, smem);
#endif
  grid.sync();

#pragma unroll 1
  for (int l = 0; l < 4; ++l) {
    int tid = threadIdx.x; asm volatile("" : "+v"(tid));
    const int lane = tid & 63, wid = tid >> 6, wr = wid >> 1, wc = wid & 1, fr = lane & 15, fq = lane >> 4;
    (void)lane; (void)wid; (void)wr; (void)wc; (void)fr; (void)fq;
#ifndef NO_CW
    convert_weights(p, l, (float*)smem, l == 0 ? 0 : 9, l == 0 ? 12 : 10, false, bid, nblk, true);
#endif
    norm_mod(p, l, p.norm1_g + l * 1024, 0, 1024);
    GSYNC();

    {
      u16* Zb1 = p.R1;
      auto epi = [=](const f32x4(&acc)[2][2][4][2], const g8::Unit& u, int wr, int wc, int fr, int fq, int) {
#pragma unroll
        for (int ai = 0; ai < 2; ++ai)
#pragma unroll
          for (int m = 0; m < 4; ++m) {
            u16* rowp = Zb1 + (size_t)(u.pm * 256 + ai * 128 + wr * 64 + m * 16 + fr) * 2560 + u.pn * 256 + wc * 32 + 8 * fq;
#pragma unroll
            for (int bj = 0; bj < 2; ++bj) {
              uint4 w;
              w.x = g8::cvt_pk_bf16(acc[ai][bj][m][0][0], acc[ai][bj][m][0][1]); w.y = g8::cvt_pk_bf16(acc[ai][bj][m][0][2], acc[ai][bj][m][0][3]);
              w.z = g8::cvt_pk_bf16(acc[ai][bj][m][1][0], acc[ai][bj][m][1][1]); w.w = g8::cvt_pk_bf16(acc[ai][bj][m][1][2], acc[ai][bj][m][1][3]);
              *(uint4*)(rowp + bj * 128) = w;
            }
          }
      };
      g8::Simple S; S.o.init(l == 3 ? 128 : 136, 10, nblk, bid); S.A = p.H; S.Bt = p.W + OFF_WINA; S.lda = 1024; S.K = 1024;
      g8::gemm_phase<true>(lds3, S, epi);
    }
    GSYNC();

    for (int rep = 0; rep < DUP_C1; ++rep)
    for (int it = bid; it < 1088 + 136; it += nblk) {
#ifndef NO_CMLP
      if (it < 1088) cmlp_item(p, l, it, smem);
#endif
#ifndef NO_CONVA
      if (it >= 1088) conva_item(p, l, it - 1088);
#endif
    }
    GSYNC();

    {
      u16* Zb2 = p.R1;
      auto epi = [=](const f32x4(&acc)[2][2][4][2], const g8::Unit& u, int wr, int wc, int fr, int fq, int) {
#pragma unroll
        for (int ai = 0; ai < 2; ++ai)
#pragma unroll
          for (int m = 0; m < 4; ++m) {
            u16* rowp = Zb2 + (size_t)(u.pm * 256 + ai * 128 + wr * 64 + m * 16 + fr) * 1792 + u.pn * 256 + wc * 32 + 8 * fq;
#pragma unroll
            for (int bj = 0; bj < 2; ++bj) {
              uint4 w;
              w.x = g8::cvt_pk_bf16(acc[ai][bj][m][0][0], acc[ai][bj][m][0][1]); w.y = g8::cvt_pk_bf16(acc[ai][bj][m][0][2], acc[ai][bj][m][0][3]);
              w.z = g8::cvt_pk_bf16(acc[ai][bj][m][1][0], acc[ai][bj][m][1][1]); w.w = g8::cvt_pk_bf16(acc[ai][bj][m][1][2], acc[ai][bj][m][1][3]);
              *(uint4*)(rowp + bj * 128) = w;
            }
          }
        const int pn = u.pn;
        if (pn == 2 || pn == 5 || pn == 6) {
          const bool inc0 = (pn != 5) || (wc >= 1);
          const bool inc1 = (pn == 2) || (pn == 5) || (wc == 0);
          float* dst = p.ssq + (size_t)(u.pm * 256 + wr * 64 + fr) * 12 + (pn == 2 ? 0 : (pn == 5 ? 4 : 8)) + wc;
#pragma unroll
          for (int ai = 0; ai < 2; ++ai)
#pragma unroll
            for (int m = 0; m < 4; ++m) {
              float ss = 0.f;
#pragma unroll
              for (int n = 0; n < 2; ++n)
#pragma unroll
                for (int jj = 0; jj < 4; ++jj) {
                  const float v0 = acc[ai][0][m][n][jj], v1 = acc[ai][1][m][n][jj];
                  ss += (inc0 ? v0 * v0 : 0.f) + (inc1 ? v1 * v1 : 0.f);
                }
              ss += __shfl_xor(ss, 16);
              ss += __shfl_xor(ss, 32);
              if (fq == 0) dst[(ai * 128 + m * 16) * 12] = ss;
              asm volatile("" ::: "memory");
            }
        }
      };
      g8::Simple S; S.o.init(136, 7, nblk, bid); S.A = p.H; S.Bt = p.W + OFF_WINB; S.lda = 1024; S.K = 1024;
      g8::gemm_phase<true>(lds3, S, epi);
    }
    GSYNC();

    for (int rep = 0; rep < DUP_C2; ++rep)
    {
      const u16* Zb2 = p.R1;
      for (int r2 = 0; r2 < DUP_LRU1; ++r2) lru_run<1>(p, l, bid, nblk, smem);
      for (int r2 = 0; r2 < DUP_PROJ; ++r2) {
      {
        struct ProjSched {
          g8::Order o; const u16* Zb2; const u16* Wq; const u16* Wkv;
          __device__ bool next(int i, g8::Unit& u) const {
            int pm, pn; if (!o.tile(i, pm, pn)) return false;
            u.pm = pm; u.lda = 1792;
            if (pn < 3) { u.pn = pn; u.aux = 0; u.K = 384; u.A = (const char*)(Zb2 + (size_t)pm * 256 * 1792 + 1312); u.B = (const char*)(Wq + (size_t)pn * 256 * 384); }
            else { u.pn = pn - 3; u.aux = 1; u.K = 256; u.A = (const char*)(Zb2 + (size_t)pm * 256 * 1792 + 512); u.B = (const char*)(Wkv + (size_t)(pn - 3) * 256 * 256); }
            return true;
          }
        };
        ProjSched S; S.o.init(136, 7, nblk, bid); S.Zb2 = Zb2; S.Wq = p.W + OFF_WQUP; S.Wkv = p.W + OFF_WKVUP;
        auto epi = [=](const f32x4(&acc)[2][2][4][2], const g8::Unit& u, int wr, int wc, int fr, int fq, int) {
          const int row0 = u.pm * 256, b = row0 / ST, tb = row0 - b * ST;
          const int kv = u.aux;
          const float* sq = p.ssq + (size_t)row0 * 12;
          const float invn = kv ? (1.f / 256.f) : (1.f / 384.f);
#pragma unroll
          for (int ai = 0; ai < 2; ++ai)
#pragma unroll
            for (int m = 0; m < 4; ++m) {
              const int rl = ai * 128 + wr * 64 + m * 16 + fr;
              const float4 p0 = *(const float4*)(sq + rl * 12), p1 = *(const float4*)(sq + rl * 12 + 4), p2 = *(const float4*)(sq + rl * 12 + 8);
              const float ssum = kv ? ((p0.x + p0.y) + (p0.z + p0.w)) : (((p1.x + p1.y) + (p1.z + p1.w)) + ((p2.x + p2.y) + (p2.z + p2.w)));
              const float inv = rsqrtf(ssum * invn + EPS);
              const int t = tb + rl;
#pragma unroll
              for (int bj = 0; bj < 2; ++bj) {
                const int c8 = u.pn * 256 + bj * 128 + wc * 32 + 8 * fq;
                float v[8];
#pragma unroll
                for (int n = 0; n < 2; ++n)
#pragma unroll
                  for (int jj = 0; jj < 4; ++jj) v[n * 4 + jj] = acc[ai][bj][m][n][jj] * inv;
                if (!kv) {
                  const int head = c8 / 96, d = c8 - head * 96;
                  *(uint4*)(p.Q + ((size_t)(b * 8 + head) * ST + t) * 96 + d) = pack8(v);
                } else {
                  const int head = c8 >> 7, w = c8 & 127;
                  if (wc < 2) {
                    *(uint4*)(p.K + ((size_t)(b * 8 + head) * ST + t) * 96 + w) = pack8(v);
                  } else {
                    u16* vp = p.Vt + ((size_t)(b * 8 + head) * 64 + (w - 64)) * ST + t;
#pragma unroll
                    for (int e = 0; e < 8; ++e) vp[(size_t)e * ST] = f2bf(v[e]);
                  }
                }
              }
              asm volatile("" ::: "memory");
            }
        };
        g8::gemm_phase<true>(lds3, S, epi);
      }
      {
        const int off = 2176;
        int first = bid;
        if (first < off) { int kk = (off - first + nblk - 1) / nblk; first += kk * nblk; }
        for (int it = first; it < off + 136; it += nblk) krope_item(p, it - off);
      }
      }
    }
    GSYNC();

    for (int rep = 0; rep < DUP_ATTN; ++rep)
    {
      int it = bid;
      for (; it < 1088; it += nblk) attn_item(p, it, smem);
      for (int r2 = 0; r2 < DUP_LRU3; ++r2) lru_run<3>(p, l, it - 1088, nblk, smem);
    }
    GSYNC();

    {
      u16* Mg = p.R1;
      const int ntile = 272 * 8;
      int te = threadIdx.x; asm volatile("" : "+v"(te));
      const int lane_e = te & 63, wid_e = te >> 6;
      const int wr = wid_e >> 1, wc = wid_e & 1, fr = lane_e & 15, fq = lane_e >> 4;
      int estr = nblk; asm volatile("" : "+s"(estr));
      const int skipctx = (l == 3);
      int id = bid;
      while (id < ntile && skipctx && (((id >> 6) * 8 + (id & 7)) % 34) >= 32) id += estr;
      bool primed = false;
      while (id < ntile) {
        const int rt = (id >> 6) * 8 + (id & 7), ct = (id & 63) >> 3;
        int nid = id + estr;
        while (nid < ntile && skipctx && (((nid >> 6) * 8 + (nid & 7)) % 34) >= 32) nid += estr;
        const bool more_tiles = nid < ntile;
        const int nrt = (nid >> 6) * 8 + (nid & 7), nct = (nid & 63) >> 3;
        f32x4 mg[2][4];
#pragma unroll
        for (int m = 0; m < 2; ++m)
#pragma unroll
          for (int n = 0; n < 4; ++n) mg[m][n] = (f32x4){0.f, 0.f, 0.f, 0.f};
        for (int nb = 0; nb < 4; ++nb) {
          f32x4 ag[2][4], ay[2][4];
#pragma unroll
          for (int m = 0; m < 2; ++m)
#pragma unroll
            for (int n = 0; n < 4; ++n) { ag[m][n] = (f32x4){0.f, 0.f, 0.f, 0.f}; ay[m][n] = (f32x4){0.f, 0.f, 0.f, 0.f}; }
          const u16* gA = p.H + (size_t)rt * 128 * 1024;
          const u16* gB = p.W + OFF_WGATE + (size_t)(nb * 1024 + ct * 128) * 1024;
          const u16* bA = p.Ycat + (size_t)rt * 128 * 2048 + nb * 512;
          const u16* bB = p.W + OFF_WBR + (size_t)(nb * 1024 + ct * 128) * 512;
          const bool last_nb = (nb == 3);
          const u16* xA = last_nb ? p.H + (size_t)nrt * 128 * 1024 : gA;
          const u16* xB = last_nb ? p.W + OFF_WGATE + (size_t)(nct * 128) * 1024 : p.W + OFF_WGATE + (size_t)((nb + 1) * 1024 + ct * 128) * 1024;
          gemm_main128(gA, 1024, gB, 1024, 1024, bA, 2048, bB, 512, true, primed, lds3, ag);
          gemm_main128(bA, 2048, bB, 512, 512, xA, 1024, xB, 1024, !last_nb || more_tiles, true, lds3, ay);
          primed = true;
#pragma unroll
          for (int m = 0; m < 2; ++m)
#pragma unroll
            for (int n = 0; n < 4; ++n)
#pragma unroll
              for (int jj = 0; jj < 4; ++jj) mg[m][n][jj] += sigmoidf_(ag[m][n][jj]) * ay[m][n][jj];
        }
#pragma unroll
        for (int m = 0; m < 2; ++m) {
          u16* dst = Mg + (size_t)(rt * 128 + wr * 32 + m * 16 + fq * 4) * 1024 + ct * 128 + wc * 64 + fr;
#pragma unroll
          for (int n = 0; n < 4; ++n)
#pragma unroll
            for (int jj = 0; jj < 4; ++jj) dst[jj * 1024 + n * 16] = f2bf(mg[m][n][jj]);
          asm volatile("" ::: "memory");
        }
        id = nid;
      }
    }
    GSYNC();

    {
      auto epi = [=](const f32x4(&acc)[2][2][4][2], const g8::Unit& u, int wr, int wc, int fr, int fq, int) {
        float* xb = xrow_ptr(p, u.pm * 256);
        const float* gate = p.mod + ((size_t)l * 9 + mod_idx(u.pm * 256)) * 6144 + 2048 + u.pn * 256 + wc * 32 + 4 * fq;
        f32x4 gv[2][2];
#pragma unroll
        for (int bj = 0; bj < 2; ++bj)
#pragma unroll
          for (int n = 0; n < 2; ++n) gv[bj][n] = *(const f32x4*)(gate + bj * 128 + n * 16);
#pragma unroll
        for (int ai = 0; ai < 2; ++ai)
#pragma unroll
          for (int m = 0; m < 4; ++m) {
            float* rowp = xb + (size_t)(ai * 128 + wr * 64 + m * 16 + fr) * DM + u.pn * 256 + wc * 32 + 4 * fq;
#pragma unroll
            for (int bj = 0; bj < 2; ++bj)
#pragma unroll
              for (int n = 0; n < 2; ++n) {
                f32x4 xv = *(const f32x4*)(rowp + bj * 128 + n * 16);
                xv += gv[bj][n] * acc[ai][bj][m][n];
                *(f32x4*)(rowp + bj * 128 + n * 16) = xv;
              }
          }
      };
      g8::Simple S; S.o.init(l == 3 ? 128 : 136, 4, nblk, bid); S.A = p.R1; S.Bt = p.W + OFF_WOUT; S.lda = 1024; S.K = 1024;
      g8::gemm_phase<false>(lds3, S, epi);
    }
    GSYNC();

    norm_mod(p, l, p.norm2_g + l * 1024, 3072, 4096);
    GSYNC();

    {
      u16* U = p.R1;
      auto epi = [=](const f32x4(&acc)[2][2][4][2], const g8::Unit& u, int wr, int wc, int fr, int fq, int) {
#pragma unroll
        for (int ai = 0; ai < 2; ++ai)
#pragma unroll
          for (int m = 0; m < 4; ++m) {
            u16* rowp = U + (size_t)(u.pm * 256 + ai * 128 + wr * 64 + m * 16 + fr) * 2816 + u.pn * 128 + wc * 32 + 8 * fq;
            float v[8];
#pragma unroll
            for (int n = 0; n < 2; ++n)
#pragma unroll
              for (int jj = 0; jj < 4; ++jj) v[n * 4 + jj] = siluf_(acc[ai][0][m][n][jj]) * acc[ai][1][m][n][jj];
            uint4 w;
            w.x = g8::cvt_pk_bf16(v[0], v[1]); w.y = g8::cvt_pk_bf16(v[2], v[3]); w.z = g8::cvt_pk_bf16(v[4], v[5]); w.w = g8::cvt_pk_bf16(v[6], v[7]);
            *(uint4*)rowp = w;
          }
      };
      g8::Simple S; S.o.init(l == 3 ? 128 : 136, 22, nblk, bid); S.A = p.H; S.Bt = p.W + OFF_WFF13; S.lda = 1024; S.K = 1024;
      g8::gemm_phase<true>(lds3, S, epi);
    }
    GSYNC();

    {
      auto epi = [=](const f32x4(&acc)[2][2][4][2], const g8::Unit& u, int wr, int wc, int fr, int fq, int) {
        float* xb = xrow_ptr(p, u.pm * 256);
        const float* gate = p.mod + ((size_t)l * 9 + mod_idx(u.pm * 256)) * 6144 + 5120 + u.pn * 256 + wc * 32 + 4 * fq;
        f32x4 gv[2][2];
#pragma unroll
        for (int bj = 0; bj < 2; ++bj)
#pragma unroll
          for (int n = 0; n < 2; ++n) gv[bj][n] = *(const f32x4*)(gate + bj * 128 + n * 16);
#pragma unroll
        for (int ai = 0; ai < 2; ++ai)
#pragma unroll
          for (int m = 0; m < 4; ++m) {
            float* rowp = xb + (size_t)(ai * 128 + wr * 64 + m * 16 + fr) * DM + u.pn * 256 + wc * 32 + 4 * fq;
#pragma unroll
            for (int bj = 0; bj < 2; ++bj)
#pragma unroll
              for (int n = 0; n < 2; ++n) {
                f32x4 xv = *(const f32x4*)(rowp + bj * 128 + n * 16);
                xv += gv[bj][n] * acc[ai][bj][m][n];
                *(f32x4*)(rowp + bj * 128 + n * 16) = xv;
              }
          }
      };
      g8::Simple S; S.o.init(l == 3 ? 128 : 136, 4, nblk, bid); S.A = p.R1; S.Bt = p.W + OFF_WFF2; S.lda = 2816; S.K = 2816;
      g8::gemm_phase<false>(lds3, S, epi);
      if (l < 3 && nblk > 32 && bid >= 32) convert_weights(p, l + 1, (float*)smem, 0, 12, true, bid - 32, nblk - 32, false);
    }
    GSYNC();

  }

  const int lane = threadIdx.x & 63, wid = threadIdx.x >> 6;
  for (int r = bid * 8 + wid; r < NB * SL; r += nblk * 8) {
    float* xr = p.out + (size_t)r * DM;
    float4 v[4];
    float ss = 0.f;
#pragma unroll
    for (int i = 0; i < 4; ++i) {
      v[i] = *(const float4*)(xr + i * 256 + lane * 4);
      ss += v[i].x * v[i].x + v[i].y * v[i].y + v[i].z * v[i].z + v[i].w * v[i].w;
    }
    ss = wave_sum(ss);
    const float inv = rsqrtf(ss * (1.f / 1024.f) + EPS);
#pragma unroll
    for (int i = 0; i < 4; ++i) {
      float4 gg = *(const float4*)(p.final_g + i * 256 + lane * 4);
      float4 ov;
      ov.x = v[i].x * inv * gg.x; ov.y = v[i].y * inv * gg.y; ov.z = v[i].z * inv * gg.z; ov.w = v[i].w * inv * gg.w;
      *(float4*)(xr + i * 256 + lane * 4) = ov;
    }
  }
}

extern "C" void kernel_launch(void* const* d_in, const int* in_sizes, int n_in, void* d_out, int out_size, void* d_ws,
                              size_t ws_size, hipStream_t stream) {
  static int grid_blocks = 0;
  if (!grid_blocks) {
    int dev = 0, cus = 0, per_cu = 0;
    hipGetDevice(&dev);
    hipDeviceGetAttribute(&cus, hipDeviceAttributeMultiprocessorCount, dev);
    hipFuncSetAttribute((const void*)mega, hipFuncAttributeMaxDynamicSharedMemorySize, LDS_BYTES);
    hipOccupancyMaxActiveBlocksPerMultiprocessor(&per_cu, (const void*)mega, NTHR, LDS_BYTES);
    if (per_cu < 1) per_cu = 1;
    if (per_cu > 1) per_cu = 1;
    grid_blocks = cus * per_cu;
    (void)hipGetLastError();
  }
  P p{};
  const float** pf = (const float**)&p;
  for (int i = 0; i < 31; ++i) pf[i] = (const float*)d_in[i];
  p.out = (float*)d_out;
  size_t off = 0;
  auto take = [&](size_t bytes) { void* r = (char*)d_ws + off; off += (bytes + 255) & ~(size_t)255; return r; };
  p.Xc = (float*)take((size_t)NB * SC * DM * 4);
  p.mod = (float*)take((size_t)4 * 9 * 6144 * 4);
  p.rope = (float*)take((size_t)SL * 32 * 4);
  p.summ = (float2*)take((size_t)NB * 2 * 512 * 34 * 8);
  p.ssq = (float*)take((size_t)12 * MTOT * 4);
  p.bar = (unsigned*)take((size_t)XCD_BAR_WORDS * 4);
  p.W = (u16*)take((size_t)W_ELEMS * 2);
  p.H = (u16*)take((size_t)MTOT * 1024 * 2);
  p.Ycat = (u16*)take((size_t)MTOT * 2048 * 2);
  p.R1 = (u16*)take((size_t)MTOT * 2560 * 2);
  p.K = (u16*)take((size_t)MTOT * 768 * 2);
  p.Vt = (u16*)take((size_t)MTOT * 512 * 2);
  p.Q = p.R1 + (size_t)MTOT * 1792;
  if (off > ws_size) { fprintf(stderr, "workspace too small: need %zu have %zu\n", off, ws_size); return; }
  (void)hipMemsetAsync(p.bar, 0, (size_t)XCD_BAR_WORDS * 4, stream);
  void* args[] = {&p};
  hipError_t e = hipLaunchCooperativeKernel((const void*)mega, dim3(grid_blocks), dim3(NTHR), args, LDS_BYTES, stream);
  if (e != hipSuccess) fprintf(stderr, "cooperative launch failed: %s (grid %d)\n", hipGetErrorString(e), grid_blocks);
}
```

```cpp
#include <hip/hip_runtime.h>
#include <hip/hip_bf16.h>
#include <hip/hip_cooperative_groups.h>
#include <cstdio>
#include <cstdint>
namespace cg = cooperative_groups;

typedef unsigned short u16;
using bf16x8 = __attribute__((ext_vector_type(8))) short;
using f32x4 = __attribute__((ext_vector_type(4))) float;
#define LAS3 __attribute__((address_space(3)))

#define NB 8
#define SL 4096
#define SC 256
#define ST 4352
#define MTOT 34816
#define DM 1024
#define NTHR 512
#define EPS 1e-6f
#define LDS_BYTES 159744
#define DUP_ATTN 1
#define DUP_C1 1
#define DUP_C2 1
#define DUP_E 1
#define EXTRA_SYNC 0
#define GSYNC() do { xcd_barrier(xb); for (int q_ = 0; q_ < EXTRA_SYNC; ++q_) xcd_barrier(xb); } while (0)
#define DUP_LRU1 1
#define DUP_LRU3 1
#define DUP_PROJ 1

#define OFF_WINA 0
#define OFF_WINB (OFF_WINA + 2560 * 1024)
#define OFF_WGATE (OFF_WINB + 1792 * 1024)
#define OFF_WBR (OFF_WGATE + 4096 * 1024)
#define OFF_WOUT (OFF_WBR + 4 * 1024 * 512)
#define OFF_WFF13 (OFF_WOUT + 1024 * 1024)
#define OFF_WFF2 (OFF_WFF13 + 5632 * 1024)
#define OFF_WQUP (OFF_WFF2 + 1024 * 2816)
#define OFF_WKVUP (OFF_WQUP + 768 * 384)
#define OFF_WS (OFF_WKVUP + 1024 * 256)
#define OFF_WLRU (OFF_WS + 4 * 128 * 128)
#define W_ELEMS (OFF_WLRU + 2 * 8 * 4 * 32 * 64)

struct P {
  const float *x, *c, *ctx, *c_ctx, *w_mod, *b_mod, *norm1_g, *norm2_g, *w_in, *conv_a_w, *lru_conv_w, *lru_conv_b,
      *lru_w_a, *lru_b_a, *lru_w_x, *lru_b_x, *lru_lam, *cmlp_ln_g, *cmlp_ln_b, *cmlp_w_s, *cmlp_b_s, *q_norm_g,
      *kv_norm_g, *w_q_up, *w_kv_up, *w_branch, *w_out, *w_ff1, *w_ff3, *w_ff2, *final_g;
  float *out, *Xc, *mod, *rope;
  float2* summ;
  float* ssq;
  unsigned* bar;
  u16 *W, *H, *Ycat, *R1, *Q, *K, *Vt;
};

__device__ __forceinline__ uint32_t pack2(float a, float b) { uint32_t r; asm("v_cvt_pk_bf16_f32 %0, %1, %2" : "=v"(r) : "v"(a), "v"(b)); return r; }
__device__ __forceinline__ u16 f2bf(float f) { return (u16)(pack2(f, f) & 0xffffu); }
__device__ __forceinline__ float bf2f(u16 h) { return __uint_as_float(((uint32_t)h) << 16); }
__device__ __forceinline__ float sigmoidf_(float x) { return __builtin_amdgcn_rcpf(1.f + __expf(-x)); }
__device__ __forceinline__ float sigmoid_rcp_(float x) { return __builtin_amdgcn_rcpf(1.f + __expf(-x)); }
__device__ __forceinline__ float siluf_(float x) { return x * __builtin_amdgcn_rcpf(1.f + __expf(-x)); }
__device__ __forceinline__ float geluf_(float x) {
  float u = 0.7978845608028654f * (x + 0.044715f * x * x * x);
  return x * __builtin_amdgcn_rcpf(1.f + __expf(-2.f * u));
}
__device__ __forceinline__ void unpack8(const uint4& v, float* f) {
  f[0] = __uint_as_float(v.x << 16); f[1] = __uint_as_float(v.x & 0xffff0000u);
  f[2] = __uint_as_float(v.y << 16); f[3] = __uint_as_float(v.y & 0xffff0000u);
  f[4] = __uint_as_float(v.z << 16); f[5] = __uint_as_float(v.z & 0xffff0000u);
  f[6] = __uint_as_float(v.w << 16); f[7] = __uint_as_float(v.w & 0xffff0000u);
}
__device__ __forceinline__ uint4 pack8(const float* f) {
  uint4 v; v.x = pack2(f[0], f[1]); v.y = pack2(f[2], f[3]); v.z = pack2(f[4], f[5]); v.w = pack2(f[6], f[7]); return v;
}
template <int CTRL, int ROWMASK>
__device__ __forceinline__ float dpp0f(float src) {
  return __int_as_float(__builtin_amdgcn_update_dpp(0, __float_as_int(src), CTRL, ROWMASK, 0xf, false));
}
__device__ __forceinline__ float wave_sum(float v) {
  v += dpp0f<0x111, 0xf>(v); v += dpp0f<0x112, 0xf>(v); v += dpp0f<0x114, 0xf>(v); v += dpp0f<0x118, 0xf>(v);
  v += dpp0f<0x142, 0xa>(v); v += dpp0f<0x143, 0xc>(v);
  return __int_as_float(__builtin_amdgcn_readlane(__float_as_int(v), 63));
}
__device__ __forceinline__ float* xrow_ptr(const P& p, int r) {
  int b = r / ST, t = r - b * ST;
  return t < SL ? p.out + ((size_t)(b * SL + t)) * DM : p.Xc + ((size_t)(b * SC + t - SL)) * DM;
}
__device__ __forceinline__ const float* xin_ptr(const P& p, int r) {
  int b = r / ST, t = r - b * ST;
  return t < SL ? p.x + ((size_t)(b * SL + t)) * DM : p.ctx + ((size_t)(b * SC + t - SL)) * DM;
}
__device__ __forceinline__ int mod_idx(int r) { int b = r / ST, t = r - b * ST; return t < SL ? b : 8; }

template <int MT>
__device__ __forceinline__ void gemm_main(const u16* __restrict__ A, int lda, const u16* __restrict__ B, int ldb, int K,
                                          u16* lds, f32x4 (&acc)[MT][4]) {
  constexpr int BM = MT * 64;
  constexpr int ASZ = BM * 72, BSZ = 128 * 72, STG = ASZ + BSZ;
  int tid = threadIdx.x; asm volatile("" : "+v"(tid));
  const int lane = tid & 63, wid = tid >> 6, wr = wid >> 1, wc = wid & 1, fr = lane & 15, fq = lane >> 4;
  uint4 ra[MT], rb[2];
  const int nk = K >> 6;
  const int crow = tid >> 3, ckc = (tid & 7) * 8;
#pragma unroll
  for (int i = 0; i < MT; ++i) ra[i] = *(const uint4*)(A + (size_t)(crow + i * 64) * lda + ckc);
#pragma unroll
  for (int i = 0; i < 2; ++i) rb[i] = *(const uint4*)(B + (size_t)(crow + i * 64) * ldb + ckc);
  {
    u16* sa = lds; u16* sb = lds + ASZ;
#pragma unroll
    for (int i = 0; i < MT; ++i) *(uint4*)(sa + (crow + i * 64) * 72 + ckc) = ra[i];
#pragma unroll
    for (int i = 0; i < 2; ++i) *(uint4*)(sb + (crow + i * 64) * 72 + ckc) = rb[i];
  }
  __syncthreads();
  for (int kt = 0; kt < nk; ++kt) {
    const bool more = (kt + 1 < nk);
    if (more) {
      const int k0 = (kt + 1) * 64 + ckc;
#pragma unroll
      for (int i = 0; i < MT; ++i) ra[i] = *(const uint4*)(A + (size_t)(crow + i * 64) * lda + k0);
#pragma unroll
      for (int i = 0; i < 2; ++i) rb[i] = *(const uint4*)(B + (size_t)(crow + i * 64) * ldb + k0);
    }
    const u16* sa = lds + (kt & 1) * STG;
    const u16* sb = sa + ASZ;
#pragma unroll
    for (int ks = 0; ks < 2; ++ks) {
      bf16x8 a[MT], b[4];
#pragma unroll
      for (int m = 0; m < MT; ++m) a[m] = *(const bf16x8*)(sa + (wr * MT * 16 + m * 16 + fr) * 72 + ks * 32 + fq * 8);
#pragma unroll
      for (int n = 0; n < 4; ++n) b[n] = *(const bf16x8*)(sb + (wc * 64 + n * 16 + fr) * 72 + ks * 32 + fq * 8);
#pragma unroll
      for (int m = 0; m < MT; ++m)
#pragma unroll
        for (int n = 0; n < 4; ++n) acc[m][n] = __builtin_amdgcn_mfma_f32_16x16x32_bf16(a[m], b[n], acc[m][n], 0, 0, 0);
    }
    if (more) {
      u16* wa = lds + ((kt + 1) & 1) * STG; u16* wb = wa + ASZ;
#pragma unroll
      for (int i = 0; i < MT; ++i) *(uint4*)(wa + (crow + i * 64) * 72 + ckc) = ra[i];
#pragma unroll
      for (int i = 0; i < 2; ++i) *(uint4*)(wb + (crow + i * 64) * 72 + ckc) = rb[i];
    }
    __syncthreads();
  }
}

__device__ __forceinline__ void gemm_main128(const u16* __restrict__ A, int lda, const u16* __restrict__ B, int ldb, int K,
                                             const u16* __restrict__ nA, int nlda, const u16* __restrict__ nB, int nldb, bool has_next, bool primed,
                                             LAS3 unsigned char* lds, f32x4 (&acc)[2][4]) {
  constexpr int OPB = 128 * 256, STGB = 2 * OPB;
  int tid = threadIdx.x; asm volatile("" : "+v"(tid));
  const int lane = tid & 63, wid = __builtin_amdgcn_readfirstlane(tid >> 6), wr = wid >> 1, wc = wid & 1, fr = lane & 15, fq = lane >> 4;
  const int drow = wid * 4 + (lane >> 4), dslot = lane & 15;
  const int gch = (dslot ^ (drow & 15)) * 8;
  const unsigned goffA = (unsigned)(drow * lda + gch), goffB = (unsigned)(drow * ldb + gch);
  const unsigned rstepA = (unsigned)(32 * lda), rstepB = (unsigned)(32 * ldb);
  const int nk = K >> 7;
#define G128_DMA(st, kt) do { const int k0_ = (kt) * 128; \
    _Pragma("unroll") for (int i_ = 0; i_ < 4; ++i_) { \
      __builtin_amdgcn_global_load_lds((const unsigned*)(A + goffA + i_ * rstepA + k0_), (LAS3 unsigned*)(lds + (st) * STGB + (i_ * 8 + wid) * 1024), 16, 0, 0); \
      __builtin_amdgcn_global_load_lds((const unsigned*)(B + goffB + i_ * rstepB + k0_), (LAS3 unsigned*)(lds + (st) * STGB + OPB + (i_ * 8 + wid) * 1024), 16, 0, 0); } } while (0)
#define G128_MMA(st) do { LAS3 const unsigned char* sa = lds + (st) * STGB; LAS3 const unsigned char* sb = sa + OPB; \
    _Pragma("unroll") for (int ks = 0; ks < 4; ++ks) { bf16x8 a[2], b[4]; \
      _Pragma("unroll") for (int m = 0; m < 2; ++m) a[m] = *(LAS3 const bf16x8*)(sa + (wr * 32 + m * 16 + fr) * 256 + (((ks * 4 + fq) ^ fr) * 16)); \
      _Pragma("unroll") for (int n = 0; n < 4; ++n) b[n] = *(LAS3 const bf16x8*)(sb + (wc * 64 + n * 16 + fr) * 256 + (((ks * 4 + fq) ^ fr) * 16)); \
      __builtin_amdgcn_s_setprio(1); \
      _Pragma("unroll") for (int m = 0; m < 2; ++m) _Pragma("unroll") for (int n = 0; n < 4; ++n) \
        acc[m][n] = __builtin_amdgcn_mfma_f32_16x16x32_bf16(a[m], b[n], acc[m][n], 0, 0, 0); \
      __builtin_amdgcn_s_setprio(0); } } while (0)
  if (!primed) {
    G128_DMA(0, 0);
    asm volatile("s_waitcnt vmcnt(0)" ::: "memory");
    __syncthreads();
  }
  for (int kt = 0; kt < nk; ++kt) {
    if (kt + 1 < nk) G128_DMA((kt + 1) & 1, kt + 1);
    else if (has_next) {
      const unsigned ngA = (unsigned)(drow * nlda + gch), ngB = (unsigned)(drow * nldb + gch);
#pragma unroll
      for (int i_ = 0; i_ < 4; ++i_) {
        __builtin_amdgcn_global_load_lds((const unsigned*)(nA + ngA + i_ * 32 * nlda), (LAS3 unsigned*)(lds + (i_ * 8 + wid) * 1024), 16, 0, 0);
        __builtin_amdgcn_global_load_lds((const unsigned*)(nB + ngB + i_ * 32 * nldb), (LAS3 unsigned*)(lds + OPB + (i_ * 8 + wid) * 1024), 16, 0, 0);
      }
    }
    G128_MMA(kt & 1);
    asm volatile("s_waitcnt vmcnt(0)" ::: "memory");
    __syncthreads();
  }
#undef G128_DMA
#undef G128_MMA
}

template <int MT, class Pre, class Epi>
__device__ __forceinline__ void gemm_phase(const u16* A, int lda, const u16* B, int ldb, int K, int nct, u16* lds, Pre pre,
                                           Epi epi, int id0, int idstride, int idoff) {
  constexpr int BM = MT * 64;
  const int nrt = MTOT / BM, ntile = nrt * nct;
  int first = id0;
  if (first < idoff) { int kk = (idoff - first + idstride - 1) / idstride; first += kk * idstride; }
  for (int gid = first; gid < idoff + ntile; gid += idstride) {
    int id = gid - idoff;
    int g = id / (8 * nct), rem = id - g * 8 * nct;
    int ct = rem >> 3, rt = g * 8 + (rem & 7);
    f32x4 acc[MT][4];
#pragma unroll
    for (int m = 0; m < MT; ++m)
#pragma unroll
      for (int n = 0; n < 4; ++n) acc[m][n] = (f32x4){0.f, 0.f, 0.f, 0.f};
    pre(rt * BM);
    gemm_main<MT>(A + (size_t)rt * BM * lda, lda, B + (size_t)ct * 128 * ldb, ldb, K, lds, acc);
    epi(rt * BM, ct * 128, acc);
    __syncthreads();
  }
}

namespace g8 {
constexpr int BM = 256, BK = 64, HALF = 128, HTB = HALF * BK * 2, STAGE_BYTES = 8 * HTB, NXCD = 8, WGM = 8;
__device__ __forceinline__ int lds_byte(int r, int c) { const int st = (r >> 4) * 2 + (c >> 5), rr = r & 15, cc = c & 31, ob = rr * 64 + cc * 2; return st * 1024 + (ob ^ (((ob >> 9) & 1) << 5)); }
__device__ __forceinline__ void stage_rc(int b, int& R, int& C) { const int st = b / 1024, sb = b % 1024, swz = sb ^ (((sb >> 9) & 1) << 5); R = (st >> 1) * 16 + swz / 64; C = (st & 1) * 32 + (swz % 64) / 2; }
__device__ __forceinline__ int perm32(int rho) { const int n = rho >> 4, i = rho & 15; return 8 * (i >> 2) + 4 * n + (i & 3); }
struct Unit { const char* A; const char* B; int lda, K, pm, pn, aux; };
struct Order {
  int nM, nN, nwg, G, c;
  __device__ void init(int nM_, int nN_, int G_, int c_) { nM = nM_; nN = nN_; nwg = nM * nN; G = G_; c = c_; }
  __device__ bool tile(int i, int& pm, int& pn) const {
    const long L = (long)i * G + c; if (L >= nwg) return false;
    int wgid = (int)L; { const int q = nwg / NXCD, r = nwg % NXCD, xcd = wgid % NXCD, off = wgid / NXCD; wgid = (xcd < r ? xcd * (q + 1) : r * (q + 1) + (xcd - r) * q) + off; }
    const int nig = WGM * nN, gid = wgid / nig, fm = gid * WGM, gsz = (nM - fm) < WGM ? (nM - fm) : WGM;
    pm = fm + ((wgid % nig) % gsz); pn = (wgid % nig) / gsz;
    if (nM == 128) pm += pm >> 4;
    return true;
  }
};
struct Simple {
  Order o; const u16* A; const u16* Bt; int lda, K;
  __device__ bool next(int i, Unit& u) const {
    int pm, pn; if (!o.tile(i, pm, pn)) return false;
    u.A = (const char*)(A + (size_t)pm * 256 * lda); u.B = (const char*)(Bt + (size_t)pn * 256 * K); u.lda = lda; u.K = K; u.pm = pm; u.pn = pn; u.aux = 0; return true;
  }
};
__device__ __forceinline__ unsigned cvt_pk_bf16(float lo, float hi) { unsigned r; asm volatile("v_cvt_pk_bf16_f32 %0, %1, %2" : "=v"(r) : "v"(lo), "v"(hi)); return r; }

template <bool PERM, class Sched, class Epi>
__device__ __forceinline__ void gemm_phase(LAS3 unsigned char* lds, const Sched& S, const Epi& E) {
  int tid = threadIdx.x; asm volatile("" : "+v"(tid));
  const int wid = __builtin_amdgcn_readfirstlane(tid >> 6), lane = tid & 63, wr = wid >> 2, wc = wid & 3, fr = lane & 15, fq = lane >> 4;
  const size_t kstep = (size_t)(BK * 2);
#define G8_VOFF(LDA_, K_) do { int _t2 = tid; asm volatile("" : "+v"(_t2)); _Pragma("unroll") for (int _i = 0; _i < 2; ++_i) { int R, C; stage_rc(_t2 * 16 + _i * 8192, R, C); \
    const int Rb = PERM ? ((R & ~31) + perm32(R & 31)) : R; voffA[_i] = (unsigned)(R * (LDA_) + C) * 2u; voffB[_i] = (unsigned)(Rb * (K_) + C) * 2u; } \
    hstepA = (size_t)HALF * (LDA_) * 2; hstepB = (size_t)HALF * (K_) * 2; } while (0)
  const unsigned ldsw = (unsigned)wid * 1024u;
  const int aoff = lds_byte(wr * 64 + fr, fq * 8), boff = lds_byte(wc * 32 + fr, fq * 8);
#define G8_SA(b, h) (((b) * 2 + (h)) * HTB)
#define G8_SB(b, h) ((4 + (b) * 2 + (h)) * HTB)
#define G8_STAGE(bufoff, gbase, voff) do { _Pragma("unroll") for (int _i = 0; _i < 2; ++_i) \
    __builtin_amdgcn_global_load_lds((const unsigned*)((const char*)(gbase) + (voff)[_i]), (LAS3 unsigned*)(lds + (bufoff) + ldsw + _i * 8192), 16, 0, 0); } while (0)
#define G8_LDA(dst, b, h) do { _Pragma("unroll") for (int m = 0; m < 4; ++m) _Pragma("unroll") for (int k = 0; k < 2; ++k) dst[m][k] = *(const LAS3 bf16x8*)(lds + G8_SA(b, h) + aoff + m * 2048 + k * 1024); } while (0)
#define G8_LDB(dst, b, h) do { _Pragma("unroll") for (int n = 0; n < 2; ++n) _Pragma("unroll") for (int k = 0; k < 2; ++k) dst[n][k] = *(const LAS3 bf16x8*)(lds + G8_SB(b, h) + boff + n * 2048 + k * 1024); } while (0)
#define G8_MMA(ai, bj, At, Bt) do { __builtin_amdgcn_s_setprio(1); _Pragma("unroll") for (int m = 0; m < 4; ++m) _Pragma("unroll") for (int n = 0; n < 2; ++n) _Pragma("unroll") for (int k = 0; k < 2; ++k) \
    acc[ai][bj][m][n] = __builtin_amdgcn_mfma_f32_16x16x32_bf16(Bt[n][k], At[m][k], acc[ai][bj][m][n], 0, 0, 0); __builtin_amdgcn_s_setprio(0); } while (0)
#define G8_WAIT_V(n) asm volatile("s_waitcnt vmcnt(" #n ")" ::: "memory")
#define G8_WAIT_L(n) asm volatile("s_waitcnt lgkmcnt(" #n ")" ::: "memory")
#define G8_BAR __builtin_amdgcn_s_barrier()
#define G8_SCHED __builtin_amdgcn_sched_barrier(0)
  Unit cur, nxt; int ui = 0;
  if (!S.next(0, cur)) return;
  f32x4 acc[2][2][4][2];
#pragma unroll
  for (int a = 0; a < 2; ++a)
#pragma unroll
    for (int b = 0; b < 2; ++b)
#pragma unroll
      for (int m = 0; m < 4; ++m)
#pragma unroll
        for (int n = 0; n < 2; ++n) acc[a][b][m][n] = (f32x4){0.f, 0.f, 0.f, 0.f};
  bf16x8 At[4][2], B0[2][2], B1[2][2];
  const char* cA = cur.A; const char* cB = cur.B;
  unsigned voffA[2], voffB[2];
  size_t hstepA, hstepB;
  G8_VOFF(cur.lda, cur.K);
  G8_STAGE(G8_SB(0, 0), cB, voffB); G8_STAGE(G8_SA(0, 0), cA, voffA); G8_STAGE(G8_SB(0, 1), cB + hstepB, voffB); G8_STAGE(G8_SA(0, 1), cA + hstepA, voffA);
  if (wr == 1) G8_BAR;
  G8_WAIT_V(4); G8_BAR;
  G8_STAGE(G8_SB(1, 0), cB + kstep, voffB); G8_STAGE(G8_SA(1, 0), cA + kstep, voffA); G8_STAGE(G8_SB(1, 1), cB + hstepB + kstep, voffB);
  G8_WAIT_V(6); G8_BAR;
  for (;;) {
    const bool has_next = S.next(ui + 1, nxt);
    if (!has_next) nxt = cur;
    const char* nA = nxt.A; const char* nB = nxt.B;
    const int nt = cur.K / BK;
    for (int t = 0; t < nt; t += 2) {
      const bool last = (t == nt - 2);
      const char* a1 = cA + (size_t)(t + 1) * kstep;
      const char* a2 = last ? nA : cA + (size_t)(t + 2) * kstep; const char* b2 = last ? nB : cB + (size_t)(t + 2) * kstep;
      const char* a3 = a2 + kstep; const char* b3 = b2 + kstep;
      G8_LDB(B0, 0, 0); G8_SCHED; G8_LDA(At, 0, 0); G8_STAGE(G8_SA(1, 1), a1 + hstepA, voffA);
      G8_WAIT_L(8); G8_BAR; G8_WAIT_L(0); G8_MMA(0, 0, At, B0); G8_BAR; G8_SCHED;
      if (last) G8_VOFF(nxt.lda, nxt.K);
      G8_LDB(B1, 0, 1); G8_STAGE(G8_SB(0, 0), b2, voffB);
      G8_BAR; G8_WAIT_L(0); G8_MMA(0, 1, At, B1); G8_BAR;
      G8_LDA(At, 0, 1); G8_STAGE(G8_SA(0, 0), a2, voffA);
      G8_BAR; G8_WAIT_L(0); G8_MMA(1, 0, At, B0); G8_BAR; G8_SCHED;
      G8_STAGE(G8_SB(0, 1), b2 + hstepB, voffB);
      G8_WAIT_V(6); G8_BAR; G8_MMA(1, 1, At, B1); G8_BAR;
      G8_LDB(B0, 1, 0); G8_SCHED; G8_LDA(At, 1, 0); G8_STAGE(G8_SA(0, 1), a2 + hstepA, voffA);
      G8_WAIT_L(8); G8_BAR; G8_WAIT_L(0); G8_MMA(0, 0, At, B0); G8_BAR; G8_SCHED;
      G8_LDB(B1, 1, 1); G8_STAGE(G8_SB(1, 0), b3, voffB);
      G8_BAR; G8_WAIT_L(0); G8_MMA(0, 1, At, B1); G8_BAR;
      G8_LDA(At, 1, 1); G8_STAGE(G8_SA(1, 0), a3, voffA);
      G8_BAR; G8_WAIT_L(0); G8_MMA(1, 0, At, B0); G8_BAR; G8_SCHED;
      G8_STAGE(G8_SB(1, 1), b3 + hstepB, voffB);
      G8_WAIT_V(6); G8_BAR; G8_MMA(1, 1, At, B1); G8_BAR;
    }
    E(acc, cur, wr, wc, fr, fq, tid);
    if (!has_next) break;
#pragma unroll
    for (int a = 0; a < 2; ++a)
#pragma unroll
      for (int b = 0; b < 2; ++b)
#pragma unroll
        for (int m = 0; m < 4; ++m)
#pragma unroll
          for (int n = 0; n < 2; ++n) acc[a][b][m][n] = (f32x4){0.f, 0.f, 0.f, 0.f};
    cur = nxt; cA = nA; cB = nB; ++ui;
  }
  G8_WAIT_V(0);
  if (wr == 0) G8_BAR;
  G8_BAR;
#undef G8_VOFF
#undef G8_SA
#undef G8_SB
#undef G8_STAGE
#undef G8_LDA
#undef G8_LDB
#undef G8_MMA
#undef G8_WAIT_V
#undef G8_WAIT_L
#undef G8_BAR
#undef G8_SCHED
}
}

__device__ __forceinline__ void convT_job(const float* src0, const float* src1, int ldsrc, int kind, int off, int nvalid, u16* dst, int K,
                          int Ndst, const float* kscale, float mult, float* lds, int vb, int vn) {
  int tid = threadIdx.x; asm volatile("" : "+v"(tid));
  const int nkt = K >> 6, nitems = nkt * (Ndst >> 7);
  for (int it = vb; it < nitems; it += vn) {
    const int kt = it % nkt, nt = it / nkt;
    float v[16];
#pragma unroll
    for (int e = 0; e < 16; ++e) {
      int idx = tid + e * 512, i = idx >> 7, j = idx & 127, n = nt * 128 + j, k = kt * 64 + i;
      if (kind == 0) {
        v[e] = (n < nvalid) ? src0[(size_t)k * ldsrc + off + n] : 0.f;
      } else {
        int g = n >> 8, w = n & 255;
        const float* sp = (w < 128) ? src0 : src1;
        v[e] = sp[(size_t)k * ldsrc + g * 128 + (w & 127)];
      }
    }
#pragma unroll
    for (int e = 0; e < 16; ++e) {
      int idx = tid + e * 512, i = idx >> 7, j = idx & 127, k = kt * 64 + i;
      float x = v[e];
      if (kscale) x *= kscale[k];
      lds[j * 65 + i] = x * mult;
    }
    __syncthreads();
#pragma unroll
    for (int e = 0; e < 8; ++e) {
      int idx = tid + e * 512, j = idx >> 5, i2 = (idx & 31) * 2;
      *(uint32_t*)(dst + (size_t)(nt * 128 + j) * K + kt * 64 + i2) = pack2(lds[j * 65 + i2], lds[j * 65 + i2 + 1]);
    }
    __syncthreads();
  }
}

__device__ __forceinline__ void convert_weights(const P& p, int l, float* lds, int job_lo, int job_hi, bool skip_ff2, int vb, int vn, bool do_small) {
  const float* win = p.w_in + (size_t)l * 1024 * 8352;
#pragma unroll 1
  for (int job = job_lo; job < job_hi; ++job) {
    if (skip_ff2 && job == 9) continue;
    const float* s0 = win; const float* s1 = nullptr; const float* ksc = nullptr;
    int ldsrc = 8352, kind = 0, off = 0, nvalid = 0, K = 1024, Ndst = 0; float mult = 1.f; u16* dst = p.W;
    if (job == 0) { off = 1696; nvalid = 2560; dst += OFF_WINA; Ndst = 2560; }
    else if (job == 1) { off = 0; nvalid = 1696; dst += OFF_WINB; Ndst = 1792; }
    else if (job == 2) { off = 4256; nvalid = 4096; dst += OFF_WGATE; Ndst = 4096; }
    else if (job < 7) { const int n = job - 3; s0 = p.w_branch + ((size_t)l * 4 + n) * 512 * 1024; ldsrc = 1024; nvalid = 1024; dst += OFF_WBR + (size_t)n * 1024 * 512; K = 512; Ndst = 1024; }
    else if (job == 7) { s0 = p.w_out + (size_t)l * 1024 * 1024; ldsrc = 1024; nvalid = 1024; dst += OFF_WOUT; Ndst = 1024; }
    else if (job == 8) { s0 = p.w_ff1 + (size_t)l * 1024 * 2816; s1 = p.w_ff3 + (size_t)l * 1024 * 2816; ldsrc = 2816; kind = 1; dst += OFF_WFF13; Ndst = 5632; }
    else if (job == 9) { s0 = p.w_ff2 + (size_t)l * 2816 * 1024; ldsrc = 1024; nvalid = 1024; dst += OFF_WFF2; K = 2816; Ndst = 1024; }
    else if (job == 10) { s0 = p.w_q_up + (size_t)l * 384 * 768; ldsrc = 768; nvalid = 768; dst += OFF_WQUP; K = 384; Ndst = 768; ksc = p.q_norm_g + l * 384; mult = 0.10206207261596575f * 1.4426950408889634f; }
    else { s0 = p.w_kv_up + (size_t)l * 256 * 1024; ldsrc = 1024; nvalid = 1024; dst += OFF_WKVUP; K = 256; Ndst = 1024; ksc = p.kv_norm_g + l * 256; }
    convT_job(s0, s1, ldsrc, kind, off, nvalid, dst, K, Ndst, ksc, mult, lds, vb, vn);
  }
  if (!do_small) return;
  int tidc = threadIdx.x; asm volatile("" : "+v"(tidc));
  const int gt = blockIdx.x * NTHR + tidc, gs = gridDim.x * NTHR;
  for (int i = gt; i < 4 * 128 * 128; i += gs) p.W[OFF_WS + i] = f2bf(p.cmlp_w_s[(size_t)l * 65536 + i]);
  for (int i = gt; i < 2 * 8 * 128 * 64; i += gs) {
    int k = i & 63, n = (i >> 6) & 127, h = (i >> 13) & 7, d = i >> 16;
    const float* src = (n < 64) ? p.lru_w_a : p.lru_w_x;
    p.W[OFF_WLRU + i] = f2bf(src[((((size_t)l * 2 + d) * 8 + h) * 64 + k) * 64 + (n & 63)]);
  }
}

__device__ __forceinline__ void phase0(const P& p, unsigned char* smem) {
  int tid = threadIdx.x; asm volatile("" : "+v"(tid));
  const int gt = blockIdx.x * NTHR + tid, gs = gridDim.x * NTHR;
  for (int idx = gt; idx < SL * 8; idx += gs) {
    int t = idx >> 3, i = idx & 7;
    float inv = exp2f(-(float)i * 0.125f * 13.287712379549449f);
    float ar = (float)(t >> 6) * inv, ac = (float)(t & 63) * inv;
    const float i2pi = 0.15915494309189535f;
    float rr = ar * i2pi; rr -= floorf(rr); rr *= 6.283185307179586f;
    float rc = ac * i2pi; rc -= floorf(rc); rc *= 6.283185307179586f;
    p.rope[t * 32 + i] = __cosf(rr); p.rope[t * 32 + 8 + i] = __sinf(rr);
    p.rope[t * 32 + 16 + i] = __cosf(rc); p.rope[t * 32 + 24 + i] = __sinf(rc);
  }
  float* sS = (float*)smem; float* red = sS + 9 * 1024;
  for (int it = blockIdx.x; it < 4 * 96; it += gridDim.x) {
    const int l = it / 96, cgp = it - l * 96;
    for (int idx = tid; idx < 9216; idx += 512) {
      int m = idx >> 10, k = idx & 1023;
      float v = (m < 8) ? p.c[m * 1024 + k] : p.c_ctx[k];
      sS[idx] = siluf_(v);
    }
    __syncthreads();
    const int cj = tid & 63, kp = tid >> 6, j = cgp * 64 + cj;
    float a[9];
#pragma unroll
    for (int m = 0; m < 9; ++m) a[m] = 0.f;
    for (int k0 = kp * 128; k0 < kp * 128 + 128; k0 += 16) {
      float w[16];
#pragma unroll
      for (int u = 0; u < 16; ++u) w[u] = p.w_mod[((size_t)l * 1024 + k0 + u) * 6144 + j];
#pragma unroll
      for (int u = 0; u < 16; ++u)
#pragma unroll
        for (int m = 0; m < 9; ++m) a[m] += sS[m * 1024 + k0 + u] * w[u];
    }
#pragma unroll
    for (int m = 0; m < 9; ++m) red[(kp * 9 + m) * 64 + cj] = a[m];
    __syncthreads();
    for (int idx = tid; idx < 576; idx += 512) {
      int m = idx >> 6, c2 = idx & 63;
      float s = 0.f;
      for (int q = 0; q < 8; ++q) s += red[(q * 9 + m) * 64 + c2];
      p.mod[((size_t)l * 9 + m) * 6144 + cgp * 64 + c2] = s + p.b_mod[l * 6144 + cgp * 64 + c2];
    }
    __syncthreads();
  }
}

__device__ __forceinline__ void norm_mod(const P& p, int l, const float* g, int off_sh, int off_sc, bool from_input) {
  int tid = threadIdx.x; asm volatile("" : "+v"(tid));
  const int lane = tid & 63, wid = tid >> 6;
  for (int r = blockIdx.x * 8 + wid; r < MTOT; r += gridDim.x * 8) {
    const float* xr = from_input ? xin_ptr(p, r) : (const float*)xrow_ptr(p, r);
    const float* md = p.mod + ((size_t)l * 9 + mod_idx(r)) * 6144;
    float4 v[4];
    float ss = 0.f;
#pragma unroll
    for (int i = 0; i < 4; ++i) {
      v[i] = *(const float4*)(xr + i * 256 + lane * 4);
      ss += v[i].x * v[i].x + v[i].y * v[i].y + v[i].z * v[i].z + v[i].w * v[i].w;
    }
    ss = wave_sum(ss);
    const float inv = rsqrtf(ss * (1.f / 1024.f) + EPS);
    if (from_input) {
      float* xw = xrow_ptr(p, r);
#pragma unroll
      for (int i = 0; i < 4; ++i) *(float4*)(xw + i * 256 + lane * 4) = v[i];
    }
#pragma unroll
    for (int i = 0; i < 4; ++i) {
      const int k = i * 256 + lane * 4;
      float4 gg = *(const float4*)(g + k);
      float4 sh = *(const float4*)(md + off_sh + k);
      float4 sc = *(const float4*)(md + off_sc + k);
      float o0 = v[i].x * inv * gg.x * (1.f + sc.x) + sh.x;
      float o1 = v[i].y * inv * gg.y * (1.f + sc.y) + sh.y;
      float o2 = v[i].z * inv * gg.z * (1.f + sc.z) + sh.z;
      float o3 = v[i].w * inv * gg.w * (1.f + sc.w) + sh.w;
      uint2 o; o.x = pack2(o0, o1); o.y = pack2(o2, o3);
      *(uint2*)(p.H + (size_t)r * 1024 + k) = o;
    }
  }
}

__device__ __forceinline__ void conva_item(const P& p, int l, int item) {
  int tid = threadIdx.x; asm volatile("" : "+v"(tid));
  const u16* Zb1 = p.R1;
  const float* cw = p.conv_a_w + (size_t)l * 3 * 512;
  for (int e = 0; e < 32; ++e) {
    int idx = tid + e * 512, rr = idx >> 6, cgp = idx & 63;
    int r = item * 256 + rr;
    int b = r / ST, t = r - b * ST;
    int isctx = t >= SL, pos = isctx ? t - SL : t, seglen = isctx ? SC : SL;
    float acc[8];
#pragma unroll
    for (int i = 0; i < 8; ++i) acc[i] = 0.f;
#pragma unroll
    for (int k = 0; k < 3; ++k) {
      int pos2 = pos - 1 + k;
      if (pos2 >= 0 && pos2 < seglen) {
        size_t r2 = (size_t)(r - 1 + k);
        uint4 vc = *(const uint4*)(Zb1 + r2 * 2560 + 512 + cgp * 8);
        uint4 vx = *(const uint4*)(Zb1 + r2 * 2560 + 1024 + cgp * 8);
        float fc[8], fx[8];
        unpack8(vc, fc); unpack8(vx, fx);
#pragma unroll
        for (int i = 0; i < 8; ++i) acc[i] += cw[k * 512 + cgp * 8 + i] * (fc[i] * fx[i]);
      }
    }
    uint4 vb = *(const uint4*)(Zb1 + (size_t)r * 2560 + cgp * 8);
    float fb[8];
    unpack8(vb, fb);
#pragma unroll
    for (int i = 0; i < 8; ++i) acc[i] *= fb[i];
    *(uint4*)(p.Ycat + (size_t)r * 2048 + cgp * 8) = pack8(acc);
  }
}

__device__ __forceinline__ void cmlp_item(const P& p, int l, int item, unsigned char* smem) {
  int tid = threadIdx.x; asm volatile("" : "+v"(tid));
  const int lane = tid & 63, wid = tid >> 6, fr = lane & 15, fq = lane >> 4;
  const int g = item & 3, bj = item >> 2;
  const int rowbase = bj * 128;
  u16* vT = (u16*)smem;
  float* sMu = (float*)(smem + 128 * 136 * 2);
  float* sRs = sMu + 128;
  const u16* Zb1 = p.R1;
  {
    uint4 vv[16];
#pragma unroll
    for (int rr = 0; rr < 16; ++rr) vv[rr] = *(const uint4*)(Zb1 + (size_t)(rowbase + wid * 16 + rr) * 2560 + 2048 + lane * 8);
#pragma unroll
    for (int rr = 0; rr < 16; ++rr) {
      int q = wid * 16 + rr;
      float f[8];
      unpack8(vv[rr], f);
      float s = 0.f;
#pragma unroll
      for (int i = 0; i < 8; ++i) { f[i] = geluf_(f[i]); s += f[i]; }
      s = wave_sum(s);
      float mu = s * (1.f / 512.f);
      float d2 = 0.f;
#pragma unroll
      for (int i = 0; i < 8; ++i) { float d = f[i] - mu; d2 += d * d; }
      d2 = wave_sum(d2);
      if (lane == 0) { sMu[q] = mu; sRs[q] = rsqrtf(d2 * (1.f / 512.f) + EPS); }
    }
  }
  __syncthreads();
  const float* lg = p.cmlp_ln_g + l * 512 + g * 128;
  const float* lb = p.cmlp_ln_b + l * 512 + g * 128;
#pragma unroll
  for (int e = 0; e < 4; ++e) {
    int idx = tid + e * 512, q = idx >> 4, dc = idx & 15;
    uint4 v = *(const uint4*)(Zb1 + (size_t)(rowbase + q) * 2560 + 2048 + g * 128 + dc * 8);
    float f[8];
    unpack8(v, f);
    float mu = sMu[q], rs = sRs[q];
#pragma unroll
    for (int i = 0; i < 8; ++i) {
      float val = (geluf_(f[i]) - mu) * rs * lg[dc * 8 + i] + lb[dc * 8 + i];
      vT[(dc * 8 + i) * 136 + q] = f2bf(val);
    }
  }
  __syncthreads();
  const u16* Ws = p.W + OFF_WS + (size_t)g * 128 * 128;
  f32x4 acc[8];
#pragma unroll
  for (int n = 0; n < 8; ++n) acc[n] = (f32x4){0.f, 0.f, 0.f, 0.f};
#pragma unroll
  for (int ks = 0; ks < 4; ++ks) {
    bf16x8 a = *(const bf16x8*)(Ws + (wid * 16 + fr) * 128 + ks * 32 + fq * 8);
#pragma unroll
    for (int n = 0; n < 8; ++n) {
      bf16x8 bb = *(const bf16x8*)(vT + (n * 16 + fr) * 136 + ks * 32 + fq * 8);
      acc[n] = __builtin_amdgcn_mfma_f32_16x16x32_bf16(bb, a, acc[n], 0, 0, 0);
    }
  }
  {
    const int pp = wid * 16 + fr;
    const size_t r = (size_t)(rowbase + pp);
    const float bsv = p.cmlp_b_s[((size_t)l * 4 + g) * 128 + pp];
    uint2 uu[8];
#pragma unroll
    for (int n = 0; n < 8; ++n) uu[n] = *(const uint2*)(Zb1 + r * 2560 + 1536 + g * 128 + n * 16 + fq * 4);
#pragma unroll
    for (int n = 0; n < 8; ++n) {
      float u0 = __uint_as_float(uu[n].x << 16), u1 = __uint_as_float(uu[n].x & 0xffff0000u);
      float u2 = __uint_as_float(uu[n].y << 16), u3 = __uint_as_float(uu[n].y & 0xffff0000u);
      uint2 ov;
      ov.x = pack2(geluf_(u0) * (acc[n][0] + bsv), geluf_(u1) * (acc[n][1] + bsv));
      ov.y = pack2(geluf_(u2) * (acc[n][2] + bsv), geluf_(u3) * (acc[n][3] + bsv));
      *(uint2*)(p.Ycat + r * 2048 + 1024 + g * 128 + n * 16 + fq * 4) = ov;
    }
  }
  __syncthreads();
}

template <int CTRL, int ROWMASK>
__device__ __forceinline__ float dppf(float old, float src) {
  return __int_as_float(__builtin_amdgcn_update_dpp(__float_as_int(old), __float_as_int(src), CTRL, ROWMASK, 0xf, false));
}
#define LSCAN_STEP(A_, B_, CTRL, RM) do { const float A2_ = dppf<CTRL, RM>(1.f, A_), B2_ = dppf<CTRL, RM>(0.f, B_); B_ = A_ * B2_ + B_; A_ = A_ * A2_; } while (0)
#define LSCAN64(A_, B_) do { LSCAN_STEP(A_, B_, 0x111, 0xf); LSCAN_STEP(A_, B_, 0x112, 0xf); LSCAN_STEP(A_, B_, 0x114, 0xf); LSCAN_STEP(A_, B_, 0x118, 0xf); \
    LSCAN_STEP(A_, B_, 0x142, 0xa); LSCAN_STEP(A_, B_, 0x143, 0xc); } while (0)

template <int PASS>
__device__ __forceinline__ void lru_run(const P& p, int l, int it_first, int it_stride, unsigned char* smem) {
  int tid = threadIdx.x; asm volatile("" : "+v"(tid));
  const int lane = tid & 63, wid = tid >> 6, fr = lane & 15, fq = lane >> 4;
  u16* sX = (u16*)smem;
  float* sA = (float*)(smem + 18432);
  float* sB = sA + 64 * 130;
  float* sH = sB + 64 * 130;
  float* sCw = sH + 128 * 65;
  float* sCarry = sCw + 320;
  float* sPar = sCarry + 128;
  u16* sW = (u16*)(sPar + 384);
  const u16* Zb2 = p.R1;
  int cur_h = -1;
  uint4 cv[2][4];
#define LRU_LOADCV(ITEM) do { const int h_ = (ITEM) & 7, bj_ = (ITEM) >> 3; const int b_ = bj_ / 34, j_ = bj_ - b_ * 34; const int ic_ = j_ >= 32; \
    const int p0_ = ic_ ? (j_ - 32) * 128 : j_ * 128, sl_ = ic_ ? SC : SL, rs_ = bj_ * 128 - p0_; \
    _Pragma("unroll") for (int e = 0; e < 2; ++e) { int idx = tid + e * 512, pp = idx >> 3, cgp = idx & 7; \
      _Pragma("unroll") for (int k = 0; k < 4; ++k) { int pos = p0_ + pp - 2 + k; cv[e][k] = make_uint4(0, 0, 0, 0); \
        if (pos >= 0 && pos < sl_) cv[e][k] = *(const uint4*)(Zb2 + (size_t)(rs_ + pos) * 1792 + h_ * 64 + cgp * 8); } } } while (0)
  if (it_first < 2176) LRU_LOADCV(it_first);
  for (int item = it_first; item < 2176; item += it_stride) {
    const int h = item & 7, bj = item >> 3;
    const int b = bj / 34, j = bj - b * 34;
    const int rowbase = bj * 128;
    const int isctx = j >= 32;
    const int ordf = isctx ? j - 32 : j + 2, ordr = 33 - j;
    float cA[16], cB[16];
    uint4 gv[2];
    if (PASS == 3) {
#pragma unroll
      for (int q = 0; q < 16; ++q) {
        const int pi = wid * 16 + q, d = pi >> 6, ch = pi & 63, o = d ? ordr : ordf;
        cA[q] = 1.f; cB[q] = 0.f;
        if (lane < o) { float2 v = p.summ[((size_t)(b * 2 + d) * 512 + h * 64 + ch) * 34 + lane]; cA[q] = v.x; cB[q] = v.y; }
      }
#pragma unroll
      for (int e = 0; e < 2; ++e) {
        int idx = tid + e * 512, pos = idx >> 3, cgp = idx & 7;
        gv[e] = *(const uint4*)(Zb2 + (size_t)(rowbase + pos) * 1792 + 800 + h * 64 + cgp * 8);
      }
    }
    if (h != cur_h) {
      cur_h = h;
      __syncthreads();
      if (tid < 320) {
        int k = tid >> 6, i = tid & 63;
        sCw[tid] = (k < 4) ? p.lru_conv_w[((size_t)l * 4 + k) * 512 + h * 64 + i] : p.lru_conv_b[l * 512 + h * 64 + i];
      }
      if (tid < 128) {
        const int d = tid >> 6, ch = tid & 63;
        const size_t pidx = ((size_t)l * 2 + d) * 512 + h * 64 + ch;
        sPar[tid * 3] = p.lru_b_a[pidx]; sPar[tid * 3 + 1] = p.lru_b_x[pidx];
        sPar[tid * 3 + 2] = 8.f * log1pf(__expf(-p.lru_lam[pidx]));
      }
#pragma unroll
      for (int e = 0; e < 4; ++e) {
        int idx = tid + e * 512, row = idx >> 3, kc = idx & 7;
        const int d = row >> 7, n = row & 127;
        *(uint4*)(sW + row * 72 + kc * 8) = *(const uint4*)(p.W + OFF_WLRU + (size_t)((d * 8 + h) * 128 + n) * 64 + kc * 8);
      }
      __syncthreads();
    }
#pragma unroll
    for (int e = 0; e < 2; ++e) {
      int idx = tid + e * 512, pp = idx >> 3, cgp = idx & 7;
      float a8[8];
#pragma unroll
      for (int i = 0; i < 8; ++i) a8[i] = sCw[256 + cgp * 8 + i];
#pragma unroll
      for (int k = 0; k < 4; ++k) {
        float f[8];
        unpack8(cv[e][k], f);
#pragma unroll
        for (int i = 0; i < 8; ++i) a8[i] += sCw[k * 64 + cgp * 8 + i] * f[i];
      }
      *(uint4*)(sX + pp * 72 + cgp * 8) = pack8(a8);
    }
    if (item + it_stride < 2176) LRU_LOADCV(item + it_stride);
    if (PASS == 3) {
#pragma unroll
      for (int q = 0; q < 16; ++q) LSCAN64(cA[q], cB[q]);
      if (lane == 63) {
#pragma unroll
        for (int q = 0; q < 16; ++q) sCarry[wid * 16 + q] = cB[q];
      }
    }
    __syncthreads();
    for (int d = 0; d < 2; ++d) {
      const u16* Wl = sW + d * 128 * 72;
      f32x4 acc[8];
#pragma unroll
      for (int n = 0; n < 8; ++n) acc[n] = (f32x4){0.f, 0.f, 0.f, 0.f};
      {
        const bf16x8 a0 = *(const bf16x8*)(sX + (wid * 16 + fr) * 72 + fq * 8);
        const bf16x8 a1 = *(const bf16x8*)(sX + (wid * 16 + fr) * 72 + 32 + fq * 8);
#pragma unroll
        for (int n = 0; n < 8; ++n) {
          const bf16x8 b0 = *(const bf16x8*)(Wl + (n * 16 + fr) * 72 + fq * 8);
          const bf16x8 b1 = *(const bf16x8*)(Wl + (n * 16 + fr) * 72 + 32 + fq * 8);
          acc[n] = __builtin_amdgcn_mfma_f32_16x16x32_bf16(a0, b0, acc[n], 0, 0, 0);
          acc[n] = __builtin_amdgcn_mfma_f32_16x16x32_bf16(a1, b1, acc[n], 0, 0, 0);
        }
      }
#pragma unroll
      for (int nt = 0; nt < 4; ++nt) {
        const int ch = nt * 16 + fr;
        const float ba = sPar[(d * 64 + ch) * 3], bx = sPar[(d * 64 + ch) * 3 + 1], sp8 = sPar[(d * 64 + ch) * 3 + 2];
#pragma unroll
        for (int jj = 0; jj < 4; ++jj) {
          const int pos = wid * 16 + fq * 4 + jj;
          const float xl = bf2f(sX[pos * 72 + ch]);
          const float rg = sigmoid_rcp_(acc[nt][jj] + ba), ig = sigmoid_rcp_(acc[nt + 4][jj] + bx);
          const float la = -sp8 * rg;
          const float av = __expf(la);
          const float x2 = 2.f * la;
          const float ser = -x2 * (1.f + x2 * (0.5f + x2 * (0.16666667f + x2 * (0.041666667f + x2 * 0.0083333333f))));
          const float om = (x2 > -0.25f) ? ser : (1.f - av * av);
          const float bb = __builtin_amdgcn_sqrtf(om) * ig * xl;
          const int si = d ? 127 - pos : pos;
          sA[ch * 130 + si] = av;
          sB[ch * 130 + si] = bb;
        }
      }
      __syncthreads();
      {
        float a0[8], b0[8], A[8], B[8];
#pragma unroll
        for (int c = 0; c < 8; ++c) {
          const int ch = wid * 8 + c;
          const float2 va = *(const float2*)(sA + ch * 130 + 2 * lane), vb = *(const float2*)(sB + ch * 130 + 2 * lane);
          a0[c] = va.x; b0[c] = vb.x;
          A[c] = va.x * va.y; B[c] = va.y * vb.x + vb.y;
        }
#pragma unroll
        for (int c = 0; c < 8; ++c) LSCAN64(A[c], B[c]);
#pragma unroll
        for (int c = 0; c < 8; ++c) {
          const int ch = wid * 8 + c;
          if (PASS == 1) {
            if (lane == 63) p.summ[((size_t)(b * 2 + d) * 512 + h * 64 + ch) * 34 + (d ? ordr : ordf)] = make_float2(A[c], B[c]);
          } else {
            const float carry = sCarry[d * 64 + ch];
            const float hincl = A[c] * carry + B[c];
            const float hprev = dppf<0x138, 0xf>(carry, hincl);
            const float heven = a0[c] * hprev + b0[c];
            const int se = 2 * lane, pe = d ? 127 - se : se, po = d ? 126 - se : se + 1;
            if (d == 0) { sH[pe * 65 + ch] = heven; sH[po * 65 + ch] = hincl; }
            else { sH[pe * 65 + ch] += heven; sH[po * 65 + ch] += hincl; }
          }
        }
      }
      __syncthreads();
    }
    if (PASS == 3) {
#pragma unroll
      for (int e = 0; e < 2; ++e) {
        int idx = tid + e * 512, pos = idx >> 3, cgp = idx & 7;
        const size_t r = (size_t)(rowbase + pos);
        float gf[8], y[8];
        unpack8(gv[e], gf);
#pragma unroll
        for (int i = 0; i < 8; ++i) y[i] = geluf_(gf[i]) * sH[pos * 65 + cgp * 8 + i];
        *(uint4*)(p.Ycat + r * 2048 + 512 + h * 64 + cgp * 8) = pack8(y);
      }
      __syncthreads();
    }
  }
}

__device__ __forceinline__ void krope_item(const P& p, int item) {
  int tid = threadIdx.x; asm volatile("" : "+v"(tid));
  const u16* Zb2 = p.R1;
#pragma unroll
  for (int e = 0; e < 8; ++e) {
    int idx = tid + e * 512, rr = idx >> 4, pi = idx & 15, axis = pi >> 3, i = pi & 7;
    int r = item * 256 + rr, b = r / ST, t = r - b * ST;
    float x1 = bf2f(Zb2[(size_t)r * 1792 + 768 + axis * 16 + i]);
    float x2 = bf2f(Zb2[(size_t)r * 1792 + 768 + axis * 16 + 8 + i]);
    float o1 = x1, o2 = x2;
    if (t < SL) {
      float cs = p.rope[t * 32 + axis * 16 + i], sn = p.rope[t * 32 + axis * 16 + 8 + i];
      o1 = x1 * cs - x2 * sn;
      o2 = x1 * sn + x2 * cs;
    }
    u16 b1 = f2bf(o1), b2 = f2bf(o2);
#pragma unroll
    for (int h = 0; h < 8; ++h) {
      size_t base = ((size_t)(b * 8 + h) * ST + t) * 96 + 64 + axis * 16 + i;
      p.K[base] = b1;
      p.K[base + 8] = b2;
    }
  }
}

__device__ __forceinline__ void attn_item(const P& p, int item, unsigned char* smem) {
  int tid = threadIdx.x; asm volatile("" : "+v"(tid));
  const int lane = tid & 63, wid = tid >> 6, fr = lane & 15, fq = lane >> 4;
  int b, h, t0, kt0, kt1;
  if (item < 1024) { b = item >> 7; h = (item >> 4) & 7; t0 = (item & 15) * 256; kt0 = 0; kt1 = 68; }
  else { int i2 = item - 1024; b = i2 >> 3; h = i2 & 7; t0 = SL; kt0 = 64; kt1 = 68; }
  const u16* Kb = p.K + (size_t)(b * 8 + h) * ST * 96;
  const u16* Vb = p.Vt + (size_t)(b * 8 + h) * 64 * ST;
  const u16* Qb = p.Q + (size_t)(b * 8 + h) * ST * 96;
  constexpr int KS = 104, VS = 136, KSZ = 128 * KS, VSZ = 64 * VS, STG = KSZ + VSZ;
  u16* lds = (u16*)smem;
  bf16x8 qf[2][3];
#pragma unroll
  for (int nq = 0; nq < 2; ++nq)
#pragma unroll
    for (int ks = 0; ks < 3; ++ks)
      qf[nq][ks] = *(const bf16x8*)(Qb + (size_t)(t0 + wid * 32 + nq * 16 + fr) * 96 + ks * 32 + fq * 8);
  if (item < 1024) {
#pragma unroll
    for (int nq = 0; nq < 2; ++nq) {
      const int t = t0 + wid * 32 + nq * 16 + fr;
      const float* rp = p.rope + t * 32 + (fq >> 1) * 16;
      union { bf16x8 v; uint32_t u[4]; } own, oth, res;
      own.v = qf[nq][2];
#pragma unroll
      for (int i = 0; i < 4; ++i) oth.u[i] = __shfl_xor(own.u[i], 16);
      float fo[8], fp[8], fres[8];
      { uint4 t4 = make_uint4(own.u[0], own.u[1], own.u[2], own.u[3]); unpack8(t4, fo); }
      { uint4 t4 = make_uint4(oth.u[0], oth.u[1], oth.u[2], oth.u[3]); unpack8(t4, fp); }
#pragma unroll
      for (int j = 0; j < 8; ++j) {
        float cs = rp[j], sn = rp[8 + j];
        fres[j] = (fq & 1) ? (fp[j] * sn + fo[j] * cs) : (fo[j] * cs - fp[j] * sn);
      }
      uint4 r4 = pack8(fres);
      res.u[0] = r4.x; res.u[1] = r4.y; res.u[2] = r4.z; res.u[3] = r4.w;
      qf[nq][2] = res.v;
    }
  }
  f32x4 o[4][2];
#pragma unroll
  for (int m = 0; m < 4; ++m)
#pragma unroll
    for (int n = 0; n < 2; ++n) o[m][n] = (f32x4){0.f, 0.f, 0.f, 0.f};
  float mrun[2] = {-1e30f, -1e30f}, lrun[2] = {0.f, 0.f};
  const int T0 = kt0 >> 1, T1 = kt1 >> 1;
  uint4 rk0, rk1, rk2, rv0, rv1;
  const int c0_ = tid, c1_ = tid + 512, c2_ = tid + 1024;
  const int kcv0_ = c0_ & 15, kcv1_ = c1_ & 15;
  const int vslot0_ = 32 * (kcv0_ >> 2) + 16 * (kcv0_ & 1) + 4 * ((kcv0_ & 3) >> 1);
  const int vslot1_ = 32 * (kcv1_ >> 2) + 16 * (kcv1_ & 1) + 4 * ((kcv1_ & 3) >> 1);
#define ATT_LD(tt) do { const size_t key0_ = (size_t)(tt) * 128; const u16* kb_ = Kb + key0_ * 96; \
    rk0 = *(const uint4*)(kb_ + (size_t)c0_ * 8); rk1 = *(const uint4*)(kb_ + (size_t)c1_ * 8); rk2 = *(const uint4*)(kb_ + (size_t)c2_ * 8); \
    rv0 = *(const uint4*)(Vb + (size_t)(c0_ >> 4) * ST + key0_ + (c0_ & 15) * 8); \
    rv1 = *(const uint4*)(Vb + (size_t)(c1_ >> 4) * ST + key0_ + (c1_ & 15) * 8); } while (0)
#define ATT_ST(st) do { u16* sk_ = lds + (st) * STG; u16* sv_ = sk_ + KSZ; \
    *(uint4*)(sk_ + (c0_ / 12) * KS + (c0_ % 12) * 8) = rk0; *(uint4*)(sk_ + (c1_ / 12) * KS + (c1_ % 12) * 8) = rk1; *(uint4*)(sk_ + (c2_ / 12) * KS + (c2_ % 12) * 8) = rk2; \
    *(uint2*)(sv_ + (c0_ >> 4) * VS + vslot0_) = make_uint2(rv0.x, rv0.y); *(uint2*)(sv_ + (c0_ >> 4) * VS + vslot0_ + 8) = make_uint2(rv0.z, rv0.w); \
    *(uint2*)(sv_ + (c1_ >> 4) * VS + vslot1_) = make_uint2(rv1.x, rv1.y); *(uint2*)(sv_ + (c1_ >> 4) * VS + vslot1_ + 8) = make_uint2(rv1.z, rv1.w); } while (0)
  ATT_LD(T0); ATT_ST(0);
  __syncthreads();
  for (int kt = T0; kt < T1; ++kt) {
    const bool more = (kt + 1 < T1);
    if (more) ATT_LD(kt + 1);
    const int cur = (kt - T0) & 1;
    const u16* sk = lds + cur * STG;
    const u16* sv = sk + KSZ;
    f32x4 s[8][2];
#pragma unroll
    for (int m = 0; m < 8; ++m)
#pragma unroll
      for (int n = 0; n < 2; ++n) s[m][n] = (f32x4){0.f, 0.f, 0.f, 0.f};
#pragma unroll
    for (int ks = 0; ks < 3; ++ks)
#pragma unroll
      for (int mt = 0; mt < 8; ++mt) {
        bf16x8 kf = *(const bf16x8*)(sk + (mt * 16 + fr) * KS + ks * 32 + fq * 8);
#pragma unroll
        for (int nq = 0; nq < 2; ++nq) s[mt][nq] = __builtin_amdgcn_mfma_f32_16x16x32_bf16(kf, qf[nq][ks], s[mt][nq], 0, 0, 0);
      }
    bf16x8 pb[2][4];
    float mloc[2];
#pragma unroll
    for (int nq = 0; nq < 2; ++nq) {
      float mx = fmaxf(fmaxf(s[0][nq][0], s[0][nq][1]), fmaxf(s[0][nq][2], s[0][nq][3]));
#pragma unroll
      for (int mt = 1; mt < 8; ++mt) mx = fmaxf(fmaxf(mx, s[mt][nq][0]), fmaxf(fmaxf(s[mt][nq][1], s[mt][nq][2]), s[mt][nq][3]));
      mloc[nq] = mx;
    }
    if (__any((mloc[0] > mrun[0] + 8.f) || (mloc[1] > mrun[1] + 8.f))) {
      float m0 = fmaxf(mloc[0], __shfl_xor(mloc[0], 16)), m1 = fmaxf(mloc[1], __shfl_xor(mloc[1], 16));
      m0 = fmaxf(m0, __shfl_xor(m0, 32)); m1 = fmaxf(m1, __shfl_xor(m1, 32));
      const float n0 = fmaxf(mrun[0], m0), n1 = fmaxf(mrun[1], m1);
      const float a0 = __builtin_amdgcn_exp2f(mrun[0] - n0), a1 = __builtin_amdgcn_exp2f(mrun[1] - n1);
      mrun[0] = n0; mrun[1] = n1;
      lrun[0] *= a0; lrun[1] *= a1;
#pragma unroll
      for (int mtv = 0; mtv < 4; ++mtv) {
        o[mtv][0][0] *= a0; o[mtv][0][1] *= a0; o[mtv][0][2] *= a0; o[mtv][0][3] *= a0;
        o[mtv][1][0] *= a1; o[mtv][1][1] *= a1; o[mtv][1][2] *= a1; o[mtv][1][3] *= a1;
      }
    }
#pragma unroll
    for (int nq = 0; nq < 2; ++nq) {
      const float mn = mrun[nq];
      float rs = 0.f;
#pragma unroll
      for (int mt = 0; mt < 8; ++mt)
#pragma unroll
        for (int jj = 0; jj < 4; ++jj) {
          float pv = __builtin_amdgcn_exp2f(s[mt][nq][jj] - mn);
          s[mt][nq][jj] = pv;
          rs += pv;
        }
      lrun[nq] += rs;
#pragma unroll
      for (int sx = 0; sx < 4; ++sx) {
        union { uint4 u; bf16x8 v; } cv;
        cv.u.x = pack2(s[2 * sx][nq][0], s[2 * sx][nq][1]); cv.u.y = pack2(s[2 * sx][nq][2], s[2 * sx][nq][3]);
        cv.u.z = pack2(s[2 * sx + 1][nq][0], s[2 * sx + 1][nq][1]); cv.u.w = pack2(s[2 * sx + 1][nq][2], s[2 * sx + 1][nq][3]);
        pb[nq][sx] = cv.v;
      }
    }
#pragma unroll
    for (int sx = 0; sx < 4; ++sx)
#pragma unroll
      for (int mtv = 0; mtv < 4; ++mtv) {
        const bf16x8 vf = *(const bf16x8*)(sv + (mtv * 16 + fr) * VS + 32 * sx + fq * 8);
#pragma unroll
        for (int nq = 0; nq < 2; ++nq) o[mtv][nq] = __builtin_amdgcn_mfma_f32_16x16x32_bf16(vf, pb[nq][sx], o[mtv][nq], 0, 0, 0);
      }
    if (more) ATT_ST(cur ^ 1);
    __syncthreads();
  }
#undef ATT_LD
#undef ATT_ST
#pragma unroll
  for (int nq = 0; nq < 2; ++nq) {
    float lt = lrun[nq];
    lt += __shfl_xor(lt, 16);
    lt += __shfl_xor(lt, 32);
    float inv = 1.f / lt;
    size_t r = (size_t)b * ST + t0 + wid * 32 + nq * 16 + fr;
#pragma unroll
    for (int mtv = 0; mtv < 4; ++mtv) {
      uint2 ov;
      ov.x = pack2(o[mtv][nq][0] * inv, o[mtv][nq][1] * inv);
      ov.y = pack2(o[mtv][nq][2] * inv, o[mtv][nq][3] * inv);
      *(uint2*)(p.Ycat + r * 2048 + 1536 + h * 64 + mtv * 16 + fq * 4) = ov;
    }
  }
}

#define XB_TMO      128
#define XB_XCNT(j)  (256  + 64 * (j))
#define XB_XSUB(j)  (1280 + 64 * (j))
#define XB_XGEN(j)  (2304 + 64 * (j))
#define XB_TOP      3328
#define XB_TOPGEN   3392
#define XCD_BAR_WORDS 3456
#define XB_SPIN_CAP (1u << 18)
__device__ __forceinline__ unsigned xb_ld(unsigned* p)              { return __hip_atomic_load(p, __ATOMIC_RELAXED, __HIP_MEMORY_SCOPE_AGENT); }
__device__ __forceinline__ unsigned xb_add(unsigned* p, unsigned v) { return __hip_atomic_fetch_add(p, v, __ATOMIC_RELAXED, __HIP_MEMORY_SCOPE_AGENT); }
__device__ __forceinline__ unsigned xb_xcc_id() { return (unsigned)__builtin_amdgcn_s_getreg((3 << 11) | 20) & 0xFu; }
#define XB_SPIN(cond, bar) do { unsigned _sp = 0; while (cond) { __builtin_amdgcn_s_sleep(1); \
    if ((++_sp & 255u) == 0u) { if (xb_ld(&(bar)[XB_TMO])) break; if (_sp > XB_SPIN_CAP) { atomicAdd(&(bar)[XB_TMO], 1u); break; } } } } while (0)
struct XcdBarrier { unsigned* bar; unsigned x; volatile __attribute__((address_space(3))) unsigned* st; };
__device__ __forceinline__ XcdBarrier xcd_barrier_post(unsigned* bar, volatile __attribute__((address_space(3))) unsigned* st) {
  XcdBarrier b; b.bar = bar; b.x = xb_xcc_id(); b.st = st;
  if (threadIdx.x == 0) (void)xb_add(&bar[XB_XCNT(b.x)], 1u);
  return b;
}
__device__ __forceinline__ void xcd_barrier_complete(unsigned* bar, unsigned x, unsigned& nloc, unsigned& nx) {
  const unsigned G = gridDim.x * gridDim.y * gridDim.z;
  unsigned sum, cnt, mine, sp = 0u;
  for (;;) {
    sum = 0u; cnt = 0u; mine = 0u;
#pragma unroll
    for (unsigned j = 0; j < 16; ++j) { const unsigned c = xb_ld(&bar[XB_XCNT(j)]); sum += c; cnt += (c > 0u) ? 1u : 0u; mine = (j == x) ? c : mine; }
    if (sum == G) break;
    __builtin_amdgcn_s_sleep(1);
    if ((++sp & 255u) == 0u) { if (xb_ld(&bar[XB_TMO])) break; if (sp > XB_SPIN_CAP) { atomicAdd(&bar[XB_TMO], 1u); break; } }
  }
  nloc = mine > 0u ? mine : 1u; nx = cnt > 0u ? cnt : 1u;
}
__device__ __forceinline__ void xcd_barrier(const XcdBarrier& b) {
  asm volatile("s_waitcnt vmcnt(0)" ::: "memory");
  __syncthreads();
  if (threadIdx.x == 0) {
    unsigned* bar = b.bar;
    __builtin_amdgcn_s_waitcnt(0);
    unsigned nloc = b.st[0], nx = b.st[1];
    if (nloc == 0u) { xcd_barrier_complete(bar, b.x, nloc, nx); b.st[0] = nloc; b.st[1] = nx; }
    const unsigned old = xb_add(&bar[XB_XSUB(b.x)], 1u);
    const unsigned gen = old / nloc;
    if (old + 1u == (gen + 1u) * nloc) {
      __builtin_amdgcn_fence(__ATOMIC_RELEASE, "agent");
      asm volatile("s_waitcnt vmcnt(0)" ::: "memory");
      const unsigned og = xb_add(&bar[XB_TOP], 1u);
      const unsigned tg = og / nx;
      if (og + 1u == (tg + 1u) * nx) xb_add(&bar[XB_TOPGEN], 1u);
      else XB_SPIN(xb_ld(&bar[XB_TOPGEN]) == tg, bar);
      __builtin_amdgcn_fence(__ATOMIC_ACQUIRE, "agent");
      xb_add(&bar[XB_XGEN(b.x)], 1u);
      asm volatile("s_waitcnt vmcnt(0)" ::: "memory");
    } else {
      XB_SPIN(xb_ld(&bar[XB_XGEN(b.x)]) == gen, bar);
      __builtin_amdgcn_fence(__ATOMIC_ACQUIRE, "agent");
      asm volatile("s_waitcnt vmcnt(0)" ::: "memory");
    }
  }
  __syncthreads();
}

__global__ void __launch_bounds__(NTHR) mega(P p) {
  extern __shared__ __attribute__((aligned(16))) unsigned char smem[];
  __shared__ uint4 xb_words;
  cg::grid_group grid = cg::this_grid();
  if (threadIdx.x == 0) xb_words = make_uint4(0u, 0u, 0u, 0u);
  __syncthreads();
  XcdBarrier xb = xcd_barrier_post(p.bar, (volatile __attribute__((address_space(3))) unsigned*)&xb_words);
  u16* lds = (u16*)smem;
  float* sInv = (float*)(smem + 131072);
  LAS3 unsigned char* lds3 = (LAS3 unsigned char*)smem;
  const int bid = blockIdx.x, nblk = gridDim.x;
  auto nopre = [](int) {};

#ifndef NO_P0
  phase0(p, smem);
#endif
  grid.sync();

#pragma unroll 1
  for (int l = 0; l < 4; ++l) {
    int tid = threadIdx.x; asm volatile("" : "+v"(tid));
    const int lane = tid & 63, wid = tid >> 6, wr = wid >> 1, wc = wid & 1, fr = lane & 15, fq = lane >> 4;
    (void)lane; (void)wid; (void)wr; (void)wc; (void)fr; (void)fq;
#ifndef NO_CW
    convert_weights(p, l, (float*)smem, l == 0 ? 0 : 9, l == 0 ? 12 : 10, false, bid, nblk, true);
#endif
    norm_mod(p, l, p.norm1_g + l * 1024, 0, 1024, l == 0);
    GSYNC();

    {
      u16* Zb1 = p.R1;
      auto epi = [=](const f32x4(&acc)[2][2][4][2], const g8::Unit& u, int wr, int wc, int fr, int fq, int) {
#pragma unroll
        for (int ai = 0; ai < 2; ++ai)
#pragma unroll
          for (int m = 0; m < 4; ++m) {
            u16* rowp = Zb1 + (size_t)(u.pm * 256 + ai * 128 + wr * 64 + m * 16 + fr) * 2560 + u.pn * 256 + wc * 32 + 8 * fq;
#pragma unroll
            for (int bj = 0; bj < 2; ++bj) {
              uint4 w;
              w.x = g8::cvt_pk_bf16(acc[ai][bj][m][0][0], acc[ai][bj][m][0][1]); w.y = g8::cvt_pk_bf16(acc[ai][bj][m][0][2], acc[ai][bj][m][0][3]);
              w.z = g8::cvt_pk_bf16(acc[ai][bj][m][1][0], acc[ai][bj][m][1][1]); w.w = g8::cvt_pk_bf16(acc[ai][bj][m][1][2], acc[ai][bj][m][1][3]);
              *(uint4*)(rowp + bj * 128) = w;
            }
          }
      };
      g8::Simple S; S.o.init(l == 3 ? 128 : 136, 10, nblk, bid); S.A = p.H; S.Bt = p.W + OFF_WINA; S.lda = 1024; S.K = 1024;
      g8::gemm_phase<true>(lds3, S, epi);
    }
    GSYNC();

    for (int rep = 0; rep < DUP_C1; ++rep)
    for (int it = bid; it < 1088 + 136; it += nblk) {
#ifndef NO_CMLP
      if (it < 1088) cmlp_item(p, l, it, smem);
#endif
#ifndef NO_CONVA
      if (it >= 1088) conva_item(p, l, it - 1088);
#endif
    }
    GSYNC();

    {
      u16* Zb2 = p.R1;
      auto epi = [=](const f32x4(&acc)[2][2][4][2], const g8::Unit& u, int wr, int wc, int fr, int fq, int) {
#pragma unroll
        for (int ai = 0; ai < 2; ++ai)
#pragma unroll
          for (int m = 0; m < 4; ++m) {
            u16* rowp = Zb2 + (size_t)(u.pm * 256 + ai * 128 + wr * 64 + m * 16 + fr) * 1792 + u.pn * 256 + wc * 32 + 8 * fq;
#pragma unroll
            for (int bj = 0; bj < 2; ++bj) {
              uint4 w;
              w.x = g8::cvt_pk_bf16(acc[ai][bj][m][0][0], acc[ai][bj][m][0][1]); w.y = g8::cvt_pk_bf16(acc[ai][bj][m][0][2], acc[ai][bj][m][0][3]);
              w.z = g8::cvt_pk_bf16(acc[ai][bj][m][1][0], acc[ai][bj][m][1][1]); w.w = g8::cvt_pk_bf16(acc[ai][bj][m][1][2], acc[ai][bj][m][1][3]);
              *(uint4*)(rowp + bj * 128) = w;
            }
          }
        const int pn = u.pn;
        if (pn == 2 || pn == 5 || pn == 6) {
          const bool inc0 = (pn != 5) || (wc >= 1);
          const bool inc1 = (pn == 2) || (pn == 5) || (wc == 0);
          float* dst = p.ssq + (size_t)(u.pm * 256 + wr * 64 + fr) * 12 + (pn == 2 ? 0 : (pn == 5 ? 4 : 8)) + wc;
#pragma unroll
          for (int ai = 0; ai < 2; ++ai)
#pragma unroll
            for (int m = 0; m < 4; ++m) {
              float ss = 0.f;
#pragma unroll
              for (int n = 0; n < 2; ++n)
#pragma unroll
                for (int jj = 0; jj < 4; ++jj) {
                  const float v0 = acc[ai][0][m][n][jj], v1 = acc[ai][1][m][n][jj];
                  ss += (inc0 ? v0 * v0 : 0.f) + (inc1 ? v1 * v1 : 0.f);
                }
              ss += __shfl_xor(ss, 16);
              ss += __shfl_xor(ss, 32);
              if (fq == 0) dst[(ai * 128 + m * 16) * 12] = ss;
              asm volatile("" ::: "memory");
            }
        }
      };
      g8::Simple S; S.o.init(136, 7, nblk, bid); S.A = p.H; S.Bt = p.W + OFF_WINB; S.lda = 1024; S.K = 1024;
      g8::gemm_phase<true>(lds3, S, epi);
    }
    GSYNC();

    for (int rep = 0; rep < DUP_C2; ++rep)
    {
      const u16* Zb2 = p.R1;
      for (int r2 = 0; r2 < DUP_LRU1; ++r2) lru_run<1>(p, l, bid, nblk, smem);
      for (int r2 = 0; r2 < DUP_PROJ; ++r2) {
      {
        struct ProjSched {
          g8::Order o; const u16* Zb2; const u16* Wq; const u16* Wkv;
          __device__ bool next(int i, g8::Unit& u) const {
            int pm, pn; if (!o.tile(i, pm, pn)) return false;
            u.pm = pm; u.lda = 1792;
            if (pn < 3) { u.pn = pn; u.aux = 0; u.K = 384; u.A = (const char*)(Zb2 + (size_t)pm * 256 * 1792 + 1312); u.B = (const char*)(Wq + (size_t)pn * 256 * 384); }
            else { u.pn = pn - 3; u.aux = 1; u.K = 256; u.A = (const char*)(Zb2 + (size_t)pm * 256 * 1792 + 512); u.B = (const char*)(Wkv + (size_t)(pn - 3) * 256 * 256); }
            return true;
          }
        };
        ProjSched S; S.o.init(136, 7, nblk, bid); S.Zb2 = Zb2; S.Wq = p.W + OFF_WQUP; S.Wkv = p.W + OFF_WKVUP;
        auto epi = [=](const f32x4(&acc)[2][2][4][2], const g8::Unit& u, int wr, int wc, int fr, int fq, int) {
          const int row0 = u.pm * 256, b = row0 / ST, tb = row0 - b * ST;
          const int kv = u.aux;
          const float* sq = p.ssq + (size_t)row0 * 12;
          const float invn = kv ? (1.f / 256.f) : (1.f / 384.f);
#pragma unroll
          for (int ai = 0; ai < 2; ++ai)
#pragma unroll
            for (int m = 0; m < 4; ++m) {
              const int rl = ai * 128 + wr * 64 + m * 16 + fr;
              const float4 p0 = *(const float4*)(sq + rl * 12), p1 = *(const float4*)(sq + rl * 12 + 4), p2 = *(const float4*)(sq + rl * 12 + 8);
              const float ssum = kv ? ((p0.x + p0.y) + (p0.z + p0.w)) : (((p1.x + p1.y) + (p1.z + p1.w)) + ((p2.x + p2.y) + (p2.z + p2.w)));
              const float inv = rsqrtf(ssum * invn + EPS);
              const int t = tb + rl;
#pragma unroll
              for (int bj = 0; bj < 2; ++bj) {
                const int c8 = u.pn * 256 + bj * 128 + wc * 32 + 8 * fq;
                float v[8];
#pragma unroll
                for (int n = 0; n < 2; ++n)
#pragma unroll
                  for (int jj = 0; jj < 4; ++jj) v[n * 4 + jj] = acc[ai][bj][m][n][jj] * inv;
                if (!kv) {
                  const int head = c8 / 96, d = c8 - head * 96;
                  *(uint4*)(p.Q + ((size_t)(b * 8 + head) * ST + t) * 96 + d) = pack8(v);
                } else {
                  const int head = c8 >> 7, w = c8 & 127;
                  if (wc < 2) {
                    *(uint4*)(p.K + ((size_t)(b * 8 + head) * ST + t) * 96 + w) = pack8(v);
                  } else {
                    u16* vp = p.Vt + ((size_t)(b * 8 + head) * 64 + (w - 64)) * ST + t;
#pragma unroll
                    for (int e = 0; e < 8; ++e) vp[(size_t)e * ST] = f2bf(v[e]);
                  }
                }
              }
              asm volatile("" ::: "memory");
            }
        };
        g8::gemm_phase<true>(lds3, S, epi);
      }
      {
        const int off = 2176;
        int first = bid;
        if (first < off) { int kk = (off - first + nblk - 1) / nblk; first += kk * nblk; }
        for (int it = first; it < off + 136; it += nblk) krope_item(p, it - off);
      }
      }
    }
    GSYNC();

    for (int rep = 0; rep < DUP_ATTN; ++rep)
    {
      int it = bid;
      for (; it < 1088; it += nblk) attn_item(p, it, smem);
      for (int r2 = 0; r2 < DUP_LRU3; ++r2) lru_run<3>(p, l, it - 1088, nblk, smem);
    }
    GSYNC();

    {
      u16* Mg = p.R1;
      const int ntile = 272 * 8;
      int te = threadIdx.x; asm volatile("" : "+v"(te));
      const int lane_e = te & 63, wid_e = te >> 6;
      const int wr = wid_e >> 1, wc = wid_e & 1, fr = lane_e & 15, fq = lane_e >> 4;
      int estr = nblk; asm volatile("" : "+s"(estr));
      const int skipctx = (l == 3);
      int id = bid;
      while (id < ntile && skipctx && (((id >> 6) * 8 + (id & 7)) % 34) >= 32) id += estr;
      bool primed = false;
      while (id < ntile) {
        const int rt = (id >> 6) * 8 + (id & 7), ct = (id & 63) >> 3;
        int nid = id + estr;
        while (nid < ntile && skipctx && (((nid >> 6) * 8 + (nid & 7)) % 34) >= 32) nid += estr;
        const bool more_tiles = nid < ntile;
        const int nrt = (nid >> 6) * 8 + (nid & 7), nct = (nid & 63) >> 3;
        f32x4 mg[2][4];
#pragma unroll
        for (int m = 0; m < 2; ++m)
#pragma unroll
          for (int n = 0; n < 4; ++n) mg[m][n] = (f32x4){0.f, 0.f, 0.f, 0.f};
        for (int nb = 0; nb < 4; ++nb) {
          f32x4 ag[2][4], ay[2][4];
#pragma unroll
          for (int m = 0; m < 2; ++m)
#pragma unroll
            for (int n = 0; n < 4; ++n) { ag[m][n] = (f32x4){0.f, 0.f, 0.f, 0.f}; ay[m][n] = (f32x4){0.f, 0.f, 0.f, 0.f}; }
          const u16* gA = p.H + (size_t)rt * 128 * 1024;
          const u16* gB = p.W + OFF_WGATE + (size_t)(nb * 1024 + ct * 128) * 1024;
          const u16* bA = p.Ycat + (size_t)rt * 128 * 2048 + nb * 512;
          const u16* bB = p.W + OFF_WBR + (size_t)(nb * 1024 + ct * 128) * 512;
          const bool last_nb = (nb == 3);
          const u16* xA = last_nb ? p.H + (size_t)nrt * 128 * 1024 : gA;
          const u16* xB = last_nb ? p.W + OFF_WGATE + (size_t)(nct * 128) * 1024 : p.W + OFF_WGATE + (size_t)((nb + 1) * 1024 + ct * 128) * 1024;
          gemm_main128(gA, 1024, gB, 1024, 1024, bA, 2048, bB, 512, true, primed, lds3, ag);
          gemm_main128(bA, 2048, bB, 512, 512, xA, 1024, xB, 1024, !last_nb || more_tiles, true, lds3, ay);
          primed = true;
#pragma unroll
          for (int m = 0; m < 2; ++m)
#pragma unroll
            for (int n = 0; n < 4; ++n)
#pragma unroll
              for (int jj = 0; jj < 4; ++jj) mg[m][n][jj] += sigmoidf_(ag[m][n][jj]) * ay[m][n][jj];
        }
#pragma unroll
        for (int m = 0; m < 2; ++m) {
          u16* dst = Mg + (size_t)(rt * 128 + wr * 32 + m * 16 + fq * 4) * 1024 + ct * 128 + wc * 64 + fr;
#pragma unroll
          for (int n = 0; n < 4; ++n)
#pragma unroll
            for (int jj = 0; jj < 4; ++jj) dst[jj * 1024 + n * 16] = f2bf(mg[m][n][jj]);
          asm volatile("" ::: "memory");
        }
        id = nid;
      }
    }
    GSYNC();

    {
      auto epi = [=](const f32x4(&acc)[2][2][4][2], const g8::Unit& u, int wr, int wc, int fr, int fq, int) {
        float* xb = xrow_ptr(p, u.pm * 256);
        const float* gate = p.mod + ((size_t)l * 9 + mod_idx(u.pm * 256)) * 6144 + 2048 + u.pn * 256 + wc * 32 + 4 * fq;
        f32x4 gv[2][2];
#pragma unroll
        for (int bj = 0; bj < 2; ++bj)
#pragma unroll
          for (int n = 0; n < 2; ++n) gv[bj][n] = *(const f32x4*)(gate + bj * 128 + n * 16);
#pragma unroll
        for (int ai = 0; ai < 2; ++ai)
#pragma unroll
          for (int m = 0; m < 4; ++m) {
            float* rowp = xb + (size_t)(ai * 128 + wr * 64 + m * 16 + fr) * DM + u.pn * 256 + wc * 32 + 4 * fq;
#pragma unroll
            for (int bj = 0; bj < 2; ++bj)
#pragma unroll
              for (int n = 0; n < 2; ++n) {
                f32x4 xv = *(const f32x4*)(rowp + bj * 128 + n * 16);
                xv += gv[bj][n] * acc[ai][bj][m][n];
                *(f32x4*)(rowp + bj * 128 + n * 16) = xv;
              }
          }
      };
      g8::Simple S; S.o.init(l == 3 ? 128 : 136, 4, nblk, bid); S.A = p.R1; S.Bt = p.W + OFF_WOUT; S.lda = 1024; S.K = 1024;
      g8::gemm_phase<false>(lds3, S, epi);
    }
    GSYNC();

    norm_mod(p, l, p.norm2_g + l * 1024, 3072, 4096, false);
    GSYNC();

    {
      u16* U = p.R1;
      auto epi = [=](const f32x4(&acc)[2][2][4][2], const g8::Unit& u, int wr, int wc, int fr, int fq, int) {
#pragma unroll
        for (int ai = 0; ai < 2; ++ai)
#pragma unroll
          for (int m = 0; m < 4; ++m) {
            u16* rowp = U + (size_t)(u.pm * 256 + ai * 128 + wr * 64 + m * 16 + fr) * 2816 + u.pn * 128 + wc * 32 + 8 * fq;
            float v[8];
#pragma unroll
            for (int n = 0; n < 2; ++n)
#pragma unroll
              for (int jj = 0; jj < 4; ++jj) v[n * 4 + jj] = siluf_(acc[ai][0][m][n][jj]) * acc[ai][1][m][n][jj];
            uint4 w;
            w.x = g8::cvt_pk_bf16(v[0], v[1]); w.y = g8::cvt_pk_bf16(v[2], v[3]); w.z = g8::cvt_pk_bf16(v[4], v[5]); w.w = g8::cvt_pk_bf16(v[6], v[7]);
            *(uint4*)rowp = w;
          }
      };
      g8::Simple S; S.o.init(l == 3 ? 128 : 136, 22, nblk, bid); S.A = p.H; S.Bt = p.W + OFF_WFF13; S.lda = 1024; S.K = 1024;
      g8::gemm_phase<true>(lds3, S, epi);
    }
    GSYNC();

    {
      auto epi = [=](const f32x4(&acc)[2][2][4][2], const g8::Unit& u, int wr, int wc, int fr, int fq, int) {
        float* xb = xrow_ptr(p, u.pm * 256);
        const float* gate = p.mod + ((size_t)l * 9 + mod_idx(u.pm * 256)) * 6144 + 5120 + u.pn * 256 + wc * 32 + 4 * fq;
        f32x4 gv[2][2];
#pragma unroll
        for (int bj = 0; bj < 2; ++bj)
#pragma unroll
          for (int n = 0; n < 2; ++n) gv[bj][n] = *(const f32x4*)(gate + bj * 128 + n * 16);
#pragma unroll
        for (int ai = 0; ai < 2; ++ai)
#pragma unroll
          for (int m = 0; m < 4; ++m) {
            float* rowp = xb + (size_t)(ai * 128 + wr * 64 + m * 16 + fr) * DM + u.pn * 256 + wc * 32 + 4 * fq;
#pragma unroll
            for (int bj = 0; bj < 2; ++bj)
#pragma unroll
              for (int n = 0; n < 2; ++n) {
                f32x4 xv = *(const f32x4*)(rowp + bj * 128 + n * 16);
                xv += gv[bj][n] * acc[ai][bj][m][n];
                *(f32x4*)(rowp + bj * 128 + n * 16) = xv;
              }
          }
      };
      g8::Simple S; S.o.init(l == 3 ? 128 : 136, 4, nblk, bid); S.A = p.R1; S.Bt = p.W + OFF_WFF2; S.lda = 2816; S.K = 2816;
      g8::gemm_phase<false>(lds3, S, epi);
      if (l < 3 && nblk > 32 && bid >= 32) convert_weights(p, l + 1, (float*)smem, 0, 12, true, bid - 32, nblk - 32, false);
    }
    GSYNC();

  }

  const int lane = threadIdx.x & 63, wid = threadIdx.x >> 6;
  for (int r = bid * 8 + wid; r < NB * SL; r += nblk * 8) {
    float* xr = p.out + (size_t)r * DM;
    float4 v[4];
    float ss = 0.f;
#pragma unroll
    for (int i = 0; i < 4; ++i) {
      v[i] = *(const float4*)(xr + i * 256 + lane * 4);
      ss += v[i].x * v[i].x + v[i].y * v[i].y + v[i].z * v[i].z + v[i].w * v[i].w;
    }
    ss = wave_sum(ss);
    const float inv = rsqrtf(ss * (1.f / 1024.f) + EPS);
#pragma unroll
    for (int i = 0; i < 4; ++i) {
      float4 gg = *(const float4*)(p.final_g + i * 256 + lane * 4);
      float4 ov;
      ov.x = v[i].x * inv * gg.x; ov.y = v[i].y * inv * gg.y; ov.z = v[i].z * inv * gg.z; ov.w = v[i].w * inv * gg.w;
      *(float4*)(xr + i * 256 + lane * 4) = ov;
    }
  }
}

extern "C" void kernel_launch(void* const* d_in, const int* in_sizes, int n_in, void* d_out, int out_size, void* d_ws,
                              size_t ws_size, hipStream_t stream) {
  static int grid_blocks = 0;
  if (!grid_blocks) {
    int dev = 0, cus = 0, per_cu = 0;
    hipGetDevice(&dev);
    hipDeviceGetAttribute(&cus, hipDeviceAttributeMultiprocessorCount, dev);
    hipFuncSetAttribute((const void*)mega, hipFuncAttributeMaxDynamicSharedMemorySize, LDS_BYTES);
    hipOccupancyMaxActiveBlocksPerMultiprocessor(&per_cu, (const void*)mega, NTHR, LDS_BYTES);
    if (per_cu < 1) per_cu = 1;
    if (per_cu > 1) per_cu = 1;
    grid_blocks = cus * per_cu;
    (void)hipGetLastError();
  }
  P p{};
  const float** pf = (const float**)&p;
  for (int i = 0; i < 31; ++i) pf[i] = (const float*)d_in[i];
  p.out = (float*)d_out;
  size_t off = 0;
  auto take = [&](size_t bytes) { void* r = (char*)d_ws + off; off += (bytes + 255) & ~(size_t)255; return r; };
  p.Xc = (float*)take((size_t)NB * SC * DM * 4);
  p.mod = (float*)take((size_t)4 * 9 * 6144 * 4);
  p.rope = (float*)take((size_t)SL * 32 * 4);
  p.summ = (float2*)take((size_t)NB * 2 * 512 * 34 * 8);
  p.ssq = (float*)take((size_t)12 * MTOT * 4);
  p.bar = (unsigned*)take((size_t)XCD_BAR_WORDS * 4);
  p.W = (u16*)take((size_t)W_ELEMS * 2);
  p.H = (u16*)take((size_t)MTOT * 1024 * 2);
  p.Ycat = (u16*)take((size_t)MTOT * 2048 * 2);
  p.R1 = (u16*)take((size_t)MTOT * 2560 * 2);
  p.K = (u16*)take((size_t)MTOT * 768 * 2);
  p.Vt = (u16*)take((size_t)MTOT * 512 * 2);
  p.Q = p.R1 + (size_t)MTOT * 1792;
  if (off > ws_size) { fprintf(stderr, "workspace too small: need %zu have %zu\n", off, ws_size); return; }
  (void)hipMemsetAsync(p.bar, 0, (size_t)XCD_BAR_WORDS * 4, stream);
  void* args[] = {&p};
  hipError_t e = hipLaunchCooperativeKernel((const void*)mega, dim3(grid_blocks), dim3(NTHR), args, LDS_BYTES, stream);
  if (e != hipSuccess) fprintf(stderr, "cooperative launch failed: %s (grid %d)\n", hipGetErrorString(e), grid_blocks);
}
```

```cpp
#include <hip/hip_runtime.h>
#include <hip/hip_bf16.h>
#include <hip/hip_cooperative_groups.h>
#include <cstdio>
#include <cstdint>
namespace cg = cooperative_groups;

typedef unsigned short u16;
using bf16x8 = __attribute__((ext_vector_type(8))) short;
using f32x4 = __attribute__((ext_vector_type(4))) float;
#define LAS3 __attribute__((address_space(3)))

#define NB 8
#define SL 4096
#define SC 256
#define ST 4352
#define MTOT 34816
#define DM 1024
#define NTHR 512
#define EPS 1e-6f
#define LDS_BYTES 159744
#define DUP_ATTN 1
#define DUP_C1 1
#define DUP_C2 1
#define DUP_E 1
#define EXTRA_SYNC 0
#define GSYNC() do { xcd_barrier(xb); for (int q_ = 0; q_ < EXTRA_SYNC; ++q_) xcd_barrier(xb); } while (0)
#define DUP_LRU1 1
#define DUP_LRU3 1
#define DUP_PROJ 1

#define OFF_WINA 0
#define OFF_WINB (OFF_WINA + 2560 * 1024)
#define OFF_WGATE (OFF_WINB + 1792 * 1024)
#define OFF_WBR (OFF_WGATE + 4096 * 1024)
#define OFF_WOUT (OFF_WBR + 4 * 1024 * 512)
#define OFF_WFF13 (OFF_WOUT + 1024 * 1024)
#define OFF_WFF2 (OFF_WFF13 + 5632 * 1024)
#define OFF_WQUP (OFF_WFF2 + 1024 * 2816)
#define OFF_WKVUP (OFF_WQUP + 768 * 384)
#define OFF_WS (OFF_WKVUP + 1024 * 256)
#define OFF_WLRU (OFF_WS + 4 * 128 * 128)
#define W_ELEMS (OFF_WLRU + 2 * 8 * 4 * 32 * 64)

struct P {
  const float *x, *c, *ctx, *c_ctx, *w_mod, *b_mod, *norm1_g, *norm2_g, *w_in, *conv_a_w, *lru_conv_w, *lru_conv_b,
      *lru_w_a, *lru_b_a, *lru_w_x, *lru_b_x, *lru_lam, *cmlp_ln_g, *cmlp_ln_b, *cmlp_w_s, *cmlp_b_s, *q_norm_g,
      *kv_norm_g, *w_q_up, *w_kv_up, *w_branch, *w_out, *w_ff1, *w_ff3, *w_ff2, *final_g;
  float *out, *Xc, *mod, *rope;
  float2* summ;
  float* ssq;
  unsigned* bar;
  u16 *W, *H, *Ycat, *R1, *Q, *K, *Vt;
};

__device__ __forceinline__ uint32_t pack2(float a, float b) { uint32_t r; asm("v_cvt_pk_bf16_f32 %0, %1, %2" : "=v"(r) : "v"(a), "v"(b)); return r; }
__device__ __forceinline__ u16 f2bf(float f) { return (u16)(pack2(f, f) & 0xffffu); }
__device__ __forceinline__ float bf2f(u16 h) { return __uint_as_float(((uint32_t)h) << 16); }
__device__ __forceinline__ float sigmoidf_(float x) { return __builtin_amdgcn_rcpf(1.f + __expf(-x)); }
__device__ __forceinline__ float sigmoid_rcp_(float x) { return __builtin_amdgcn_rcpf(1.f + __expf(-x)); }
__device__ __forceinline__ float siluf_(float x) { return x * __builtin_amdgcn_rcpf(1.f + __expf(-x)); }
__device__ __forceinline__ float geluf_(float x) {
  float u = 0.7978845608028654f * (x + 0.044715f * x * x * x);
  return x * __builtin_amdgcn_rcpf(1.f + __expf(-2.f * u));
}
__device__ __forceinline__ void unpack8(const uint4& v, float* f) {
  f[0] = __uint_as_float(v.x << 16); f[1] = __uint_as_float(v.x & 0xffff0000u);
  f[2] = __uint_as_float(v.y << 16); f[3] = __uint_as_float(v.y & 0xffff0000u);
  f[4] = __uint_as_float(v.z << 16); f[5] = __uint_as_float(v.z & 0xffff0000u);
  f[6] = __uint_as_float(v.w << 16); f[7] = __uint_as_float(v.w & 0xffff0000u);
}
__device__ __forceinline__ uint4 pack8(const float* f) {
  uint4 v; v.x = pack2(f[0], f[1]); v.y = pack2(f[2], f[3]); v.z = pack2(f[4], f[5]); v.w = pack2(f[6], f[7]); return v;
}
template <int CTRL, int ROWMASK>
__device__ __forceinline__ float dpp0f(float src) {
  return __int_as_float(__builtin_amdgcn_update_dpp(0, __float_as_int(src), CTRL, ROWMASK, 0xf, false));
}
__device__ __forceinline__ float wave_sum(float v) {
  v += dpp0f<0x111, 0xf>(v); v += dpp0f<0x112, 0xf>(v); v += dpp0f<0x114, 0xf>(v); v += dpp0f<0x118, 0xf>(v);
  v += dpp0f<0x142, 0xa>(v); v += dpp0f<0x143, 0xc>(v);
  return __int_as_float(__builtin_amdgcn_readlane(__float_as_int(v), 63));
}
__device__ __forceinline__ float* xrow_ptr(const P& p, int r) {
  int b = r / ST, t = r - b * ST;
  return t < SL ? p.out + ((size_t)(b * SL + t)) * DM : p.Xc + ((size_t)(b * SC + t - SL)) * DM;
}
__device__ __forceinline__ const float* xin_ptr(const P& p, int r) {
  int b = r / ST, t = r - b * ST;
  return t < SL ? p.x + ((size_t)(b * SL + t)) * DM : p.ctx + ((size_t)(b * SC + t - SL)) * DM;
}
__device__ __forceinline__ int mod_idx(int r) { int b = r / ST, t = r - b * ST; return t < SL ? b : 8; }

template <int MT>
__device__ __forceinline__ void gemm_main(const u16* __restrict__ A, int lda, const u16* __restrict__ B, int ldb, int K,
                                          u16* lds, f32x4 (&acc)[MT][4]) {
  constexpr int BM = MT * 64;
  constexpr int ASZ = BM * 72, BSZ = 128 * 72, STG = ASZ + BSZ;
  int tid = threadIdx.x; asm volatile("" : "+v"(tid));
  const int lane = tid & 63, wid = tid >> 6, wr = wid >> 1, wc = wid & 1, fr = lane & 15, fq = lane >> 4;
  uint4 ra[MT], rb[2];
  const int nk = K >> 6;
  const int crow = tid >> 3, ckc = (tid & 7) * 8;
#pragma unroll
  for (int i = 0; i < MT; ++i) ra[i] = *(const uint4*)(A + (size_t)(crow + i * 64) * lda + ckc);
#pragma unroll
  for (int i = 0; i < 2; ++i) rb[i] = *(const uint4*)(B + (size_t)(crow + i * 64) * ldb + ckc);
  {
    u16* sa = lds; u16* sb = lds + ASZ;
#pragma unroll
    for (int i = 0; i < MT; ++i) *(uint4*)(sa + (crow + i * 64) * 72 + ckc) = ra[i];
#pragma unroll
    for (int i = 0; i < 2; ++i) *(uint4*)(sb + (crow + i * 64) * 72 + ckc) = rb[i];
  }
  __syncthreads();
  for (int kt = 0; kt < nk; ++kt) {
    const bool more = (kt + 1 < nk);
    if (more) {
      const int k0 = (kt + 1) * 64 + ckc;
#pragma unroll
      for (int i = 0; i < MT; ++i) ra[i] = *(const uint4*)(A + (size_t)(crow + i * 64) * lda + k0);
#pragma unroll
      for (int i = 0; i < 2; ++i) rb[i] = *(const uint4*)(B + (size_t)(crow + i * 64) * ldb + k0);
    }
    const u16* sa = lds + (kt & 1) * STG;
    const u16* sb = sa + ASZ;
#pragma unroll
    for (int ks = 0; ks < 2; ++ks) {
      bf16x8 a[MT], b[4];
#pragma unroll
      for (int m = 0; m < MT; ++m) a[m] = *(const bf16x8*)(sa + (wr * MT * 16 + m * 16 + fr) * 72 + ks * 32 + fq * 8);
#pragma unroll
      for (int n = 0; n < 4; ++n) b[n] = *(const bf16x8*)(sb + (wc * 64 + n * 16 + fr) * 72 + ks * 32 + fq * 8);
#pragma unroll
      for (int m = 0; m < MT; ++m)
#pragma unroll
        for (int n = 0; n < 4; ++n) acc[m][n] = __builtin_amdgcn_mfma_f32_16x16x32_bf16(a[m], b[n], acc[m][n], 0, 0, 0);
    }
    if (more) {
      u16* wa = lds + ((kt + 1) & 1) * STG; u16* wb = wa + ASZ;
#pragma unroll
      for (int i = 0; i < MT; ++i) *(uint4*)(wa + (crow + i * 64) * 72 + ckc) = ra[i];
#pragma unroll
      for (int i = 0; i < 2; ++i) *(uint4*)(wb + (crow + i * 64) * 72 + ckc) = rb[i];
    }
    __syncthreads();
  }
}

__device__ __forceinline__ void gemm_main128(const u16* __restrict__ A, int lda, const u16* __restrict__ B, int ldb, int K,
                                             const u16* __restrict__ nA, int nlda, const u16* __restrict__ nB, int nldb, bool has_next, bool primed,
                                             LAS3 unsigned char* lds, f32x4 (&acc)[2][4]) {
  constexpr int OPB = 128 * 256, STGB = 2 * OPB;
  int tid = threadIdx.x; asm volatile("" : "+v"(tid));
  const int lane = tid & 63, wid = __builtin_amdgcn_readfirstlane(tid >> 6), wr = wid >> 1, wc = wid & 1, fr = lane & 15, fq = lane >> 4;
  const int drow = wid * 4 + (lane >> 4), dslot = lane & 15;
  const int gch = (dslot ^ (drow & 15)) * 8;
  const unsigned goffA = (unsigned)(drow * lda + gch), goffB = (unsigned)(drow * ldb + gch);
  const unsigned rstepA = (unsigned)(32 * lda), rstepB = (unsigned)(32 * ldb);
  const int nk = K >> 7;
#define G128_DMA(st, kt) do { const int k0_ = (kt) * 128; \
    _Pragma("unroll") for (int i_ = 0; i_ < 4; ++i_) { \
      __builtin_amdgcn_global_load_lds((const unsigned*)(A + goffA + i_ * rstepA + k0_), (LAS3 unsigned*)(lds + (st) * STGB + (i_ * 8 + wid) * 1024), 16, 0, 0); \
      __builtin_amdgcn_global_load_lds((const unsigned*)(B + goffB + i_ * rstepB + k0_), (LAS3 unsigned*)(lds + (st) * STGB + OPB + (i_ * 8 + wid) * 1024), 16, 0, 0); } } while (0)
#define G128_MMA(st) do { LAS3 const unsigned char* sa = lds + (st) * STGB; LAS3 const unsigned char* sb = sa + OPB; \
    _Pragma("unroll") for (int ks = 0; ks < 4; ++ks) { bf16x8 a[2], b[4]; \
      _Pragma("unroll") for (int m = 0; m < 2; ++m) a[m] = *(LAS3 const bf16x8*)(sa + (wr * 32 + m * 16 + fr) * 256 + (((ks * 4 + fq) ^ fr) * 16)); \
      _Pragma("unroll") for (int n = 0; n < 4; ++n) b[n] = *(LAS3 const bf16x8*)(sb + (wc * 64 + n * 16 + fr) * 256 + (((ks * 4 + fq) ^ fr) * 16)); \
      __builtin_amdgcn_s_setprio(1); \
      _Pragma("unroll") for (int m = 0; m < 2; ++m) _Pragma("unroll") for (int n = 0; n < 4; ++n) \
        acc[m][n] = __builtin_amdgcn_mfma_f32_16x16x32_bf16(a[m], b[n], acc[m][n], 0, 0, 0); \
      __builtin_amdgcn_s_setprio(0); } } while (0)
  if (!primed) {
    G128_DMA(0, 0);
    asm volatile("s_waitcnt vmcnt(0)" ::: "memory");
    __syncthreads();
  }
  for (int kt = 0; kt < nk; ++kt) {
    if (kt + 1 < nk) G128_DMA((kt + 1) & 1, kt + 1);
    else if (has_next) {
      const unsigned ngA = (unsigned)(drow * nlda + gch), ngB = (unsigned)(drow * nldb + gch);
#pragma unroll
      for (int i_ = 0; i_ < 4; ++i_) {
        __builtin_amdgcn_global_load_lds((const unsigned*)(nA + ngA + i_ * 32 * nlda), (LAS3 unsigned*)(lds + (i_ * 8 + wid) * 1024), 16, 0, 0);
        __builtin_amdgcn_global_load_lds((const unsigned*)(nB + ngB + i_ * 32 * nldb), (LAS3 unsigned*)(lds + OPB + (i_ * 8 + wid) * 1024), 16, 0, 0);
      }
    }
    G128_MMA(kt & 1);
    asm volatile("s_waitcnt vmcnt(0)" ::: "memory");
    __syncthreads();
  }
#undef G128_DMA
#undef G128_MMA
}

template <int MT, class Pre, class Epi>
__device__ __forceinline__ void gemm_phase(const u16* A, int lda, const u16* B, int ldb, int K, int nct, u16* lds, Pre pre,
                                           Epi epi, int id0, int idstride, int idoff) {
  constexpr int BM = MT * 64;
  const int nrt = MTOT / BM, ntile = nrt * nct;
  int first = id0;
  if (first < idoff) { int kk = (idoff - first + idstride - 1) / idstride; first += kk * idstride; }
  for (int gid = first; gid < idoff + ntile; gid += idstride) {
    int id = gid - idoff;
    int g = id / (8 * nct), rem = id - g * 8 * nct;
    int ct = rem >> 3, rt = g * 8 + (rem & 7);
    f32x4 acc[MT][4];
#pragma unroll
    for (int m = 0; m < MT; ++m)
#pragma unroll
      for (int n = 0; n < 4; ++n) acc[m][n] = (f32x4){0.f, 0.f, 0.f, 0.f};
    pre(rt * BM);
    gemm_main<MT>(A + (size_t)rt * BM * lda, lda, B + (size_t)ct * 128 * ldb, ldb, K, lds, acc);
    epi(rt * BM, ct * 128, acc);
    __syncthreads();
  }
}

namespace g8 {
constexpr int BM = 256, BK = 64, HALF = 128, HTB = HALF * BK * 2, STAGE_BYTES = 8 * HTB, NXCD = 8, WGM = 8;
__device__ __forceinline__ int lds_byte(int r, int c) { const int st = (r >> 4) * 2 + (c >> 5), rr = r & 15, cc = c & 31, ob = rr * 64 + cc * 2; return st * 1024 + (ob ^ (((ob >> 9) & 1) << 5)); }
__device__ __forceinline__ void stage_rc(int b, int& R, int& C) { const int st = b / 1024, sb = b % 1024, swz = sb ^ (((sb >> 9) & 1) << 5); R = (st >> 1) * 16 + swz / 64; C = (st & 1) * 32 + (swz % 64) / 2; }
__device__ __forceinline__ int perm32(int rho) { const int n = rho >> 4, i = rho & 15; return 8 * (i >> 2) + 4 * n + (i & 3); }
struct Unit { const char* A; const char* B; int lda, K, pm, pn, aux; };
struct Order {
  int nM, nN, nwg, G, c;
  __device__ void init(int nM_, int nN_, int G_, int c_) { nM = nM_; nN = nN_; nwg = nM * nN; G = G_; c = c_; }
  __device__ bool tile(int i, int& pm, int& pn) const {
    const long L = (long)i * G + c; if (L >= nwg) return false;
    int wgid = (int)L; { const int q = nwg / NXCD, r = nwg % NXCD, xcd = wgid % NXCD, off = wgid / NXCD; wgid = (xcd < r ? xcd * (q + 1) : r * (q + 1) + (xcd - r) * q) + off; }
    const int nig = WGM * nN, gid = wgid / nig, fm = gid * WGM, gsz = (nM - fm) < WGM ? (nM - fm) : WGM;
    pm = fm + ((wgid % nig) % gsz); pn = (wgid % nig) / gsz;
    if (nM == 128) pm += pm >> 4;
    return true;
  }
};
struct Simple {
  Order o; const u16* A; const u16* Bt; int lda, K;
  __device__ bool next(int i, Unit& u) const {
    int pm, pn; if (!o.tile(i, pm, pn)) return false;
    u.A = (const char*)(A + (size_t)pm * 256 * lda); u.B = (const char*)(Bt + (size_t)pn * 256 * K); u.lda = lda; u.K = K; u.pm = pm; u.pn = pn; u.aux = 0; return true;
  }
};
__device__ __forceinline__ unsigned cvt_pk_bf16(float lo, float hi) { unsigned r; asm volatile("v_cvt_pk_bf16_f32 %0, %1, %2" : "=v"(r) : "v"(lo), "v"(hi)); return r; }

template <bool PERM, class Sched, class Epi>
__device__ __forceinline__ void gemm_phase(LAS3 unsigned char* lds, const Sched& S, const Epi& E) {
  int tid = threadIdx.x; asm volatile("" : "+v"(tid));
  const int wid = __builtin_amdgcn_readfirstlane(tid >> 6), lane = tid & 63, wr = wid >> 2, wc = wid & 3, fr = lane & 15, fq = lane >> 4;
  const size_t kstep = (size_t)(BK * 2);
#define G8_VOFF(LDA_, K_) do { int _t2 = tid; asm volatile("" : "+v"(_t2)); _Pragma("unroll") for (int _i = 0; _i < 2; ++_i) { int R, C; stage_rc(_t2 * 16 + _i * 8192, R, C); \
    const int Rb = PERM ? ((R & ~31) + perm32(R & 31)) : R; voffA[_i] = (unsigned)(R * (LDA_) + C) * 2u; voffB[_i] = (unsigned)(Rb * (K_) + C) * 2u; } \
    hstepA = (size_t)HALF * (LDA_) * 2; hstepB = (size_t)HALF * (K_) * 2; } while (0)
  const unsigned ldsw = (unsigned)wid * 1024u;
  const int aoff = lds_byte(wr * 64 + fr, fq * 8), boff = lds_byte(wc * 32 + fr, fq * 8);
#define G8_SA(b, h) (((b) * 2 + (h)) * HTB)
#define G8_SB(b, h) ((4 + (b) * 2 + (h)) * HTB)
#define G8_STAGE(bufoff, gbase, voff) do { _Pragma("unroll") for (int _i = 0; _i < 2; ++_i) \
    __builtin_amdgcn_global_load_lds((const unsigned*)((const char*)(gbase) + (voff)[_i]), (LAS3 unsigned*)(lds + (bufoff) + ldsw + _i * 8192), 16, 0, 0); } while (0)
#define G8_LDA(dst, b, h) do { _Pragma("unroll") for (int m = 0; m < 4; ++m) _Pragma("unroll") for (int k = 0; k < 2; ++k) dst[m][k] = *(const LAS3 bf16x8*)(lds + G8_SA(b, h) + aoff + m * 2048 + k * 1024); } while (0)
#define G8_LDB(dst, b, h) do { _Pragma("unroll") for (int n = 0; n < 2; ++n) _Pragma("unroll") for (int k = 0; k < 2; ++k) dst[n][k] = *(const LAS3 bf16x8*)(lds + G8_SB(b, h) + boff + n * 2048 + k * 1024); } while (0)
#define G8_MMA(ai, bj, At, Bt) do { __builtin_amdgcn_s_setprio(1); _Pragma("unroll") for (int m = 0; m < 4; ++m) _Pragma("unroll") for (int n = 0; n < 2; ++n) _Pragma("unroll") for (int k = 0; k < 2; ++k) \
    acc[ai][bj][m][n] = __builtin_amdgcn_mfma_f32_16x16x32_bf16(Bt[n][k], At[m][k], acc[ai][bj][m][n], 0, 0, 0); __builtin_amdgcn_s_setprio(0); } while (0)
#define G8_WAIT_V(n) asm volatile("s_waitcnt vmcnt(" #n ")" ::: "memory")
#define G8_WAIT_L(n) asm volatile("s_waitcnt lgkmcnt(" #n ")" ::: "memory")
#define G8_BAR __builtin_amdgcn_s_barrier()
#define G8_SCHED __builtin_amdgcn_sched_barrier(0)
  Unit cur, nxt; int ui = 0;
  if (!S.next(0, cur)) return;
  f32x4 acc[2][2][4][2];
#pragma unroll
  for (int a = 0; a < 2; ++a)
#pragma unroll
    for (int b = 0; b < 2; ++b)
#pragma unroll
      for (int m = 0; m < 4; ++m)
#pragma unroll
        for (int n = 0; n < 2; ++n) acc[a][b][m][n] = (f32x4){0.f, 0.f, 0.f, 0.f};
  bf16x8 At[4][2], B0[2][2], B1[2][2];
  const char* cA = cur.A; const char* cB = cur.B;
  unsigned voffA[2], voffB[2];
  size_t hstepA, hstepB;
  G8_VOFF(cur.lda, cur.K);
  G8_STAGE(G8_SB(0, 0), cB, voffB); G8_STAGE(G8_SA(0, 0), cA, voffA); G8_STAGE(G8_SB(0, 1), cB + hstepB, voffB); G8_STAGE(G8_SA(0, 1), cA + hstepA, voffA);
  if (wr == 1) G8_BAR;
  G8_WAIT_V(4); G8_BAR;
  G8_STAGE(G8_SB(1, 0), cB + kstep, voffB); G8_STAGE(G8_SA(1, 0), cA + kstep, voffA); G8_STAGE(G8_SB(1, 1), cB + hstepB + kstep, voffB);
  G8_WAIT_V(6); G8_BAR;
  for (;;) {
    const bool has_next = S.next(ui + 1, nxt);
    if (!has_next) nxt = cur;
    const char* nA = nxt.A; const char* nB = nxt.B;
    const int nt = cur.K / BK;
    for (int t = 0; t < nt; t += 2) {
      const bool last = (t == nt - 2);
      const char* a1 = cA + (size_t)(t + 1) * kstep;
      const char* a2 = last ? nA : cA + (size_t)(t + 2) * kstep; const char* b2 = last ? nB : cB + (size_t)(t + 2) * kstep;
      const char* a3 = a2 + kstep; const char* b3 = b2 + kstep;
      G8_LDB(B0, 0, 0); G8_SCHED; G8_LDA(At, 0, 0); G8_STAGE(G8_SA(1, 1), a1 + hstepA, voffA);
      G8_WAIT_L(8); G8_BAR; G8_WAIT_L(0); G8_MMA(0, 0, At, B0); G8_BAR; G8_SCHED;
      if (last) G8_VOFF(nxt.lda, nxt.K);
      G8_LDB(B1, 0, 1); G8_STAGE(G8_SB(0, 0), b2, voffB);
      G8_BAR; G8_WAIT_L(0); G8_MMA(0, 1, At, B1); G8_BAR;
      G8_LDA(At, 0, 1); G8_STAGE(G8_SA(0, 0), a2, voffA);
      G8_BAR; G8_WAIT_L(0); G8_MMA(1, 0, At, B0); G8_BAR; G8_SCHED;
      G8_STAGE(G8_SB(0, 1), b2 + hstepB, voffB);
      G8_WAIT_V(6); G8_BAR; G8_MMA(1, 1, At, B1); G8_BAR;
      G8_LDB(B0, 1, 0); G8_SCHED; G8_LDA(At, 1, 0); G8_STAGE(G8_SA(0, 1), a2 + hstepA, voffA);
      G8_WAIT_L(8); G8_BAR; G8_WAIT_L(0); G8_MMA(0, 0, At, B0); G8_BAR; G8_SCHED;
      G8_LDB(B1, 1, 1); G8_STAGE(G8_SB(1, 0), b3, voffB);
      G8_BAR; G8_WAIT_L(0); G8_MMA(0, 1, At, B1); G8_BAR;
      G8_LDA(At, 1, 1); G8_STAGE(G8_SA(1, 0), a3, voffA);
      G8_BAR; G8_WAIT_L(0); G8_MMA(1, 0, At, B0); G8_BAR; G8_SCHED;
      G8_STAGE(G8_SB(1, 1), b3 + hstepB, voffB);
      G8_WAIT_V(6); G8_BAR; G8_MMA(1, 1, At, B1); G8_BAR;
    }
    E(acc, cur, wr, wc, fr, fq, tid);
    if (!has_next) break;
#pragma unroll
    for (int a = 0; a < 2; ++a)
#pragma unroll
      for (int b = 0; b < 2; ++b)
#pragma unroll
        for (int m = 0; m < 4; ++m)
#pragma unroll
          for (int n = 0; n < 2; ++n) acc[a][b][m][n] = (f32x4){0.f, 0.f, 0.f, 0.f};
    cur = nxt; cA = nA; cB = nB; ++ui;
  }
  G8_WAIT_V(0);
  if (wr == 0) G8_BAR;
  G8_BAR;
#undef G8_VOFF
#undef G8_SA
#undef G8_SB
#undef G8_STAGE
#undef G8_LDA
#undef G8_LDB
#undef G8_MMA
#undef G8_WAIT_V
#undef G8_WAIT_L
#undef G8_BAR
#undef G8_SCHED
}
}

__device__ __forceinline__ void convT_job(const float* src0, const float* src1, int ldsrc, int kind, int off, int nvalid, u16* dst, int K,
                          int Ndst, const float* kscale, float mult, float* lds, int vb, int vn) {
  int tid = threadIdx.x; asm volatile("" : "+v"(tid));
  const int nkt = K >> 6, nitems = nkt * (Ndst >> 7);
  for (int it = vb; it < nitems; it += vn) {
    const int kt = it % nkt, nt = it / nkt;
    float v[16];
#pragma unroll
    for (int e = 0; e < 16; ++e) {
      int idx = tid + e * 512, i = idx >> 7, j = idx & 127, n = nt * 128 + j, k = kt * 64 + i;
      if (kind == 0) {
        v[e] = (n < nvalid) ? src0[(size_t)k * ldsrc + off + n] : 0.f;
      } else {
        int g = n >> 8, w = n & 255;
        const float* sp = (w < 128) ? src0 : src1;
        v[e] = sp[(size_t)k * ldsrc + g * 128 + (w & 127)];
      }
    }
#pragma unroll
    for (int e = 0; e < 16; ++e) {
      int idx = tid + e * 512, i = idx >> 7, j = idx & 127, k = kt * 64 + i;
      float x = v[e];
      if (kscale) x *= kscale[k];
      lds[j * 65 + i] = x * mult;
    }
    __syncthreads();
#pragma unroll
    for (int e = 0; e < 8; ++e) {
      int idx = tid + e * 512, j = idx >> 5, i2 = (idx & 31) * 2;
      *(uint32_t*)(dst + (size_t)(nt * 128 + j) * K + kt * 64 + i2) = pack2(lds[j * 65 + i2], lds[j * 65 + i2 + 1]);
    }
    __syncthreads();
  }
}

__device__ __forceinline__ void convert_weights(const P& p, int l, float* lds, int job_lo, int job_hi, bool skip_ff2, int vb, int vn, bool do_small) {
  const float* win = p.w_in + (size_t)l * 1024 * 8352;
#pragma unroll 1
  for (int job = job_lo; job < job_hi; ++job) {
    if (skip_ff2 && job == 9) continue;
    const float* s0 = win; const float* s1 = nullptr; const float* ksc = nullptr;
    int ldsrc = 8352, kind = 0, off = 0, nvalid = 0, K = 1024, Ndst = 0; float mult = 1.f; u16* dst = p.W;
    if (job == 0) { off = 1696; nvalid = 2560; dst += OFF_WINA; Ndst = 2560; }
    else if (job == 1) { off = 0; nvalid = 1696; dst += OFF_WINB; Ndst = 1792; }
    else if (job == 2) { off = 4256; nvalid = 4096; dst += OFF_WGATE; Ndst = 4096; }
    else if (job < 7) { const int n = job - 3; s0 = p.w_branch + ((size_t)l * 4 + n) * 512 * 1024; ldsrc = 1024; nvalid = 1024; dst += OFF_WBR + (size_t)n * 1024 * 512; K = 512; Ndst = 1024; }
    else if (job == 7) { s0 = p.w_out + (size_t)l * 1024 * 1024; ldsrc = 1024; nvalid = 1024; dst += OFF_WOUT; Ndst = 1024; }
    else if (job == 8) { s0 = p.w_ff1 + (size_t)l * 1024 * 2816; s1 = p.w_ff3 + (size_t)l * 1024 * 2816; ldsrc = 2816; kind = 1; dst += OFF_WFF13; Ndst = 5632; }
    else if (job == 9) { s0 = p.w_ff2 + (size_t)l * 2816 * 1024; ldsrc = 1024; nvalid = 1024; dst += OFF_WFF2; K = 2816; Ndst = 1024; }
    else if (job == 10) { s0 = p.w_q_up + (size_t)l * 384 * 768; ldsrc = 768; nvalid = 768; dst += OFF_WQUP; K = 384; Ndst = 768; ksc = p.q_norm_g + l * 384; mult = 0.10206207261596575f * 1.4426950408889634f; }
    else { s0 = p.w_kv_up + (size_t)l * 256 * 1024; ldsrc = 1024; nvalid = 1024; dst += OFF_WKVUP; K = 256; Ndst = 1024; ksc = p.kv_norm_g + l * 256; }
    convT_job(s0, s1, ldsrc, kind, off, nvalid, dst, K, Ndst, ksc, mult, lds, vb, vn);
  }
  if (!do_small) return;
  int tidc = threadIdx.x; asm volatile("" : "+v"(tidc));
  const int gt = blockIdx.x * NTHR + tidc, gs = gridDim.x * NTHR;
  for (int i = gt; i < 4 * 128 * 128; i += gs) p.W[OFF_WS + i] = f2bf(p.cmlp_w_s[(size_t)l * 65536 + i]);
  for (int i = gt; i < 2 * 8 * 128 * 64; i += gs) {
    int k = i & 63, n = (i >> 6) & 127, h = (i >> 13) & 7, d = i >> 16;
    const float* src = (n < 64) ? p.lru_w_a : p.lru_w_x;
    p.W[OFF_WLRU + i] = f2bf(src[((((size_t)l * 2 + d) * 8 + h) * 64 + k) * 64 + (n & 63)]);
  }
}

__device__ __forceinline__ void phase0(const P& p, unsigned char* smem) {
  int tid = threadIdx.x; asm volatile("" : "+v"(tid));
  const int gt = blockIdx.x * NTHR + tid, gs = gridDim.x * NTHR;
  for (int idx = gt; idx < SL * 8; idx += gs) {
    int t = idx >> 3, i = idx & 7;
    float inv = exp2f(-(float)i * 0.125f * 13.287712379549449f);
    float ar = (float)(t >> 6) * inv, ac = (float)(t & 63) * inv;
    const float i2pi = 0.15915494309189535f;
    float rr = ar * i2pi; rr -= floorf(rr); rr *= 6.283185307179586f;
    float rc = ac * i2pi; rc -= floorf(rc); rc *= 6.283185307179586f;
    p.rope[t * 32 + i] = __cosf(rr); p.rope[t * 32 + 8 + i] = __sinf(rr);
    p.rope[t * 32 + 16 + i] = __cosf(rc); p.rope[t * 32 + 24 + i] = __sinf(rc);
  }
  float* sS = (float*)smem; float* red = sS + 9 * 1024;
  for (int it = blockIdx.x; it < 4 * 96; it += gridDim.x) {
    const int l = it / 96, cgp = it - l * 96;
    for (int idx = tid; idx < 9216; idx += 512) {
      int m = idx >> 10, k = idx & 1023;
      float v = (m < 8) ? p.c[m * 1024 + k] : p.c_ctx[k];
      sS[idx] = siluf_(v);
    }
    __syncthreads();
    const int cj = tid & 63, kp = tid >> 6, j = cgp * 64 + cj;
    float a[9];
#pragma unroll
    for (int m = 0; m < 9; ++m) a[m] = 0.f;
    for (int k0 = kp * 128; k0 < kp * 128 + 128; k0 += 16) {
      float w[16];
#pragma unroll
      for (int u = 0; u < 16; ++u) w[u] = p.w_mod[((size_t)l * 1024 + k0 + u) * 6144 + j];
#pragma unroll
      for (int u = 0; u < 16; ++u)
#pragma unroll
        for (int m = 0; m < 9; ++m) a[m] += sS[m * 1024 + k0 + u] * w[u];
    }
#pragma unroll
    for (int m = 0; m < 9; ++m) red[(kp * 9 + m) * 64 + cj] = a[m];
    __syncthreads();
    for (int idx = tid; idx < 576; idx += 512) {
      int m = idx >> 6, c2 = idx & 63;
      float s = 0.f;
      for (int q = 0; q < 8; ++q) s += red[(q * 9 + m) * 64 + c2];
      p.mod[((size_t)l * 9 + m) * 6144 + cgp * 64 + c2] = s + p.b_mod[l * 6144 + cgp * 64 + c2];
    }
    __syncthreads();
  }
}

__device__ __forceinline__ void norm_mod(const P& p, int l, const float* g, int off_sh, int off_sc, bool from_input) {
  int tid = threadIdx.x; asm volatile("" : "+v"(tid));
  const int lane = tid & 63, wid = tid >> 6;
  const int rstride = gridDim.x * 8;
  int r = blockIdx.x * 8 + wid;
  float4 nv[4];
  if (r < MTOT) {
    const float* xr0 = from_input ? xin_ptr(p, r) : (const float*)xrow_ptr(p, r);
#pragma unroll
    for (int i = 0; i < 4; ++i) nv[i] = *(const float4*)(xr0 + i * 256 + lane * 4);
  }
  for (; r < MTOT; r += rstride) {
    const float* md = p.mod + ((size_t)l * 9 + mod_idx(r)) * 6144;
    float4 v[4];
#pragma unroll
    for (int i = 0; i < 4; ++i) v[i] = nv[i];
    const int rn = r + rstride;
    if (rn < MTOT) {
      const float* xrn = from_input ? xin_ptr(p, rn) : (const float*)xrow_ptr(p, rn);
#pragma unroll
      for (int i = 0; i < 4; ++i) nv[i] = *(const float4*)(xrn + i * 256 + lane * 4);
    }
    float ss = 0.f;
#pragma unroll
    for (int i = 0; i < 4; ++i) ss += v[i].x * v[i].x + v[i].y * v[i].y + v[i].z * v[i].z + v[i].w * v[i].w;
    ss = wave_sum(ss);
    const float inv = rsqrtf(ss * (1.f / 1024.f) + EPS);
    if (from_input) {
      float* xw = xrow_ptr(p, r);
#pragma unroll
      for (int i = 0; i < 4; ++i) *(float4*)(xw + i * 256 + lane * 4) = v[i];
    }
#pragma unroll
    for (int i = 0; i < 4; ++i) {
      const int k = i * 256 + lane * 4;
      float4 gg = *(const float4*)(g + k);
      float4 sh = *(const float4*)(md + off_sh + k);
      float4 sc = *(const float4*)(md + off_sc + k);
      float o0 = v[i].x * inv * gg.x * (1.f + sc.x) + sh.x;
      float o1 = v[i].y * inv * gg.y * (1.f + sc.y) + sh.y;
      float o2 = v[i].z * inv * gg.z * (1.f + sc.z) + sh.z;
      float o3 = v[i].w * inv * gg.w * (1.f + sc.w) + sh.w;
      uint2 o; o.x = pack2(o0, o1); o.y = pack2(o2, o3);
      *(uint2*)(p.H + (size_t)r * 1024 + k) = o;
    }
  }
}

__device__ __forceinline__ void conva_item(const P& p, int l, int item) {
  int tid = threadIdx.x; asm volatile("" : "+v"(tid));
  const u16* Zb1 = p.R1;
  const float* cw = p.conv_a_w + (size_t)l * 3 * 512;
  for (int e = 0; e < 32; ++e) {
    int idx = tid + e * 512, rr = idx >> 6, cgp = idx & 63;
    int r = item * 256 + rr;
    int b = r / ST, t = r - b * ST;
    int isctx = t >= SL, pos = isctx ? t - SL : t, seglen = isctx ? SC : SL;
    float acc[8];
#pragma unroll
    for (int i = 0; i < 8; ++i) acc[i] = 0.f;
#pragma unroll
    for (int k = 0; k < 3; ++k) {
      int pos2 = pos - 1 + k;
      if (pos2 >= 0 && pos2 < seglen) {
        size_t r2 = (size_t)(r - 1 + k);
        uint4 vc = *(const uint4*)(Zb1 + r2 * 2560 + 512 + cgp * 8);
        uint4 vx = *(const uint4*)(Zb1 + r2 * 2560 + 1024 + cgp * 8);
        float fc[8], fx[8];
        unpack8(vc, fc); unpack8(vx, fx);
#pragma unroll
        for (int i = 0; i < 8; ++i) acc[i] += cw[k * 512 + cgp * 8 + i] * (fc[i] * fx[i]);
      }
    }
    uint4 vb = *(const uint4*)(Zb1 + (size_t)r * 2560 + cgp * 8);
    float fb[8];
    unpack8(vb, fb);
#pragma unroll
    for (int i = 0; i < 8; ++i) acc[i] *= fb[i];
    *(uint4*)(p.Ycat + (size_t)r * 2048 + cgp * 8) = pack8(acc);
  }
}

__device__ __forceinline__ void cmlp_item(const P& p, int l, int item, unsigned char* smem) {
  int tid = threadIdx.x; asm volatile("" : "+v"(tid));
  const int lane = tid & 63, wid = tid >> 6, fr = lane & 15, fq = lane >> 4;
  const int g = item & 3, bj = item >> 2;
  const int rowbase = bj * 128;
  u16* vT = (u16*)smem;
  float* sMu = (float*)(smem + 128 * 136 * 2);
  float* sRs = sMu + 128;
  const u16* Zb1 = p.R1;
  {
    uint4 vv[16];
#pragma unroll
    for (int rr = 0; rr < 16; ++rr) vv[rr] = *(const uint4*)(Zb1 + (size_t)(rowbase + wid * 16 + rr) * 2560 + 2048 + lane * 8);
#pragma unroll
    for (int rr = 0; rr < 16; ++rr) {
      int q = wid * 16 + rr;
      float f[8];
      unpack8(vv[rr], f);
      float s = 0.f;
#pragma unroll
      for (int i = 0; i < 8; ++i) { f[i] = geluf_(f[i]); s += f[i]; }
      s = wave_sum(s);
      float mu = s * (1.f / 512.f);
      float d2 = 0.f;
#pragma unroll
      for (int i = 0; i < 8; ++i) { float d = f[i] - mu; d2 += d * d; }
      d2 = wave_sum(d2);
      if (lane == 0) { sMu[q] = mu; sRs[q] = rsqrtf(d2 * (1.f / 512.f) + EPS); }
    }
  }
  __syncthreads();
  const float* lg = p.cmlp_ln_g + l * 512 + g * 128;
  const float* lb = p.cmlp_ln_b + l * 512 + g * 128;
#pragma unroll
  for (int e = 0; e < 4; ++e) {
    int idx = tid + e * 512, q = idx >> 4, dc = idx & 15;
    uint4 v = *(const uint4*)(Zb1 + (size_t)(rowbase + q) * 2560 + 2048 + g * 128 + dc * 8);
    float f[8];
    unpack8(v, f);
    float mu = sMu[q], rs = sRs[q];
#pragma unroll
    for (int i = 0; i < 8; ++i) {
      float val = (geluf_(f[i]) - mu) * rs * lg[dc * 8 + i] + lb[dc * 8 + i];
      vT[(dc * 8 + i) * 136 + q] = f2bf(val);
    }
  }
  __syncthreads();
  const u16* Ws = p.W + OFF_WS + (size_t)g * 128 * 128;
  f32x4 acc[8];
#pragma unroll
  for (int n = 0; n < 8; ++n) acc[n] = (f32x4){0.f, 0.f, 0.f, 0.f};
#pragma unroll
  for (int ks = 0; ks < 4; ++ks) {
    bf16x8 a = *(const bf16x8*)(Ws + (wid * 16 + fr) * 128 + ks * 32 + fq * 8);
#pragma unroll
    for (int n = 0; n < 8; ++n) {
      bf16x8 bb = *(const bf16x8*)(vT + (n * 16 + fr) * 136 + ks * 32 + fq * 8);
      acc[n] = __builtin_amdgcn_mfma_f32_16x16x32_bf16(bb, a, acc[n], 0, 0, 0);
    }
  }
  {
    const int pp = wid * 16 + fr;
    const size_t r = (size_t)(rowbase + pp);
    const float bsv = p.cmlp_b_s[((size_t)l * 4 + g) * 128 + pp];
    uint2 uu[8];
#pragma unroll
    for (int n = 0; n < 8; ++n) uu[n] = *(const uint2*)(Zb1 + r * 2560 + 1536 + g * 128 + n * 16 + fq * 4);
#pragma unroll
    for (int n = 0; n < 8; ++n) {
      float u0 = __uint_as_float(uu[n].x << 16), u1 = __uint_as_float(uu[n].x & 0xffff0000u);
      float u2 = __uint_as_float(uu[n].y << 16), u3 = __uint_as_float(uu[n].y & 0xffff0000u);
      uint2 ov;
      ov.x = pack2(geluf_(u0) * (acc[n][0] + bsv), geluf_(u1) * (acc[n][1] + bsv));
      ov.y = pack2(geluf_(u2) * (acc[n][2] + bsv), geluf_(u3) * (acc[n][3] + bsv));
      *(uint2*)(p.Ycat + r * 2048 + 1024 + g * 128 + n * 16 + fq * 4) = ov;
    }
  }
  __syncthreads();
}

template <int CTRL, int ROWMASK>
__device__ __forceinline__ float dppf(float old, float src) {
  return __int_as_float(__builtin_amdgcn_update_dpp(__float_as_int(old), __float_as_int(src), CTRL, ROWMASK, 0xf, false));
}
#define LSCAN_STEP(A_, B_, CTRL, RM) do { const float A2_ = dppf<CTRL, RM>(1.f, A_), B2_ = dppf<CTRL, RM>(0.f, B_); B_ = A_ * B2_ + B_; A_ = A_ * A2_; } while (0)
#define LSCAN64(A_, B_) do { LSCAN_STEP(A_, B_, 0x111, 0xf); LSCAN_STEP(A_, B_, 0x112, 0xf); LSCAN_STEP(A_, B_, 0x114, 0xf); LSCAN_STEP(A_, B_, 0x118, 0xf); \
    LSCAN_STEP(A_, B_, 0x142, 0xa); LSCAN_STEP(A_, B_, 0x143, 0xc); } while (0)

template <int PASS>
__device__ __forceinline__ void lru_run(const P& p, int l, int it_first, int it_stride, unsigned char* smem) {
  int tid = threadIdx.x; asm volatile("" : "+v"(tid));
  const int lane = tid & 63, wid = tid >> 6, fr = lane & 15, fq = lane >> 4;
  u16* sX = (u16*)smem;
  float* sA = (float*)(smem + 18432);
  float* sB = sA + 64 * 130;
  float* sH = sB + 64 * 130;
  float* sCw = sH + 128 * 65;
  float* sCarry = sCw + 320;
  float* sPar = sCarry + 128;
  u16* sW = (u16*)(sPar + 384);
  const u16* Zb2 = p.R1;
  int cur_h = -1;
  uint4 cv[2][4];
#define LRU_LOADCV(ITEM) do { const int h_ = (ITEM) & 7, bj_ = (ITEM) >> 3; const int b_ = bj_ / 34, j_ = bj_ - b_ * 34; const int ic_ = j_ >= 32; \
    const int p0_ = ic_ ? (j_ - 32) * 128 : j_ * 128, sl_ = ic_ ? SC : SL, rs_ = bj_ * 128 - p0_; \
    _Pragma("unroll") for (int e = 0; e < 2; ++e) { int idx = tid + e * 512, pp = idx >> 3, cgp = idx & 7; \
      _Pragma("unroll") for (int k = 0; k < 4; ++k) { int pos = p0_ + pp - 2 + k; cv[e][k] = make_uint4(0, 0, 0, 0); \
        if (pos >= 0 && pos < sl_) cv[e][k] = *(const uint4*)(Zb2 + (size_t)(rs_ + pos) * 1792 + h_ * 64 + cgp * 8); } } } while (0)
  if (it_first < 2176) LRU_LOADCV(it_first);
  for (int item = it_first; item < 2176; item += it_stride) {
    const int h = item & 7, bj = item >> 3;
    const int b = bj / 34, j = bj - b * 34;
    const int rowbase = bj * 128;
    const int isctx = j >= 32;
    const int ordf = isctx ? j - 32 : j + 2, ordr = 33 - j;
    float cA[16], cB[16];
    uint4 gv[2];
    if (PASS == 3) {
#pragma unroll
      for (int q = 0; q < 16; ++q) {
        const int pi = wid * 16 + q, d = pi >> 6, ch = pi & 63, o = d ? ordr : ordf;
        cA[q] = 1.f; cB[q] = 0.f;
        if (lane < o) { float2 v = p.summ[((size_t)(b * 2 + d) * 512 + h * 64 + ch) * 34 + lane]; cA[q] = v.x; cB[q] = v.y; }
      }
#pragma unroll
      for (int e = 0; e < 2; ++e) {
        int idx = tid + e * 512, pos = idx >> 3, cgp = idx & 7;
        gv[e] = *(const uint4*)(Zb2 + (size_t)(rowbase + pos) * 1792 + 800 + h * 64 + cgp * 8);
      }
    }
    if (h != cur_h) {
      cur_h = h;
      __syncthreads();
      if (tid < 320) {
        int k = tid >> 6, i = tid & 63;
        sCw[tid] = (k < 4) ? p.lru_conv_w[((size_t)l * 4 + k) * 512 + h * 64 + i] : p.lru_conv_b[l * 512 + h * 64 + i];
      }
      if (tid < 128) {
        const int d = tid >> 6, ch = tid & 63;
        const size_t pidx = ((size_t)l * 2 + d) * 512 + h * 64 + ch;
        sPar[tid * 3] = p.lru_b_a[pidx]; sPar[tid * 3 + 1] = p.lru_b_x[pidx];
        sPar[tid * 3 + 2] = 8.f * log1pf(__expf(-p.lru_lam[pidx]));
      }
#pragma unroll
      for (int e = 0; e < 4; ++e) {
        int idx = tid + e * 512, row = idx >> 3, kc = idx & 7;
        const int d = row >> 7, n = row & 127;
        *(uint4*)(sW + row * 72 + kc * 8) = *(const uint4*)(p.W + OFF_WLRU + (size_t)((d * 8 + h) * 128 + n) * 64 + kc * 8);
      }
      __syncthreads();
    }
#pragma unroll
    for (int e = 0; e < 2; ++e) {
      int idx = tid + e * 512, pp = idx >> 3, cgp = idx & 7;
      float a8[8];
#pragma unroll
      for (int i = 0; i < 8; ++i) a8[i] = sCw[256 + cgp * 8 + i];
#pragma unroll
      for (int k = 0; k < 4; ++k) {
        float f[8];
        unpack8(cv[e][k], f);
#pragma unroll
        for (int i = 0; i < 8; ++i) a8[i] += sCw[k * 64 + cgp * 8 + i] * f[i];
      }
      *(uint4*)(sX + pp * 72 + cgp * 8) = pack8(a8);
    }
    if (item + it_stride < 2176) LRU_LOADCV(item + it_stride);
    if (PASS == 3) {
#pragma unroll
      for (int q = 0; q < 16; ++q) LSCAN64(cA[q], cB[q]);
      if (lane == 63) {
#pragma unroll
        for (int q = 0; q < 16; ++q) sCarry[wid * 16 + q] = cB[q];
      }
    }
    __syncthreads();
    for (int d = 0; d < 2; ++d) {
      const u16* Wl = sW + d * 128 * 72;
      f32x4 acc[8];
#pragma unroll
      for (int n = 0; n < 8; ++n) acc[n] = (f32x4){0.f, 0.f, 0.f, 0.f};
      {
        const bf16x8 a0 = *(const bf16x8*)(sX + (wid * 16 + fr) * 72 + fq * 8);
        const bf16x8 a1 = *(const bf16x8*)(sX + (wid * 16 + fr) * 72 + 32 + fq * 8);
#pragma unroll
        for (int n = 0; n < 8; ++n) {
          const bf16x8 b0 = *(const bf16x8*)(Wl + (n * 16 + fr) * 72 + fq * 8);
          const bf16x8 b1 = *(const bf16x8*)(Wl + (n * 16 + fr) * 72 + 32 + fq * 8);
          acc[n] = __builtin_amdgcn_mfma_f32_16x16x32_bf16(a0, b0, acc[n], 0, 0, 0);
          acc[n] = __builtin_amdgcn_mfma_f32_16x16x32_bf16(a1, b1, acc[n], 0, 0, 0);
        }
      }
#pragma unroll
      for (int nt = 0; nt < 4; ++nt) {
        const int ch = nt * 16 + fr;
        const float ba = sPar[(d * 64 + ch) * 3], bx = sPar[(d * 64 + ch) * 3 + 1], sp8 = sPar[(d * 64 + ch) * 3 + 2];
#pragma unroll
        for (int jj = 0; jj < 4; ++jj) {
          const int pos = wid * 16 + fq * 4 + jj;
          const float xl = bf2f(sX[pos * 72 + ch]);
          const float rg = sigmoid_rcp_(acc[nt][jj] + ba), ig = sigmoid_rcp_(acc[nt + 4][jj] + bx);
          const float la = -sp8 * rg;
          const float av = __expf(la);
          const float x2 = 2.f * la;
          const float ser = -x2 * (1.f + x2 * (0.5f + x2 * (0.16666667f + x2 * (0.041666667f + x2 * 0.0083333333f))));
          const float om = (x2 > -0.25f) ? ser : (1.f - av * av);
          const float bb = __builtin_amdgcn_sqrtf(om) * ig * xl;
          const int si = d ? 127 - pos : pos;
          sA[ch * 130 + si] = av;
          sB[ch * 130 + si] = bb;
        }
      }
      __syncthreads();
      {
        float a0[8], b0[8], A[8], B[8];
#pragma unroll
        for (int c = 0; c < 8; ++c) {
          const int ch = wid * 8 + c;
          const float2 va = *(const float2*)(sA + ch * 130 + 2 * lane), vb = *(const float2*)(sB + ch * 130 + 2 * lane);
          a0[c] = va.x; b0[c] = vb.x;
          A[c] = va.x * va.y; B[c] = va.y * vb.x + vb.y;
        }
#pragma unroll
        for (int c = 0; c < 8; ++c) LSCAN64(A[c], B[c]);
#pragma unroll
        for (int c = 0; c < 8; ++c) {
          const int ch = wid * 8 + c;
          if (PASS == 1) {
            if (lane == 63) p.summ[((size_t)(b * 2 + d) * 512 + h * 64 + ch) * 34 + (d ? ordr : ordf)] = make_float2(A[c], B[c]);
          } else {
            const float carry = sCarry[d * 64 + ch];
            const float hincl = A[c] * carry + B[c];
            const float hprev = dppf<0x138, 0xf>(carry, hincl);
            const float heven = a0[c] * hprev + b0[c];
            const int se = 2 * lane, pe = d ? 127 - se : se, po = d ? 126 - se : se + 1;
            if (d == 0) { sH[pe * 65 + ch] = heven; sH[po * 65 + ch] = hincl; }
            else { sH[pe * 65 + ch] += heven; sH[po * 65 + ch] += hincl; }
          }
        }
      }
      __syncthreads();
    }
    if (PASS == 3) {
#pragma unroll
      for (int e = 0; e < 2; ++e) {
        int idx = tid + e * 512, pos = idx >> 3, cgp = idx & 7;
        const size_t r = (size_t)(rowbase + pos);
        float gf[8], y[8];
        unpack8(gv[e], gf);
#pragma unroll
        for (int i = 0; i < 8; ++i) y[i] = geluf_(gf[i]) * sH[pos * 65 + cgp * 8 + i];
        *(uint4*)(p.Ycat + r * 2048 + 512 + h * 64 + cgp * 8) = pack8(y);
      }
      __syncthreads();
    }
  }
}

__device__ __forceinline__ void krope_item(const P& p, int item) {
  int tid = threadIdx.x; asm volatile("" : "+v"(tid));
  const u16* Zb2 = p.R1;
#pragma unroll
  for (int e = 0; e < 8; ++e) {
    int idx = tid + e * 512, rr = idx >> 4, pi = idx & 15, axis = pi >> 3, i = pi & 7;
    int r = item * 256 + rr, b = r / ST, t = r - b * ST;
    float x1 = bf2f(Zb2[(size_t)r * 1792 + 768 + axis * 16 + i]);
    float x2 = bf2f(Zb2[(size_t)r * 1792 + 768 + axis * 16 + 8 + i]);
    float o1 = x1, o2 = x2;
    if (t < SL) {
      float cs = p.rope[t * 32 + axis * 16 + i], sn = p.rope[t * 32 + axis * 16 + 8 + i];
      o1 = x1 * cs - x2 * sn;
      o2 = x1 * sn + x2 * cs;
    }
    u16 b1 = f2bf(o1), b2 = f2bf(o2);
#pragma unroll
    for (int h = 0; h < 8; ++h) {
      size_t base = ((size_t)(b * 8 + h) * ST + t) * 96 + 64 + axis * 16 + i;
      p.K[base] = b1;
      p.K[base + 8] = b2;
    }
  }
}

__device__ __forceinline__ void attn_item(const P& p, int item, unsigned char* smem) {
  int tid = threadIdx.x; asm volatile("" : "+v"(tid));
  const int lane = tid & 63, wid = tid >> 6, fr = lane & 15, fq = lane >> 4;
  int b, h, t0, kt0, kt1;
  if (item < 1024) { b = item >> 7; h = (item >> 4) & 7; t0 = (item & 15) * 256; kt0 = 0; kt1 = 68; }
  else { int i2 = item - 1024; b = i2 >> 3; h = i2 & 7; t0 = SL; kt0 = 64; kt1 = 68; }
  const u16* Kb = p.K + (size_t)(b * 8 + h) * ST * 96;
  const u16* Vb = p.Vt + (size_t)(b * 8 + h) * 64 * ST;
  const u16* Qb = p.Q + (size_t)(b * 8 + h) * ST * 96;
  constexpr int KS = 104, VS = 136, KSZ = 128 * KS, VSZ = 64 * VS, STG = KSZ + VSZ;
  u16* lds = (u16*)smem;
  bf16x8 qf[2][3];
#pragma unroll
  for (int nq = 0; nq < 2; ++nq)
#pragma unroll
    for (int ks = 0; ks < 3; ++ks)
      qf[nq][ks] = *(const bf16x8*)(Qb + (size_t)(t0 + wid * 32 + nq * 16 + fr) * 96 + ks * 32 + fq * 8);
  if (item < 1024) {
#pragma unroll
    for (int nq = 0; nq < 2; ++nq) {
      const int t = t0 + wid * 32 + nq * 16 + fr;
      const float* rp = p.rope + t * 32 + (fq >> 1) * 16;
      union { bf16x8 v; uint32_t u[4]; } own, oth, res;
      own.v = qf[nq][2];
#pragma unroll
      for (int i = 0; i < 4; ++i) oth.u[i] = __shfl_xor(own.u[i], 16);
      float fo[8], fp[8], fres[8];
      { uint4 t4 = make_uint4(own.u[0], own.u[1], own.u[2], own.u[3]); unpack8(t4, fo); }
      { uint4 t4 = make_uint4(oth.u[0], oth.u[1], oth.u[2], oth.u[3]); unpack8(t4, fp); }
#pragma unroll
      for (int j = 0; j < 8; ++j) {
        float cs = rp[j], sn = rp[8 + j];
        fres[j] = (fq & 1) ? (fp[j] * sn + fo[j] * cs) : (fo[j] * cs - fp[j] * sn);
      }
      uint4 r4 = pack8(fres);
      res.u[0] = r4.x; res.u[1] = r4.y; res.u[2] = r4.z; res.u[3] = r4.w;
      qf[nq][2] = res.v;
    }
  }
  f32x4 o[4][2];
#pragma unroll
  for (int m = 0; m < 4; ++m)
#pragma unroll
    for (int n = 0; n < 2; ++n) o[m][n] = (f32x4){0.f, 0.f, 0.f, 0.f};
  float mrun[2] = {-1e30f, -1e30f}, lrun[2] = {0.f, 0.f};
  const int T0 = kt0 >> 1, T1 = kt1 >> 1;
  uint4 rk0, rk1, rk2, rv0, rv1;
  const int c0_ = tid, c1_ = tid + 512, c2_ = tid + 1024;
  const int kcv0_ = c0_ & 15, kcv1_ = c1_ & 15;
  const int vslot0_ = 32 * (kcv0_ >> 2) + 16 * (kcv0_ & 1) + 4 * ((kcv0_ & 3) >> 1);
  const int vslot1_ = 32 * (kcv1_ >> 2) + 16 * (kcv1_ & 1) + 4 * ((kcv1_ & 3) >> 1);
#define ATT_LD(tt) do { const size_t key0_ = (size_t)(tt) * 128; const u16* kb_ = Kb + key0_ * 96; \
    rk0 = *(const uint4*)(kb_ + (size_t)c0_ * 8); rk1 = *(const uint4*)(kb_ + (size_t)c1_ * 8); rk2 = *(const uint4*)(kb_ + (size_t)c2_ * 8); \
    rv0 = *(const uint4*)(Vb + (size_t)(c0_ >> 4) * ST + key0_ + (c0_ & 15) * 8); \
    rv1 = *(const uint4*)(Vb + (size_t)(c1_ >> 4) * ST + key0_ + (c1_ & 15) * 8); } while (0)
#define ATT_ST(st) do { u16* sk_ = lds + (st) * STG; u16* sv_ = sk_ + KSZ; \
    *(uint4*)(sk_ + (c0_ / 12) * KS + (c0_ % 12) * 8) = rk0; *(uint4*)(sk_ + (c1_ / 12) * KS + (c1_ % 12) * 8) = rk1; *(uint4*)(sk_ + (c2_ / 12) * KS + (c2_ % 12) * 8) = rk2; \
    *(uint2*)(sv_ + (c0_ >> 4) * VS + vslot0_) = make_uint2(rv0.x, rv0.y); *(uint2*)(sv_ + (c0_ >> 4) * VS + vslot0_ + 8) = make_uint2(rv0.z, rv0.w); \
    *(uint2*)(sv_ + (c1_ >> 4) * VS + vslot1_) = make_uint2(rv1.x, rv1.y); *(uint2*)(sv_ + (c1_ >> 4) * VS + vslot1_ + 8) = make_uint2(rv1.z, rv1.w); } while (0)
  ATT_LD(T0); ATT_ST(0);
  __syncthreads();
  for (int kt = T0; kt < T1; ++kt) {
    const bool more = (kt + 1 < T1);
    if (more) ATT_LD(kt + 1);
    const int cur = (kt - T0) & 1;
    const u16* sk = lds + cur * STG;
    const u16* sv = sk + KSZ;
    f32x4 s[8][2];
#pragma unroll
    for (int m = 0; m < 8; ++m)
#pragma unroll
      for (int n = 0; n < 2; ++n) s[m][n] = (f32x4){0.f, 0.f, 0.f, 0.f};
#pragma unroll
    for (int ks = 0; ks < 3; ++ks)
#pragma unroll
      for (int mt = 0; mt < 8; ++mt) {
        bf16x8 kf = *(const bf16x8*)(sk + (mt * 16 + fr) * KS + ks * 32 + fq * 8);
#pragma unroll
        for (int nq = 0; nq < 2; ++nq) s[mt][nq] = __builtin_amdgcn_mfma_f32_16x16x32_bf16(kf, qf[nq][ks], s[mt][nq], 0, 0, 0);
      }
    bf16x8 pb[2][4];
    float mloc[2];
#pragma unroll
    for (int nq = 0; nq < 2; ++nq) {
      float mx = fmaxf(fmaxf(s[0][nq][0], s[0][nq][1]), fmaxf(s[0][nq][2], s[0][nq][3]));
#pragma unroll
      for (int mt = 1; mt < 8; ++mt) mx = fmaxf(fmaxf(mx, s[mt][nq][0]), fmaxf(fmaxf(s[mt][nq][1], s[mt][nq][2]), s[mt][nq][3]));
      mloc[nq] = mx;
    }
    if (__any((mloc[0] > mrun[0] + 8.f) || (mloc[1] > mrun[1] + 8.f))) {
      float m0 = fmaxf(mloc[0], __shfl_xor(mloc[0], 16)), m1 = fmaxf(mloc[1], __shfl_xor(mloc[1], 16));
      m0 = fmaxf(m0, __shfl_xor(m0, 32)); m1 = fmaxf(m1, __shfl_xor(m1, 32));
      const float n0 = fmaxf(mrun[0], m0), n1 = fmaxf(mrun[1], m1);
      const float a0 = __builtin_amdgcn_exp2f(mrun[0] - n0), a1 = __builtin_amdgcn_exp2f(mrun[1] - n1);
      mrun[0] = n0; mrun[1] = n1;
      lrun[0] *= a0; lrun[1] *= a1;
#pragma unroll
      for (int mtv = 0; mtv < 4; ++mtv) {
        o[mtv][0][0] *= a0; o[mtv][0][1] *= a0; o[mtv][0][2] *= a0; o[mtv][0][3] *= a0;
        o[mtv][1][0] *= a1; o[mtv][1][1] *= a1; o[mtv][1][2] *= a1; o[mtv][1][3] *= a1;
      }
    }
#pragma unroll
    for (int nq = 0; nq < 2; ++nq) {
      const float mn = mrun[nq];
      float rs = 0.f;
#pragma unroll
      for (int mt = 0; mt < 8; ++mt)
#pragma unroll
        for (int jj = 0; jj < 4; ++jj) {
          float pv = __builtin_amdgcn_exp2f(s[mt][nq][jj] - mn);
          s[mt][nq][jj] = pv;
          rs += pv;
        }
      lrun[nq] += rs;
#pragma unroll
      for (int sx = 0; sx < 4; ++sx) {
        union { uint4 u; bf16x8 v; } cv;
        cv.u.x = pack2(s[2 * sx][nq][0], s[2 * sx][nq][1]); cv.u.y = pack2(s[2 * sx][nq][2], s[2 * sx][nq][3]);
        cv.u.z = pack2(s[2 * sx + 1][nq][0], s[2 * sx + 1][nq][1]); cv.u.w = pack2(s[2 * sx + 1][nq][2], s[2 * sx + 1][nq][3]);
        pb[nq][sx] = cv.v;
      }
    }
#pragma unroll
    for (int sx = 0; sx < 4; ++sx)
#pragma unroll
      for (int mtv = 0; mtv < 4; ++mtv) {
        const bf16x8 vf = *(const bf16x8*)(sv + (mtv * 16 + fr) * VS + 32 * sx + fq * 8);
#pragma unroll
        for (int nq = 0; nq < 2; ++nq) o[mtv][nq] = __builtin_amdgcn_mfma_f32_16x16x32_bf16(vf, pb[nq][sx], o[mtv][nq], 0, 0, 0);
      }
    if (more) ATT_ST(cur ^ 1);
    __syncthreads();
  }
#undef ATT_LD
#undef ATT_ST
#pragma unroll
  for (int nq = 0; nq < 2; ++nq) {
    float lt = lrun[nq];
    lt += __shfl_xor(lt, 16);
    lt += __shfl_xor(lt, 32);
    float inv = 1.f / lt;
    size_t r = (size_t)b * ST + t0 + wid * 32 + nq * 16 + fr;
#pragma unroll
    for (int mtv = 0; mtv < 4; ++mtv) {
      uint2 ov;
      ov.x = pack2(o[mtv][nq][0] * inv, o[mtv][nq][1] * inv);
      ov.y = pack2(o[mtv][nq][2] * inv, o[mtv][nq][3] * inv);
      *(uint2*)(p.Ycat + r * 2048 + 1536 + h * 64 + mtv * 16 + fq * 4) = ov;
    }
  }
}

#define XB_TMO      128
#define XB_XCNT(j)  (256  + 64 * (j))
#define XB_XSUB(j)  (1280 + 64 * (j))
#define XB_XGEN(j)  (2304 + 64 * (j))
#define XB_TOP      3328
#define XB_TOPGEN   3392
#define XCD_BAR_WORDS 3456
#define XB_SPIN_CAP (1u << 18)
__device__ __forceinline__ unsigned xb_ld(unsigned* p)              { return __hip_atomic_load(p, __ATOMIC_RELAXED, __HIP_MEMORY_SCOPE_AGENT); }
__device__ __forceinline__ unsigned xb_add(unsigned* p, unsigned v) { return __hip_atomic_fetch_add(p, v, __ATOMIC_RELAXED, __HIP_MEMORY_SCOPE_AGENT); }
__device__ __forceinline__ unsigned xb_xcc_id() { return (unsigned)__builtin_amdgcn_s_getreg((3 << 11) | 20) & 0xFu; }
#define XB_SPIN(cond, bar) do { unsigned _sp = 0; while (cond) { __builtin_amdgcn_s_sleep(1); \
    if ((++_sp & 255u) == 0u) { if (xb_ld(&(bar)[XB_TMO])) break; if (_sp > XB_SPIN_CAP) { atomicAdd(&(bar)[XB_TMO], 1u); break; } } } } while (0)
struct XcdBarrier { unsigned* bar; unsigned x; volatile __attribute__((address_space(3))) unsigned* st; };
__device__ __forceinline__ XcdBarrier xcd_barrier_post(unsigned* bar, volatile __attribute__((address_space(3))) unsigned* st) {
  XcdBarrier b; b.bar = bar; b.x = xb_xcc_id(); b.st = st;
  if (threadIdx.x == 0) (void)xb_add(&bar[XB_XCNT(b.x)], 1u);
  return b;
}
__device__ __forceinline__ void xcd_barrier_complete(unsigned* bar, unsigned x, unsigned& nloc, unsigned& nx) {
  const unsigned G = gridDim.x * gridDim.y * gridDim.z;
  unsigned sum, cnt, mine, sp = 0u;
  for (;;) {
    sum = 0u; cnt = 0u; mine = 0u;
#pragma unroll
    for (unsigned j = 0; j < 16; ++j) { const unsigned c = xb_ld(&bar[XB_XCNT(j)]); sum += c; cnt += (c > 0u) ? 1u : 0u; mine = (j == x) ? c : mine; }
    if (sum == G) break;
    __builtin_amdgcn_s_sleep(1);
    if ((++sp & 255u) == 0u) { if (xb_ld(&bar[XB_TMO])) break; if (sp > XB_SPIN_CAP) { atomicAdd(&bar[XB_TMO], 1u); break; } }
  }
  nloc = mine > 0u ? mine : 1u; nx = cnt > 0u ? cnt : 1u;
}
__device__ __forceinline__ void xcd_barrier(const XcdBarrier& b) {
  asm volatile("s_waitcnt vmcnt(0)" ::: "memory");
  __syncthreads();
  if (threadIdx.x == 0) {
    unsigned* bar = b.bar;
    __builtin_amdgcn_s_waitcnt(0);
    unsigned nloc = b.st[0], nx = b.st[1];
    if (nloc == 0u) { xcd_barrier_complete(bar, b.x, nloc, nx); b.st[0] = nloc; b.st[1] = nx; }
    const unsigned old = xb_add(&bar[XB_XSUB(b.x)], 1u);
    const unsigned gen = old / nloc;
    if (old + 1u == (gen + 1u) * nloc) {
      __builtin_amdgcn_fence(__ATOMIC_RELEASE, "agent");
      asm volatile("s_waitcnt vmcnt(0)" ::: "memory");
      const unsigned og = xb_add(&bar[XB_TOP], 1u);
      const unsigned tg = og / nx;
      if (og + 1u == (tg + 1u) * nx) xb_add(&bar[XB_TOPGEN], 1u);
      else XB_SPIN(xb_ld(&bar[XB_TOPGEN]) == tg, bar);
      __builtin_amdgcn_fence(__ATOMIC_ACQUIRE, "agent");
      xb_add(&bar[XB_XGEN(b.x)], 1u);
      asm volatile("s_waitcnt vmcnt(0)" ::: "memory");
    } else {
      XB_SPIN(xb_ld(&bar[XB_XGEN(b.x)]) == gen, bar);
      __builtin_amdgcn_fence(__ATOMIC_ACQUIRE, "agent");
      asm volatile("s_waitcnt vmcnt(0)" ::: "memory");
    }
  }
  __syncthreads();
}

__global__ void __launch_bounds__(NTHR) mega(P p) {
  extern __shared__ __attribute__((aligned(16))) unsigned char smem[];
  __shared__ uint4 xb_words;
  cg::grid_group grid = cg::this_grid();
  if (threadIdx.x == 0) xb_words = make_uint4(0u, 0u, 0u, 0u);
  __syncthreads();
  XcdBarrier xb = xcd_barrier_post(p.bar, (volatile __attribute__((address_space(3))) unsigned*)&xb_words);
  u16* lds = (u16*)smem;
  float* sInv = (float*)(smem + 131072);
  LAS3 unsigned char* lds3 = (LAS3 unsigned char*)smem;
  const int bid = blockIdx.x, nblk = gridDim.x;
  auto nopre = [](int) {};

#ifndef NO_P0
  phase0(p, smem);
#endif
  grid.sync();

#pragma unroll 1
  for (int l = 0; l < 4; ++l) {
    int tid = threadIdx.x; asm volatile("" : "+v"(tid));
    const int lane = tid & 63, wid = tid >> 6, wr = wid >> 1, wc = wid & 1, fr = lane & 15, fq = lane >> 4;
    (void)lane; (void)wid; (void)wr; (void)wc; (void)fr; (void)fq;
#ifndef NO_CW
    convert_weights(p, l, (float*)smem, l == 0 ? 0 : 9, l == 0 ? 12 : 10, false, bid, nblk, true);
#endif
    norm_mod(p, l, p.norm1_g + l * 1024, 0, 1024, l == 0);
    GSYNC();

    {
      u16* Zb1 = p.R1;
      auto epi = [=](const f32x4(&acc)[2][2][4][2], const g8::Unit& u, int wr, int wc, int fr, int fq, int) {
#pragma unroll
        for (int ai = 0; ai < 2; ++ai)
#pragma unroll
          for (int m = 0; m < 4; ++m) {
            u16* rowp = Zb1 + (size_t)(u.pm * 256 + ai * 128 + wr * 64 + m * 16 + fr) * 2560 + u.pn * 256 + wc * 32 + 8 * fq;
#pragma unroll
            for (int bj = 0; bj < 2; ++bj) {
              uint4 w;
              w.x = g8::cvt_pk_bf16(acc[ai][bj][m][0][0], acc[ai][bj][m][0][1]); w.y = g8::cvt_pk_bf16(acc[ai][bj][m][0][2], acc[ai][bj][m][0][3]);
              w.z = g8::cvt_pk_bf16(acc[ai][bj][m][1][0], acc[ai][bj][m][1][1]); w.w = g8::cvt_pk_bf16(acc[ai][bj][m][1][2], acc[ai][bj][m][1][3]);
              *(uint4*)(rowp + bj * 128) = w;
            }
          }
      };
      g8::Simple S; S.o.init(l == 3 ? 128 : 136, 10, nblk, bid); S.A = p.H; S.Bt = p.W + OFF_WINA; S.lda = 1024; S.K = 1024;
      g8::gemm_phase<true>(lds3, S, epi);
    }
    GSYNC();

    for (int rep = 0; rep < DUP_C1; ++rep)
    for (int it = bid; it < 1088 + 136; it += nblk) {
#ifndef NO_CMLP
      if (it < 1088) cmlp_item(p, l, it, smem);
#endif
#ifndef NO_CONVA
      if (it >= 1088) conva_item(p, l, it - 1088);
#endif
    }
    GSYNC();

    {
      u16* Zb2 = p.R1;
      auto epi = [=](const f32x4(&acc)[2][2][4][2], const g8::Unit& u, int wr, int wc, int fr, int fq, int) {
#pragma unroll
        for (int ai = 0; ai < 2; ++ai)
#pragma unroll
          for (int m = 0; m < 4; ++m) {
            u16* rowp = Zb2 + (size_t)(u.pm * 256 + ai * 128 + wr * 64 + m * 16 + fr) * 1792 + u.pn * 256 + wc * 32 + 8 * fq;
#pragma unroll
            for (int bj = 0; bj < 2; ++bj) {
              uint4 w;
              w.x = g8::cvt_pk_bf16(acc[ai][bj][m][0][0], acc[ai][bj][m][0][1]); w.y = g8::cvt_pk_bf16(acc[ai][bj][m][0][2], acc[ai][bj][m][0][3]);
              w.z = g8::cvt_pk_bf16(acc[ai][bj][m][1][0], acc[ai][bj][m][1][1]); w.w = g8::cvt_pk_bf16(acc[ai][bj][m][1][2], acc[ai][bj][m][1][3]);
              *(uint4*)(rowp + bj * 128) = w;
            }
          }
        const int pn = u.pn;
        if (pn == 2 || pn == 5 || pn == 6) {
          const bool inc0 = (pn != 5) || (wc >= 1);
          const bool inc1 = (pn == 2) || (pn == 5) || (wc == 0);
          float* dst = p.ssq + (size_t)(u.pm * 256 + wr * 64 + fr) * 12 + (pn == 2 ? 0 : (pn == 5 ? 4 : 8)) + wc;
#pragma unroll
          for (int ai = 0; ai < 2; ++ai)
#pragma unroll
            for (int m = 0; m < 4; ++m) {
              float ss = 0.f;
#pragma unroll
              for (int n = 0; n < 2; ++n)
#pragma unroll
                for (int jj = 0; jj < 4; ++jj) {
                  const float v0 = acc[ai][0][m][n][jj], v1 = acc[ai][1][m][n][jj];
                  ss += (inc0 ? v0 * v0 : 0.f) + (inc1 ? v1 * v1 : 0.f);
                }
              ss += __shfl_xor(ss, 16);
              ss += __shfl_xor(ss, 32);
              if (fq == 0) dst[(ai * 128 + m * 16) * 12] = ss;
              asm volatile("" ::: "memory");
            }
        }
      };
      g8::Simple S; S.o.init(136, 7, nblk, bid); S.A = p.H; S.Bt = p.W + OFF_WINB; S.lda = 1024; S.K = 1024;
      g8::gemm_phase<true>(lds3, S, epi);
    }
    GSYNC();

    for (int rep = 0; rep < DUP_C2; ++rep)
    {
      const u16* Zb2 = p.R1;
      for (int r2 = 0; r2 < DUP_LRU1; ++r2) lru_run<1>(p, l, bid, nblk, smem);
      for (int r2 = 0; r2 < DUP_PROJ; ++r2) {
      {
        struct ProjSched {
          g8::Order o; const u16* Zb2; const u16* Wq; const u16* Wkv;
          __device__ bool next(int i, g8::Unit& u) const {
            int pm, pn; if (!o.tile(i, pm, pn)) return false;
            u.pm = pm; u.lda = 1792;
            if (pn < 3) { u.pn = pn; u.aux = 0; u.K = 384; u.A = (const char*)(Zb2 + (size_t)pm * 256 * 1792 + 1312); u.B = (const char*)(Wq + (size_t)pn * 256 * 384); }
            else { u.pn = pn - 3; u.aux = 1; u.K = 256; u.A = (const char*)(Zb2 + (size_t)pm * 256 * 1792 + 512); u.B = (const char*)(Wkv + (size_t)(pn - 3) * 256 * 256); }
            return true;
          }
        };
        ProjSched S; S.o.init(136, 7, nblk, bid); S.Zb2 = Zb2; S.Wq = p.W + OFF_WQUP; S.Wkv = p.W + OFF_WKVUP;
        auto epi = [=](const f32x4(&acc)[2][2][4][2], const g8::Unit& u, int wr, int wc, int fr, int fq, int) {
          const int row0 = u.pm * 256, b = row0 / ST, tb = row0 - b * ST;
          const int kv = u.aux;
          const float* sq = p.ssq + (size_t)row0 * 12;
          const float invn = kv ? (1.f / 256.f) : (1.f / 384.f);
#pragma unroll
          for (int ai = 0; ai < 2; ++ai)
#pragma unroll
            for (int m = 0; m < 4; ++m) {
              const int rl = ai * 128 + wr * 64 + m * 16 + fr;
              const float4 p0 = *(const float4*)(sq + rl * 12), p1 = *(const float4*)(sq + rl * 12 + 4), p2 = *(const float4*)(sq + rl * 12 + 8);
              const float ssum = kv ? ((p0.x + p0.y) + (p0.z + p0.w)) : (((p1.x + p1.y) + (p1.z + p1.w)) + ((p2.x + p2.y) + (p2.z + p2.w)));
              const float inv = rsqrtf(ssum * invn + EPS);
              const int t = tb + rl;
#pragma unroll
              for (int bj = 0; bj < 2; ++bj) {
                const int c8 = u.pn * 256 + bj * 128 + wc * 32 + 8 * fq;
                float v[8];
#pragma unroll
                for (int n = 0; n < 2; ++n)
#pragma unroll
                  for (int jj = 0; jj < 4; ++jj) v[n * 4 + jj] = acc[ai][bj][m][n][jj] * inv;
                if (!kv) {
                  const int head = c8 / 96, d = c8 - head * 96;
                  *(uint4*)(p.Q + ((size_t)(b * 8 + head) * ST + t) * 96 + d) = pack8(v);
                } else {
                  const int head = c8 >> 7, w = c8 & 127;
                  if (wc < 2) {
                    *(uint4*)(p.K + ((size_t)(b * 8 + head) * ST + t) * 96 + w) = pack8(v);
                  } else {
                    u16* vp = p.Vt + ((size_t)(b * 8 + head) * 64 + (w - 64)) * ST + t;
#pragma unroll
                    for (int e = 0; e < 8; ++e) vp[(size_t)e * ST] = f2bf(v[e]);
                  }
                }
              }
              asm volatile("" ::: "memory");
            }
        };
        g8::gemm_phase<true>(lds3, S, epi);
      }
      {
        const int off = 2176;
        int first = bid;
        if (first < off) { int kk = (off - first + nblk - 1) / nblk; first += kk * nblk; }
        for (int it = first; it < off + 136; it += nblk) krope_item(p, it - off);
      }
      }
    }
    GSYNC();

    for (int rep = 0; rep < DUP_ATTN; ++rep)
    {
      int it = bid;
      for (; it < 1088; it += nblk) attn_item(p, it, smem);
      for (int r2 = 0; r2 < DUP_LRU3; ++r2) lru_run<3>(p, l, it - 1088, nblk, smem);
    }
    GSYNC();

    {
      u16* Mg = p.R1;
      const int ntile = 272 * 8;
      int te = threadIdx.x; asm volatile("" : "+v"(te));
      const int lane_e = te & 63, wid_e = te >> 6;
      const int wr = wid_e >> 1, wc = wid_e & 1, fr = lane_e & 15, fq = lane_e >> 4;
      int estr = nblk; asm volatile("" : "+s"(estr));
      const int skipctx = (l == 3);
      int id = bid;
      while (id < ntile && skipctx && (((id >> 6) * 8 + (id & 7)) % 34) >= 32) id += estr;
      bool primed = false;
      while (id < ntile) {
        const int rt = (id >> 6) * 8 + (id & 7), ct = (id & 63) >> 3;
        int nid = id + estr;
        while (nid < ntile && skipctx && (((nid >> 6) * 8 + (nid & 7)) % 34) >= 32) nid += estr;
        const bool more_tiles = nid < ntile;
        const int nrt = (nid >> 6) * 8 + (nid & 7), nct = (nid & 63) >> 3;
        f32x4 mg[2][4];
#pragma unroll
        for (int m = 0; m < 2; ++m)
#pragma unroll
          for (int n = 0; n < 4; ++n) mg[m][n] = (f32x4){0.f, 0.f, 0.f, 0.f};
        for (int nb = 0; nb < 4; ++nb) {
          f32x4 ag[2][4], ay[2][4];
#pragma unroll
          for (int m = 0; m < 2; ++m)
#pragma unroll
            for (int n = 0; n < 4; ++n) { ag[m][n] = (f32x4){0.f, 0.f, 0.f, 0.f}; ay[m][n] = (f32x4){0.f, 0.f, 0.f, 0.f}; }
          const u16* gA = p.H + (size_t)rt * 128 * 1024;
          const u16* gB = p.W + OFF_WGATE + (size_t)(nb * 1024 + ct * 128) * 1024;
          const u16* bA = p.Ycat + (size_t)rt * 128 * 2048 + nb * 512;
          const u16* bB = p.W + OFF_WBR + (size_t)(nb * 1024 + ct * 128) * 512;
          const bool last_nb = (nb == 3);
          const u16* xA = last_nb ? p.H + (size_t)nrt * 128 * 1024 : gA;
          const u16* xB = last_nb ? p.W + OFF_WGATE + (size_t)(nct * 128) * 1024 : p.W + OFF_WGATE + (size_t)((nb + 1) * 1024 + ct * 128) * 1024;
          gemm_main128(gA, 1024, gB, 1024, 1024, bA, 2048, bB, 512, true, primed, lds3, ag);
          gemm_main128(bA, 2048, bB, 512, 512, xA, 1024, xB, 1024, !last_nb || more_tiles, true, lds3, ay);
          primed = true;
#pragma unroll
          for (int m = 0; m < 2; ++m)
#pragma unroll
            for (int n = 0; n < 4; ++n)
#pragma unroll
              for (int jj = 0; jj < 4; ++jj) mg[m][n][jj] += sigmoidf_(ag[m][n][jj]) * ay[m][n][jj];
        }
#pragma unroll
        for (int m = 0; m < 2; ++m) {
          u16* dst = Mg + (size_t)(rt * 128 + wr * 32 + m * 16 + fq * 4) * 1024 + ct * 128 + wc * 64 + fr;
#pragma unroll
          for (int n = 0; n < 4; ++n)
#pragma unroll
            for (int jj = 0; jj < 4; ++jj) dst[jj * 1024 + n * 16] = f2bf(mg[m][n][jj]);
          asm volatile("" ::: "memory");
        }
        id = nid;
      }
    }
    GSYNC();

    {
      auto epi = [=](const f32x4(&acc)[2][2][4][2], const g8::Unit& u, int wr, int wc, int fr, int fq, int) {
        float* xb = xrow_ptr(p, u.pm * 256);
        const float* gate = p.mod + ((size_t)l * 9 + mod_idx(u.pm * 256)) * 6144 + 2048 + u.pn * 256 + wc * 32 + 4 * fq;
        f32x4 gv[2][2];
#pragma unroll
        for (int bj = 0; bj < 2; ++bj)
#pragma unroll
          for (int n = 0; n < 2; ++n) gv[bj][n] = *(const f32x4*)(gate + bj * 128 + n * 16);
#pragma unroll
        for (int ai = 0; ai < 2; ++ai)
#pragma unroll
          for (int m = 0; m < 4; ++m) {
            float* rowp = xb + (size_t)(ai * 128 + wr * 64 + m * 16 + fr) * DM + u.pn * 256 + wc * 32 + 4 * fq;
#pragma unroll
            for (int bj = 0; bj < 2; ++bj)
#pragma unroll
              for (int n = 0; n < 2; ++n) {
                f32x4 xv = *(const f32x4*)(rowp + bj * 128 + n * 16);
                xv += gv[bj][n] * acc[ai][bj][m][n];
                *(f32x4*)(rowp + bj * 128 + n * 16) = xv;
              }
          }
      };
      g8::Simple S; S.o.init(l == 3 ? 128 : 136, 4, nblk, bid); S.A = p.R1; S.Bt = p.W + OFF_WOUT; S.lda = 1024; S.K = 1024;
      g8::gemm_phase<false>(lds3, S, epi);
    }
    GSYNC();

    norm_mod(p, l, p.norm2_g + l * 1024, 3072, 4096, false);
    GSYNC();

    {
      u16* U = p.R1;
      auto epi = [=](const f32x4(&acc)[2][2][4][2], const g8::Unit& u, int wr, int wc, int fr, int fq, int) {
#pragma unroll
        for (int ai = 0; ai < 2; ++ai)
#pragma unroll
          for (int m = 0; m < 4; ++m) {
            u16* rowp = U + (size_t)(u.pm * 256 + ai * 128 + wr * 64 + m * 16 + fr) * 2816 + u.pn * 128 + wc * 32 + 8 * fq;
            float v[8];
#pragma unroll
            for (int n = 0; n < 2; ++n)
#pragma unroll
              for (int jj = 0; jj < 4; ++jj) v[n * 4 + jj] = siluf_(acc[ai][0][m][n][jj]) * acc[ai][1][m][n][jj];
            uint4 w;
            w.x = g8::cvt_pk_bf16(v[0], v[1]); w.y = g8::cvt_pk_bf16(v[2], v[3]); w.z = g8::cvt_pk_bf16(v[4], v[5]); w.w = g8::cvt_pk_bf16(v[6], v[7]);
            *(uint4*)rowp = w;
          }
      };
      g8::Simple S; S.o.init(l == 3 ? 128 : 136, 22, nblk, bid); S.A = p.H; S.Bt = p.W + OFF_WFF13; S.lda = 1024; S.K = 1024;
      g8::gemm_phase<true>(lds3, S, epi);
    }
    GSYNC();

    {
      auto epi = [=](const f32x4(&acc)[2][2][4][2], const g8::Unit& u, int wr, int wc, int fr, int fq, int) {
        float* xb = xrow_ptr(p, u.pm * 256);
        const float* gate = p.mod + ((size_t)l * 9 + mod_idx(u.pm * 256)) * 6144 + 5120 + u.pn * 256 + wc * 32 + 4 * fq;
        f32x4 gv[2][2];
#pragma unroll
        for (int bj = 0; bj < 2; ++bj)
#pragma unroll
          for (int n = 0; n < 2; ++n) gv[bj][n] = *(const f32x4*)(gate + bj * 128 + n * 16);
#pragma unroll
        for (int ai = 0; ai < 2; ++ai)
#pragma unroll
          for (int m = 0; m < 4; ++m) {
            float* rowp = xb + (size_t)(ai * 128 + wr * 64 + m * 16 + fr) * DM + u.pn * 256 + wc * 32 + 4 * fq;
#pragma unroll
            for (int bj = 0; bj < 2; ++bj)
#pragma unroll
              for (int n = 0; n < 2; ++n) {
                f32x4 xv = *(const f32x4*)(rowp + bj * 128 + n * 16);
                xv += gv[bj][n] * acc[ai][bj][m][n];
                *(f32x4*)(rowp + bj * 128 + n * 16) = xv;
              }
          }
      };
      g8::Simple S; S.o.init(l == 3 ? 128 : 136, 4, nblk, bid); S.A = p.R1; S.Bt = p.W + OFF_WFF2; S.lda = 2816; S.K = 2816;
      g8::gemm_phase<false>(lds3, S, epi);
      if (l < 3 && nblk > 32 && bid >= 32) convert_weights(p, l + 1, (float*)smem, 0, 12, true, bid - 32, nblk - 32, false);
    }
    GSYNC();

  }

  const int lane = threadIdx.x & 63, wid = threadIdx.x >> 6;
  for (int r = bid * 8 + wid; r < NB * SL; r += nblk * 8) {
    float* xr = p.out + (size_t)r * DM;
    float4 v[4];
    float ss = 0.f;
#pragma unroll
    for (int i = 0; i < 4; ++i) {
      v[i] = *(const float4*)(xr + i * 256 + lane * 4);
      ss += v[i].x * v[i].x + v[i].y * v[i].y + v[i].z * v[i].z + v[i].w * v[i].w;
    }
    ss = wave_sum(ss);
    const float inv = rsqrtf(ss * (1.f / 1024.f) + EPS);
#pragma unroll
    for (int i = 0; i < 4; ++i) {
      float4 gg = *(const float4*)(p.final_g + i * 256 + lane * 4);
      float4 ov;
      ov.x = v[i].x * inv * gg.x; ov.y = v[i].y * inv * gg.y; ov.z = v[i].z * inv * gg.z; ov.w = v[i].w * inv * gg.w;
      *(float4*)(xr + i * 256 + lane * 4) = ov;
    }
  }
}

extern "C" void kernel_launch(void* const* d_in, const int* in_sizes, int n_in, void* d_out, int out_size, void* d_ws,
                              size_t ws_size, hipStream_t stream) {
  static int grid_blocks = 0;
  if (!grid_blocks) {
    int dev = 0, cus = 0, per_cu = 0;
    hipGetDevice(&dev);
    hipDeviceGetAttribute(&cus, hipDeviceAttributeMultiprocessorCount, dev);
    hipFuncSetAttribute((const void*)mega, hipFuncAttributeMaxDynamicSharedMemorySize, LDS_BYTES);
    hipOccupancyMaxActiveBlocksPerMultiprocessor(&per_cu, (const void*)mega, NTHR, LDS_BYTES);
    if (per_cu < 1) per_cu = 1;
    if (per_cu > 1) per_cu = 1;
    grid_blocks = cus * per_cu;
    (void)hipGetLastError();
  }
  P p{};
  const float** pf = (const float**)&p;
  for (int i = 0; i < 31; ++i) pf[i] = (const float*)d_in[i];
  p.out = (float*)d_out;
  size_t off = 0;
  auto take = [&](size_t bytes) { void* r = (char*)d_ws + off; off += (bytes + 255) & ~(size_t)255; return r; };
  p.Xc = (float*)take((size_t)NB * SC * DM * 4);
  p.mod = (float*)take((size_t)4 * 9 * 6144 * 4);
  p.rope = (float*)take((size_t)SL * 32 * 4);
  p.summ = (float2*)take((size_t)NB * 2 * 512 * 34 * 8);
  p.ssq = (float*)take((size_t)12 * MTOT * 4);
  p.bar = (unsigned*)take((size_t)XCD_BAR_WORDS * 4);
  p.W = (u16*)take((size_t)W_ELEMS * 2);
  p.H = (u16*)take((size_t)MTOT * 1024 * 2);
  p.Ycat = (u16*)take((size_t)MTOT * 2048 * 2);
  p.R1 = (u16*)take((size_t)MTOT * 2560 * 2);
  p.K = (u16*)take((size_t)MTOT * 768 * 2);
  p.Vt = (u16*)take((size_t)MTOT * 512 * 2);
  p.Q = p.R1 + (size_t)MTOT * 1792;
  if (off > ws_size) { fprintf(stderr, "workspace too small: need %zu have %zu\n", off, ws_size); return; }
  (void)hipMemsetAsync(p.bar, 0, (size_t)XCD_BAR_WORDS * 4, stream);
  void* args[] = {&p};
  hipError_t e = hipLaunchCooperativeKernel((const void*)mega, dim3(grid_blocks), dim3(NTHR), args, LDS_BYTES, stream);
  if (e != hipSuccess) fprintf(stderr, "cooperative launch failed: %s (grid %d)\n", hipGetErrorString(e), grid_blocks);
}
```

```cpp
#include <hip/hip_runtime.h>
#include <hip/hip_bf16.h>
#include <hip/hip_cooperative_groups.h>
#include <cstdio>
#include <cstdint>
namespace cg = cooperative_groups;

typedef unsigned short u16;
using bf16x8 = __attribute__((ext_vector_type(8))) short;
using f32x4 = __attribute__((ext_vector_type(4))) float;
#define LAS3 __attribute__((address_space(3)))

#define NB 8
#define SL 4096
#define SC 256
#define ST 4352
#define MTOT 34816
#define DM 1024
#define NTHR 512
#define EPS 1e-6f
#define LDS_BYTES 159744
#define DUP_ATTN 1
#define DUP_C1 1
#define DUP_C2 1
#define DUP_E 1
#define EXTRA_SYNC 0
#define GSYNC() do { xcd_barrier(xb); for (int q_ = 0; q_ < EXTRA_SYNC; ++q_) xcd_barrier(xb); } while (0)
#define DUP_LRU1 1
#define DUP_LRU3 1
#define DUP_PROJ 1

#define OFF_WINA 0
#define OFF_WINB (OFF_WINA + 2560 * 1024)
#define OFF_WGATE (OFF_WINB + 1792 * 1024)
#define OFF_WBR (OFF_WGATE + 4096 * 1024)
#define OFF_WOUT (OFF_WBR + 4 * 1024 * 512)
#define OFF_WFF13 (OFF_WOUT + 1024 * 1024)
#define OFF_WFF2 (OFF_WFF13 + 5632 * 1024)
#define OFF_WQUP (OFF_WFF2 + 1024 * 2816)
#define OFF_WKVUP (OFF_WQUP + 768 * 384)
#define OFF_WS (OFF_WKVUP + 1024 * 256)
#define OFF_WLRU (OFF_WS + 4 * 128 * 128)
#define W_ELEMS (OFF_WLRU + 2 * 8 * 4 * 32 * 64)

struct P {
  const float *x, *c, *ctx, *c_ctx, *w_mod, *b_mod, *norm1_g, *norm2_g, *w_in, *conv_a_w, *lru_conv_w, *lru_conv_b,
      *lru_w_a, *lru_b_a, *lru_w_x, *lru_b_x, *lru_lam, *cmlp_ln_g, *cmlp_ln_b, *cmlp_w_s, *cmlp_b_s, *q_norm_g,
      *kv_norm_g, *w_q_up, *w_kv_up, *w_branch, *w_out, *w_ff1, *w_ff3, *w_ff2, *final_g;
  float *out, *Xc, *mod, *rope;
  float2* summ;
  float* ssq;
  unsigned* bar;
  u16 *W, *H, *Ycat, *R1, *Q, *K, *Vt;
};

__device__ __forceinline__ uint32_t pack2(float a, float b) { uint32_t r; asm("v_cvt_pk_bf16_f32 %0, %1, %2" : "=v"(r) : "v"(a), "v"(b)); return r; }
__device__ __forceinline__ u16 f2bf(float f) { return (u16)(pack2(f, f) & 0xffffu); }
__device__ __forceinline__ float bf2f(u16 h) { return __uint_as_float(((uint32_t)h) << 16); }
__device__ __forceinline__ float sigmoidf_(float x) { return __builtin_amdgcn_rcpf(1.f + __expf(-x)); }
__device__ __forceinline__ float sigmoid_rcp_(float x) { return __builtin_amdgcn_rcpf(1.f + __expf(-x)); }
__device__ __forceinline__ float siluf_(float x) { return x * __builtin_amdgcn_rcpf(1.f + __expf(-x)); }
__device__ __forceinline__ float geluf_(float x) {
  float u = 0.7978845608028654f * (x + 0.044715f * x * x * x);
  return x * __builtin_amdgcn_rcpf(1.f + __expf(-2.f * u));
}
__device__ __forceinline__ void unpack8(const uint4& v, float* f) {
  f[0] = __uint_as_float(v.x << 16); f[1] = __uint_as_float(v.x & 0xffff0000u);
  f[2] = __uint_as_float(v.y << 16); f[3] = __uint_as_float(v.y & 0xffff0000u);
  f[4] = __uint_as_float(v.z << 16); f[5] = __uint_as_float(v.z & 0xffff0000u);
  f[6] = __uint_as_float(v.w << 16); f[7] = __uint_as_float(v.w & 0xffff0000u);
}
__device__ __forceinline__ uint4 pack8(const float* f) {
  uint4 v; v.x = pack2(f[0], f[1]); v.y = pack2(f[2], f[3]); v.z = pack2(f[4], f[5]); v.w = pack2(f[6], f[7]); return v;
}
template <int CTRL, int ROWMASK>
__device__ __forceinline__ float dpp0f(float src) {
  return __int_as_float(__builtin_amdgcn_update_dpp(0, __float_as_int(src), CTRL, ROWMASK, 0xf, false));
}
__device__ __forceinline__ float wave_sum(float v) {
  v += dpp0f<0x111, 0xf>(v); v += dpp0f<0x112, 0xf>(v); v += dpp0f<0x114, 0xf>(v); v += dpp0f<0x118, 0xf>(v);
  v += dpp0f<0x142, 0xa>(v); v += dpp0f<0x143, 0xc>(v);
  return __int_as_float(__builtin_amdgcn_readlane(__float_as_int(v), 63));
}
__device__ __forceinline__ float* xrow_ptr(const P& p, int r) {
  int b = r / ST, t = r - b * ST;
  return t < SL ? p.out + ((size_t)(b * SL + t)) * DM : p.Xc + ((size_t)(b * SC + t - SL)) * DM;
}
__device__ __forceinline__ const float* xin_ptr(const P& p, int r) {
  int b = r / ST, t = r - b * ST;
  return t < SL ? p.x + ((size_t)(b * SL + t)) * DM : p.ctx + ((size_t)(b * SC + t - SL)) * DM;
}
__device__ __forceinline__ int mod_idx(int r) { int b = r / ST, t = r - b * ST; return t < SL ? b : 8; }

template <int MT>
__device__ __forceinline__ void gemm_main(const u16* __restrict__ A, int lda, const u16* __restrict__ B, int ldb, int K,
                                          u16* lds, f32x4 (&acc)[MT][4]) {
  constexpr int BM = MT * 64;
  constexpr int ASZ = BM * 72, BSZ = 128 * 72, STG = ASZ + BSZ;
  int tid = threadIdx.x; asm volatile("" : "+v"(tid));
  const int lane = tid & 63, wid = tid >> 6, wr = wid >> 1, wc = wid & 1, fr = lane & 15, fq = lane >> 4;
  uint4 ra[MT], rb[2];
  const int nk = K >> 6;
  const int crow = tid >> 3, ckc = (tid & 7) * 8;
#pragma unroll
  for (int i = 0; i < MT; ++i) ra[i] = *(const uint4*)(A + (size_t)(crow + i * 64) * lda + ckc);
#pragma unroll
  for (int i = 0; i < 2; ++i) rb[i] = *(const uint4*)(B + (size_t)(crow + i * 64) * ldb + ckc);
  {
    u16* sa = lds; u16* sb = lds + ASZ;
#pragma unroll
    for (int i = 0; i < MT; ++i) *(uint4*)(sa + (crow + i * 64) * 72 + ckc) = ra[i];
#pragma unroll
    for (int i = 0; i < 2; ++i) *(uint4*)(sb + (crow + i * 64) * 72 + ckc) = rb[i];
  }
  __syncthreads();
  for (int kt = 0; kt < nk; ++kt) {
    const bool more = (kt + 1 < nk);
    if (more) {
      const int k0 = (kt + 1) * 64 + ckc;
#pragma unroll
      for (int i = 0; i < MT; ++i) ra[i] = *(const uint4*)(A + (size_t)(crow + i * 64) * lda + k0);
#pragma unroll
      for (int i = 0; i < 2; ++i) rb[i] = *(const uint4*)(B + (size_t)(crow + i * 64) * ldb + k0);
    }
    const u16* sa = lds + (kt & 1) * STG;
    const u16* sb = sa + ASZ;
#pragma unroll
    for (int ks = 0; ks < 2; ++ks) {
      bf16x8 a[MT], b[4];
#pragma unroll
      for (int m = 0; m < MT; ++m) a[m] = *(const bf16x8*)(sa + (wr * MT * 16 + m * 16 + fr) * 72 + ks * 32 + fq * 8);
#pragma unroll
      for (int n = 0; n < 4; ++n) b[n] = *(const bf16x8*)(sb + (wc * 64 + n * 16 + fr) * 72 + ks * 32 + fq * 8);
#pragma unroll
      for (int m = 0; m < MT; ++m)
#pragma unroll
        for (int n = 0; n < 4; ++n) acc[m][n] = __builtin_amdgcn_mfma_f32_16x16x32_bf16(a[m], b[n], acc[m][n], 0, 0, 0);
    }
    if (more) {
      u16* wa = lds + ((kt + 1) & 1) * STG; u16* wb = wa + ASZ;
#pragma unroll
      for (int i = 0; i < MT; ++i) *(uint4*)(wa + (crow + i * 64) * 72 + ckc) = ra[i];
#pragma unroll
      for (int i = 0; i < 2; ++i) *(uint4*)(wb + (crow + i * 64) * 72 + ckc) = rb[i];
    }
    __syncthreads();
  }
}

__device__ __forceinline__ void gemm_main128(const u16* __restrict__ A, int lda, const u16* __restrict__ B, int ldb, int K,
                                             const u16* __restrict__ nA, int nlda, const u16* __restrict__ nB, int nldb, bool has_next, bool primed,
                                             LAS3 unsigned char* lds, f32x4 (&acc)[2][4]) {
  constexpr int OPB = 128 * 256, STGB = 2 * OPB;
  int tid = threadIdx.x; asm volatile("" : "+v"(tid));
  const int lane = tid & 63, wid = __builtin_amdgcn_readfirstlane(tid >> 6), wr = wid >> 1, wc = wid & 1, fr = lane & 15, fq = lane >> 4;
  const int drow = wid * 4 + (lane >> 4), dslot = lane & 15;
  const int gch = (dslot ^ (drow & 15)) * 8;
  const unsigned goffA = (unsigned)(drow * lda + gch), goffB = (unsigned)(drow * ldb + gch);
  const unsigned rstepA = (unsigned)(32 * lda), rstepB = (unsigned)(32 * ldb);
  const int nk = K >> 7;
#define G128_DMA(st, kt) do { const int k0_ = (kt) * 128; \
    _Pragma("unroll") for (int i_ = 0; i_ < 4; ++i_) { \
      __builtin_amdgcn_global_load_lds((const unsigned*)(A + goffA + i_ * rstepA + k0_), (LAS3 unsigned*)(lds + (st) * STGB + (i_ * 8 + wid) * 1024), 16, 0, 0); \
      __builtin_amdgcn_global_load_lds((const unsigned*)(B + goffB + i_ * rstepB + k0_), (LAS3 unsigned*)(lds + (st) * STGB + OPB + (i_ * 8 + wid) * 1024), 16, 0, 0); } } while (0)
#define G128_MMA(st) do { LAS3 const unsigned char* sa = lds + (st) * STGB; LAS3 const unsigned char* sb = sa + OPB; \
    _Pragma("unroll") for (int ks = 0; ks < 4; ++ks) { bf16x8 a[2], b[4]; \
      _Pragma("unroll") for (int m = 0; m < 2; ++m) a[m] = *(LAS3 const bf16x8*)(sa + (wr * 32 + m * 16 + fr) * 256 + (((ks * 4 + fq) ^ fr) * 16)); \
      _Pragma("unroll") for (int n = 0; n < 4; ++n) b[n] = *(LAS3 const bf16x8*)(sb + (wc * 64 + n * 16 + fr) * 256 + (((ks * 4 + fq) ^ fr) * 16)); \
      __builtin_amdgcn_s_setprio(1); \
      _Pragma("unroll") for (int m = 0; m < 2; ++m) _Pragma("unroll") for (int n = 0; n < 4; ++n) \
        acc[m][n] = __builtin_amdgcn_mfma_f32_16x16x32_bf16(a[m], b[n], acc[m][n], 0, 0, 0); \
      __builtin_amdgcn_s_setprio(0); } } while (0)
  if (!primed) {
    G128_DMA(0, 0);
    asm volatile("s_waitcnt vmcnt(0)" ::: "memory");
    __syncthreads();
  }
  for (int kt = 0; kt < nk; ++kt) {
    if (kt + 1 < nk) G128_DMA((kt + 1) & 1, kt + 1);
    else if (has_next) {
      const unsigned ngA = (unsigned)(drow * nlda + gch), ngB = (unsigned)(drow * nldb + gch);
#pragma unroll
      for (int i_ = 0; i_ < 4; ++i_) {
        __builtin_amdgcn_global_load_lds((const unsigned*)(nA + ngA + i_ * 32 * nlda), (LAS3 unsigned*)(lds + (i_ * 8 + wid) * 1024), 16, 0, 0);
        __builtin_amdgcn_global_load_lds((const unsigned*)(nB + ngB + i_ * 32 * nldb), (LAS3 unsigned*)(lds + OPB + (i_ * 8 + wid) * 1024), 16, 0, 0);
      }
    }
    G128_MMA(kt & 1);
    asm volatile("s_waitcnt vmcnt(0)" ::: "memory");
    __syncthreads();
  }
#undef G128_DMA
#undef G128_MMA
}

template <int MT, class Pre, class Epi>
__device__ __forceinline__ void gemm_phase(const u16* A, int lda, const u16* B, int ldb, int K, int nct, u16* lds, Pre pre,
                                           Epi epi, int id0, int idstride, int idoff) {
  constexpr int BM = MT * 64;
  const int nrt = MTOT / BM, ntile = nrt * nct;
  int first = id0;
  if (first < idoff) { int kk = (idoff - first + idstride - 1) / idstride; first += kk * idstride; }
  for (int gid = first; gid < idoff + ntile; gid += idstride) {
    int id = gid - idoff;
    int g = id / (8 * nct), rem = id - g * 8 * nct;
    int ct = rem >> 3, rt = g * 8 + (rem & 7);
    f32x4 acc[MT][4];
#pragma unroll
    for (int m = 0; m < MT; ++m)
#pragma unroll
      for (int n = 0; n < 4; ++n) acc[m][n] = (f32x4){0.f, 0.f, 0.f, 0.f};
    pre(rt * BM);
    gemm_main<MT>(A + (size_t)rt * BM * lda, lda, B + (size_t)ct * 128 * ldb, ldb, K, lds, acc);
    epi(rt * BM, ct * 128, acc);
    __syncthreads();
  }
}

namespace g8 {
constexpr int BM = 256, BK = 64, HALF = 128, HTB = HALF * BK * 2, STAGE_BYTES = 8 * HTB, NXCD = 8, WGM = 8;
__device__ __forceinline__ int lds_byte(int r, int c) { const int st = (r >> 4) * 2 + (c >> 5), rr = r & 15, cc = c & 31, ob = rr * 64 + cc * 2; return st * 1024 + (ob ^ (((ob >> 9) & 1) << 5)); }
__device__ __forceinline__ void stage_rc(int b, int& R, int& C) { const int st = b / 1024, sb = b % 1024, swz = sb ^ (((sb >> 9) & 1) << 5); R = (st >> 1) * 16 + swz / 64; C = (st & 1) * 32 + (swz % 64) / 2; }
__device__ __forceinline__ int perm32(int rho) { const int n = rho >> 4, i = rho & 15; return 8 * (i >> 2) + 4 * n + (i & 3); }
struct Unit { const char* A; const char* B; int lda, K, pm, pn, aux; };
struct Order {
  int nM, nN, nwg, G, c;
  __device__ void init(int nM_, int nN_, int G_, int c_) { nM = nM_; nN = nN_; nwg = nM * nN; G = G_; c = c_; }
  __device__ bool tile(int i, int& pm, int& pn) const {
    const long L = (long)i * G + c; if (L >= nwg) return false;
    int wgid = (int)L; { const int q = nwg / NXCD, r = nwg % NXCD, xcd = wgid % NXCD, off = wgid / NXCD; wgid = (xcd < r ? xcd * (q + 1) : r * (q + 1) + (xcd - r) * q) + off; }
    const int nig = WGM * nN, gid = wgid / nig, fm = gid * WGM, gsz = (nM - fm) < WGM ? (nM - fm) : WGM;
    pm = fm + ((wgid % nig) % gsz); pn = (wgid % nig) / gsz;
    if (nM == 128) pm += pm >> 4;
    return true;
  }
};
struct Simple {
  Order o; const u16* A; const u16* Bt; int lda, K;
  __device__ bool next(int i, Unit& u) const {
    int pm, pn; if (!o.tile(i, pm, pn)) return false;
    u.A = (const char*)(A + (size_t)pm * 256 * lda); u.B = (const char*)(Bt + (size_t)pn * 256 * K); u.lda = lda; u.K = K; u.pm = pm; u.pn = pn; u.aux = 0; return true;
  }
};
__device__ __forceinline__ unsigned cvt_pk_bf16(float lo, float hi) { unsigned r; asm volatile("v_cvt_pk_bf16_f32 %0, %1, %2" : "=v"(r) : "v"(lo), "v"(hi)); return r; }

template <bool PERM, class Sched, class Epi>
__device__ __forceinline__ void gemm_phase(LAS3 unsigned char* lds, const Sched& S, const Epi& E) {
  int tid = threadIdx.x; asm volatile("" : "+v"(tid));
  const int wid = __builtin_amdgcn_readfirstlane(tid >> 6), lane = tid & 63, wr = wid >> 2, wc = wid & 3, fr = lane & 15, fq = lane >> 4;
  const size_t kstep = (size_t)(BK * 2);
#define G8_VOFF(LDA_, K_) do { int _t2 = tid; asm volatile("" : "+v"(_t2)); _Pragma("unroll") for (int _i = 0; _i < 2; ++_i) { int R, C; stage_rc(_t2 * 16 + _i * 8192, R, C); \
    const int Rb = PERM ? ((R & ~31) + perm32(R & 31)) : R; voffA[_i] = (unsigned)(R * (LDA_) + C) * 2u; voffB[_i] = (unsigned)(Rb * (K_) + C) * 2u; } \
    hstepA = (size_t)HALF * (LDA_) * 2; hstepB = (size_t)HALF * (K_) * 2; } while (0)
  const unsigned ldsw = (unsigned)wid * 1024u;
  const int aoff = lds_byte(wr * 64 + fr, fq * 8), boff = lds_byte(wc * 32 + fr, fq * 8);
#define G8_SA(b, h) (((b) * 2 + (h)) * HTB)
#define G8_SB(b, h) ((4 + (b) * 2 + (h)) * HTB)
#define G8_STAGE(bufoff, gbase, voff) do { _Pragma("unroll") for (int _i = 0; _i < 2; ++_i) \
    __builtin_amdgcn_global_load_lds((const unsigned*)((const char*)(gbase) + (voff)[_i]), (LAS3 unsigned*)(lds + (bufoff) + ldsw + _i * 8192), 16, 0, 0); } while (0)
#define G8_LDA(dst, b, h) do { _Pragma("unroll") for (int m = 0; m < 4; ++m) _Pragma("unroll") for (int k = 0; k < 2; ++k) dst[m][k] = *(const LAS3 bf16x8*)(lds + G8_SA(b, h) + aoff + m * 2048 + k * 1024); } while (0)
#define G8_LDB(dst, b, h) do { _Pragma("unroll") for (int n = 0; n < 2; ++n) _Pragma("unroll") for (int k = 0; k < 2; ++k) dst[n][k] = *(const LAS3 bf16x8*)(lds + G8_SB(b, h) + boff + n * 2048 + k * 1024); } while (0)
#define G8_MMA(ai, bj, At, Bt) do { __builtin_amdgcn_s_setprio(1); _Pragma("unroll") for (int m = 0; m < 4; ++m) _Pragma("unroll") for (int n = 0; n < 2; ++n) _Pragma("unroll") for (int k = 0; k < 2; ++k) \
    acc[ai][bj][m][n] = __builtin_amdgcn_mfma_f32_16x16x32_bf16(Bt[n][k], At[m][k], acc[ai][bj][m][n], 0, 0, 0); __builtin_amdgcn_s_setprio(0); } while (0)
#define G8_WAIT_V(n) asm volatile("s_waitcnt vmcnt(" #n ")" ::: "memory")
#define G8_WAIT_L(n) asm volatile("s_waitcnt lgkmcnt(" #n ")" ::: "memory")
#define G8_BAR __builtin_amdgcn_s_barrier()
#define G8_SCHED __builtin_amdgcn_sched_barrier(0)
  Unit cur, nxt; int ui = 0;
  if (!S.next(0, cur)) return;
  f32x4 acc[2][2][4][2];
#pragma unroll
  for (int a = 0; a < 2; ++a)
#pragma unroll
    for (int b = 0; b < 2; ++b)
#pragma unroll
      for (int m = 0; m < 4; ++m)
#pragma unroll
        for (int n = 0; n < 2; ++n) acc[a][b][m][n] = (f32x4){0.f, 0.f, 0.f, 0.f};
  bf16x8 At[4][2], B0[2][2], B1[2][2];
  const char* cA = cur.A; const char* cB = cur.B;
  unsigned voffA[2], voffB[2];
  size_t hstepA, hstepB;
  G8_VOFF(cur.lda, cur.K);
  G8_STAGE(G8_SB(0, 0), cB, voffB); G8_STAGE(G8_SA(0, 0), cA, voffA); G8_STAGE(G8_SB(0, 1), cB + hstepB, voffB); G8_STAGE(G8_SA(0, 1), cA + hstepA, voffA);
  if (wr == 1) G8_BAR;
  G8_WAIT_V(4); G8_BAR;
  G8_STAGE(G8_SB(1, 0), cB + kstep, voffB); G8_STAGE(G8_SA(1, 0), cA + kstep, voffA); G8_STAGE(G8_SB(1, 1), cB + hstepB + kstep, voffB);
  G8_WAIT_V(6); G8_BAR;
  for (;;) {
    const bool has_next = S.next(ui + 1, nxt);
    if (!has_next) nxt = cur;
    const char* nA = nxt.A; const char* nB = nxt.B;
    const int nt = cur.K / BK;
    for (int t = 0; t < nt; t += 2) {
      const bool last = (t == nt - 2);
      const char* a1 = cA + (size_t)(t + 1) * kstep;
      const char* a2 = last ? nA : cA + (size_t)(t + 2) * kstep; const char* b2 = last ? nB : cB + (size_t)(t + 2) * kstep;
      const char* a3 = a2 + kstep; const char* b3 = b2 + kstep;
      G8_LDB(B0, 0, 0); G8_SCHED; G8_LDA(At, 0, 0); G8_STAGE(G8_SA(1, 1), a1 + hstepA, voffA);
      G8_WAIT_L(8); G8_BAR; G8_WAIT_L(0); G8_MMA(0, 0, At, B0); G8_BAR; G8_SCHED;
      if (last) G8_VOFF(nxt.lda, nxt.K);
      G8_LDB(B1, 0, 1); G8_STAGE(G8_SB(0, 0), b2, voffB);
      G8_BAR; G8_WAIT_L(0); G8_MMA(0, 1, At, B1); G8_BAR;
      G8_LDA(At, 0, 1); G8_STAGE(G8_SA(0, 0), a2, voffA);
      G8_BAR; G8_WAIT_L(0); G8_MMA(1, 0, At, B0); G8_BAR; G8_SCHED;
      G8_STAGE(G8_SB(0, 1), b2 + hstepB, voffB);
      G8_WAIT_V(6); G8_BAR; G8_MMA(1, 1, At, B1); G8_BAR;
      G8_LDB(B0, 1, 0); G8_SCHED; G8_LDA(At, 1, 0); G8_STAGE(G8_SA(0, 1), a2 + hstepA, voffA);
      G8_WAIT_L(8); G8_BAR; G8_WAIT_L(0); G8_MMA(0, 0, At, B0); G8_BAR; G8_SCHED;
      G8_LDB(B1, 1, 1); G8_STAGE(G8_SB(1, 0), b3, voffB);
      G8_BAR; G8_WAIT_L(0); G8_MMA(0, 1, At, B1); G8_BAR;
      G8_LDA(At, 1, 1); G8_STAGE(G8_SA(1, 0), a3, voffA);
      G8_BAR; G8_WAIT_L(0); G8_MMA(1, 0, At, B0); G8_BAR; G8_SCHED;
      G8_STAGE(G8_SB(1, 1), b3 + hstepB, voffB);
      G8_WAIT_V(6); G8_BAR; G8_MMA(1, 1, At, B1); G8_BAR;
    }
    E(acc, cur, wr, wc, fr, fq, tid);
    if (!has_next) break;
#pragma unroll
    for (int a = 0; a < 2; ++a)
#pragma unroll
      for (int b = 0; b < 2; ++b)
#pragma unroll
        for (int m = 0; m < 4; ++m)
#pragma unroll
          for (int n = 0; n < 2; ++n) acc[a][b][m][n] = (f32x4){0.f, 0.f, 0.f, 0.f};
    cur = nxt; cA = nA; cB = nB; ++ui;
  }
  G8_WAIT_V(0);
  if (wr == 0) G8_BAR;
  G8_BAR;
#undef G8_VOFF
#undef G8_SA
#undef G8_SB
#undef G8_STAGE
#undef G8_LDA
#undef G8_LDB
#undef G8_MMA
#undef G8_WAIT_V
#undef G8_WAIT_L
#undef G8_BAR
#undef G8_SCHED
}
}

__device__ __forceinline__ void convT_job(const float* src0, const float* src1, int ldsrc, int kind, int off, int nvalid, u16* dst, int K,
                          int Ndst, const float* kscale, float mult, float* lds, int vb, int vn) {
  int tid = threadIdx.x; asm volatile("" : "+v"(tid));
  const int nkt = K >> 6, nitems = nkt * (Ndst >> 7);
  for (int it = vb; it < nitems; it += vn) {
    const int kt = it % nkt, nt = it / nkt;
    float v[16];
#pragma unroll
    for (int e = 0; e < 16; ++e) {
      int idx = tid + e * 512, i = idx >> 7, j = idx & 127, n = nt * 128 + j, k = kt * 64 + i;
      if (kind == 0) {
        v[e] = (n < nvalid) ? src0[(size_t)k * ldsrc + off + n] : 0.f;
      } else {
        int g = n >> 8, w = n & 255;
        const float* sp = (w < 128) ? src0 : src1;
        v[e] = sp[(size_t)k * ldsrc + g * 128 + (w & 127)];
      }
    }
#pragma unroll
    for (int e = 0; e < 16; ++e) {
      int idx = tid + e * 512, i = idx >> 7, j = idx & 127, k = kt * 64 + i;
      float x = v[e];
      if (kscale) x *= kscale[k];
      lds[j * 65 + i] = x * mult;
    }
    __syncthreads();
#pragma unroll
    for (int e = 0; e < 8; ++e) {
      int idx = tid + e * 512, j = idx >> 5, i2 = (idx & 31) * 2;
      *(uint32_t*)(dst + (size_t)(nt * 128 + j) * K + kt * 64 + i2) = pack2(lds[j * 65 + i2], lds[j * 65 + i2 + 1]);
    }
    __syncthreads();
  }
}

__device__ __forceinline__ void convert_weights(const P& p, int l, float* lds, int job_lo, int job_hi, bool skip_ff2, int vb, int vn, bool do_small) {
  const float* win = p.w_in + (size_t)l * 1024 * 8352;
#pragma unroll 1
  for (int job = job_lo; job < job_hi; ++job) {
    if (skip_ff2 && job == 9) continue;
    const float* s0 = win; const float* s1 = nullptr; const float* ksc = nullptr;
    int ldsrc = 8352, kind = 0, off = 0, nvalid = 0, K = 1024, Ndst = 0; float mult = 1.f; u16* dst = p.W;
    if (job == 0) { off = 1696; nvalid = 2560; dst += OFF_WINA; Ndst = 2560; }
    else if (job == 1) { off = 0; nvalid = 1696; dst += OFF_WINB; Ndst = 1792; }
    else if (job == 2) { off = 4256; nvalid = 4096; dst += OFF_WGATE; Ndst = 4096; }
    else if (job < 7) { const int n = job - 3; s0 = p.w_branch + ((size_t)l * 4 + n) * 512 * 1024; ldsrc = 1024; nvalid = 1024; dst += OFF_WBR + (size_t)n * 1024 * 512; K = 512; Ndst = 1024; }
    else if (job == 7) { s0 = p.w_out + (size_t)l * 1024 * 1024; ldsrc = 1024; nvalid = 1024; dst += OFF_WOUT; Ndst = 1024; }
    else if (job == 8) { s0 = p.w_ff1 + (size_t)l * 1024 * 2816; s1 = p.w_ff3 + (size_t)l * 1024 * 2816; ldsrc = 2816; kind = 1; dst += OFF_WFF13; Ndst = 5632; }
    else if (job == 9) { s0 = p.w_ff2 + (size_t)l * 2816 * 1024; ldsrc = 1024; nvalid = 1024; dst += OFF_WFF2; K = 2816; Ndst = 1024; }
    else if (job == 10) { s0 = p.w_q_up + (size_t)l * 384 * 768; ldsrc = 768; nvalid = 768; dst += OFF_WQUP; K = 384; Ndst = 768; ksc = p.q_norm_g + l * 384; mult = 0.10206207261596575f * 1.4426950408889634f; }
    else { s0 = p.w_kv_up + (size_t)l * 256 * 1024; ldsrc = 1024; nvalid = 1024; dst += OFF_WKVUP; K = 256; Ndst = 1024; ksc = p.kv_norm_g + l * 256; }
    convT_job(s0, s1, ldsrc, kind, off, nvalid, dst, K, Ndst, ksc, mult, lds, vb, vn);
  }
  if (!do_small) return;
  int tidc = threadIdx.x; asm volatile("" : "+v"(tidc));
  const int gt = blockIdx.x * NTHR + tidc, gs = gridDim.x * NTHR;
  for (int i = gt; i < 4 * 128 * 128; i += gs) p.W[OFF_WS + i] = f2bf(p.cmlp_w_s[(size_t)l * 65536 + i]);
  for (int i = gt; i < 2 * 8 * 128 * 64; i += gs) {
    int k = i & 63, n = (i >> 6) & 127, h = (i >> 13) & 7, d = i >> 16;
    const float* src = (n < 64) ? p.lru_w_a : p.lru_w_x;
    p.W[OFF_WLRU + i] = f2bf(src[((((size_t)l * 2 + d) * 8 + h) * 64 + k) * 64 + (n & 63)]);
  }
}

__device__ __forceinline__ void phase0(const P& p, unsigned char* smem) {
  int tid = threadIdx.x; asm volatile("" : "+v"(tid));
  const int gt = blockIdx.x * NTHR + tid, gs = gridDim.x * NTHR;
  for (int idx = gt; idx < SL * 8; idx += gs) {
    int t = idx >> 3, i = idx & 7;
    float inv = exp2f(-(float)i * 0.125f * 13.287712379549449f);
    float ar = (float)(t >> 6) * inv, ac = (float)(t & 63) * inv;
    const float i2pi = 0.15915494309189535f;
    float rr = ar * i2pi; rr -= floorf(rr); rr *= 6.283185307179586f;
    float rc = ac * i2pi; rc -= floorf(rc); rc *= 6.283185307179586f;
    p.rope[t * 32 + i] = __cosf(rr); p.rope[t * 32 + 8 + i] = __sinf(rr);
    p.rope[t * 32 + 16 + i] = __cosf(rc); p.rope[t * 32 + 24 + i] = __sinf(rc);
  }
  float* sS = (float*)smem; float* red = sS + 9 * 1024;
  for (int it = blockIdx.x; it < 4 * 96; it += gridDim.x) {
    const int l = it / 96, cgp = it - l * 96;
    for (int idx = tid; idx < 9216; idx += 512) {
      int m = idx >> 10, k = idx & 1023;
      float v = (m < 8) ? p.c[m * 1024 + k] : p.c_ctx[k];
      sS[idx] = siluf_(v);
    }
    __syncthreads();
    const int cj = tid & 63, kp = tid >> 6, j = cgp * 64 + cj;
    float a[9];
#pragma unroll
    for (int m = 0; m < 9; ++m) a[m] = 0.f;
    for (int k0 = kp * 128; k0 < kp * 128 + 128; k0 += 16) {
      float w[16];
#pragma unroll
      for (int u = 0; u < 16; ++u) w[u] = p.w_mod[((size_t)l * 1024 + k0 + u) * 6144 + j];
#pragma unroll
      for (int u = 0; u < 16; ++u)
#pragma unroll
        for (int m = 0; m < 9; ++m) a[m] += sS[m * 1024 + k0 + u] * w[u];
    }
#pragma unroll
    for (int m = 0; m < 9; ++m) red[(kp * 9 + m) * 64 + cj] = a[m];
    __syncthreads();
    for (int idx = tid; idx < 576; idx += 512) {
      int m = idx >> 6, c2 = idx & 63;
      float s = 0.f;
      for (int q = 0; q < 8; ++q) s += red[(q * 9 + m) * 64 + c2];
      p.mod[((size_t)l * 9 + m) * 6144 + cgp * 64 + c2] = s + p.b_mod[l * 6144 + cgp * 64 + c2];
    }
    __syncthreads();
  }
}

__device__ __forceinline__ void norm_mod(const P& p, int l, const float* g, int off_sh, int off_sc, bool from_input) {
  int tid = threadIdx.x; asm volatile("" : "+v"(tid));
  const int lane = tid & 63, wid = tid >> 6;
  const int rstride = gridDim.x * 8;
  int r = blockIdx.x * 8 + wid;
  float4 nv[4];
  if (r < MTOT) {
    const float* xr0 = from_input ? xin_ptr(p, r) : (const float*)xrow_ptr(p, r);
#pragma unroll
    for (int i = 0; i < 4; ++i) nv[i] = *(const float4*)(xr0 + i * 256 + lane * 4);
  }
  for (; r < MTOT; r += rstride) {
    const float* md = p.mod + ((size_t)l * 9 + mod_idx(r)) * 6144;
    float4 v[4];
#pragma unroll
    for (int i = 0; i < 4; ++i) v[i] = nv[i];
    const int rn = r + rstride;
    if (rn < MTOT) {
      const float* xrn = from_input ? xin_ptr(p, rn) : (const float*)xrow_ptr(p, rn);
#pragma unroll
      for (int i = 0; i < 4; ++i) nv[i] = *(const float4*)(xrn + i * 256 + lane * 4);
    }
    float ss = 0.f;
#pragma unroll
    for (int i = 0; i < 4; ++i) ss += v[i].x * v[i].x + v[i].y * v[i].y + v[i].z * v[i].z + v[i].w * v[i].w;
    ss = wave_sum(ss);
    const float inv = rsqrtf(ss * (1.f / 1024.f) + EPS);
    if (from_input) {
      float* xw = xrow_ptr(p, r);
#pragma unroll
      for (int i = 0; i < 4; ++i) *(float4*)(xw + i * 256 + lane * 4) = v[i];
    }
#pragma unroll
    for (int i = 0; i < 4; ++i) {
      const int k = i * 256 + lane * 4;
      float4 gg = *(const float4*)(g + k);
      float4 sh = *(const float4*)(md + off_sh + k);
      float4 sc = *(const float4*)(md + off_sc + k);
      float o0 = v[i].x * inv * gg.x * (1.f + sc.x) + sh.x;
      float o1 = v[i].y * inv * gg.y * (1.f + sc.y) + sh.y;
      float o2 = v[i].z * inv * gg.z * (1.f + sc.z) + sh.z;
      float o3 = v[i].w * inv * gg.w * (1.f + sc.w) + sh.w;
      uint2 o; o.x = pack2(o0, o1); o.y = pack2(o2, o3);
      *(uint2*)(p.H + (size_t)r * 1024 + k) = o;
    }
  }
}

__device__ __forceinline__ void conva_item(const P& p, int l, int item) {
  int tid = threadIdx.x; asm volatile("" : "+v"(tid));
  const u16* Zb1 = p.R1;
  const float* cw = p.conv_a_w + (size_t)l * 3 * 512;
  for (int e = 0; e < 8; ++e) {
    int idx = tid + e * 512, rr = idx >> 6, cgp = idx & 63;
    int r = item * 64 + rr;
    int b = r / ST, t = r - b * ST;
    int isctx = t >= SL, pos = isctx ? t - SL : t, seglen = isctx ? SC : SL;
    float acc[8];
#pragma unroll
    for (int i = 0; i < 8; ++i) acc[i] = 0.f;
#pragma unroll
    for (int k = 0; k < 3; ++k) {
      int pos2 = pos - 1 + k;
      if (pos2 >= 0 && pos2 < seglen) {
        size_t r2 = (size_t)(r - 1 + k);
        uint4 vc = *(const uint4*)(Zb1 + r2 * 2560 + 512 + cgp * 8);
        uint4 vx = *(const uint4*)(Zb1 + r2 * 2560 + 1024 + cgp * 8);
        float fc[8], fx[8];
        unpack8(vc, fc); unpack8(vx, fx);
#pragma unroll
        for (int i = 0; i < 8; ++i) acc[i] += cw[k * 512 + cgp * 8 + i] * (fc[i] * fx[i]);
      }
    }
    uint4 vb = *(const uint4*)(Zb1 + (size_t)r * 2560 + cgp * 8);
    float fb[8];
    unpack8(vb, fb);
#pragma unroll
    for (int i = 0; i < 8; ++i) acc[i] *= fb[i];
    *(uint4*)(p.Ycat + (size_t)r * 2048 + cgp * 8) = pack8(acc);
  }
}

__device__ __forceinline__ void cmlp_item(const P& p, int l, int item, unsigned char* smem) {
  int tid = threadIdx.x; asm volatile("" : "+v"(tid));
  const int lane = tid & 63, wid = tid >> 6, fr = lane & 15, fq = lane >> 4;
  const int g = item & 3, bj = item >> 2;
  const int rowbase = bj * 128;
  u16* vT = (u16*)smem;
  float* sMu = (float*)(smem + 128 * 136 * 2);
  float* sRs = sMu + 128;
  const u16* Zb1 = p.R1;
  {
    uint4 vv[16];
#pragma unroll
    for (int rr = 0; rr < 16; ++rr) vv[rr] = *(const uint4*)(Zb1 + (size_t)(rowbase + wid * 16 + rr) * 2560 + 2048 + lane * 8);
#pragma unroll
    for (int rr = 0; rr < 16; ++rr) {
      int q = wid * 16 + rr;
      float f[8];
      unpack8(vv[rr], f);
      float s = 0.f;
#pragma unroll
      for (int i = 0; i < 8; ++i) { f[i] = geluf_(f[i]); s += f[i]; }
      s = wave_sum(s);
      float mu = s * (1.f / 512.f);
      float d2 = 0.f;
#pragma unroll
      for (int i = 0; i < 8; ++i) { float d = f[i] - mu; d2 += d * d; }
      d2 = wave_sum(d2);
      if (lane == 0) { sMu[q] = mu; sRs[q] = rsqrtf(d2 * (1.f / 512.f) + EPS); }
    }
  }
  __syncthreads();
  const float* lg = p.cmlp_ln_g + l * 512 + g * 128;
  const float* lb = p.cmlp_ln_b + l * 512 + g * 128;
#pragma unroll
  for (int e = 0; e < 4; ++e) {
    int idx = tid + e * 512, q = idx >> 4, dc = idx & 15;
    uint4 v = *(const uint4*)(Zb1 + (size_t)(rowbase + q) * 2560 + 2048 + g * 128 + dc * 8);
    float f[8];
    unpack8(v, f);
    float mu = sMu[q], rs = sRs[q];
#pragma unroll
    for (int i = 0; i < 8; ++i) {
      float val = (geluf_(f[i]) - mu) * rs * lg[dc * 8 + i] + lb[dc * 8 + i];
      vT[(dc * 8 + i) * 136 + q] = f2bf(val);
    }
  }
  __syncthreads();
  const u16* Ws = p.W + OFF_WS + (size_t)g * 128 * 128;
  f32x4 acc[8];
#pragma unroll
  for (int n = 0; n < 8; ++n) acc[n] = (f32x4){0.f, 0.f, 0.f, 0.f};
#pragma unroll
  for (int ks = 0; ks < 4; ++ks) {
    bf16x8 a = *(const bf16x8*)(Ws + (wid * 16 + fr) * 128 + ks * 32 + fq * 8);
#pragma unroll
    for (int n = 0; n < 8; ++n) {
      bf16x8 bb = *(const bf16x8*)(vT + (n * 16 + fr) * 136 + ks * 32 + fq * 8);
      acc[n] = __builtin_amdgcn_mfma_f32_16x16x32_bf16(bb, a, acc[n], 0, 0, 0);
    }
  }
  {
    const int pp = wid * 16 + fr;
    const size_t r = (size_t)(rowbase + pp);
    const float bsv = p.cmlp_b_s[((size_t)l * 4 + g) * 128 + pp];
    uint2 uu[8];
#pragma unroll
    for (int n = 0; n < 8; ++n) uu[n] = *(const uint2*)(Zb1 + r * 2560 + 1536 + g * 128 + n * 16 + fq * 4);
#pragma unroll
    for (int n = 0; n < 8; ++n) {
      float u0 = __uint_as_float(uu[n].x << 16), u1 = __uint_as_float(uu[n].x & 0xffff0000u);
      float u2 = __uint_as_float(uu[n].y << 16), u3 = __uint_as_float(uu[n].y & 0xffff0000u);
      uint2 ov;
      ov.x = pack2(geluf_(u0) * (acc[n][0] + bsv), geluf_(u1) * (acc[n][1] + bsv));
      ov.y = pack2(geluf_(u2) * (acc[n][2] + bsv), geluf_(u3) * (acc[n][3] + bsv));
      *(uint2*)(p.Ycat + r * 2048 + 1024 + g * 128 + n * 16 + fq * 4) = ov;
    }
  }
  __syncthreads();
}

template <int CTRL, int ROWMASK>
__device__ __forceinline__ float dppf(float old, float src) {
  return __int_as_float(__builtin_amdgcn_update_dpp(__float_as_int(old), __float_as_int(src), CTRL, ROWMASK, 0xf, false));
}
#define LSCAN_STEP(A_, B_, CTRL, RM) do { const float A2_ = dppf<CTRL, RM>(1.f, A_), B2_ = dppf<CTRL, RM>(0.f, B_); B_ = A_ * B2_ + B_; A_ = A_ * A2_; } while (0)
#define LSCAN64(A_, B_) do { LSCAN_STEP(A_, B_, 0x111, 0xf); LSCAN_STEP(A_, B_, 0x112, 0xf); LSCAN_STEP(A_, B_, 0x114, 0xf); LSCAN_STEP(A_, B_, 0x118, 0xf); \
    LSCAN_STEP(A_, B_, 0x142, 0xa); LSCAN_STEP(A_, B_, 0x143, 0xc); } while (0)

template <int PASS>
__device__ __forceinline__ void lru_run(const P& p, int l, int it_first, int it_stride, unsigned char* smem) {
  int tid = threadIdx.x; asm volatile("" : "+v"(tid));
  const int lane = tid & 63, wid = tid >> 6, fr = lane & 15, fq = lane >> 4;
  u16* sX = (u16*)smem;
  float* sA = (float*)(smem + 18432);
  float* sB = sA + 64 * 130;
  float* sH = sB + 64 * 130;
  float* sCw = sH + 128 * 65;
  float* sCarry = sCw + 320;
  float* sPar = sCarry + 128;
  u16* sW = (u16*)(sPar + 384);
  const u16* Zb2 = p.R1;
  int cur_h = -1;
  uint4 cv[2][4];
#define LRU_LOADCV(ITEM) do { const int h_ = (ITEM) & 7, bj_ = (ITEM) >> 3; const int b_ = bj_ / 34, j_ = bj_ - b_ * 34; const int ic_ = j_ >= 32; \
    const int p0_ = ic_ ? (j_ - 32) * 128 : j_ * 128, sl_ = ic_ ? SC : SL, rs_ = bj_ * 128 - p0_; \
    _Pragma("unroll") for (int e = 0; e < 2; ++e) { int idx = tid + e * 512, pp = idx >> 3, cgp = idx & 7; \
      _Pragma("unroll") for (int k = 0; k < 4; ++k) { int pos = p0_ + pp - 2 + k; cv[e][k] = make_uint4(0, 0, 0, 0); \
        if (pos >= 0 && pos < sl_) cv[e][k] = *(const uint4*)(Zb2 + (size_t)(rs_ + pos) * 1792 + h_ * 64 + cgp * 8); } } } while (0)
  if (it_first < 2176) LRU_LOADCV(it_first);
  for (int item = it_first; item < 2176; item += it_stride) {
    const int h = item & 7, bj = item >> 3;
    const int b = bj / 34, j = bj - b * 34;
    const int rowbase = bj * 128;
    const int isctx = j >= 32;
    const int ordf = isctx ? j - 32 : j + 2, ordr = 33 - j;
    float cA[16], cB[16];
    uint4 gv[2];
    if (PASS == 3) {
#pragma unroll
      for (int q = 0; q < 16; ++q) {
        const int pi = wid * 16 + q, d = pi >> 6, ch = pi & 63, o = d ? ordr : ordf;
        cA[q] = 1.f; cB[q] = 0.f;
        if (lane < o) { float2 v = p.summ[((size_t)(b * 2 + d) * 512 + h * 64 + ch) * 34 + lane]; cA[q] = v.x; cB[q] = v.y; }
      }
#pragma unroll
      for (int e = 0; e < 2; ++e) {
        int idx = tid + e * 512, pos = idx >> 3, cgp = idx & 7;
        gv[e] = *(const uint4*)(Zb2 + (size_t)(rowbase + pos) * 1792 + 800 + h * 64 + cgp * 8);
      }
    }
    if (h != cur_h) {
      cur_h = h;
      __syncthreads();
      if (tid < 320) {
        int k = tid >> 6, i = tid & 63;
        sCw[tid] = (k < 4) ? p.lru_conv_w[((size_t)l * 4 + k) * 512 + h * 64 + i] : p.lru_conv_b[l * 512 + h * 64 + i];
      }
      if (tid < 128) {
        const int d = tid >> 6, ch = tid & 63;
        const size_t pidx = ((size_t)l * 2 + d) * 512 + h * 64 + ch;
        sPar[tid * 3] = p.lru_b_a[pidx]; sPar[tid * 3 + 1] = p.lru_b_x[pidx];
        sPar[tid * 3 + 2] = 8.f * log1pf(__expf(-p.lru_lam[pidx]));
      }
#pragma unroll
      for (int e = 0; e < 4; ++e) {
        int idx = tid + e * 512, row = idx >> 3, kc = idx & 7;
        const int d = row >> 7, n = row & 127;
        *(uint4*)(sW + row * 72 + kc * 8) = *(const uint4*)(p.W + OFF_WLRU + (size_t)((d * 8 + h) * 128 + n) * 64 + kc * 8);
      }
      __syncthreads();
    }
#pragma unroll
    for (int e = 0; e < 2; ++e) {
      int idx = tid + e * 512, pp = idx >> 3, cgp = idx & 7;
      float a8[8];
#pragma unroll
      for (int i = 0; i < 8; ++i) a8[i] = sCw[256 + cgp * 8 + i];
#pragma unroll
      for (int k = 0; k < 4; ++k) {
        float f[8];
        unpack8(cv[e][k], f);
#pragma unroll
        for (int i = 0; i < 8; ++i) a8[i] += sCw[k * 64 + cgp * 8 + i] * f[i];
      }
      *(uint4*)(sX + pp * 72 + cgp * 8) = pack8(a8);
    }
    if (item + it_stride < 2176) LRU_LOADCV(item + it_stride);
    if (PASS == 3) {
#pragma unroll
      for (int q = 0; q < 16; ++q) LSCAN64(cA[q], cB[q]);
      if (lane == 63) {
#pragma unroll
        for (int q = 0; q < 16; ++q) sCarry[wid * 16 + q] = cB[q];
      }
    }
    __syncthreads();
    for (int d = 0; d < 2; ++d) {
      const u16* Wl = sW + d * 128 * 72;
      f32x4 acc[8];
#pragma unroll
      for (int n = 0; n < 8; ++n) acc[n] = (f32x4){0.f, 0.f, 0.f, 0.f};
      {
        const bf16x8 a0 = *(const bf16x8*)(sX + (wid * 16 + fr) * 72 + fq * 8);
        const bf16x8 a1 = *(const bf16x8*)(sX + (wid * 16 + fr) * 72 + 32 + fq * 8);
#pragma unroll
        for (int n = 0; n < 8; ++n) {
          const bf16x8 b0 = *(const bf16x8*)(Wl + (n * 16 + fr) * 72 + fq * 8);
          const bf16x8 b1 = *(const bf16x8*)(Wl + (n * 16 + fr) * 72 + 32 + fq * 8);
          acc[n] = __builtin_amdgcn_mfma_f32_16x16x32_bf16(a0, b0, acc[n], 0, 0, 0);
          acc[n] = __builtin_amdgcn_mfma_f32_16x16x32_bf16(a1, b1, acc[n], 0, 0, 0);
        }
      }
#pragma unroll
      for (int nt = 0; nt < 4; ++nt) {
        const int ch = nt * 16 + fr;
        const float ba = sPar[(d * 64 + ch) * 3], bx = sPar[(d * 64 + ch) * 3 + 1], sp8 = sPar[(d * 64 + ch) * 3 + 2];
#pragma unroll
        for (int jj = 0; jj < 4; ++jj) {
          const int pos = wid * 16 + fq * 4 + jj;
          const float xl = bf2f(sX[pos * 72 + ch]);
          const float rg = sigmoid_rcp_(acc[nt][jj] + ba), ig = sigmoid_rcp_(acc[nt + 4][jj] + bx);
          const float la = -sp8 * rg;
          const float av = __expf(la);
          const float x2 = 2.f * la;
          const float ser = -x2 * (1.f + x2 * (0.5f + x2 * (0.16666667f + x2 * (0.041666667f + x2 * 0.0083333333f))));
          const float om = (x2 > -0.25f) ? ser : (1.f - av * av);
          const float bb = __builtin_amdgcn_sqrtf(om) * ig * xl;
          const int si = d ? 127 - pos : pos;
          sA[ch * 130 + si] = av;
          sB[ch * 130 + si] = bb;
        }
      }
      __syncthreads();
      {
        float a0[8], b0[8], A[8], B[8];
#pragma unroll
        for (int c = 0; c < 8; ++c) {
          const int ch = wid * 8 + c;
          const float2 va = *(const float2*)(sA + ch * 130 + 2 * lane), vb = *(const float2*)(sB + ch * 130 + 2 * lane);
          a0[c] = va.x; b0[c] = vb.x;
          A[c] = va.x * va.y; B[c] = va.y * vb.x + vb.y;
        }
#pragma unroll
        for (int c = 0; c < 8; ++c) LSCAN64(A[c], B[c]);
#pragma unroll
        for (int c = 0; c < 8; ++c) {
          const int ch = wid * 8 + c;
          if (PASS == 1) {
            if (lane == 63) p.summ[((size_t)(b * 2 + d) * 512 + h * 64 + ch) * 34 + (d ? ordr : ordf)] = make_float2(A[c], B[c]);
          } else {
            const float carry = sCarry[d * 64 + ch];
            const float hincl = A[c] * carry + B[c];
            const float hprev = dppf<0x138, 0xf>(carry, hincl);
            const float heven = a0[c] * hprev + b0[c];
            const int se = 2 * lane, pe = d ? 127 - se : se, po = d ? 126 - se : se + 1;
            if (d == 0) { sH[pe * 65 + ch] = heven; sH[po * 65 + ch] = hincl; }
            else { sH[pe * 65 + ch] += heven; sH[po * 65 + ch] += hincl; }
          }
        }
      }
      __syncthreads();
    }
    if (PASS == 3) {
#pragma unroll
      for (int e = 0; e < 2; ++e) {
        int idx = tid + e * 512, pos = idx >> 3, cgp = idx & 7;
        const size_t r = (size_t)(rowbase + pos);
        float gf[8], y[8];
        unpack8(gv[e], gf);
#pragma unroll
        for (int i = 0; i < 8; ++i) y[i] = geluf_(gf[i]) * sH[pos * 65 + cgp * 8 + i];
        *(uint4*)(p.Ycat + r * 2048 + 512 + h * 64 + cgp * 8) = pack8(y);
      }
      __syncthreads();
    }
  }
}

__device__ __forceinline__ void krope_item(const P& p, int item) {
  int tid = threadIdx.x; asm volatile("" : "+v"(tid));
  const u16* Zb2 = p.R1;
#pragma unroll
  for (int e = 0; e < 8; ++e) {
    int idx = tid + e * 512, rr = idx >> 4, pi = idx & 15, axis = pi >> 3, i = pi & 7;
    int r = item * 256 + rr, b = r / ST, t = r - b * ST;
    float x1 = bf2f(Zb2[(size_t)r * 1792 + 768 + axis * 16 + i]);
    float x2 = bf2f(Zb2[(size_t)r * 1792 + 768 + axis * 16 + 8 + i]);
    float o1 = x1, o2 = x2;
    if (t < SL) {
      float cs = p.rope[t * 32 + axis * 16 + i], sn = p.rope[t * 32 + axis * 16 + 8 + i];
      o1 = x1 * cs - x2 * sn;
      o2 = x1 * sn + x2 * cs;
    }
    u16 b1 = f2bf(o1), b2 = f2bf(o2);
#pragma unroll
    for (int h = 0; h < 8; ++h) {
      size_t base = ((size_t)(b * 8 + h) * ST + t) * 96 + 64 + axis * 16 + i;
      p.K[base] = b1;
      p.K[base + 8] = b2;
    }
  }
}

__device__ __forceinline__ void attn_item(const P& p, int item, unsigned char* smem) {
  int tid = threadIdx.x; asm volatile("" : "+v"(tid));
  const int lane = tid & 63, wid = tid >> 6, fr = lane & 15, fq = lane >> 4;
  int b, h, t0, kt0, kt1;
  if (item < 1024) { b = item >> 7; h = (item >> 4) & 7; t0 = (item & 15) * 256; kt0 = 0; kt1 = 68; }
  else { int i2 = item - 1024; b = i2 >> 3; h = i2 & 7; t0 = SL; kt0 = 64; kt1 = 68; }
  const u16* Kb = p.K + (size_t)(b * 8 + h) * ST * 96;
  const u16* Vb = p.Vt + (size_t)(b * 8 + h) * 64 * ST;
  const u16* Qb = p.Q + (size_t)(b * 8 + h) * ST * 96;
  constexpr int KS = 104, VS = 136, KSZ = 128 * KS, VSZ = 64 * VS, STG = KSZ + VSZ;
  u16* lds = (u16*)smem;
  bf16x8 qf[2][3];
#pragma unroll
  for (int nq = 0; nq < 2; ++nq)
#pragma unroll
    for (int ks = 0; ks < 3; ++ks)
      qf[nq][ks] = *(const bf16x8*)(Qb + (size_t)(t0 + wid * 32 + nq * 16 + fr) * 96 + ks * 32 + fq * 8);
  if (item < 1024) {
#pragma unroll
    for (int nq = 0; nq < 2; ++nq) {
      const int t = t0 + wid * 32 + nq * 16 + fr;
      const float* rp = p.rope + t * 32 + (fq >> 1) * 16;
      union { bf16x8 v; uint32_t u[4]; } own, oth, res;
      own.v = qf[nq][2];
#pragma unroll
      for (int i = 0; i < 4; ++i) oth.u[i] = __shfl_xor(own.u[i], 16);
      float fo[8], fp[8], fres[8];
      { uint4 t4 = make_uint4(own.u[0], own.u[1], own.u[2], own.u[3]); unpack8(t4, fo); }
      { uint4 t4 = make_uint4(oth.u[0], oth.u[1], oth.u[2], oth.u[3]); unpack8(t4, fp); }
#pragma unroll
      for (int j = 0; j < 8; ++j) {
        float cs = rp[j], sn = rp[8 + j];
        fres[j] = (fq & 1) ? (fp[j] * sn + fo[j] * cs) : (fo[j] * cs - fp[j] * sn);
      }
      uint4 r4 = pack8(fres);
      res.u[0] = r4.x; res.u[1] = r4.y; res.u[2] = r4.z; res.u[3] = r4.w;
      qf[nq][2] = res.v;
    }
  }
  f32x4 o[4][2];
#pragma unroll
  for (int m = 0; m < 4; ++m)
#pragma unroll
    for (int n = 0; n < 2; ++n) o[m][n] = (f32x4){0.f, 0.f, 0.f, 0.f};
  float mrun[2] = {-1e30f, -1e30f}, lrun[2] = {0.f, 0.f};
  const int T0 = kt0 >> 1, T1 = kt1 >> 1;
  uint4 rk0, rk1, rk2, rv0, rv1;
  const int c0_ = tid, c1_ = tid + 512, c2_ = tid + 1024;
  const int kcv0_ = c0_ & 15, kcv1_ = c1_ & 15;
  const int vslot0_ = 32 * (kcv0_ >> 2) + 16 * (kcv0_ & 1) + 4 * ((kcv0_ & 3) >> 1);
  const int vslot1_ = 32 * (kcv1_ >> 2) + 16 * (kcv1_ & 1) + 4 * ((kcv1_ & 3) >> 1);
#define ATT_LD(tt) do { const size_t key0_ = (size_t)(tt) * 128; const u16* kb_ = Kb + key0_ * 96; \
    rk0 = *(const uint4*)(kb_ + (size_t)c0_ * 8); rk1 = *(const uint4*)(kb_ + (size_t)c1_ * 8); rk2 = *(const uint4*)(kb_ + (size_t)c2_ * 8); \
    rv0 = *(const uint4*)(Vb + (size_t)(c0_ >> 4) * ST + key0_ + (c0_ & 15) * 8); \
    rv1 = *(const uint4*)(Vb + (size_t)(c1_ >> 4) * ST + key0_ + (c1_ & 15) * 8); } while (0)
#define ATT_ST(st) do { u16* sk_ = lds + (st) * STG; u16* sv_ = sk_ + KSZ; \
    *(uint4*)(sk_ + (c0_ / 12) * KS + (c0_ % 12) * 8) = rk0; *(uint4*)(sk_ + (c1_ / 12) * KS + (c1_ % 12) * 8) = rk1; *(uint4*)(sk_ + (c2_ / 12) * KS + (c2_ % 12) * 8) = rk2; \
    *(uint2*)(sv_ + (c0_ >> 4) * VS + vslot0_) = make_uint2(rv0.x, rv0.y); *(uint2*)(sv_ + (c0_ >> 4) * VS + vslot0_ + 8) = make_uint2(rv0.z, rv0.w); \
    *(uint2*)(sv_ + (c1_ >> 4) * VS + vslot1_) = make_uint2(rv1.x, rv1.y); *(uint2*)(sv_ + (c1_ >> 4) * VS + vslot1_ + 8) = make_uint2(rv1.z, rv1.w); } while (0)
  ATT_LD(T0); ATT_ST(0);
  __syncthreads();
  for (int kt = T0; kt < T1; ++kt) {
    const bool more = (kt + 1 < T1);
    if (more) ATT_LD(kt + 1);
    const int cur = (kt - T0) & 1;
    const u16* sk = lds + cur * STG;
    const u16* sv = sk + KSZ;
    f32x4 s[8][2];
#pragma unroll
    for (int m = 0; m < 8; ++m)
#pragma unroll
      for (int n = 0; n < 2; ++n) s[m][n] = (f32x4){0.f, 0.f, 0.f, 0.f};
#pragma unroll
    for (int ks = 0; ks < 3; ++ks)
#pragma unroll
      for (int mt = 0; mt < 8; ++mt) {
        bf16x8 kf = *(const bf16x8*)(sk + (mt * 16 + fr) * KS + ks * 32 + fq * 8);
#pragma unroll
        for (int nq = 0; nq < 2; ++nq) s[mt][nq] = __builtin_amdgcn_mfma_f32_16x16x32_bf16(kf, qf[nq][ks], s[mt][nq], 0, 0, 0);
      }
    bf16x8 pb[2][4];
    float mloc[2];
#pragma unroll
    for (int nq = 0; nq < 2; ++nq) {
      float mx = fmaxf(fmaxf(s[0][nq][0], s[0][nq][1]), fmaxf(s[0][nq][2], s[0][nq][3]));
#pragma unroll
      for (int mt = 1; mt < 8; ++mt) mx = fmaxf(fmaxf(mx, s[mt][nq][0]), fmaxf(fmaxf(s[mt][nq][1], s[mt][nq][2]), s[mt][nq][3]));
      mloc[nq] = mx;
    }
    if (__any((mloc[0] > mrun[0] + 8.f) || (mloc[1] > mrun[1] + 8.f))) {
      float m0 = fmaxf(mloc[0], __shfl_xor(mloc[0], 16)), m1 = fmaxf(mloc[1], __shfl_xor(mloc[1], 16));
      m0 = fmaxf(m0, __shfl_xor(m0, 32)); m1 = fmaxf(m1, __shfl_xor(m1, 32));
      const float n0 = fmaxf(mrun[0], m0), n1 = fmaxf(mrun[1], m1);
      const float a0 = __builtin_amdgcn_exp2f(mrun[0] - n0), a1 = __builtin_amdgcn_exp2f(mrun[1] - n1);
      mrun[0] = n0; mrun[1] = n1;
      lrun[0] *= a0; lrun[1] *= a1;
#pragma unroll
      for (int mtv = 0; mtv < 4; ++mtv) {
        o[mtv][0][0] *= a0; o[mtv][0][1] *= a0; o[mtv][0][2] *= a0; o[mtv][0][3] *= a0;
        o[mtv][1][0] *= a1; o[mtv][1][1] *= a1; o[mtv][1][2] *= a1; o[mtv][1][3] *= a1;
      }
    }
#pragma unroll
    for (int nq = 0; nq < 2; ++nq) {
      const float mn = mrun[nq];
      float rs = 0.f;
#pragma unroll
      for (int mt = 0; mt < 8; ++mt)
#pragma unroll
        for (int jj = 0; jj < 4; ++jj) {
          float pv = __builtin_amdgcn_exp2f(s[mt][nq][jj] - mn);
          s[mt][nq][jj] = pv;
          rs += pv;
        }
      lrun[nq] += rs;
#pragma unroll
      for (int sx = 0; sx < 4; ++sx) {
        union { uint4 u; bf16x8 v; } cv;
        cv.u.x = pack2(s[2 * sx][nq][0], s[2 * sx][nq][1]); cv.u.y = pack2(s[2 * sx][nq][2], s[2 * sx][nq][3]);
        cv.u.z = pack2(s[2 * sx + 1][nq][0], s[2 * sx + 1][nq][1]); cv.u.w = pack2(s[2 * sx + 1][nq][2], s[2 * sx + 1][nq][3]);
        pb[nq][sx] = cv.v;
      }
    }
#pragma unroll
    for (int sx = 0; sx < 4; ++sx)
#pragma unroll
      for (int mtv = 0; mtv < 4; ++mtv) {
        const bf16x8 vf = *(const bf16x8*)(sv + (mtv * 16 + fr) * VS + 32 * sx + fq * 8);
#pragma unroll
        for (int nq = 0; nq < 2; ++nq) o[mtv][nq] = __builtin_amdgcn_mfma_f32_16x16x32_bf16(vf, pb[nq][sx], o[mtv][nq], 0, 0, 0);
      }
    if (more) ATT_ST(cur ^ 1);
    __syncthreads();
  }
#undef ATT_LD
#undef ATT_ST
#pragma unroll
  for (int nq = 0; nq < 2; ++nq) {
    float lt = lrun[nq];
    lt += __shfl_xor(lt, 16);
    lt += __shfl_xor(lt, 32);
    float inv = 1.f / lt;
    size_t r = (size_t)b * ST + t0 + wid * 32 + nq * 16 + fr;
#pragma unroll
    for (int mtv = 0; mtv < 4; ++mtv) {
      uint2 ov;
      ov.x = pack2(o[mtv][nq][0] * inv, o[mtv][nq][1] * inv);
      ov.y = pack2(o[mtv][nq][2] * inv, o[mtv][nq][3] * inv);
      *(uint2*)(p.Ycat + r * 2048 + 1536 + h * 64 + mtv * 16 + fq * 4) = ov;
    }
  }
}

#define XB_TMO      128
#define XB_XCNT(j)  (256  + 64 * (j))
#define XB_XSUB(j)  (1280 + 64 * (j))
#define XB_XGEN(j)  (2304 + 64 * (j))
#define XB_TOP      3328
#define XB_TOPGEN   3392
#define XCD_BAR_WORDS 3456
#define XB_SPIN_CAP (1u << 18)
__device__ __forceinline__ unsigned xb_ld(unsigned* p)              { return __hip_atomic_load(p, __ATOMIC_RELAXED, __HIP_MEMORY_SCOPE_AGENT); }
__device__ __forceinline__ unsigned xb_add(unsigned* p, unsigned v) { return __hip_atomic_fetch_add(p, v, __ATOMIC_RELAXED, __HIP_MEMORY_SCOPE_AGENT); }
__device__ __forceinline__ unsigned xb_xcc_id() { return (unsigned)__builtin_amdgcn_s_getreg((3 << 11) | 20) & 0xFu; }
#define XB_SPIN(cond, bar) do { unsigned _sp = 0; while (cond) { __builtin_amdgcn_s_sleep(1); \
    if ((++_sp & 255u) == 0u) { if (xb_ld(&(bar)[XB_TMO])) break; if (_sp > XB_SPIN_CAP) { atomicAdd(&(bar)[XB_TMO], 1u); break; } } } } while (0)
struct XcdBarrier { unsigned* bar; unsigned x; volatile __attribute__((address_space(3))) unsigned* st; };
__device__ __forceinline__ XcdBarrier xcd_barrier_post(unsigned* bar, volatile __attribute__((address_space(3))) unsigned* st) {
  XcdBarrier b; b.bar = bar; b.x = xb_xcc_id(); b.st = st;
  if (threadIdx.x == 0) (void)xb_add(&bar[XB_XCNT(b.x)], 1u);
  return b;
}
__device__ __forceinline__ void xcd_barrier_complete(unsigned* bar, unsigned x, unsigned& nloc, unsigned& nx) {
  const unsigned G = gridDim.x * gridDim.y * gridDim.z;
  unsigned sum, cnt, mine, sp = 0u;
  for (;;) {
    sum = 0u; cnt = 0u; mine = 0u;
#pragma unroll
    for (unsigned j = 0; j < 16; ++j) { const unsigned c = xb_ld(&bar[XB_XCNT(j)]); sum += c; cnt += (c > 0u) ? 1u : 0u; mine = (j == x) ? c : mine; }
    if (sum == G) break;
    __builtin_amdgcn_s_sleep(1);
    if ((++sp & 255u) == 0u) { if (xb_ld(&bar[XB_TMO])) break; if (sp > XB_SPIN_CAP) { atomicAdd(&bar[XB_TMO], 1u); break; } }
  }
  nloc = mine > 0u ? mine : 1u; nx = cnt > 0u ? cnt : 1u;
}
__device__ __forceinline__ void xcd_barrier(const XcdBarrier& b) {
  asm volatile("s_waitcnt vmcnt(0)" ::: "memory");
  __syncthreads();
  if (threadIdx.x == 0) {
    unsigned* bar = b.bar;
    __builtin_amdgcn_s_waitcnt(0);
    unsigned nloc = b.st[0], nx = b.st[1];
    if (nloc == 0u) { xcd_barrier_complete(bar, b.x, nloc, nx); b.st[0] = nloc; b.st[1] = nx; }
    const unsigned old = xb_add(&bar[XB_XSUB(b.x)], 1u);
    const unsigned gen = old / nloc;
    if (old + 1u == (gen + 1u) * nloc) {
      __builtin_amdgcn_fence(__ATOMIC_RELEASE, "agent");
      asm volatile("s_waitcnt vmcnt(0)" ::: "memory");
      const unsigned og = xb_add(&bar[XB_TOP], 1u);
      const unsigned tg = og / nx;
      if (og + 1u == (tg + 1u) * nx) xb_add(&bar[XB_TOPGEN], 1u);
      else XB_SPIN(xb_ld(&bar[XB_TOPGEN]) == tg, bar);
      __builtin_amdgcn_fence(__ATOMIC_ACQUIRE, "agent");
      xb_add(&bar[XB_XGEN(b.x)], 1u);
      asm volatile("s_waitcnt vmcnt(0)" ::: "memory");
    } else {
      XB_SPIN(xb_ld(&bar[XB_XGEN(b.x)]) == gen, bar);
      __builtin_amdgcn_fence(__ATOMIC_ACQUIRE, "agent");
      asm volatile("s_waitcnt vmcnt(0)" ::: "memory");
    }
  }
  __syncthreads();
}

__global__ void __launch_bounds__(NTHR) mega(P p) {
  extern __shared__ __attribute__((aligned(16))) unsigned char smem[];
  __shared__ uint4 xb_words;
  cg::grid_group grid = cg::this_grid();
  if (threadIdx.x == 0) xb_words = make_uint4(0u, 0u, 0u, 0u);
  __syncthreads();
  XcdBarrier xb = xcd_barrier_post(p.bar, (volatile __attribute__((address_space(3))) unsigned*)&xb_words);
  u16* lds = (u16*)smem;
  float* sInv = (float*)(smem + 131072);
  LAS3 unsigned char* lds3 = (LAS3 unsigned char*)smem;
  const int bid = blockIdx.x, nblk = gridDim.x;
  auto nopre = [](int) {};

#ifndef NO_P0
  phase0(p, smem);
#endif
  grid.sync();

#pragma unroll 1
  for (int l = 0; l < 4; ++l) {
    int tid = threadIdx.x; asm volatile("" : "+v"(tid));
    const int lane = tid & 63, wid = tid >> 6, wr = wid >> 1, wc = wid & 1, fr = lane & 15, fq = lane >> 4;
    (void)lane; (void)wid; (void)wr; (void)wc; (void)fr; (void)fq;
#ifndef NO_CW
    convert_weights(p, l, (float*)smem, l == 0 ? 0 : 9, l == 0 ? 12 : 10, false, bid, nblk, true);
#endif
    norm_mod(p, l, p.norm1_g + l * 1024, 0, 1024, l == 0);
    GSYNC();

    {
      u16* Zb1 = p.R1;
      auto epi = [=](const f32x4(&acc)[2][2][4][2], const g8::Unit& u, int wr, int wc, int fr, int fq, int) {
#pragma unroll
        for (int ai = 0; ai < 2; ++ai)
#pragma unroll
          for (int m = 0; m < 4; ++m) {
            u16* rowp = Zb1 + (size_t)(u.pm * 256 + ai * 128 + wr * 64 + m * 16 + fr) * 2560 + u.pn * 256 + wc * 32 + 8 * fq;
#pragma unroll
            for (int bj = 0; bj < 2; ++bj) {
              uint4 w;
              w.x = g8::cvt_pk_bf16(acc[ai][bj][m][0][0], acc[ai][bj][m][0][1]); w.y = g8::cvt_pk_bf16(acc[ai][bj][m][0][2], acc[ai][bj][m][0][3]);
              w.z = g8::cvt_pk_bf16(acc[ai][bj][m][1][0], acc[ai][bj][m][1][1]); w.w = g8::cvt_pk_bf16(acc[ai][bj][m][1][2], acc[ai][bj][m][1][3]);
              *(uint4*)(rowp + bj * 128) = w;
            }
          }
      };
      g8::Simple S; S.o.init(l == 3 ? 128 : 136, 10, nblk, bid); S.A = p.H; S.Bt = p.W + OFF_WINA; S.lda = 1024; S.K = 1024;
      g8::gemm_phase<true>(lds3, S, epi);
    }
    GSYNC();

    for (int rep = 0; rep < DUP_C1; ++rep)
    for (int it = bid; it < 1088 + 544; it += nblk) {
#ifndef NO_CMLP
      if (it < 1088) cmlp_item(p, l, it, smem);
#endif
#ifndef NO_CONVA
      if (it >= 1088) conva_item(p, l, it - 1088);
#endif
    }
    GSYNC();

    {
      u16* Zb2 = p.R1;
      auto epi = [=](const f32x4(&acc)[2][2][4][2], const g8::Unit& u, int wr, int wc, int fr, int fq, int) {
#pragma unroll
        for (int ai = 0; ai < 2; ++ai)
#pragma unroll
          for (int m = 0; m < 4; ++m) {
            u16* rowp = Zb2 + (size_t)(u.pm * 256 + ai * 128 + wr * 64 + m * 16 + fr) * 1792 + u.pn * 256 + wc * 32 + 8 * fq;
#pragma unroll
            for (int bj = 0; bj < 2; ++bj) {
              uint4 w;
              w.x = g8::cvt_pk_bf16(acc[ai][bj][m][0][0], acc[ai][bj][m][0][1]); w.y = g8::cvt_pk_bf16(acc[ai][bj][m][0][2], acc[ai][bj][m][0][3]);
              w.z = g8::cvt_pk_bf16(acc[ai][bj][m][1][0], acc[ai][bj][m][1][1]); w.w = g8::cvt_pk_bf16(acc[ai][bj][m][1][2], acc[ai][bj][m][1][3]);
              *(uint4*)(rowp + bj * 128) = w;
            }
          }
        const int pn = u.pn;
        if (pn == 2 || pn == 5 || pn == 6) {
          const bool inc0 = (pn != 5) || (wc >= 1);
          const bool inc1 = (pn == 2) || (pn == 5) || (wc == 0);
          float* dst = p.ssq + (size_t)(u.pm * 256 + wr * 64 + fr) * 12 + (pn == 2 ? 0 : (pn == 5 ? 4 : 8)) + wc;
#pragma unroll
          for (int ai = 0; ai < 2; ++ai)
#pragma unroll
            for (int m = 0; m < 4; ++m) {
              float ss = 0.f;
#pragma unroll
              for (int n = 0; n < 2; ++n)
#pragma unroll
                for (int jj = 0; jj < 4; ++jj) {
                  const float v0 = acc[ai][0][m][n][jj], v1 = acc[ai][1][m][n][jj];
                  ss += (inc0 ? v0 * v0 : 0.f) + (inc1 ? v1 * v1 : 0.f);
                }
              ss += __shfl_xor(ss, 16);
              ss += __shfl_xor(ss, 32);
              if (fq == 0) dst[(ai * 128 + m * 16) * 12] = ss;
              asm volatile("" ::: "memory");
            }
        }
      };
      g8::Simple S; S.o.init(136, 7, nblk, bid); S.A = p.H; S.Bt = p.W + OFF_WINB; S.lda = 1024; S.K = 1024;
      g8::gemm_phase<true>(lds3, S, epi);
    }
    GSYNC();

    for (int rep = 0; rep < DUP_C2; ++rep)
    {
      const u16* Zb2 = p.R1;
      for (int r2 = 0; r2 < DUP_LRU1; ++r2) lru_run<1>(p, l, bid, nblk, smem);
      for (int r2 = 0; r2 < DUP_PROJ; ++r2) {
      {
        struct ProjSched {
          g8::Order o; const u16* Zb2; const u16* Wq; const u16* Wkv;
          __device__ bool next(int i, g8::Unit& u) const {
            int pm, pn; if (!o.tile(i, pm, pn)) return false;
            u.pm = pm; u.lda = 1792;
            if (pn < 3) { u.pn = pn; u.aux = 0; u.K = 384; u.A = (const char*)(Zb2 + (size_t)pm * 256 * 1792 + 1312); u.B = (const char*)(Wq + (size_t)pn * 256 * 384); }
            else { u.pn = pn - 3; u.aux = 1; u.K = 256; u.A = (const char*)(Zb2 + (size_t)pm * 256 * 1792 + 512); u.B = (const char*)(Wkv + (size_t)(pn - 3) * 256 * 256); }
            return true;
          }
        };
        ProjSched S; S.o.init(136, 7, nblk, bid); S.Zb2 = Zb2; S.Wq = p.W + OFF_WQUP; S.Wkv = p.W + OFF_WKVUP;
        auto epi = [=](const f32x4(&acc)[2][2][4][2], const g8::Unit& u, int wr, int wc, int fr, int fq, int) {
          const int row0 = u.pm * 256, b = row0 / ST, tb = row0 - b * ST;
          const int kv = u.aux;
          const float* sq = p.ssq + (size_t)row0 * 12;
          const float invn = kv ? (1.f / 256.f) : (1.f / 384.f);
#pragma unroll
          for (int ai = 0; ai < 2; ++ai)
#pragma unroll
            for (int m = 0; m < 4; ++m) {
              const int rl = ai * 128 + wr * 64 + m * 16 + fr;
              const float4 p0 = *(const float4*)(sq + rl * 12), p1 = *(const float4*)(sq + rl * 12 + 4), p2 = *(const float4*)(sq + rl * 12 + 8);
              const float ssum = kv ? ((p0.x + p0.y) + (p0.z + p0.w)) : (((p1.x + p1.y) + (p1.z + p1.w)) + ((p2.x + p2.y) + (p2.z + p2.w)));
              const float inv = rsqrtf(ssum * invn + EPS);
              const int t = tb + rl;
#pragma unroll
              for (int bj = 0; bj < 2; ++bj) {
                const int c8 = u.pn * 256 + bj * 128 + wc * 32 + 8 * fq;
                float v[8];
#pragma unroll
                for (int n = 0; n < 2; ++n)
#pragma unroll
                  for (int jj = 0; jj < 4; ++jj) v[n * 4 + jj] = acc[ai][bj][m][n][jj] * inv;
                if (!kv) {
                  const int head = c8 / 96, d = c8 - head * 96;
                  *(uint4*)(p.Q + ((size_t)(b * 8 + head) * ST + t) * 96 + d) = pack8(v);
                } else {
                  const int head = c8 >> 7, w = c8 & 127;
                  if (wc < 2) {
                    *(uint4*)(p.K + ((size_t)(b * 8 + head) * ST + t) * 96 + w) = pack8(v);
                  } else {
                    u16* vp = p.Vt + ((size_t)(b * 8 + head) * 64 + (w - 64)) * ST + t;
#pragma unroll
                    for (int e = 0; e < 8; ++e) vp[(size_t)e * ST] = f2bf(v[e]);
                  }
                }
              }
              asm volatile("" ::: "memory");
            }
        };
        g8::gemm_phase<true>(lds3, S, epi);
      }
      {
        const int off = 2176;
        int first = bid;
        if (first < off) { int kk = (off - first + nblk - 1) / nblk; first += kk * nblk; }
        for (int it = first; it < off + 136; it += nblk) krope_item(p, it - off);
      }
      }
    }
    GSYNC();

    for (int rep = 0; rep < DUP_ATTN; ++rep)
    {
      int it = bid;
      for (; it < 1088; it += nblk) attn_item(p, it, smem);
      for (int r2 = 0; r2 < DUP_LRU3; ++r2) lru_run<3>(p, l, it - 1088, nblk, smem);
    }
    GSYNC();

    {
      u16* Mg = p.R1;
      const int ntile = 272 * 8;
      int te = threadIdx.x; asm volatile("" : "+v"(te));
      const int lane_e = te & 63, wid_e = te >> 6;
      const int wr = wid_e >> 1, wc = wid_e & 1, fr = lane_e & 15, fq = lane_e >> 4;
      int estr = nblk; asm volatile("" : "+s"(estr));
      const int skipctx = (l == 3);
      int id = bid;
      while (id < ntile && skipctx && (((id >> 6) * 8 + (id & 7)) % 34) >= 32) id += estr;
      bool primed = false;
      while (id < ntile) {
        const int rt = (id >> 6) * 8 + (id & 7), ct = (id & 63) >> 3;
        int nid = id + estr;
        while (nid < ntile && skipctx && (((nid >> 6) * 8 + (nid & 7)) % 34) >= 32) nid += estr;
        const bool more_tiles = nid < ntile;
        const int nrt = (nid >> 6) * 8 + (nid & 7), nct = (nid & 63) >> 3;
        f32x4 mg[2][4];
#pragma unroll
        for (int m = 0; m < 2; ++m)
#pragma unroll
          for (int n = 0; n < 4; ++n) mg[m][n] = (f32x4){0.f, 0.f, 0.f, 0.f};
        for (int nb = 0; nb < 4; ++nb) {
          f32x4 ag[2][4], ay[2][4];
#pragma unroll
          for (int m = 0; m < 2; ++m)
#pragma unroll
            for (int n = 0; n < 4; ++n) { ag[m][n] = (f32x4){0.f, 0.f, 0.f, 0.f}; ay[m][n] = (f32x4){0.f, 0.f, 0.f, 0.f}; }
          const u16* gA = p.H + (size_t)rt * 128 * 1024;
          const u16* gB = p.W + OFF_WGATE + (size_t)(nb * 1024 + ct * 128) * 1024;
          const u16* bA = p.Ycat + (size_t)rt * 128 * 2048 + nb * 512;
          const u16* bB = p.W + OFF_WBR + (size_t)(nb * 1024 + ct * 128) * 512;
          const bool last_nb = (nb == 3);
          const u16* xA = last_nb ? p.H + (size_t)nrt * 128 * 1024 : gA;
          const u16* xB = last_nb ? p.W + OFF_WGATE + (size_t)(nct * 128) * 1024 : p.W + OFF_WGATE + (size_t)((nb + 1) * 1024 + ct * 128) * 1024;
          gemm_main128(gA, 1024, gB, 1024, 1024, bA, 2048, bB, 512, true, primed, lds3, ag);
          gemm_main128(bA, 2048, bB, 512, 512, xA, 1024, xB, 1024, !last_nb || more_tiles, true, lds3, ay);
          primed = true;
#pragma unroll
          for (int m = 0; m < 2; ++m)
#pragma unroll
            for (int n = 0; n < 4; ++n)
#pragma unroll
              for (int jj = 0; jj < 4; ++jj) mg[m][n][jj] += sigmoidf_(ag[m][n][jj]) * ay[m][n][jj];
        }
#pragma unroll
        for (int m = 0; m < 2; ++m) {
          u16* dst = Mg + (size_t)(rt * 128 + wr * 32 + m * 16 + fq * 4) * 1024 + ct * 128 + wc * 64 + fr;
#pragma unroll
          for (int n = 0; n < 4; ++n)
#pragma unroll
            for (int jj = 0; jj < 4; ++jj) dst[jj * 1024 + n * 16] = f2bf(mg[m][n][jj]);
          asm volatile("" ::: "memory");
        }
        id = nid;
      }
    }
    GSYNC();

    {
      auto epi = [=](const f32x4(&acc)[2][2][4][2], const g8::Unit& u, int wr, int wc, int fr, int fq, int) {
        float* xb = xrow_ptr(p, u.pm * 256);
        const float* gate = p.mod + ((size_t)l * 9 + mod_idx(u.pm * 256)) * 6144 + 2048 + u.pn * 256 + wc * 32 + 4 * fq;
        f32x4 gv[2][2];
#pragma unroll
        for (int bj = 0; bj < 2; ++bj)
#pragma unroll
          for (int n = 0; n < 2; ++n) gv[bj][n] = *(const f32x4*)(gate + bj * 128 + n * 16);
#pragma unroll
        for (int ai = 0; ai < 2; ++ai)
#pragma unroll
          for (int m = 0; m < 4; ++m) {
            float* rowp = xb + (size_t)(ai * 128 + wr * 64 + m * 16 + fr) * DM + u.pn * 256 + wc * 32 + 4 * fq;
#pragma unroll
            for (int bj = 0; bj < 2; ++bj)
#pragma unroll
              for (int n = 0; n < 2; ++n) {
                f32x4 xv = *(const f32x4*)(rowp + bj * 128 + n * 16);
                xv += gv[bj][n] * acc[ai][bj][m][n];
                *(f32x4*)(rowp + bj * 128 + n * 16) = xv;
              }
          }
      };
      g8::Simple S; S.o.init(l == 3 ? 128 : 136, 4, nblk, bid); S.A = p.R1; S.Bt = p.W + OFF_WOUT; S.lda = 1024; S.K = 1024;
      g8::gemm_phase<false>(lds3, S, epi);
    }
    GSYNC();

    norm_mod(p, l, p.norm2_g + l * 1024, 3072, 4096, false);
    GSYNC();

    {
      u16* U = p.R1;
      auto epi = [=](const f32x4(&acc)[2][2][4][2], const g8::Unit& u, int wr, int wc, int fr, int fq, int) {
#pragma unroll
        for (int ai = 0; ai < 2; ++ai)
#pragma unroll
          for (int m = 0; m < 4; ++m) {
            u16* rowp = U + (size_t)(u.pm * 256 + ai * 128 + wr * 64 + m * 16 + fr) * 2816 + u.pn * 128 + wc * 32 + 8 * fq;
            float v[8];
#pragma unroll
            for (int n = 0; n < 2; ++n)
#pragma unroll
              for (int jj = 0; jj < 4; ++jj) v[n * 4 + jj] = siluf_(acc[ai][0][m][n][jj]) * acc[ai][1][m][n][jj];
            uint4 w;
            w.x = g8::cvt_pk_bf16(v[0], v[1]); w.y = g8::cvt_pk_bf16(v[2], v[3]); w.z = g8::cvt_pk_bf16(v[4], v[5]); w.w = g8::cvt_pk_bf16(v[6], v[7]);
            *(uint4*)rowp = w;
          }
      };
      g8::Simple S; S.o.init(l == 3 ? 128 : 136, 22, nblk, bid); S.A = p.H; S.Bt = p.W + OFF_WFF13; S.lda = 1024; S.K = 1024;
      g8::gemm_phase<true>(lds3, S, epi);
    }
    GSYNC();

    {
      auto epi = [=](const f32x4(&acc)[2][2][4][2], const g8::Unit& u, int wr, int wc, int fr, int fq, int) {
        float* xb = xrow_ptr(p, u.pm * 256);
        const float* gate = p.mod + ((size_t)l * 9 + mod_idx(u.pm * 256)) * 6144 + 5120 + u.pn * 256 + wc * 32 + 4 * fq;
        f32x4 gv[2][2];
#pragma unroll
        for (int bj = 0; bj < 2; ++bj)
#pragma unroll
          for (int n = 0; n < 2; ++n) gv[bj][n] = *(const f32x4*)(gate + bj * 128 + n * 16);
#pragma unroll
        for (int ai = 0; ai < 2; ++ai)
#pragma unroll
          for (int m = 0; m < 4; ++m) {
            float* rowp = xb + (size_t)(ai * 128 + wr * 64 + m * 16 + fr) * DM + u.pn * 256 + wc * 32 + 4 * fq;
#pragma unroll
            for (int bj = 0; bj < 2; ++bj)
#pragma unroll
              for (int n = 0; n < 2; ++n) {
                f32x4 xv = *(const f32x4*)(rowp + bj * 128 + n * 16);
                xv += gv[bj][n] * acc[ai][bj][m][n];
                *(f32x4*)(rowp + bj * 128 + n * 16) = xv;
              }
          }
      };
      g8::Simple S; S.o.init(l == 3 ? 128 : 136, 4, nblk, bid); S.A = p.R1; S.Bt = p.W + OFF_WFF2; S.lda = 2816; S.K = 2816;
      g8::gemm_phase<false>(lds3, S, epi);
      if (l < 3 && nblk > 32 && bid >= 32) convert_weights(p, l + 1, (float*)smem, 0, 12, true, bid - 32, nblk - 32, false);
    }
    GSYNC();

  }

  const int lane = threadIdx.x & 63, wid = threadIdx.x >> 6;
  for (int r = bid * 8 + wid; r < NB * SL; r += nblk * 8) {
    float* xr = p.out + (size_t)r * DM;
    float4 v[4];
    float ss = 0.f;
#pragma unroll
    for (int i = 0; i < 4; ++i) {
      v[i] = *(const float4*)(xr + i * 256 + lane * 4);
      ss += v[i].x * v[i].x + v[i].y * v[i].y + v[i].z * v[i].z + v[i].w * v[i].w;
    }
    ss = wave_sum(ss);
    const float inv = rsqrtf(ss * (1.f / 1024.f) + EPS);
#pragma unroll
    for (int i = 0; i < 4; ++i) {
      float4 gg = *(const float4*)(p.final_g + i * 256 + lane * 4);
      float4 ov;
      ov.x = v[i].x * inv * gg.x; ov.y = v[i].y * inv * gg.y; ov.z = v[i].z * inv * gg.z; ov.w = v[i].w * inv * gg.w;
      *(float4*)(xr + i * 256 + lane * 4) = ov;
    }
  }
}

extern "C" void kernel_launch(void* const* d_in, const int* in_sizes, int n_in, void* d_out, int out_size, void* d_ws,
                              size_t ws_size, hipStream_t stream) {
  static int grid_blocks = 0;
  if (!grid_blocks) {
    int dev = 0, cus = 0, per_cu = 0;
    hipGetDevice(&dev);
    hipDeviceGetAttribute(&cus, hipDeviceAttributeMultiprocessorCount, dev);
    hipFuncSetAttribute((const void*)mega, hipFuncAttributeMaxDynamicSharedMemorySize, LDS_BYTES);
    hipOccupancyMaxActiveBlocksPerMultiprocessor(&per_cu, (const void*)mega, NTHR, LDS_BYTES);
    if (per_cu < 1) per_cu = 1;
    if (per_cu > 1) per_cu = 1;
    grid_blocks = cus * per_cu;
    (void)hipGetLastError();
  }
  P p{};
  const float** pf = (const float**)&p;
  for (int i = 0; i < 31; ++i) pf[i] = (const float*)d_in[i];
  p.out = (float*)d_out;
  size_t off = 0;
  auto take = [&](size_t bytes) { void* r = (char*)d_ws + off; off += (bytes + 255) & ~(size_t)255; return r; };
  p.Xc = (float*)take((size_t)NB * SC * DM * 4);
  p.mod = (float*)take((size_t)4 * 9 * 6144 * 4);
  p.rope = (float*)take((size_t)SL * 32 * 4);
  p.summ = (float2*)take((size_t)NB * 2 * 512 * 34 * 8);
  p.ssq = (float*)take((size_t)12 * MTOT * 4);
  p.bar = (unsigned*)take((size_t)XCD_BAR_WORDS * 4);
  p.W = (u16*)take((size_t)W_ELEMS * 2);
  p.H = (u16*)take((size_t)MTOT * 1024 * 2);
  p.Ycat = (u16*)take((size_t)MTOT * 2048 * 2);
  p.R1 = (u16*)take((size_t)MTOT * 2560 * 2);
  p.K = (u16*)take((size_t)MTOT * 768 * 2);
  p.Vt = (u16*)take((size_t)MTOT * 512 * 2);
  p.Q = p.R1 + (size_t)MTOT * 1792;
  if (off > ws_size) { fprintf(stderr, "workspace too small: need %zu have %zu\n", off, ws_size); return; }
  (void)hipMemsetAsync(p.bar, 0, (size_t)XCD_BAR_WORDS * 4, stream);
  void* args[] = {&p};
  hipError_t e = hipLaunchCooperativeKernel((const void*)mega, dim3(grid_blocks), dim3(NTHR), args, LDS_BYTES, stream);
  if (e != hipSuccess) fprintf(stderr, "cooperative launch failed: %s (grid %d)\n", hipGetErrorString(e), grid_blocks);
}
```
